# Optimizing an MI355X kernel written in HIP

```python
import jax, jax.numpy as jnp
from jax import lax
import numpy as np

D_MODEL = 1024
BATCH = 16
SEQ = 2048
DEPTH = 1

GRID_W = 64
CTX_LEN = 256
HG_HEADS = 4
HG_DK = 128
HG_DV = 128
HG_KEY = HG_HEADS * HG_DK
HG_VAL = HG_HEADS * HG_DV
HG_CHUNK = 64
ATT_HEADS = 8
ATT_KV_HEADS = 2
ATT_HEAD_DIM = 64
ATT_GROUPS = ATT_HEADS // ATT_KV_HEADS
ATT_Q = ATT_HEADS * ATT_HEAD_DIM
ATT_KV = ATT_KV_HEADS * ATT_HEAD_DIM
Q_BLOCK = 128
ROPE_AXIS_DIM = ATT_HEAD_DIM // 2
ROPE_THETA = 10000.0
N_EXPERTS = 16
EC_CAPACITY_FACTOR = 2
EXPERT_FF = 1024
IN_SPLITS = (HG_KEY, HG_KEY, HG_KEY, HG_VAL, HG_VAL, ATT_Q, ATT_KV, ATT_KV, D_MODEL, D_MODEL)
IN_COLS = 3 * HG_KEY + 2 * HG_VAL + ATT_Q + 2 * ATT_KV + 2 * D_MODEL
N_MOD = 6
NORM_EPS = 1e-6

kernel_name = "hybrid_hgrn2_gqa_ec_moe_diffusion_layer"


def rms_norm(x, g):
    xf = x.astype(jnp.float32)
    y = xf * lax.rsqrt(jnp.mean(xf * xf, axis=-1, keepdims=True) + NORM_EPS)
    return (y * g.astype(jnp.float32)).astype(x.dtype)


def modulate(h, shift, scale):
    return h * (1 + scale) + shift


def adaln_params(cond, w_mod, b_mod):
    m = jax.nn.silu(cond) @ w_mod + b_mod
    return jnp.split(m[..., None, :], N_MOD, axis=-1)


def axial_rope_tables(length):
    rows = length // GRID_W
    row = jnp.repeat(jnp.arange(rows, dtype=jnp.float32), GRID_W)
    col = jnp.tile(jnp.arange(GRID_W, dtype=jnp.float32), rows)
    inv_freq = ROPE_THETA ** (-jnp.arange(0, ROPE_AXIS_DIM, 2, dtype=jnp.float32) / ROPE_AXIS_DIM)
    ang = jnp.concatenate([row[:, None] * inv_freq, col[:, None] * inv_freq], axis=-1)
    return jnp.cos(ang), jnp.sin(ang)


def apply_axial_rope(x, cos, sin):
    b_, length, h_, d = x.shape
    half = ROPE_AXIS_DIM // 2
    xs = x.astype(jnp.float32).reshape(b_, length, h_, 2, ROPE_AXIS_DIM)
    x1, x2 = xs[..., :half], xs[..., half:]
    c = cos.reshape(length, 1, 2, half)
    s = sin.reshape(length, 1, 2, half)
    out = jnp.concatenate([x1 * c - x2 * s, x2 * c + x1 * s], axis=-1)
    return out.reshape(b_, length, h_, d).astype(x.dtype)


def heads(a, n):
    return a.reshape(a.shape[0], a.shape[1], n, -1)


def hgrn_gates(f_pre, lb):
    f_pre = heads(f_pre.astype(jnp.float32), HG_HEADS)
    lb = lb.reshape(HG_HEADS, HG_DK)
    log_f = jnp.log(lb + (1 - lb) * jax.nn.sigmoid(f_pre))
    key = (1 - lb) * jax.nn.sigmoid(-f_pre)
    return key, log_f


def hgrn_chunk_scan(q, k, v, log_f, s0):
    b_, length, h_, _ = q.shape
    dv = v.shape[-1]
    n_chunks = length // HG_CHUNK

    def chunks(a):
        return a.astype(jnp.float32).reshape(b_, n_chunks, HG_CHUNK, h_, a.shape[-1]).transpose(1, 0, 3, 2, 4)

    incl = jnp.tril(jnp.ones((HG_CHUNK, HG_CHUNK), dtype=bool))[:, :, None]

    def step(state, inp):
        qc, kc, vc, fc = inp
        cum = jnp.cumsum(fc, axis=2)
        rel = jnp.where(incl, cum[:, :, :, None, :] - cum[:, :, None, :, :], -jnp.inf)
        scores = jnp.einsum("bhtk,bhsk,bhtsk->bhts", qc, kc, jnp.exp(rel))
        o = (jnp.einsum("bhts,bhsv->bhtv", scores, vc)
             + jnp.einsum("bhtk,bhkv->bhtv", qc * jnp.exp(cum), state))
        last = cum[:, :, -1:, :]
        new_state = (jnp.exp(last[:, :, 0, :, None]) * state
                     + jnp.einsum("bhsk,bhsv->bhkv", kc * jnp.exp(last - cum), vc))
        return new_state, o

    s_fin, o = lax.scan(step, s0.astype(jnp.float32), tuple(chunks(a) for a in (q, k, v, log_f)))
    o = o.transpose(1, 0, 3, 2, 4).reshape(b_, length, h_, dv)
    return o.astype(v.dtype), s_fin


def hgrn_bidir(q, i, k_f, lf_f, k_b, lf_b, s_f0, s_b0):
    o_f, s_f = hgrn_chunk_scan(q, k_f, i, lf_f, s_f0)
    flip = lambda a: a[:, ::-1]
    o_b, s_b = hgrn_chunk_scan(flip(q), flip(k_b), flip(i), flip(lf_b), s_b0)
    return o_f + flip(o_b), s_f, s_b


def attend_blocks(q, k, v):
    b_, lq = q.shape[:2]
    nb = lq // Q_BLOCK
    qb = q.reshape(b_, nb, Q_BLOCK, ATT_KV_HEADS, ATT_GROUPS, ATT_HEAD_DIM).transpose(1, 0, 2, 3, 4, 5)
    scale = ATT_HEAD_DIM ** -0.5

    def one_block(qi):
        s = jnp.einsum("bqhgd,bkhd->bhgqk", qi, k, preferred_element_type=jnp.float32) * scale
        p = jax.nn.softmax(s, axis=-1)
        return jnp.einsum("bhgqk,bkhd->bqhgd", p.astype(v.dtype), v)

    o = lax.map(one_block, qb)
    return o.transpose(1, 0, 2, 3, 4, 5).reshape(b_, lq, ATT_Q)


def token_mix(hx, hc, w_in, lb_f, lb_b, hg_norm_g, q_norm_g, k_norm_g,
              w_branch_a, w_branch_b, w_out, cos, sin, ctx_out):
    split_at = np.cumsum(IN_SPLITS)[:-1].tolist()

    def project(h):
        return jnp.split(h @ w_in, split_at, axis=-1)

    def qk_norm(aq, ak):
        return rms_norm(heads(aq, ATT_HEADS), q_norm_g), rms_norm(heads(ak, ATT_KV_HEADS), k_norm_g)

    def merge(o_hg, g_hg, o_att, ga, gb):
        b_, length = g_hg.shape[:2]
        a = (rms_norm(o_hg, hg_norm_g.reshape(HG_HEADS, HG_DV)).reshape(b_, length, HG_VAL)
             * jax.nn.silu(g_hg)) @ w_branch_a
        bb = o_att @ w_branch_b
        return (jax.nn.sigmoid(ga) * a + jax.nn.sigmoid(gb) * bb) @ w_out

    cq, cff, cfb, ci, cg, caq, cak, cav, cga, cgb = project(hc)
    ckf, clf = hgrn_gates(cff, lb_f)
    ckb, clb = hgrn_gates(cfb, lb_b)
    zeros = jnp.zeros((hc.shape[0], HG_HEADS, HG_DK, HG_DV), jnp.float32)
    co, cs_f, cs_b = hgrn_bidir(heads(cq, HG_HEADS), heads(ci, HG_HEADS), ckf, clf, ckb, clb, zeros, zeros)
    cqa, cka = qk_norm(caq, cak)
    cva = heads(cav, ATT_KV_HEADS)

    xq, xff, xfb, xi, xg, xaq, xak, xav, xga, xgb = project(hx)
    xkf, xlf = hgrn_gates(xff, lb_f)
    xkb, xlb = hgrn_gates(xfb, lb_b)
    xo, _, _ = hgrn_bidir(heads(xq, HG_HEADS), heads(xi, HG_HEADS), xkf, xlf, xkb, xlb, cs_f, cs_b)
    xqa, xka = qk_norm(xaq, xak)
    xqa = apply_axial_rope(xqa, cos, sin)
    xka = apply_axial_rope(xka, cos, sin)
    keys = jnp.concatenate([cka, xka], axis=1)
    vals = jnp.concatenate([cva, heads(xav, ATT_KV_HEADS)], axis=1)
    y_x = merge(xo, xg, attend_blocks(xqa, keys, vals), xga, xgb)
    if not ctx_out:
        return y_x, None
    y_c = merge(co, cg, attend_blocks(cqa, cka, cva), cga, cgb)
    return y_x, y_c


def expert_choice_moe(h, w_router, w_gate, w_up, w_down):
    b_, length, _ = h.shape
    cap = EC_CAPACITY_FACTOR * length // N_EXPERTS
    aff = jax.nn.softmax((h @ w_router).astype(jnp.float32), axis=-1)
    gate, idx = lax.top_k(jnp.swapaxes(aff, 1, 2), cap)
    bidx = jnp.arange(b_)[:, None, None]
    xe = h[bidx, idx]
    hid = jax.nn.silu(jnp.einsum("becd,edf->becf", xe, w_gate)) * jnp.einsum("becd,edf->becf", xe, w_up)
    ye = jnp.einsum("becf,efd->becd", hid, w_down) * gate[..., None].astype(h.dtype)
    return jnp.zeros_like(h).at[bidx, idx].add(ye)


def setup_inputs(seed: int = 0) -> dict:
    key = jax.random.key(seed)
    ks = jax.random.split(key, 24)
    n = jax.random.normal
    f32 = jnp.float32
    d = D_MODEL
    return {
        "x": n(ks[0], (BATCH, SEQ, d), f32),
        "c": n(ks[1], (BATCH, d), f32),
        "ctx": n(ks[2], (BATCH, CTX_LEN, d), f32),
        "c_ctx": n(ks[3], (d,), f32),
        "w_mod": n(ks[4], (DEPTH, d, N_MOD * d), f32) * (0.5 * d ** -0.5),
        "b_mod": n(ks[5], (DEPTH, N_MOD * d), f32) * 0.02,
        "norm1_g": 1.0 + 0.1 * n(ks[6], (DEPTH, d), f32),
        "norm2_g": 1.0 + 0.1 * n(ks[7], (DEPTH, d), f32),
        "w_in": n(ks[8], (DEPTH, d, IN_COLS), f32) * d ** -0.5,
        "hg_lb_logits": 0.5 * n(ks[9], (2, DEPTH + 1, HG_KEY), f32),
        "hg_norm_g": 1.0 + 0.1 * n(ks[10], (DEPTH, HG_VAL), f32),
        "q_norm_g": 1.0 + 0.1 * n(ks[11], (DEPTH, ATT_HEAD_DIM), f32),
        "k_norm_g": 1.0 + 0.1 * n(ks[12], (DEPTH, ATT_HEAD_DIM), f32),
        "w_branch_a": n(ks[13], (DEPTH, HG_VAL, d), f32) * HG_VAL ** -0.5,
        "w_branch_b": n(ks[14], (DEPTH, ATT_Q, d), f32) * ATT_Q ** -0.5,
        "w_out": n(ks[15], (DEPTH, d, d), f32) * d ** -0.5,
        "w_router": n(ks[16], (DEPTH, d, N_EXPERTS), f32) * d ** -0.5,
        "w_exp_gate": n(ks[17], (DEPTH, N_EXPERTS, d, EXPERT_FF), f32) * d ** -0.5,
        "w_exp_up": n(ks[18], (DEPTH, N_EXPERTS, d, EXPERT_FF), f32) * d ** -0.5,
        "w_exp_down": n(ks[19], (DEPTH, N_EXPERTS, EXPERT_FF, d), f32) * EXPERT_FF ** -0.5,
        "final_norm_g": 1.0 + 0.1 * n(ks[20], (d,), f32),
    }


def reference(x, c, ctx, c_ctx, w_mod, b_mod, norm1_g, norm2_g, w_in, hg_lb_logits, hg_norm_g,
              q_norm_g, k_norm_g, w_branch_a, w_branch_b, w_out, w_router, w_exp_gate, w_exp_up,
              w_exp_down, final_norm_g):
    cos, sin = axial_rope_tables(x.shape[1])
    lb_all = jnp.cumsum(jax.nn.softmax(hg_lb_logits.astype(jnp.float32), axis=1), axis=1)
    for l in range(DEPTH):
        last = l == DEPTH - 1
        sh1, sc1, g1, sh2, sc2, g2 = adaln_params(c, w_mod[l], b_mod[l])
        csh1, csc1, cg1, csh2, csc2, cg2 = adaln_params(c_ctx, w_mod[l], b_mod[l])
        hx = modulate(rms_norm(x, norm1_g[l]), sh1, sc1)
        hc = modulate(rms_norm(ctx, norm1_g[l]), csh1, csc1)
        y_x, y_c = token_mix(hx, hc, w_in[l], lb_all[0, l], lb_all[1, l], hg_norm_g[l], q_norm_g[l],
                             k_norm_g[l], w_branch_a[l], w_branch_b[l], w_out[l], cos, sin, not last)
        x = x + g1 * y_x
        x = x + g2 * expert_choice_moe(modulate(rms_norm(x, norm2_g[l]), sh2, sc2),
                                       w_router[l], w_exp_gate[l], w_exp_up[l], w_exp_down[l])
        if not last:
            ctx = ctx + cg1 * y_c
            ctx = ctx + cg2 * expert_choice_moe(modulate(rms_norm(ctx, norm2_g[l]), csh2, csc2),
                                                w_router[l], w_exp_gate[l], w_exp_up[l], w_exp_down[l])
    return rms_norm(x, final_norm_g)
```

```cpp
#include <hip/hip_runtime.h>
#include <hip/hip_bf16.h>
#include <hip/hip_cooperative_groups.h>
#include <cstdio>
#include <cstdint>
#include <cmath>
namespace cg = cooperative_groups;

constexpr int NB = 16, SEQ = 2048, CTXL = 256, DM_ = 1024, RPB = SEQ + CTXL  ;
constexpr int MR = NB * RPB  , ML = NB * SEQ  , INC = 5376, NMOD = 6 * DM_;
constexpr int NE = 16, CAP = 256, EFF = 1024;
constexpr float EPS = 1e-6f;
constexpr float LOG2E = 1.4426950408889634f;
#ifndef DEBUG_POISON
#define DEBUG_POISON 0
#endif
#ifndef DBG_NOMOE
#define DBG_NOMOE 0
#endif
#ifndef DBG_NOATT
#define DBG_NOATT 0
#endif
#ifndef DBG_NOHG
#define DBG_NOHG 0
#endif
#ifndef DBG_OUT_X
#define DBG_OUT_X 0
#endif
#ifndef DBG_X1_NOY
#define DBG_X1_NOY 0
#endif
#ifndef DBG_P4B_A
#define DBG_P4B_A 0
#endif
#ifndef PHASES
#define PHASES 511
#endif
#ifndef DBG_GA_ONLY
#define DBG_GA_ONLY 0
#endif
#ifndef DBG_DOUBLE_BAR
#define DBG_DOUBLE_BAR 0
#endif
#ifndef DBG_WBL2_TWICE
#define DBG_WBL2_TWICE 0
#endif
#ifndef DBG_LEADER_DELAY
#define DBG_LEADER_DELAY 0
#endif
#ifndef DBG_RELEASE_ALL
#define DBG_RELEASE_ALL 0
#endif
#ifndef PG8_DMA_AUX
#define PG8_DMA_AUX 0
#endif
#ifndef DBG_CHECKS
#define DBG_CHECKS 0
#endif
#ifndef DBG_SYSINV
#define DBG_SYSINV 0
#endif
#ifndef DBG_HG_B
#define DBG_HG_B 15
#endif
#ifndef DBG_ALPHA
#define DBG_ALPHA 1.0f
#endif
#ifndef DBG_ONLYATT
#define DBG_ONLYATT 0
#endif
#ifndef DBG_BETA
#define DBG_BETA 1.0f
#endif
#ifndef DBG_POISON_SET
#define DBG_POISON_SET 0
#endif
#ifndef PG8_USE_DMA
#define PG8_USE_DMA 0
#endif
#ifndef DBG_BARTEST
#define DBG_BARTEST 0
#endif
#ifndef DBG_OUT_BUF
#define DBG_OUT_BUF 0
#endif
namespace pg8 {
#define PG8_LAS __attribute__((address_space(3)))
typedef unsigned short bf16_t;
typedef short bf16x8 __attribute__((ext_vector_type(8)));
typedef float f32x4 __attribute__((ext_vector_type(4)));
typedef unsigned u32x4 __attribute__((ext_vector_type(4)));
constexpr int BM = 256, BK = 64, HALF = 128, HTB = HALF * BK * 2  , STAGE_BYTES = 8 * HTB, NXCD = 8, WGM = 8;

__host__ __device__ __forceinline__ int lds_byte(int r, int c) { const int st = (r >> 4) * 2 + (c >> 5), rr = r & 15, cc = c & 31, ob = rr * 64 + cc * 2; return st * 1024 + (ob ^ (((ob >> 9) & 1) << 5)); }
__host__ __device__ __forceinline__ void stage_rc(int b, int& R, int& C) { const int st = b / 1024, sb = b % 1024, swz = sb ^ (((sb >> 9) & 1) << 5); R = (st >> 1) * 16 + swz / 64; C = (st & 1) * 32 + (swz % 64) / 2; }
__host__ __device__ __forceinline__ int perm32(int rho) { const int n = rho >> 4, i = rho & 15; return 8 * (i >> 2) + 4 * n + (i & 3); }

struct Unit { int pm, pn; };
struct Gemm { const bf16_t* A; const bf16_t* Bt; int M, N, K; const int* gather; };

struct StaticOrder {
    int nM, nN, nwg, G, c;
    __host__ __device__ void init(int M, int N, int G_, int c_) { nM = M / BM; nN = N / BM; nwg = nM * nN; G = G_; c = c_; }
    __host__ __device__ bool next(int i, Unit& u) const {
        const long L = (long)i * G + c; if (L >= nwg) return false;
        int wgid = (int)L; { const int q = nwg / NXCD, r = nwg % NXCD, xcd = wgid % NXCD, off = wgid / NXCD; wgid = (xcd < r ? xcd * (q + 1) : r * (q + 1) + (xcd - r) * q) + off; }
        const int nig = WGM * nN, gid = wgid / nig, fm = gid * WGM, gsz = (nM - fm) < WGM ? (nM - fm) : WGM;
        u.pm = fm + ((wgid % nig) % gsz); u.pn = (wgid % nig) / gsz; return true;
    }
    __device__ __forceinline__ void a_ready(const Unit&) const {}
    __device__ __forceinline__ void done(const Unit&) const {}
};

typedef float f32x2_c __attribute__((ext_vector_type(2))); typedef __bf16 bf16x2_c __attribute__((ext_vector_type(2)));
__device__ __forceinline__ unsigned cvt_pk_bf16(float lo, float hi) { const f32x2_c v = {lo, hi}; return __builtin_bit_cast(unsigned, __builtin_convertvector(v, bf16x2_c)); }
__device__ __forceinline__ float bf_lo(unsigned u) { return __uint_as_float(u << 16); }
__device__ __forceinline__ float bf_hi(unsigned u) { return __uint_as_float(u & 0xffff0000u); }
__device__ __forceinline__ void st8(bf16_t* p, const f32x4 a, const f32x4 b) { u32x4 w; w.x = cvt_pk_bf16(a[0], a[1]); w.y = cvt_pk_bf16(a[2], a[3]); w.z = cvt_pk_bf16(b[0], b[1]); w.w = cvt_pk_bf16(b[2], b[3]); *(u32x4*)p = w; }
__device__ __forceinline__ void ld8(const bf16_t* p, f32x4& a, f32x4& b) { const u32x4 w = *(const u32x4*)p; a = (f32x4){bf_lo(w.x), bf_hi(w.x), bf_lo(w.y), bf_hi(w.y)}; b = (f32x4){bf_lo(w.z), bf_hi(w.z), bf_lo(w.w), bf_hi(w.w)}; }
__device__ __forceinline__ float fsigmoid(float x) { return __builtin_amdgcn_rcpf(1.0f + __builtin_amdgcn_exp2f(-1.4426950408889634f * x)); }
__device__ __forceinline__ f32x4 sig4(const f32x4 v) { return (f32x4){fsigmoid(v[0]), fsigmoid(v[1]), fsigmoid(v[2]), fsigmoid(v[3])}; }
__device__ __forceinline__ f32x4 silu4(const f32x4 v) { return v * sig4(v); }

struct EpiInProj {
    static constexpr bool PERM = true, AFTER_DRAIN = false;
    bf16_t *HQ, *FF, *FB, *HI, *SG, *Q, *K, *V, *GA, *GB;
    const float* rope;
    const float *qg, *kg;
    template <int ACT> __device__ __forceinline__ void plain(const f32x4 (&acc)[2][2][4][2], bf16_t* base, long row0, int pitch, int col0) const {
#pragma unroll
        for (int ai = 0; ai < 2; ++ai)
#pragma unroll
            for (int m = 0; m < 4; ++m) { bf16_t* rowp = base + (row0 + ai * HALF + m * 16) * pitch + col0;
#pragma unroll
                for (int bj = 0; bj < 2; ++bj) { f32x4 v0 = acc[ai][bj][m][0], v1 = acc[ai][bj][m][1];
                    if (ACT == 1) { v0 = silu4(v0); v1 = silu4(v1); } if (ACT == 2) { v0 = sig4(v0); v1 = sig4(v1); }
                    st8(rowp + bj * HALF, v0, v1); } }
    }
    __device__ __forceinline__ void qk(const f32x4 (&acc)[2][2][4][2], bf16_t* base, long row0, int pitch, int col0, const float* gain, bool do_rope, int t0, float oscale, int fq) const {
        f32x4 gv[2][2];
#pragma unroll
        for (int bj = 0; bj < 2; ++bj)
#pragma unroll
            for (int n = 0; n < 2; ++n) gv[bj][n] = *(const f32x4*)(gain + 32 * bj + 16 * n + 4 * fq);
#pragma unroll
        for (int ai = 0; ai < 2; ++ai)
#pragma unroll
            for (int m = 0; m < 4; ++m) {
                float ss = 0.f;
#pragma unroll
                for (int bj = 0; bj < 2; ++bj)
#pragma unroll
                    for (int n = 0; n < 2; ++n) { const f32x4 x = acc[ai][bj][m][n]; ss += (x[0] * x[0] + x[1] * x[1]) + (x[2] * x[2] + x[3] * x[3]); }
                ss += __shfl_xor(ss, 16); ss += __shfl_xor(ss, 32);
                const float rstd = 1.0f / sqrtf(ss * (1.0f / 64.0f) + 1e-6f);
                const int t = t0 + ai * HALF + m * 16;
                bf16_t* rowp = base + (row0 + ai * HALF + m * 16) * pitch + col0;
#pragma unroll
                for (int bj = 0; bj < 2; ++bj) {
                    f32x4 x1 = acc[ai][bj][m][0] * rstd * gv[bj][0], x2 = acc[ai][bj][m][1] * rstd * gv[bj][1];
                    if (do_rope) { const int pos = bj ? (t & 63) : (t >> 6);
                        const f32x4 c = *(const f32x4*)(rope + pos * 32 + 4 * fq), s = *(const f32x4*)(rope + pos * 32 + 16 + 4 * fq);
                        const f32x4 o1 = x1 * c - x2 * s, o2 = x2 * c + x1 * s; x1 = o1; x2 = o2; }
                    st8(rowp + bj * 32, x1 * oscale, x2 * oscale); }
            }
    }
    __device__ __forceinline__ void operator()(const f32x4 (&acc)[2][2][4][2], const Unit& u, int wr, int wc, int fr_, int fq_) const {
        int fr = fr_, fq = fq_; asm volatile("" : "+v"(fr), "+v"(fq));
        const int pn = u.pn, bb = u.pm / 9, jt = u.pm - bb * 9;
        const int rloc = wr * 64 + fr;
        const long r0 = (long)u.pm * BM + rloc;
        const long rl0 = (long)bb * 2048 + (jt - 1) * 256 + rloc;
        const int c8 = wc * 32 + 8 * fq;
        if (pn < 2)        plain<0>(acc, HQ, rl0, 512, pn * 256 + c8);
        else if (pn < 4)   plain<0>(acc, FF, r0, 512, (pn - 2) * 256 + c8);
        else if (pn < 6)   plain<0>(acc, FB, r0, 512, (pn - 4) * 256 + c8);
        else if (pn < 8)   plain<0>(acc, HI, r0, 512, (pn - 6) * 256 + c8);
        else if (pn < 10)  plain<1>(acc, SG, rl0, 512, (pn - 8) * 256 + c8);
        else if (pn < 12)  qk(acc, Q, rl0, 512, ((pn - 10) * 4 + wc) * 64 + 8 * fq, qg, true, (jt - 1) * 256 + rloc, 0.125f * 1.4426950408889634f, fq);
        else if (pn == 12) {
            if (wc < 2)    qk(acc, K, r0, 128, wc * 64 + 8 * fq, kg, jt >= 1, (jt - 1) * 256 + rloc, 1.0f, fq);
            else {
#pragma unroll
                for (int ai = 0; ai < 2; ++ai)
#pragma unroll
                    for (int m = 0; m < 4; ++m) { bf16_t* rowp = V + (r0 + ai * HALF + m * 16) * 128 + (wc - 2) * 64 + 8 * fq;
#pragma unroll
                        for (int bj = 0; bj < 2; ++bj) st8(rowp + bj * 32, acc[ai][bj][m][0], acc[ai][bj][m][1]); }
            }
        }
        else if (pn < 17)  plain<2>(acc, GA, rl0, 1024, (pn - 13) * 256 + c8);
        else               plain<2>(acc, GB, rl0, 1024, (pn - 17) * 256 + c8);
    }
};

template <int SECOND> struct EpiZ {
    static constexpr bool PERM = true, AFTER_DRAIN = false;
    bf16_t* Z; const bf16_t* G;
    __device__ __forceinline__ void operator()(const f32x4 (&acc)[2][2][4][2], const Unit& u, int wr, int wc, int fr, int fq) const {
        const long row0 = (long)u.pm * BM + wr * 64 + fr; const int col0 = u.pn * BM + wc * 32 + 8 * fq;
#pragma unroll
        for (int ai = 0; ai < 2; ++ai)
#pragma unroll
            for (int m = 0; m < 4; ++m) { const long off = (row0 + ai * HALF + m * 16) * 1024 + col0;
#pragma unroll
                for (int bj = 0; bj < 2; ++bj) { f32x4 g0, g1; ld8(G + off + bj * HALF, g0, g1);
                    f32x4 v0 = acc[ai][bj][m][0] * g0, v1 = acc[ai][bj][m][1] * g1;
                    if (SECOND) { f32x4 z0, z1; ld8(Z + off + bj * HALF, z0, z1); v0 += z0; v1 += z1; }
                    st8(Z + off + bj * HALF, v0, v1); } }
    }
};
struct EpiX1 {
    static constexpr bool PERM = false, AFTER_DRAIN = false;
    const float* x; const float* mod; float* out;
    __device__ __forceinline__ void operator()(const f32x4 (&acc)[2][2][4][2], const Unit& u, int wr, int wc, int fr, int fq) const {
        const long row0 = (long)u.pm * BM + wr * 64 + fr; const int col0 = u.pn * BM + wc * 32 + 4 * fq; const int b = u.pm >> 3;
        f32x4 gv[2][2];
#pragma unroll
        for (int bj = 0; bj < 2; ++bj)
#pragma unroll
            for (int n = 0; n < 2; ++n) gv[bj][n] = *(const f32x4*)(mod + (size_t)b * 6144 + 2048 + col0 + bj * HALF + n * 16);
#pragma unroll
        for (int ai = 0; ai < 2; ++ai)
#pragma unroll
            for (int m = 0; m < 4; ++m) { const long off = (row0 + ai * HALF + m * 16) * 1024 + col0;
#pragma unroll
                for (int bj = 0; bj < 2; ++bj)
#pragma unroll
                    for (int n = 0; n < 2; ++n) { const f32x4 xv = *(const f32x4*)(x + off + bj * HALF + n * 16); *(f32x4*)(out + off + bj * HALF + n * 16) = DBG_X1_NOY == 1 ? xv : DBG_X1_NOY == 2 ? xv + 0.3f * acc[ai][bj][m][n] : DBG_X1_NOY == 3 ? xv + gv[bj][n] : xv + (DBG_ALPHA * gv[bj][n]) * acc[ai][bj][m][n]; } }
    }
};
struct EpiHid {
    static constexpr bool PERM = true, AFTER_DRAIN = false;
    bf16_t* H;
    __device__ __forceinline__ void operator()(const f32x4 (&acc)[2][2][4][2], const Unit& u, int wr, int wc, int fr, int fq) const {
        const int row0 = wr * 64 + fr, col0 = u.pn * HALF + wc * 32 + 8 * fq;
#pragma unroll
        for (int ai = 0; ai < 2; ++ai)
#pragma unroll
            for (int m = 0; m < 4; ++m) st8(H + (size_t)(row0 + ai * HALF + m * 16) * 1024 + col0, silu4(acc[ai][0][m][0]) * acc[ai][1][m][0], silu4(acc[ai][0][m][1]) * acc[ai][1][m][1]);
    }
};
struct EpiYe {
    static constexpr bool PERM = true, AFTER_DRAIN = false;
    bf16_t* Y; const float* gate;
    __device__ __forceinline__ void operator()(const f32x4 (&acc)[2][2][4][2], const Unit& u, int wr, int wc, int fr, int fq) const {
        const int row0 = wr * 64 + fr, col0 = u.pn * BM + wc * 32 + 8 * fq;
#pragma unroll
        for (int ai = 0; ai < 2; ++ai)
#pragma unroll
            for (int m = 0; m < 4; ++m) { const int r = row0 + ai * HALF + m * 16; const float gt = gate[r];
#pragma unroll
                for (int bj = 0; bj < 2; ++bj) st8(Y + (size_t)r * 1024 + col0 + bj * HALF, acc[ai][bj][m][0] * gt, acc[ai][bj][m][1] * gt); }
    }
};
struct InProjOrder {
    StaticOrder so;
    __device__ void init(int G_, int c_) { so.init(ML, INC, G_, c_); }
    __device__ bool next(int i, Unit& u) const {
#if DBG_GA_ONLY
        { const long L = (long)i * so.G + so.c; if (L >= 512) return false; u.pm = (int)(L >> 2); u.pn = 13 + (int)(L & 3); u.pm = (u.pm >> 3) * 9 + 1 + (u.pm & 7); return true; }
#endif
        if (so.next(i, u)) { u.pm = (u.pm >> 3) * 9 + 1 + (u.pm & 7); return true; }
        const long L = (long)i * so.G + so.c - so.nwg; if (L >= 16 * 7) return false;
        const int cb = (int)L / 7, k = (int)L % 7; u.pm = cb * 9; u.pn = k < 6 ? 2 + k : 12; return true;
    }
    __device__ __forceinline__ void a_ready(const Unit&) const {}
    __device__ __forceinline__ void done(const Unit&) const {}
};
struct LocalOrder {
    int n;
    __device__ bool next(int i, Unit& u) const { if (i >= n) return false; u.pm = 0; u.pn = i; return true; }
    __device__ __forceinline__ void a_ready(const Unit&) const {}
    __device__ __forceinline__ void done(const Unit&) const {}
};
template <class Epi, class Sched>
__device__ __forceinline__ void gemm_phase(PG8_LAS unsigned char* lds, const Gemm g, const Sched& S, const Epi& E) {
    int tid_ = threadIdx.x; asm volatile("" : "+v"(tid_));
    const int tid = tid_, wid = __builtin_amdgcn_readfirstlane(tid >> 6), lane = tid & 63, wr = wid >> 2, wc = wid & 3, fr = lane & 15, fq = lane >> 4;
    const int K = g.K, nt = K / BK;
    unsigned voffA[2], voffA1[2], voffB[2];
#pragma unroll
    for (int i = 0; i < 2; ++i) { int R, C; stage_rc(tid * 16 + i * 8192, R, C); const int Rb = Epi::PERM ? ((R & ~31) + perm32(R & 31)) : R;
        if (g.gather) { voffA[i] = ((unsigned)g.gather[R] * (unsigned)K + (unsigned)C) * 2u; voffA1[i] = ((unsigned)g.gather[R + HALF] * (unsigned)K + (unsigned)C) * 2u; }
        else { voffA[i] = (unsigned)(R * K + C) * 2u; voffA1[i] = voffA[i] + (unsigned)(HALF * K * 2); }
        voffB[i] = (unsigned)(Rb * K + C) * 2u; }
    const size_t kstep = (size_t)(BK * 2);
    const size_t hstep = (size_t)HALF * K * 2;
    const size_t tstep = 2 * hstep;
    const unsigned ldsw = (unsigned)wid * 1024u;
    const int aoff = lds_byte(wr * 64 + fr, fq * 8), boff = lds_byte(wc * 32 + fr, fq * 8);
#define PG8_SA(b, h) (((b) * 2 + (h)) * HTB)
#define PG8_SB(b, h) ((4 + (b) * 2 + (h)) * HTB)
#if PG8_USE_DMA
#define PG8_STAGE(bufoff, gbase, voff) do { _Pragma("unroll") for (int _i = 0; _i < 2; ++_i) \
        __builtin_amdgcn_global_load_lds((const unsigned*)((const char*)(gbase) + (voff)[_i]), (PG8_LAS unsigned*)(lds + (bufoff) + ldsw + _i * 8192), 16, 0, 0); } while (0)
#define PG8_STAGE_TILE(b, pa, pb) do { PG8_STAGE(PG8_SA(b, 0), pa, voffA); PG8_STAGE(PG8_SA(b, 1), pa, voffA1); PG8_STAGE(PG8_SB(b, 0), pb, voffB); PG8_STAGE(PG8_SB(b, 1), (pb) + hstep, voffB); } while (0)
#define PG8_WRITE_TILE(b) do { } while (0)
#else
    u32x4 stg[4];
#define PG8_LD2(k0, rsrc, soff, voff) do { _Pragma("unroll") for (int _i = 0; _i < 2; ++_i) stg[(k0) + _i] = __builtin_amdgcn_raw_buffer_load_b128(rsrc, (int)(voff)[_i], (int)(soff), 0); } while (0)
#define PG8_WR2(k0, bufoff) do { _Pragma("unroll") for (int _i = 0; _i < 2; ++_i) *(PG8_LAS u32x4*)(lds + (bufoff) + ldsw + _i * 8192 + lane * 16) = stg[(k0) + _i]; } while (0)
    const __amdgpu_buffer_rsrc_t rsA = __builtin_amdgcn_make_buffer_rsrc((void*)g.A, 0, 0x7fffffff, 0x00020000), rsB = __builtin_amdgcn_make_buffer_rsrc((void*)g.Bt, 0, 0x7fffffff, 0x00020000);
#define PG8_LOAD_A(pa) do { PG8_LD2(0, rsA, pa, voffA); PG8_LD2(2, rsA, pa, voffA1); } while (0)
#define PG8_LOAD_B(pb) do { PG8_LD2(0, rsB, pb, voffB); PG8_LD2(2, rsB, (pb) + (unsigned)hstep, voffB); } while (0)
#define PG8_WRITE_A(b) do { PG8_WR2(0, PG8_SA(b, 0)); PG8_WR2(2, PG8_SA(b, 1)); } while (0)
#define PG8_WRITE_B(b) do { PG8_WR2(0, PG8_SB(b, 0)); PG8_WR2(2, PG8_SB(b, 1)); } while (0)
#endif
#define PG8_LDA2(dst, b, h, mh) do { _Pragma("unroll") for (int m = 0; m < 2; ++m) _Pragma("unroll") for (int k = 0; k < 2; ++k) dst[m][k] = *(const PG8_LAS bf16x8*)(lds + PG8_SA(b, h) + aoff + (2 * (mh) + m) * 2048 + k * 1024); } while (0)
#define PG8_LDB(dst, b, h) do { _Pragma("unroll") for (int n = 0; n < 2; ++n) _Pragma("unroll") for (int k = 0; k < 2; ++k) dst[n][k] = *(const PG8_LAS bf16x8*)(lds + PG8_SB(b, h) + boff + n * 2048 + k * 1024); } while (0)
#define PG8_MMA2(ai, bj, mh, At, Bt) do { _Pragma("unroll") for (int m = 0; m < 2; ++m) _Pragma("unroll") for (int n = 0; n < 2; ++n) _Pragma("unroll") for (int k = 0; k < 2; ++k) \
        acc[ai][bj][2 * (mh) + m][n] = __builtin_amdgcn_mfma_f32_16x16x32_bf16(Bt[n][k], At[m][k], acc[ai][bj][2 * (mh) + m][n], 0, 0, 0); } while (0)
#define PG8_QUAD(b, ai, bj) do { PG8_LDB(B0, b, bj); PG8_LDA2(At, b, ai, 0); PG8_MMA2(ai, bj, 0, At, B0); PG8_LDA2(At, b, ai, 1); PG8_MMA2(ai, bj, 1, At, B0); } while (0)
#define PG8_HALF0(b) do { PG8_QUAD(b, 0, 0); PG8_QUAD(b, 0, 1); } while (0)
#define PG8_HALF1(b) do { PG8_QUAD(b, 1, 1); PG8_QUAD(b, 1, 0); } while (0)
#define PG8_SYNC() do { asm volatile("s_waitcnt vmcnt(0)" ::: "memory"); __syncthreads(); } while (0)
    Unit cur; int ui = 0;
    if (!S.next(0, cur)) return;
    f32x4 acc[2][2][4][2];
    bf16x8 At[2][2], B0[2][2];
    for (;;) {
#pragma unroll
        for (int a = 0; a < 2; ++a)
#pragma unroll
            for (int b = 0; b < 2; ++b)
#pragma unroll
                for (int m = 0; m < 4; ++m)
#pragma unroll
                    for (int n = 0; n < 2; ++n) acc[a][b][m][n] = (f32x4){0.f, 0.f, 0.f, 0.f};
        const unsigned cA = (unsigned)((size_t)cur.pm * tstep), cB = (unsigned)((size_t)cur.pn * tstep);
        PG8_LOAD_A(cA); PG8_WRITE_A(0); PG8_LOAD_B(cB); PG8_WRITE_B(0);
        PG8_SYNC();
        for (int t = 0; t < nt; t += 2) {
            { const unsigned pa = cA + (unsigned)((t + 1) * kstep), pb = cB + (unsigned)((t + 1) * kstep);
              PG8_LOAD_A(pa); PG8_HALF0(0); PG8_WRITE_A(1); PG8_LOAD_B(pb); PG8_HALF1(0); PG8_WRITE_B(1); }
            PG8_SYNC();
            { const bool more = t + 2 < nt; const unsigned pa = cA + (unsigned)((t + 2) * kstep), pb = cB + (unsigned)((t + 2) * kstep);
              if (more) PG8_LOAD_A(pa); PG8_HALF0(1); if (more) { PG8_WRITE_A(0); PG8_LOAD_B(pb); } PG8_HALF1(1); if (more) PG8_WRITE_B(0); }
            PG8_SYNC();
        }
        E(acc, cur, wr, wc, fr, fq);
        if (!S.next(++ui, cur)) break;
    }
#undef PG8_SA
#undef PG8_SB
#undef PG8_STAGE_TILE
#undef PG8_WRITE_TILE
#undef PG8_LDA2
#undef PG8_MMA2
#undef PG8_QUAD
#undef PG8_LDB
#undef PG8_HALF0
#undef PG8_HALF1
#undef PG8_SYNC
}
}
#include <hip/hip_bf16.h>
#include <cmath>
namespace attn_body {
using bf16=__hip_bfloat16;
using bf16x8=__attribute__((ext_vector_type(8)))short;
using s16x4=__attribute__((ext_vector_type(4)))short;
using f32x16=__attribute__((ext_vector_type(16)))float;
using u32x4=__attribute__((ext_vector_type(4)))unsigned;
constexpr int D=64,QP=512,KP=128,NKT=36;
constexpr int NW=8,QBLK=32,QB=QBLK*NW,KVBLK=64;
__device__ __forceinline__ int crow(int r,int hi){return (r&3)+8*(r>>2)+4*hi;}
#define SBAR() __builtin_amdgcn_sched_barrier(0)
constexpr int NSLOT=3, SLOTB=8192;
constexpr int LDS_K=0, LDS_V=NSLOT*SLOTB, LDS_WS=2*NSLOT*SLOTB, LDS_OST=LDS_WS+NW*64*4, LDS_BYTES=LDS_OST+NW*4096;
constexpr float C2=0.125f*1.4426950408889634f;
__device__ __forceinline__ void glds16(const void*gsrc,unsigned lds_dst){unsigned keep;
  asm volatile("s_mov_b32 %0, m0\n\ts_mov_b32 m0, %2\n\ts_nop 0\n\tglobal_load_lds_dwordx4 %1, off\n\ts_mov_b32 m0, %0":"=&s"(keep):"v"(gsrc),"s"(lds_dst):"memory");}
__device__ __forceinline__ float max3f(float a,float b,float c){float r;asm("v_max3_f32 %0, %1, %2, %3":"=v"(r):"v"(a),"v"(b),"v"(c));return r;}
__device__ __forceinline__ float max2f(float a,float b){float r;asm("v_max_f32_e32 %0, %1, %2":"=v"(r):"v"(a),"v"(b));return r;}
__device__ __forceinline__ float fadd_s(float a,float b){float r;asm("v_add_f32_e32 %0, %1, %2":"=v"(r):"v"(a),"v"(b));return r;}
__device__ __forceinline__ float fsub_s(float a,float b){float r;asm("v_sub_f32_e32 %0, %1, %2":"=v"(r):"v"(a),"v"(b));return r;}
typedef float f32x2_t __attribute__((ext_vector_type(2))); typedef __bf16 bf16x2_t __attribute__((ext_vector_type(2)));
__device__ __forceinline__ unsigned cvtpk_s(float lo,float hi){f32x2_t v={lo,hi};bf16x2_t b=__builtin_convertvector(v,bf16x2_t);return __builtin_bit_cast(unsigned,b);}
#define WAIT_BAR(N) asm volatile("s_waitcnt vmcnt(0) lgkmcnt(0)\n\ts_barrier":::"memory")

__device__ __forceinline__ void qkt(f32x16&p0,f32x16&p1,const char*Kslot,const bf16x8*qr,const f32x16&negm,int r32,int hi){
  const char*kb=Kslot+hi*1024+r32*16;
  #pragma unroll
  for(int d0=0;d0<4;++d0){
    const bf16x8 b0=*reinterpret_cast<const bf16x8*>(kb+d0*2048);
    const bf16x8 b1=*reinterpret_cast<const bf16x8*>(kb+d0*2048+512);
    if(d0==0){p0=__builtin_amdgcn_mfma_f32_32x32x16_bf16(b0,qr[0],negm,0,0,0);p1=__builtin_amdgcn_mfma_f32_32x32x16_bf16(b1,qr[0],negm,0,0,0);}
    else{p0=__builtin_amdgcn_mfma_f32_32x32x16_bf16(b0,qr[d0],p0,0,0,0);p1=__builtin_amdgcn_mfma_f32_32x32x16_bf16(b1,qr[d0],p1,0,0,0);}}
}
typedef __attribute__((address_space(3))) const char* lds_cptr;
typedef short v4i16_t __attribute__((ext_vector_type(4)));
__device__ __forceinline__ void kload8(bf16x8*kf,lds_cptr kp){
  kf[0]=*(const __attribute__((address_space(3))) bf16x8*)(kp);      kf[1]=*(const __attribute__((address_space(3))) bf16x8*)(kp+512);
  kf[2]=*(const __attribute__((address_space(3))) bf16x8*)(kp+2048); kf[3]=*(const __attribute__((address_space(3))) bf16x8*)(kp+2560);
  kf[4]=*(const __attribute__((address_space(3))) bf16x8*)(kp+4096); kf[5]=*(const __attribute__((address_space(3))) bf16x8*)(kp+4608);
  kf[6]=*(const __attribute__((address_space(3))) bf16x8*)(kp+6144); kf[7]=*(const __attribute__((address_space(3))) bf16x8*)(kp+6656);
}
__device__ __forceinline__ void kload2(bf16x8*kf,lds_cptr kp,int j){ kf[2*j]=*(const __attribute__((address_space(3))) bf16x8*)(kp+j*2048); kf[2*j+1]=*(const __attribute__((address_space(3))) bf16x8*)(kp+j*2048+512); }
__device__ __forceinline__ s16x4 vtr(lds_cptr p){ return __builtin_bit_cast(s16x4,__builtin_amdgcn_ds_read_tr16_b64_v4i16((__attribute__((address_space(3))) v4i16_t*)p)); }
__device__ __forceinline__ float rowmax(const f32x16&p0,const f32x16&p1){
  float a=max3f(p0[0],p0[1],p1[0]),b=max3f(p0[2],p0[3],p1[1]);a=max3f(a,p1[2],p1[3]);
  #pragma unroll
  for(int r=4;r<16;r+=4){a=max3f(a,p0[r],p0[r+1]);b=max3f(b,p0[r+2],p0[r+3]);a=max3f(a,p1[r],p1[r+1]);b=max3f(b,p1[r+2],p1[r+3]);}
  const float m=max2f(a,b);
  auto rr=__builtin_amdgcn_permlane32_swap(__float_as_uint(m),__float_as_uint(m),false,false);
  return max2f(__uint_as_float(rr[0]),__uint_as_float(rr[1]));
}
__device__ __forceinline__ void pv(f32x16*o,int vb,bf16x8 pa0,bf16x8 pa1,bf16x8 pa2,bf16x8 pa3){
  #pragma unroll
  for(int d0=0;d0<2;++d0){s16x4 lo[4],hi[4];
    #pragma unroll
    for(int ks=0;ks<4;++ks){
      asm volatile("ds_read_b64_tr_b16 %0,%1 offset:%c2":"=&v"(lo[ks]):"v"(vb),"i"(d0*4096+ks*1024):"memory");
      asm volatile("ds_read_b64_tr_b16 %0,%1 offset:%c2":"=&v"(hi[ks]):"v"(vb),"i"(d0*4096+ks*1024+512):"memory");}
    asm volatile("s_waitcnt lgkmcnt(0)":::"memory");SBAR();
    #define PK(k) (bf16x8){lo[k][0],lo[k][1],lo[k][2],lo[k][3],hi[k][0],hi[k][1],hi[k][2],hi[k][3]}
    o[d0]=__builtin_amdgcn_mfma_f32_32x32x16_bf16(pa0,PK(0),o[d0],0,0,0);
    o[d0]=__builtin_amdgcn_mfma_f32_32x32x16_bf16(pa1,PK(1),o[d0],0,0,0);
    o[d0]=__builtin_amdgcn_mfma_f32_32x32x16_bf16(pa2,PK(2),o[d0],0,0,0);
    o[d0]=__builtin_amdgcn_mfma_f32_32x32x16_bf16(pa3,PK(3),o[d0],0,0,0);
    #undef PK
  }
}

#ifndef ATTN_STORE16
#define ATTN_STORE16(p,v) (*(u32x4*)(p)=(v))
#endif
template<int THRL> __device__ __forceinline__ void attn_unit(long qrow0,int h,long kvrow0,int kvh,const bf16*Q,const bf16*__restrict__ K,const bf16*__restrict__ V,bf16*O,char*shm){
  int tid_=threadIdx.x; asm volatile("":"+v"(tid_)); const int tid=tid_,lane=tid&63,r32=lane&31,hi=lane>>5; const int wid=__builtin_amdgcn_readfirstlane(tid>>6);
  const bf16*Qw=Q+(qrow0+wid*QBLK)*QP+h*D;
  const bf16*Kh=K+kvrow0*KP+kvh*D,*Vh=V+kvrow0*KP+kvh*D;
  const unsigned lds0=(unsigned)(uintptr_t)shm;
  float*wsf=(float*)(shm+LDS_WS)+wid*64;
  const bf16*ksrc=Kh+(long)lane*KP+wid*8;
  const bf16*vsrc=Vh+(long)(16*(wid&3)+(lane>>2))*KP+(wid>>2)*32+(lane&3)*8;
  const unsigned kdst=lds0+LDS_K+wid*1024, vdst=lds0+LDS_V+wid*1024;
  #define DMA_K(t,slot) glds16(ksrc+(long)(t)*KVBLK*KP,(unsigned)__builtin_amdgcn_readfirstlane(kdst+(slot)))
  #define DMA_V(t,slot) glds16(vsrc+(long)(t)*KVBLK*KP,(unsigned)__builtin_amdgcn_readfirstlane(vdst+(slot)))
  const int vb0=(int)(lds0+LDS_V)+((lane>>4)&1)*32+(lane&3)*8+(4*hi+((lane&15)>>2))*64;
  const char*Kbase=shm+LDS_K; bf16x8 kf[8];
  const lds_cptr shm3=(lds_cptr)shm; const lds_cptr kp0=shm3+LDS_K+hi*1024+r32*16; const lds_cptr vp0=shm3+LDS_V+((lane>>4)&1)*32+(lane&3)*8+(4*hi+((lane&15)>>2))*64;
  constexpr int NT=NKT;
  DMA_K(0,0);DMA_V(0,0);DMA_K(1,SLOTB);
  bf16x8 qr[4];
  #pragma unroll
  for(int d0=0;d0<4;++d0)qr[d0]=*reinterpret_cast<const bf16x8*>(&Qw[(long)r32*QP+d0*16+hi*8]);
  float mhat=0.f,l_reg=0.f;f32x16 o[2];o[0]=f32x16{};o[1]=f32x16{};f32x16 negm=f32x16{};asm volatile("":"+v"(negm));
  #define CMASK(P0,P1,t) do{}while(0)
  bool resc=false;
  #define START(P0,P1) do{ const float rm=rowmax(P0,P1); resc=false; \
    { const float dl=rm; mhat=fadd_s(mhat,dl); \
      _Pragma("unroll") for(int r=0;r<16;++r){P0[r]=fsub_s(P0[r],dl);P1[r]=fsub_s(P1[r],dl);} \
      _Pragma("unroll") for(int r=0;r<16;++r)negm[r]=-mhat; asm volatile("":"+v"(negm)); } \
    _Pragma("unroll") for(int r=0;r<16;++r)P0[r]=__builtin_amdgcn_exp2f(P0[r]); }while(0)
  #define RESC() do{ if(resc){ asm volatile("s_waitcnt lgkmcnt(0)":::"memory"); \
      _Pragma("unroll") for(int d_=0;d_<2;++d_) _Pragma("unroll") for(int r=0;r<16;++r)o[d_][r]*=wsf[crow(r,hi)]; } }while(0)
  f32x16 pA0,pA1,pB0,pB1;
  int sl_prev=0,sl_cur=0,sl_next=SLOTB;
  #define ROT() do{sl_prev=sl_cur;sl_cur=sl_next;sl_next=(sl_next==(NSLOT-1)*SLOTB)?0:sl_next+SLOTB;}while(0)
  DMA_K(2,2*SLOTB);
  WAIT_BAR(3);
  qkt(pA0,pA1,Kbase,qr,negm,r32,hi);asm volatile("s_nop 15\n\ts_nop 7":"+v"(pA0),"+v"(pA1));CMASK(pA0,pA1,0);
  START(pA0,pA1);
  _Pragma("unroll") for(int r=0;r<16;++r)pA1[r]=__builtin_amdgcn_exp2f(pA1[r]);
  WAIT_BAR(0);
  DMA_K(3,0);DMA_V(1,SLOTB);
  ROT();
  kload8(kf,kp0+sl_cur);
  WAIT_BAR(2);
  s16x4 vlo[8],vhi[8]; u32x4 pw0,pw1,pw2,pw3;
  #define PKW(P,B) cvtpk_s(P[B],P[B+1])
  #define PAF(k) __builtin_bit_cast(bf16x8,pw##k)
  #define VFR(i) (bf16x8){vlo[i][0],vlo[i][1],vlo[i][2],vlo[i][3],vhi[i][0],vhi[i][1],vhi[i][2],vhi[i][3]}
  #define PIN(x) asm volatile("":"+v"(x))
  #define MX3(a,b,c) __builtin_fmaxf(__builtin_fmaxf((a),(b)),(c))
  #define GAPA(MF,A0,A1,A2,A3,W0,W1,PW) do{ MF; sacc+=A0; sacc+=A1; sacc+=A2; sacc+=A3; PIN(sacc); W0; W1; PIN(PW); SBAR(); }while(0)
  #define EX(v) __builtin_amdgcn_exp2f(v)
  #define GAPB(MF,X,B) do{ MF; X[B]=EX(X[B]); X[B+1]=EX(X[B+1]); X[B+2]=EX(X[B+2]); X[B+3]=EX(X[B+3]); PIN(X); SBAR(); }while(0)
  #define VRD(i) do{ vlo[i]=vtr(vp_+(((i)>>2)*4096+((i)&3)*1024)); vhi[i]=vtr(vp_+(((i)>>2)*4096+((i)&3)*1024+512)); }while(0)
  #define KRD(G,j) do{ if(G){ kload2(kf,kp0+sl_next,j); SBAR(); } }while(0)
  #define STEP(C0,C1,P0,P1,t,GK,GV,GL) do{ SBAR(); \
    const lds_cptr vp_=vp0+sl_prev; \
    VRD(0); SBAR(); float sacc=(P0[0]+P0[1]); \
    GAPA(C0=__builtin_amdgcn_mfma_f32_32x32x16_bf16(kf[0],qr[0],negm,0,0,0), P0[2],P0[3],P0[4],P0[5],     pw0[0]=PKW(P0,0), pw0[1]=PKW(P0,2), pw0); \
    VRD(4); SBAR(); GAPA(C1=__builtin_amdgcn_mfma_f32_32x32x16_bf16(kf[1],qr[0],negm,0,0,0), P0[6],P0[7],P0[8],P0[9],     pw0[2]=PKW(P0,4), pw0[3]=PKW(P0,6), pw0); \
    VRD(1); SBAR(); GAPA(C0=__builtin_amdgcn_mfma_f32_32x32x16_bf16(kf[2],qr[1],C0,0,0,0),   P0[10],P0[11],P0[12],P0[13], pw1[0]=PKW(P0,8), pw1[1]=PKW(P0,10), pw1); \
    VRD(5); SBAR(); GAPA(C1=__builtin_amdgcn_mfma_f32_32x32x16_bf16(kf[3],qr[1],C1,0,0,0),   P0[14],P0[15],P1[0],P1[1],   pw1[2]=PKW(P0,12),pw1[3]=PKW(P0,14), pw1); \
    VRD(2); SBAR(); GAPA(C0=__builtin_amdgcn_mfma_f32_32x32x16_bf16(kf[4],qr[2],C0,0,0,0),   P1[2],P1[3],P1[4],P1[5],     pw2[0]=PKW(P1,0), pw2[1]=PKW(P1,2), pw2); \
    VRD(6); SBAR(); GAPA(C1=__builtin_amdgcn_mfma_f32_32x32x16_bf16(kf[5],qr[2],C1,0,0,0),   P1[6],P1[7],P1[8],P1[9],     pw2[2]=PKW(P1,4), pw2[3]=PKW(P1,6), pw2); \
    VRD(3); SBAR(); GAPA(C0=__builtin_amdgcn_mfma_f32_32x32x16_bf16(kf[6],qr[3],C0,0,0,0),   P1[10],P1[11],P1[12],P1[13], pw3[0]=PKW(P1,8), pw3[1]=PKW(P1,10), pw3); \
    VRD(7); SBAR(); GAPA(C1=__builtin_amdgcn_mfma_f32_32x32x16_bf16(kf[7],qr[3],C1,0,0,0),   P1[14],P1[15],0.f,0.f,       pw3[2]=PKW(P1,12),pw3[3]=PKW(P1,14), pw3); \
    l_reg+=sacc; \
    if(GK){DMA_K((t)+3,sl_cur);} if(GV){DMA_V((t)+1,sl_next);} \
    CMASK(C0,C1,t); \
    { float a=MX3(C0[0],C0[1],C1[0]),b=MX3(C0[2],C0[3],C1[1]); a=MX3(a,C1[2],C1[3]); \
      _Pragma("unroll") for(int r=4;r<16;r+=4){a=MX3(a,C0[r],C0[r+1]);b=MX3(b,C0[r+2],C0[r+3]);a=MX3(a,C1[r],C1[r+1]);b=MX3(b,C1[r+2],C1[r+3]);} \
      float rm=__builtin_fmaxf(a,b); { auto rr=__builtin_amdgcn_permlane32_swap(__float_as_uint(rm),__float_as_uint(rm),false,false); rm=__builtin_fmaxf(__uint_as_float(rr[0]),__uint_as_float(rr[1])); } \
      resc=false; \
      if(__builtin_expect(__any(rm>(float)THRL),0)){ const float dl=__builtin_fmaxf(rm,0.f); mhat+=dl; \
        _Pragma("unroll") for(int r=0;r<16;++r){C0[r]-=dl;C1[r]-=dl;} \
        _Pragma("unroll") for(int r=0;r<16;++r)negm[r]=-mhat; asm volatile("":"+v"(negm)); \
        const float f=__builtin_amdgcn_exp2f(-dl); l_reg*=f; if(hi==0)wsf[r32]=f; resc=true; } } \
    SBAR(); \
    GAPB(o[0]=__builtin_amdgcn_mfma_f32_32x32x16_bf16(PAF(0),VFR(0),o[0],0,0,0), C0,0); \
    GAPB(o[1]=__builtin_amdgcn_mfma_f32_32x32x16_bf16(PAF(0),VFR(4),o[1],0,0,0), C0,4); \
    KRD(GL,0); GAPB(o[0]=__builtin_amdgcn_mfma_f32_32x32x16_bf16(PAF(1),VFR(1),o[0],0,0,0), C0,8); \
    KRD(GL,1); GAPB(o[1]=__builtin_amdgcn_mfma_f32_32x32x16_bf16(PAF(1),VFR(5),o[1],0,0,0), C0,12); \
    KRD(GL,2); GAPB(o[0]=__builtin_amdgcn_mfma_f32_32x32x16_bf16(PAF(2),VFR(2),o[0],0,0,0), C1,0); \
    KRD(GL,3); GAPB(o[1]=__builtin_amdgcn_mfma_f32_32x32x16_bf16(PAF(2),VFR(6),o[1],0,0,0), C1,4); \
    GAPB(o[0]=__builtin_amdgcn_mfma_f32_32x32x16_bf16(PAF(3),VFR(3),o[0],0,0,0), C1,8); \
    GAPB(o[1]=__builtin_amdgcn_mfma_f32_32x32x16_bf16(PAF(3),VFR(7),o[1],0,0,0), C1,12); \
    }while(0)
  int t=1;
  #undef CMASK
  #define CMASK(P0,P1,t) do{}while(0)
  for(;t+5<NT;t+=2){
    STEP(pB0,pB1,pA0,pA1,t,true,true,true);     WAIT_BAR(2); RESC(); ROT();
    STEP(pA0,pA1,pB0,pB1,t+1,true,true,true);   WAIT_BAR(2); RESC(); ROT();
  }
  #undef CMASK
  #define CMASK(P0,P1,t) do{}while(0)
  #define ENDW(tt) do{ if((tt)+3<NT){WAIT_BAR(2);} else if((tt)+2<NT){WAIT_BAR(1);} else {WAIT_BAR(0);} }while(0)
  for(;t+1<NT;t+=2){
    STEP(pB0,pB1,pA0,pA1,t,(t+3<NT),(t+1<NT),(t+1<NT));       ENDW(t);   RESC(); ROT();
    STEP(pA0,pA1,pB0,pB1,t+1,(t+4<NT),(t+2<NT),(t+2<NT));     ENDW(t+1); RESC(); ROT();
  }
  STEP(pB0,pB1,pA0,pA1,NT-1,false,false,false); RESC();
  { float sacc=pB0[0]+pB0[1]; _Pragma("unroll") for(int r=2;r<16;++r)sacc+=pB0[r]; _Pragma("unroll") for(int r=0;r<16;++r)sacc+=pB1[r]; l_reg+=sacc;
    pw0=(u32x4){PKW(pB0,0),PKW(pB0,2),PKW(pB0,4),PKW(pB0,6)};pw1=(u32x4){PKW(pB0,8),PKW(pB0,10),PKW(pB0,12),PKW(pB0,14)};pw2=(u32x4){PKW(pB1,0),PKW(pB1,2),PKW(pB1,4),PKW(pB1,6)};pw3=(u32x4){PKW(pB1,8),PKW(pB1,10),PKW(pB1,12),PKW(pB1,14)};
    SBAR(); pv(o,vb0+sl_cur,PAF(0),PAF(1),PAF(2),PAF(3)); }
  #undef PKW
  #undef PAF
  #undef VFR
  #undef PIN
  #undef MX3
  #undef GAPA
  #undef GAPB
  #undef EX
  #undef VRD
  #undef KRD
  #undef STEP
  #undef ENDW
  {auto rr=__builtin_amdgcn_permlane32_swap(__float_as_uint(l_reg),__float_as_uint(l_reg),false,false);l_reg=__uint_as_float(rr[0])+__uint_as_float(rr[1]);}
  if(hi==0)wsf[32+r32]=l_reg;asm volatile("s_waitcnt lgkmcnt(0)":::"memory");
  float rli[16];
  #pragma unroll
  for(int r=0;r<16;++r)rli[r]=__builtin_amdgcn_rcpf(wsf[32+crow(r,hi)]);
  bf16*Ow=O+(qrow0+wid*QBLK)*QP+h*D;
  { bf16*stg=(bf16*)(shm+LDS_OST)+wid*2048;
    #pragma unroll
    for(int r=0;r<16;++r){const int orow=crow(r,hi);
      #pragma unroll
      for(int d0=0;d0<2;++d0)stg[orow*64+d0*32+r32]=__float2bfloat16(o[d0][r]*rli[r]);}
    asm volatile("s_waitcnt lgkmcnt(0)":::"memory");
    #pragma unroll
    for(int i=0;i<4;++i){const int row=i*8+(lane>>3),ch=lane&7; const u32x4 v=*(const u32x4*)(stg+row*64+ch*8); ATTN_STORE16(Ow+(long)row*QP+ch*8,v);} }
  asm volatile("s_waitcnt lgkmcnt(0)\n\ts_barrier":::"memory");
  #undef DMA_K
  #undef DMA_V
  #undef CMASK
  #undef START
  #undef RESC
  #undef ROT
}
constexpr int ATTN_LDS_BYTES=LDS_BYTES;
#undef SBAR
#undef WAIT_BAR
}
constexpr int NWAVES = 8;
using pg8::bf16_t; using pg8::bf16x8; using pg8::f32x4; using pg8::u32x4;
typedef unsigned u32x2 __attribute__((ext_vector_type(2)));
#define LAS __attribute__((address_space(3)))
#define GAS __attribute__((address_space(1)))
#define RLX_AGENT __ATOMIC_RELAXED, __HIP_MEMORY_SCOPE_AGENT
#define LDS_WAIT() asm volatile("s_waitcnt lgkmcnt(0)" ::: "memory")
#define VM_WAIT() asm volatile("s_waitcnt vmcnt(0)" ::: "memory")

constexpr size_t MiB = 1u << 20;
constexpr size_t WS_CTL = 0, CTL_ZERO_BYTES = 64 * 1024;
constexpr size_t WS_MOD = 1 * MiB;
constexpr size_t WS_LB = WS_MOD + 512 * 1024;
constexpr size_t WS_ROPE = WS_LB + 8 * 1024;
constexpr size_t WS_WIN = 2 * MiB;
constexpr size_t WS_WA = 13 * MiB, WS_WB = 14 * MiB, WS_WO = 15 * MiB;
constexpr size_t WS_WGU = 17 * MiB, WS_WD = 81 * MiB;
constexpr size_t WS_HX = 17 * MiB;
constexpr size_t WS_A1 = 17 * MiB, WS_OATT = 49 * MiB, WS_OR = 81 * MiB;
constexpr size_t WS_HQ = 113 * MiB, WS_FF = 145 * MiB, WS_FB = 181 * MiB, WS_HI = 217 * MiB, WS_SG = 253 * MiB, WS_Q = 285 * MiB, WS_K = 317 * MiB, WS_V = 326 * MiB;
constexpr size_t WS_GA = 335 * MiB, WS_GB = 399 * MiB;
constexpr size_t WS_Z = 113 * MiB;
constexpr size_t WS_H2 = 177 * MiB;
constexpr size_t WS_AFF = 241 * MiB;
constexpr size_t WS_IDX = 243 * MiB;
constexpr size_t WS_SLOT = 244 * MiB;
constexpr size_t WS_HID = 246 * MiB, WS_YE = 374 * MiB;
constexpr size_t WS_END = 502 * MiB;
constexpr int CW_Q3 = 64;
constexpr int CW_BAR = 1024;

constexpr int RING_BYTES = 131072, MISC_OFF = RING_BYTES, LDS_BYTES = 147456;

struct Args {
    const float *x, *c, *ctx, *c_ctx, *w_mod, *b_mod, *n1g, *n2g, *w_in, *lbl, *hgn, *qng, *kng, *wa, *wb, *wo, *wr, *weg, *weu, *wed, *fng;
    float* out; unsigned char* ws;
};

#define XB_TMO      128
#define XB_XCNT(j)  (256  + 64 * (j))
#define XB_XSUB(j)  (1280 + 64 * (j))
#define XB_XGEN(j)  (2304 + 64 * (j))
#define XB_TOP      3328
#define XB_TOPGEN   3392
#define XCD_BAR_WORDS 3456
#define XB_SPIN_CAP (1u << 18)
#ifndef XB_SCOPE
#define XB_SCOPE "agent"
#endif

__device__ __forceinline__ unsigned xb_ld(unsigned* p)              { return __hip_atomic_load(p, __ATOMIC_RELAXED, __HIP_MEMORY_SCOPE_AGENT); }
__device__ __forceinline__ unsigned xb_add(unsigned* p, unsigned v) { return __hip_atomic_fetch_add(p, v, __ATOMIC_RELAXED, __HIP_MEMORY_SCOPE_AGENT); }
__device__ __forceinline__ unsigned xb_xcc_id() { return (unsigned)__builtin_amdgcn_s_getreg((3 << 11) | 20) & 0xFu; }
#define XB_SPIN(cond, bar) do { unsigned _sp = 0; while (cond) { __builtin_amdgcn_s_sleep(1); \
    if ((++_sp & 255u) == 0u) { if (xb_ld(&(bar)[XB_TMO])) break; if (_sp > XB_SPIN_CAP) { atomicAdd(&(bar)[XB_TMO], 1u); break; } } } } while (0)

struct XcdBarrier {
    unsigned* bar; unsigned x;
    volatile LAS unsigned* st;
};

__device__ __forceinline__ XcdBarrier xcd_barrier_post(unsigned* bar, volatile LAS unsigned* st) {
    XcdBarrier b; b.bar = bar; b.x = xb_xcc_id(); b.st = st;
    if (threadIdx.x == 0) (void)xb_add(&bar[XB_XCNT(b.x)], 1u);
    return b;
}
__device__ __forceinline__ void xcd_barrier_complete(unsigned* bar, unsigned x, unsigned& nloc, unsigned& nx) {
    const unsigned G = gridDim.x * gridDim.y * gridDim.z;
    unsigned sum, cnt, mine, sp = 0u;
    for (;;) {
        sum = 0u; cnt = 0u; mine = 0u;
#pragma unroll
        for (unsigned j = 0; j < 16; ++j) { const unsigned c = xb_ld(&bar[XB_XCNT(j)]); sum += c; cnt += (c > 0u) ? 1u : 0u; mine = (j == x) ? c : mine; }
        if (sum == G) break;
        __builtin_amdgcn_s_sleep(1);
        if ((++sp & 255u) == 0u) { if (xb_ld(&bar[XB_TMO])) break; if (sp > XB_SPIN_CAP) { atomicAdd(&bar[XB_TMO], 1u); break; } }
    }
    nloc = mine > 0u ? mine : 1u; nx = cnt > 0u ? cnt : 1u;
}

__device__ __forceinline__ void xcd_barrier(const XcdBarrier& b) {
    asm volatile("s_waitcnt vmcnt(0)" ::: "memory");
    __syncthreads();
    if (threadIdx.x == 0) {
        unsigned* bar = b.bar;
        __builtin_amdgcn_s_waitcnt(0);
        unsigned nloc = b.st[0], nx = b.st[1];
        if (nloc == 0u) { xcd_barrier_complete(bar, b.x, nloc, nx); b.st[0] = nloc; b.st[1] = nx; }
#if DBG_RELEASE_ALL
        __builtin_amdgcn_fence(__ATOMIC_RELEASE, "agent"); asm volatile("s_waitcnt vmcnt(0)" ::: "memory");
#endif
        const unsigned old = xb_add(&bar[XB_XSUB(b.x)], 1u);
        const unsigned gen = old / nloc;
        if (old + 1u == (gen + 1u) * nloc) {
#if DBG_LEADER_DELAY
            { const unsigned long long t0_ = __builtin_amdgcn_s_memrealtime(); while (__builtin_amdgcn_s_memrealtime() - t0_ < (unsigned long long)DBG_LEADER_DELAY) __builtin_amdgcn_s_sleep(2); }
#endif
            __builtin_amdgcn_fence(__ATOMIC_RELEASE, XB_SCOPE);
            asm volatile("s_waitcnt vmcnt(0)" ::: "memory");
#if DBG_WBL2_TWICE
            { const unsigned long long t0_ = __builtin_amdgcn_s_memrealtime(); while (__builtin_amdgcn_s_memrealtime() - t0_ < 150ull) __builtin_amdgcn_s_sleep(2); }
            asm volatile("buffer_wbl2 sc1\n\ts_waitcnt vmcnt(0)" ::: "memory");
#endif
            const unsigned og = xb_add(&bar[XB_TOP], 1u);
            const unsigned tg = og / nx;
            if (og + 1u == (tg + 1u) * nx) xb_add(&bar[XB_TOPGEN], 1u);
            else XB_SPIN(xb_ld(&bar[XB_TOPGEN]) == tg, bar);
            __builtin_amdgcn_fence(__ATOMIC_ACQUIRE, XB_SCOPE);
            xb_add(&bar[XB_XGEN(b.x)], 1u);
            asm volatile("s_waitcnt vmcnt(0)" ::: "memory");
        } else {
            XB_SPIN(xb_ld(&bar[XB_XGEN(b.x)]) == gen, bar);
            __builtin_amdgcn_fence(__ATOMIC_ACQUIRE, XB_SCOPE);
            asm volatile("s_waitcnt vmcnt(0)" ::: "memory");
        }
    }
    __syncthreads();
}

__device__ __forceinline__ float wave_sum(float v) {
#pragma unroll
    for (int o = 1; o < 64; o <<= 1) v += __shfl_xor(v, o);
    return v;
}
__device__ __forceinline__ unsigned f2bf(float f) { unsigned u = __builtin_bit_cast(unsigned, f); return (u + 0x7fffu + ((u >> 16) & 1u)) >> 16; }
__device__ __forceinline__ unsigned pk2(float lo, float hi) { return f2bf(lo) | (f2bf(hi) << 16); }
__device__ __forceinline__ float bf2f(unsigned short h) { return __uint_as_float((unsigned)h << 16); }

template <bool QKPERM>
__device__ __forceinline__ void transpose_item(const float* W, int K, int Nsrc, int n0, int k0, bf16_t* WT, long drow0, LAS float* scr, int lane) {
#pragma unroll 8
    for (int i = 0; i < 32; ++i) { const int kk = 2 * i + (lane >> 5); scr[kk * 33 + (lane & 31)] = W[(size_t)(k0 + kk) * Nsrc + n0 + (lane & 31)]; }
    LDS_WAIT(); asm volatile("" ::: "memory");
    const int c = lane & 7;
#pragma unroll
    for (int j = 0; j < 4; ++j) { const int n = (lane >> 3) + 8 * j;
        const int ns = QKPERM ? (16 * ((n & 7) >> 2) + 4 * (n >> 3) + (n & 3)) : n;
        const LAS float* s = scr + (8 * c) * 33 + ns;
        u32x4 o; o.x = pk2(s[0 * 33], s[1 * 33]); o.y = pk2(s[2 * 33], s[3 * 33]); o.z = pk2(s[4 * 33], s[5 * 33]); o.w = pk2(s[6 * 33], s[7 * 33]);
        *(u32x4*)(WT + (size_t)(drow0 + n) * K + k0 + 8 * c) = o; }
    LDS_WAIT(); asm volatile("" ::: "memory");
}
__device__ __forceinline__ void p0_adaln_item(const Args& A, LAS unsigned char* lds, int item, int tid) {
    LAS float* sc = (LAS float*)lds;
    LAS float* red = (LAS float*)(lds + 17 * 1024 * 4);
    const int wave = tid >> 6, lane = tid & 63;
    for (int i = tid; i < 17 * 1024; i += 512) { const int b = i >> 10, k = i & 1023; const float v = b < 16 ? A.c[b * 1024 + k] : A.c_ctx[k]; sc[i] = v * pg8::fsigmoid(v); }
    __syncthreads();
    float acc[17];
#pragma unroll
    for (int b = 0; b < 17; ++b) acc[b] = 0.f;
    const float* wp = A.w_mod + (size_t)(wave * 128) * NMOD + item * 64 + lane;
#pragma unroll 4
    for (int k = 0; k < 128; ++k) { const float w = wp[(size_t)k * NMOD];
#pragma unroll
        for (int b = 0; b < 17; ++b) acc[b] += sc[b * 1024 + wave * 128 + k] * w; }
#pragma unroll
    for (int b = 0; b < 17; ++b) red[(wave * 17 + b) * 64 + lane] = acc[b];
    __syncthreads();
    float* mod = (float*)(A.ws + WS_MOD);
    for (int i = tid; i < 17 * 64; i += 512) { const int b = i >> 6, cidx = i & 63; float s = 0.f;
#pragma unroll
        for (int w = 0; w < 8; ++w) s += red[(w * 17 + b) * 64 + cidx];
        mod[b * NMOD + item * 64 + cidx] = s + A.b_mod[item * 64 + cidx]; }
    __syncthreads();
}
__device__ __forceinline__ void p0_prologue(const Args& A, LAS unsigned char* lds, int vcu, int G, int tid) {
    const int wave = tid >> 6, lane = tid & 63;
    for (int it = vcu; it < NMOD / 64; it += G) p0_adaln_item(A, lds, it, tid);
    if (vcu == G - 1) {
        float* lb = (float*)(A.ws + WS_LB); float* rope = (float*)(A.ws + WS_ROPE);
        for (int i = tid; i < 1024; i += 512) { const int d = i >> 9, k = i & 511; const float l0 = A.lbl[(d * 2 + 0) * 512 + k], l1 = A.lbl[(d * 2 + 1) * 512 + k]; lb[i] = 1.0f / (1.0f + expf(l1 - l0)); }
        for (int i = tid; i < 64 * 16; i += 512) { const int pos = i >> 4, f = i & 15; const float inv = powf(10000.0f, -(float)(2 * f) / 32.0f); const float ang = (float)pos * inv; rope[pos * 32 + f] = cosf(ang); rope[pos * 32 + 16 + f] = sinf(ang); }
    }
    LAS float* scr = (LAS float*)(lds + wave * 8704);
    const int gw = vcu * NWAVES + wave, NGW = G * NWAVES;
    constexpr int I_IN = 16 * (INC / 32), I_A = 8 * 32, I_O = 16 * 32;
    constexpr int NIT = I_IN + 2 * I_A + I_O;
    bf16_t* WinT = (bf16_t*)(A.ws + WS_WIN); bf16_t* WaT = (bf16_t*)(A.ws + WS_WA); bf16_t* WbT = (bf16_t*)(A.ws + WS_WB); bf16_t* WoT = (bf16_t*)(A.ws + WS_WO);
    for (int it = gw; it < NIT; it += NGW) {
        int r = it;
        if (r < I_IN) { const int kb = r / (INC / 32), g32 = r % (INC / 32);
            const int pn = g32 >> 3, bj = (g32 >> 2) & 1, wc = g32 & 3;
            if (pn == 10 || pn == 11) transpose_item<true>(A.w_in, 1024, INC, 2560 + (pn - 10) * 256 + wc * 64 + 32 * bj, 64 * kb, WinT, (long)g32 * 32, scr, lane);
            else if (pn == 12 && wc < 2) transpose_item<true>(A.w_in, 1024, INC, 3072 + wc * 64 + 32 * bj, 64 * kb, WinT, (long)g32 * 32, scr, lane);
            else if (pn == 12) transpose_item<false>(A.w_in, 1024, INC, 3200 + (wc - 2) * 64 + 32 * bj, 64 * kb, WinT, (long)g32 * 32, scr, lane);
            else transpose_item<false>(A.w_in, 1024, INC, g32 * 32, 64 * kb, WinT, (long)g32 * 32, scr, lane);
            continue; }
        r -= I_IN;
        if (r < I_A) { transpose_item<false>(A.wa, 512, 1024, (r & 31) * 32, 64 * (r >> 5), WaT, (long)(r & 31) * 32, scr, lane); continue; } r -= I_A;
        if (r < I_A) { transpose_item<false>(A.wb, 512, 1024, (r & 31) * 32, 64 * (r >> 5), WbT, (long)(r & 31) * 32, scr, lane); continue; } r -= I_A;
        transpose_item<false>(A.wo, 1024, 1024, (r & 31) * 32, 64 * (r >> 5), WoT, (long)(r & 31) * 32, scr, lane);
    }
}

__device__ __forceinline__ void p1_rows(const Args& A, int vcu, int G, int tid) {
    const int wave = tid >> 6, lane = tid & 63; const int gw = vcu * NWAVES + wave, NGW = G * NWAVES;
    const float* mod = (const float*)(A.ws + WS_MOD); bf16_t* HX = (bf16_t*)(A.ws + WS_HX);
    for (int r = gw; r < MR; r += NGW) {
        const int b = r / RPB, s = r - b * RPB;
        const float* src = s < CTXL ? A.ctx + ((size_t)b * CTXL + s) * 1024 : A.x + ((size_t)b * SEQ + (s - CTXL)) * 1024;
        const float* mrow = mod + (size_t)(s < CTXL ? 16 : b) * NMOD;
        f32x4 v[4]; float ss = 0.f;
#pragma unroll
        for (int j = 0; j < 4; ++j) { v[j] = *(const f32x4*)(src + 4 * lane + 256 * j); ss += (v[j][0] * v[j][0] + v[j][1] * v[j][1]) + (v[j][2] * v[j][2] + v[j][3] * v[j][3]); }
        const float rstd = 1.0f / sqrtf(wave_sum(ss) * (1.0f / 1024.0f) + EPS);
#pragma unroll
        for (int j = 0; j < 4; ++j) { const int cidx = 4 * lane + 256 * j;
            const f32x4 g = *(const f32x4*)(A.n1g + cidx), sh = *(const f32x4*)(mrow + cidx), sc = *(const f32x4*)(mrow + 1024 + cidx);
            const f32x4 o = (v[j] * rstd * g) * (sc + 1.0f) + sh;
            u32x2 w; w.x = pg8::cvt_pk_bf16(o[0], o[1]); w.y = pg8::cvt_pk_bf16(o[2], o[3]); *(u32x2*)(HX + (size_t)r * 1024 + cidx) = w; }
    }
}

namespace hg {
constexpr int QS = 0, KD = 17408, KE = 34816, KHT = 52224, VT = 70656, PP = 89088, TT = 98304, EQ = 100352, EG = 102400, DK = 103936, SSQ = 104448, END = 106496;
constexpr int RS = 272  , TS = 144  ;
typedef float f32x4 __attribute__((ext_vector_type(4)));
__device__ __forceinline__ bf16x8 pack8(const f32x4 a, const f32x4 b) { u32x4 w; w.x = pg8::cvt_pk_bf16(a[0], a[1]); w.y = pg8::cvt_pk_bf16(a[2], a[3]); w.z = pg8::cvt_pk_bf16(b[0], b[1]); w.w = pg8::cvt_pk_bf16(b[2], b[3]); return __builtin_bit_cast(bf16x8, w); }
__device__ __forceinline__ void unpack8(const u32x4 w, f32x4& a, f32x4& b) { a = (f32x4){pg8::bf_lo(w.x), pg8::bf_hi(w.x), pg8::bf_lo(w.y), pg8::bf_hi(w.y)}; b = (f32x4){pg8::bf_lo(w.z), pg8::bf_hi(w.z), pg8::bf_lo(w.w), pg8::bf_hi(w.w)}; }

template <bool BWD, bool latent>
__device__ __forceinline__ void chunk_step(const Args& A, LAS unsigned char* lds, int b, int h, int c, bool second, f32x4 (&S)[8], int tid_in) {
    int tid = tid_in; asm volatile("" : "+v"(tid));
    const int wave = __builtin_amdgcn_readfirstlane(tid >> 6), lane = tid & 63, l15 = lane & 15, g = lane >> 4;
    const long rbase = (long)b * RPB + 64 * c;
    const long rlbase = (long)b * SEQ + 64 * (c - 4);
    const bf16_t* F = (const bf16_t*)(A.ws + (BWD ? WS_FB : WS_FF)) + (rbase * 512 + h * 128); const bf16_t* HI = (const bf16_t*)(A.ws + WS_HI) + (rbase * 512 + h * 128);
    const bf16_t* HQ = (const bf16_t*)(A.ws + WS_HQ) + (rlbase * 512 + h * 128);
    const float* lbt = (const float*)(A.ws + WS_LB) + (BWD ? 512 : 0) + h * 128;
    const int k = tid & 127, part = tid >> 7;
    float lc[16], kk[16];
    {
        const float lbv = lbt[k]; float run = 0.f;
        unsigned short fraw[16], qraw[16];
#pragma unroll
        for (int e = 0; e < 16; ++e) { const int tau = 16 * part + e, rho = BWD ? 63 - tau : tau; fraw[e] = F[(unsigned)(rho * 512 + k)]; qraw[e] = latent ? HQ[(unsigned)(rho * 512 + k)] : (unsigned short)0; }
#pragma unroll
        for (int e = 0; e < 16; ++e) { const float fp = bf2f(fraw[e]); const float sg = pg8::fsigmoid(fp); const float f = lbv + (1.0f - lbv) * sg;
            run += __builtin_amdgcn_logf(f); lc[e] = run; kk[e] = (1.0f - lbv) * (1.0f - sg); }
        const float T = run;
        if (latent) {
#pragma unroll
            for (int e = 0; e < 16; ++e) { const int tau = 16 * part + e; const float q = bf2f(qraw[e]);
                *(LAS unsigned short*)(lds + QS + tau * RS + 2 * k) = (unsigned short)f2bf(q * __builtin_amdgcn_exp2f(lc[e]));
                *(LAS unsigned short*)(lds + KD + tau * RS + 2 * k) = (unsigned short)f2bf(kk[e] * __builtin_amdgcn_exp2f(-lc[e]));
                *(LAS unsigned short*)(lds + KE + tau * RS + 2 * k) = (unsigned short)f2bf(kk[e] * __builtin_amdgcn_exp2f(T - lc[e])); }
        }
        *(LAS float*)(lds + TT + (part * 128 + k) * 4) = T;
    }
#pragma unroll
    for (int it = 0; it < 2; ++it) { const int idx = tid + 512 * it, sig = idx >> 4, dv0 = (idx & 15) * 8; const int rho = BWD ? 63 - sig : sig;
        const u32x4 w = *(const u32x4*)(HI + (unsigned)(rho * 512 + dv0));
        LAS unsigned short* vt = (LAS unsigned short*)(lds + VT + dv0 * TS + 2 * sig);
        vt[0 * (TS / 2)] = (unsigned short)(w.x & 0xffff); vt[1 * (TS / 2)] = (unsigned short)(w.x >> 16); vt[2 * (TS / 2)] = (unsigned short)(w.y & 0xffff); vt[3 * (TS / 2)] = (unsigned short)(w.y >> 16);
        vt[4 * (TS / 2)] = (unsigned short)(w.z & 0xffff); vt[5 * (TS / 2)] = (unsigned short)(w.z >> 16); vt[6 * (TS / 2)] = (unsigned short)(w.w & 0xffff); vt[7 * (TS / 2)] = (unsigned short)(w.w >> 16); }
    __syncthreads();
    {
        const float T0 = *(LAS float*)(lds + TT + (0 * 128 + k) * 4), T1 = *(LAS float*)(lds + TT + (1 * 128 + k) * 4), T2 = *(LAS float*)(lds + TT + (2 * 128 + k) * 4), T3 = *(LAS float*)(lds + TT + (3 * 128 + k) * 4);
        const float suf = part == 0 ? T1 + T2 + T3 : part == 1 ? T2 + T3 : part == 2 ? T3 : 0.f;
        const float Tme = part == 0 ? T0 : part == 1 ? T1 : part == 2 ? T2 : T3;
#pragma unroll
        for (int e = 0; e < 16; ++e) *(LAS unsigned short*)(lds + KHT + k * TS + 2 * (16 * part + e)) = (unsigned short)f2bf(kk[e] * __builtin_amdgcn_exp2f(Tme - lc[e] + suf));
        if (part == 0) {
            LAS float* eq = (LAS float*)(lds + EQ); eq[k] = 1.0f; eq[128 + k] = __builtin_amdgcn_exp2f(T0); eq[256 + k] = __builtin_amdgcn_exp2f(T0 + T1); eq[384 + k] = __builtin_amdgcn_exp2f(T0 + T1 + T2);
            LAS float* eg = (LAS float*)(lds + EG); eg[k] = __builtin_amdgcn_exp2f(T1); eg[128 + k] = __builtin_amdgcn_exp2f(T2); eg[256 + k] = __builtin_amdgcn_exp2f(T1 + T2);
            *(LAS float*)(lds + DK + 4 * k) = __builtin_amdgcn_exp2f(T0 + T1 + T2 + T3);
        }
    }
    __syncthreads();
    if (latent) {
        for (int pi = wave; pi < 10; pi += 8) {
            const int bi = pi < 4 ? pi : pi < 7 ? pi - 3 : pi < 9 ? pi - 5 : 3;
            const int bjx = pi < 4 ? pi : pi < 7 ? pi - 4 : pi < 9 ? pi - 7 : 0;
            f32x4 cacc = (f32x4){0.f, 0.f, 0.f, 0.f};
            const int egsel = (bi == 2 && bjx == 0) ? 0 : (bi == 3 && bjx == 1) ? 1 : (bi == 3 && bjx == 0) ? 2 : -1;
#pragma unroll
            for (int s = 0; s < 4; ++s) {
                u32x4 aw = *(const LAS u32x4*)(lds + QS + (16 * bi + l15) * RS + (32 * s + 8 * g) * 2);
                if (egsel >= 0) { f32x4 a0, a1; unpack8(aw, a0, a1); const f32x4 e0 = *(const LAS f32x4*)(lds + EG + (egsel * 128 + 32 * s + 8 * g) * 4), e1 = *(const LAS f32x4*)(lds + EG + (egsel * 128 + 32 * s + 8 * g + 4) * 4);
                    aw = __builtin_bit_cast(u32x4, pack8(a0 * e0, a1 * e1)); }
                const u32x4 bw = *(const LAS u32x4*)(lds + (bi == bjx ? KD : KE) + (16 * bjx + l15) * RS + (32 * s + 8 * g) * 2);
                cacc = __builtin_amdgcn_mfma_f32_16x16x32_bf16(__builtin_bit_cast(bf16x8, aw), __builtin_bit_cast(bf16x8, bw), cacc, 0, 0, 0);
            }
#pragma unroll
            for (int r = 0; r < 4; ++r) { const int tl = 4 * g + r; float v = cacc[r]; if (bi == bjx && l15 > tl) v = 0.f;
                *(LAS unsigned short*)(lds + PP + (16 * bi + tl) * TS + 2 * (16 * bjx + l15)) = (unsigned short)f2bf(v); }
        }
    }
    __syncthreads();
    bf16x8 vf[2];
#pragma unroll
    for (int s = 0; s < 2; ++s) vf[s] = *(const LAS bf16x8*)(lds + VT + (16 * wave + l15) * TS + (32 * s + 8 * g) * 2);
    f32x4 oT[4];
    if (latent) {
#pragma unroll
        for (int m = 0; m < 4; ++m) oT[m] = (f32x4){0.f, 0.f, 0.f, 0.f};
#pragma unroll
        for (int m = 0; m < 4; ++m)
#pragma unroll
            for (int s = 0; s < 2; ++s) { const bf16x8 pf = *(const LAS bf16x8*)(lds + PP + (16 * m + l15) * TS + (32 * s + 8 * g) * 2);
                oT[m] = __builtin_amdgcn_mfma_f32_16x16x32_bf16(vf[s], pf, oT[m], 0, 0, 0); }
#pragma unroll
        for (int s = 0; s < 4; ++s) {
            asm volatile("" ::: "memory");
            const bf16x8 sf = pack8(S[2 * s], S[2 * s + 1]);
#pragma unroll
            for (int m = 0; m < 4; ++m) {
                const u32x2 q0w = *(const LAS u32x2*)(lds + QS + (16 * m + l15) * RS + (32 * s + 4 * g) * 2), q1w = *(const LAS u32x2*)(lds + QS + (16 * m + l15) * RS + (32 * s + 16 + 4 * g) * 2);
                const f32x4 e0 = *(const LAS f32x4*)(lds + EQ + (m * 128 + 32 * s + 4 * g) * 4), e1 = *(const LAS f32x4*)(lds + EQ + (m * 128 + 32 * s + 16 + 4 * g) * 4);
                const f32x4 a0 = (f32x4){pg8::bf_lo(q0w.x), pg8::bf_hi(q0w.x), pg8::bf_lo(q0w.y), pg8::bf_hi(q0w.y)} * e0, a1 = (f32x4){pg8::bf_lo(q1w.x), pg8::bf_hi(q1w.x), pg8::bf_lo(q1w.y), pg8::bf_hi(q1w.y)} * e1;
                oT[m] = __builtin_amdgcn_mfma_f32_16x16x32_bf16(sf, pack8(a0, a1), oT[m], 0, 0, 0);
            }
        }
    }
#pragma unroll
    for (int t = 0; t < 8; ++t) { const f32x4 dk4 = *(const LAS f32x4*)(lds + DK + (16 * t + 4 * g) * 4); S[t] = S[t] * dk4;
#pragma unroll
        for (int s = 0; s < 2; ++s) { const bf16x8 kf = *(const LAS bf16x8*)(lds + KHT + (16 * t + l15) * TS + (32 * s + 8 * g) * 2);
            S[t] = __builtin_amdgcn_mfma_f32_16x16x32_bf16(kf, vf[s], S[t], 0, 0, 0); } }
    if (latent) {
        bf16_t* ORb = (bf16_t*)(A.ws + WS_OR) + (rlbase * 512 + h * 128 + 16 * wave);
        if (!second) {
#pragma unroll
            for (int m = 0; m < 4; ++m) { const int tau = 16 * m + l15, rho = BWD ? 63 - tau : tau;
                const unsigned long long w = (unsigned long long)pg8::cvt_pk_bf16(oT[m][0], oT[m][1]) | ((unsigned long long)pg8::cvt_pk_bf16(oT[m][2], oT[m][3]) << 32);
                __hip_atomic_store((unsigned long long*)(ORb + (unsigned)(rho * 512 + 4 * g)), w, RLX_AGENT); }
        } else {
#pragma unroll
            for (int m = 0; m < 4; ++m) { const int tau = 16 * m + l15, rho = BWD ? 63 - tau : tau;
                const unsigned long long w = __hip_atomic_load((unsigned long long*)(ORb + (unsigned)(rho * 512 + 4 * g)), RLX_AGENT);
                const unsigned lo = (unsigned)w, hi = (unsigned)(w >> 32);
                oT[m] += (f32x4){pg8::bf_lo(lo), pg8::bf_hi(lo), pg8::bf_lo(hi), pg8::bf_hi(hi)};
                float ss = (oT[m][0] * oT[m][0] + oT[m][1] * oT[m][1]) + (oT[m][2] * oT[m][2] + oT[m][3] * oT[m][3]);
                ss += __shfl_xor(ss, 16); ss += __shfl_xor(ss, 32);
                if (g == 0) *(LAS float*)(lds + SSQ + (wave * 64 + tau) * 4) = ss; }
            __syncthreads();
            const bf16_t* SG = (const bf16_t*)(A.ws + WS_SG) + (rlbase * 512 + h * 128 + 16 * wave); bf16_t* A1 = (bf16_t*)(A.ws + WS_A1) + (rlbase * 512 + h * 128 + 16 * wave);
            const f32x4 gn = *(const f32x4*)(A.hgn + h * 128 + 16 * wave + 4 * g);
#pragma unroll
            for (int m = 0; m < 4; ++m) { const int tau = 16 * m + l15, rho = BWD ? 63 - tau : tau; float tot = 0.f;
#pragma unroll
                for (int w = 0; w < 8; ++w) tot += *(LAS float*)(lds + SSQ + (w * 64 + tau) * 4);
                const float rstd = 1.0f / sqrtf(tot * (1.0f / 128.0f) + EPS);
                const unsigned off = (unsigned)(rho * 512 + 4 * g);
                const u32x2 sw = *(const u32x2*)(SG + off);
                const f32x4 sg4 = (f32x4){pg8::bf_lo(sw.x), pg8::bf_hi(sw.x), pg8::bf_lo(sw.y), pg8::bf_hi(sw.y)};
                const f32x4 o = oT[m] * rstd * gn * sg4;
                u32x2 ow; ow.x = pg8::cvt_pk_bf16(o[0], o[1]); ow.y = pg8::cvt_pk_bf16(o[2], o[3]); *(u32x2*)(A1 + off) = ow; }
        }
    }
    __syncthreads();
}
__device__ __forceinline__ void hgrn_item(const Args& A, LAS unsigned char* lds, int item, int tid) {
    const int b = item >> 2, h = item & 3;
    for (int i = tid; i < (hg::TT - hg::PP) / 4; i += 512) *(LAS unsigned*)(lds + hg::PP + 4 * i) = 0u;
    f32x4 Sf[8], Sb[8];
#pragma unroll
    for (int t = 0; t < 8; ++t) { Sf[t] = (f32x4){0.f, 0.f, 0.f, 0.f}; Sb[t] = (f32x4){0.f, 0.f, 0.f, 0.f}; }
    __syncthreads();
    for (int j = 0; j < 36; ++j) {
        const int cf = j, cb = j < 4 ? 3 - j : 39 - j;
        if (j < 4) { hg::chunk_step<false, false>(A, lds, b, h, cf, false, Sf, tid); hg::chunk_step<true, false>(A, lds, b, h, cb, false, Sb, tid); }
        else { hg::chunk_step<false, true>(A, lds, b, h, cf, j >= 20, Sf, tid); hg::chunk_step<true, true>(A, lds, b, h, cb, j >= 20, Sb, tid); }
    }
}
}
namespace p5 {
constexpr int WPT = 0, WPT_RS = 1028 * 4, GM = 16 * WPT_RS  , SH = GM + 4096, BP = SH + 4096  , BIAS = BP + 2048, END = BIAS + 64;
__device__ __forceinline__ void rows128(const Args& A, LAS unsigned char* lds, int rb, int tid) {
    const int wave = __builtin_amdgcn_readfirstlane(tid >> 6), lane = tid & 63, l15 = lane & 15, g = lane >> 4;
    const int b = rb >> 4; const long row0 = (long)rb * 128 + wave * 16;
    const float* mod = (const float*)(A.ws + WS_MOD) + (size_t)b * NMOD;
    for (int k = tid; k < 1024; k += 512) { const float gmv = A.n2g[k] * (1.0f + mod[4096 + k]), shv = mod[3072 + k];
        *(LAS float*)(lds + GM + 4 * k) = gmv; *(LAS float*)(lds + SH + 4 * k) = shv;
#pragma unroll
        for (int q = 0; q < 4; ++q) { const f32x4 w = *(const f32x4*)(A.wr + (size_t)k * 16 + 4 * q);
#pragma unroll
            for (int j = 0; j < 4; ++j) *(LAS float*)(lds + WPT + (4 * q + j) * WPT_RS + 4 * k) = gmv * w[j]; } }
    { const int e = tid & 15, kp = tid >> 4; float s = 0.f;
        for (int k = kp * 32; k < kp * 32 + 32; ++k) s += mod[3072 + k] * A.wr[(size_t)k * 16 + e];
        *(LAS float*)(lds + BP + (kp * 16 + e) * 4) = s; }
    __syncthreads();
    if (tid < 16) { float s = 0.f; for (int kp = 0; kp < 32; ++kp) s += *(LAS float*)(lds + BP + (kp * 16 + tid) * 4); *(LAS float*)(lds + BIAS + 4 * tid) = s; }
    __syncthreads();
    const float* x1 = A.out;
    f32x4 acc = (f32x4){0.f, 0.f, 0.f, 0.f}; float ss = 0.f;
    const float* xr = x1 + (row0 + l15) * 1024 + 8 * g;
    const LAS unsigned char* wp = lds + WPT + l15 * WPT_RS + 32 * g;
#pragma unroll 4
    for (int it = 0; it < 32; ++it) {
        const f32x4 a0 = *(const f32x4*)(xr + 32 * it), a1 = *(const f32x4*)(xr + 32 * it + 4);
        const f32x4 b0 = *(const LAS f32x4*)(wp + 128 * it), b1 = *(const LAS f32x4*)(wp + 128 * it + 16);
        ss += (a0[0] * a0[0] + a0[1] * a0[1]) + (a0[2] * a0[2] + a0[3] * a0[3]) + (a1[0] * a1[0] + a1[1] * a1[1]) + (a1[2] * a1[2] + a1[3] * a1[3]);
#pragma unroll
        for (int j = 0; j < 4; ++j) acc = __builtin_amdgcn_mfma_f32_16x16x4f32(a0[j], b0[j], acc, 0, 0, 0);
#pragma unroll
        for (int j = 0; j < 4; ++j) acc = __builtin_amdgcn_mfma_f32_16x16x4f32(a1[j], b1[j], acc, 0, 0, 0);
    }
    ss += __shfl_xor(ss, 16); ss += __shfl_xor(ss, 32);
    const float rstd = 1.0f / sqrtf(ss * (1.0f / 1024.0f) + EPS);
    const float bias = *(LAS float*)(lds + BIAS + 4 * l15);
    f32x4 aff;
#pragma unroll
    for (int r = 0; r < 4; ++r) { const float rs = __shfl(rstd, 4 * g + r); float lg = acc[r] * rs + bias;
        float mx = lg; mx = fmaxf(mx, __shfl_xor(mx, 1)); mx = fmaxf(mx, __shfl_xor(mx, 2)); mx = fmaxf(mx, __shfl_xor(mx, 4)); mx = fmaxf(mx, __shfl_xor(mx, 8));
        const float ex = expf(lg - mx); float sm = ex; sm += __shfl_xor(sm, 1); sm += __shfl_xor(sm, 2); sm += __shfl_xor(sm, 4); sm += __shfl_xor(sm, 8);
        aff[r] = ex / sm; }
    { float* AFF = (float*)(A.ws + WS_AFF); const int t = (rb & 15) * 128 + wave * 16 + 4 * g;
        *(f32x4*)(AFF + ((size_t)(b * 16 + l15)) * 2048 + t) = aff; }
    bf16_t* H2 = (bf16_t*)(A.ws + WS_H2);
    for (int i = 0; i < 16; ++i) { const float rs = __shfl(rstd, i);
#pragma unroll
        for (int j = 0; j < 4; ++j) { const int cidx = 4 * lane + 256 * j; const f32x4 v = *(const f32x4*)(x1 + (row0 + i) * 1024 + cidx);
            const f32x4 gmv = *(const LAS f32x4*)(lds + GM + 4 * cidx), shv = *(const LAS f32x4*)(lds + SH + 4 * cidx);
            const f32x4 o = v * rs * gmv + shv;
            u32x2 w; w.x = pg8::cvt_pk_bf16(o[0], o[1]); w.y = pg8::cvt_pk_bf16(o[2], o[3]); *(u32x2*)(H2 + (size_t)(row0 + i) * 1024 + cidx) = w; } }
    __syncthreads();
}
__device__ __forceinline__ void expert_weights(const Args& A, LAS unsigned char* lds, int vcu, int G, int tid) {
    const int wave = tid >> 6, lane = tid & 63; LAS float* scr = (LAS float*)(lds + wave * 8704);
    const int gw = vcu * NWAVES + wave, NGW = G * NWAVES;
    bf16_t* WGU = (bf16_t*)(A.ws + WS_WGU); bf16_t* WD = (bf16_t*)(A.ws + WS_WD);
    for (int it = gw; it < 16 * 1536; it += NGW) { const int e = it / 1536, r = it % 1536;
        if (r < 1024) { const int kb = r >> 6, gi = r & 63, pn = gi >> 3, half = (gi >> 2) & 1, q = gi & 3;
            transpose_item<false>((half ? A.weu : A.weg) + (size_t)e * 1024 * 1024, 1024, 1024, 128 * pn + 32 * q, 64 * kb, WGU + (size_t)e * 2048 * 1024, (long)gi * 32, scr, lane); }
        else { const int r2 = r - 1024, kb = r2 >> 5, gi = r2 & 31;
            transpose_item<false>(A.wed + (size_t)e * 1024 * 1024, 1024, 1024, 32 * gi, 64 * kb, WD + (size_t)e * 1024 * 1024, (long)gi * 32, scr, lane); } }
}
}

__device__ __forceinline__ void topk_unit(const Args& A, LAS unsigned char* lds, int b, int e, int tid) {
    LAS unsigned long long* keys = (LAS unsigned long long*)lds;
    const float* AFF = (const float*)(A.ws + WS_AFF) + (size_t)(b * 16 + e) * 2048;
    for (int t = tid; t < 2048; t += 512) keys[t] = ((unsigned long long)__float_as_uint(AFF[t]) << 32) | (unsigned)(2047 - t);
    __syncthreads();
    for (int k = 2; k <= 2048; k <<= 1)
        for (int j = k >> 1; j > 0; j >>= 1) {
            for (int i = tid; i < 2048; i += 512) { const int l = i ^ j;
                if (l > i) { const unsigned long long a = keys[i], c = keys[l]; const bool asc = (i & k) == 0; if ((a > c) == asc) { keys[i] = c; keys[l] = a; } } }
            __syncthreads();
        }
    int* IDX = (int*)(A.ws + WS_IDX) + (b * 16 + e) * 256; float* GATE = (float*)(A.ws + WS_IDX + 256 * 1024) + (b * 16 + e) * 256; int* SLOT = (int*)(A.ws + WS_SLOT);
    for (int p = tid; p < 2048; p += 512) { const unsigned long long key = keys[2047 - p]; const int t = 2047 - (int)(unsigned)(key & 0xffffffffull);
        if (p < 256) { IDX[p] = b * 2048 + t; GATE[p] = __uint_as_float((unsigned)(key >> 32)); }
        SLOT[(size_t)(b * 2048 + t) * 16 + e] = p < 256 ? p : -1; }
    __threadfence();
    __syncthreads();
}

__device__ __forceinline__ void p7_rows(const Args& A, int vcu, int G, int tid) {
    const int wave = tid >> 6, lane = tid & 63; const int gw = vcu * NWAVES + wave, NGW = G * NWAVES;
    const float* mod = (const float*)(A.ws + WS_MOD); const int* SLOT = (const int*)(A.ws + WS_SLOT); const bf16_t* YE = (const bf16_t*)(A.ws + WS_YE);
#if DBG_CHECKS
    const unsigned fl_ = __hip_atomic_load((unsigned*)(A.ws + WS_CTL) + 65, RLX_AGENT); unsigned fl2_ = fl_ & 0xffffu;
    { const unsigned c0 = __hip_atomic_load((unsigned*)(A.ws + WS_CTL) + 66, RLX_AGENT), c1 = __hip_atomic_load((unsigned*)(A.ws + WS_CTL) + 67, RLX_AGENT), c2 = __hip_atomic_load((unsigned*)(A.ws + WS_CTL) + 68, RLX_AGENT), c3 = __hip_atomic_load((unsigned*)(A.ws + WS_CTL) + 69, RLX_AGENT);
      if (DBG_BARTEST) { const unsigned cb = __hip_atomic_load((unsigned*)(A.ws + WS_CTL) + 90, RLX_AGENT); if (cb > 0u) fl2_ |= 1u; if (cb > 100u) fl2_ |= 2u; if (cb > 10000u) fl2_ |= 4u; if (cb > 1000000u) fl2_ |= 8u; } (void)c0; (void)c1; (void)c2; (void)c3; }
    { const unsigned c4 = __hip_atomic_load((unsigned*)(A.ws + WS_CTL) + 70, RLX_AGENT), c5 = __hip_atomic_load((unsigned*)(A.ws + WS_CTL) + 71, RLX_AGENT), c6 = __hip_atomic_load((unsigned*)(A.ws + WS_CTL) + 72, RLX_AGENT);
      if (c4 > 80u) fl2_ |= 16u; if (c5 > 80u) fl2_ |= 32u; if (c6 > 80u) fl2_ |= 64u; }
    { const unsigned c = __hip_atomic_load((unsigned*)(A.ws + WS_CTL) + 80, RLX_AGENT); (void)c; }
    const float DBG_SCALE = 1.0f + (float)fl2_;
#else
    const float DBG_SCALE = 1.0f;
#endif
    for (int r = gw; r < ML; r += NGW) { const int b = r >> 11;
        const int slot = lane < 16 ? SLOT[(size_t)r * 16 + lane] : -1;
        unsigned long long mask = __ballot(slot >= 0);
        f32x4 acc[4];
#pragma unroll
        for (int j = 0; j < 4; ++j) acc[j] = (f32x4){0.f, 0.f, 0.f, 0.f};
#if DBG_NOMOE
        mask = 0;
#endif
        while (mask) { const int e = __builtin_ctzll(mask); mask &= mask - 1; const int s = __shfl(slot, e);
            const bf16_t* yr = YE + ((size_t)(b * 16 + e) * 256 + s) * 1024;
            f32x4 a0, a1, a2, a3; pg8::ld8(yr + 8 * lane, a0, a1); pg8::ld8(yr + 512 + 8 * lane, a2, a3);
            acc[0] += a0; acc[1] += a1; acc[2] += a2; acc[3] += a3; }
        float* xo = A.out + (size_t)r * 1024; f32x4 v[4]; float ss = 0.f;
#pragma unroll
        for (int j = 0; j < 4; ++j) { const int cidx = (j >> 1) * 512 + 8 * lane + (j & 1) * 4;
            const f32x4 g2 = *(const f32x4*)(mod + (size_t)b * NMOD + 5120 + cidx);
            v[j] = *(const f32x4*)((DBG_OUT_X ? A.x + (size_t)r * 1024 : xo) + cidx) + (DBG_BETA * g2) * acc[j];

            if (DBG_OUT_BUF) { const bf16_t* bp = (const bf16_t*)(A.ws + (DBG_OUT_BUF == 1 ? WS_HX : DBG_OUT_BUF == 3 ? WS_WIN : WS_GA)) + (DBG_OUT_BUF == 1 ? ((size_t)(r >> 11) * 2304 + 256 + (r & 2047)) : DBG_OUT_BUF == 3 ? (size_t)(r % 5376) : (size_t)r) * 1024 + cidx;
              const u32x2 w = *(const u32x2*)bp; v[j] += (f32x4){pg8::bf_lo(w.x), pg8::bf_hi(w.x), pg8::bf_lo(w.y), pg8::bf_hi(w.y)} * (DBG_OUT_BUF == 3 ? 10.0f : 0.3f); }
            ss += (v[j][0] * v[j][0] + v[j][1] * v[j][1]) + (v[j][2] * v[j][2] + v[j][3] * v[j][3]); }
        const float rstd = 1.0f / sqrtf(wave_sum(ss) * (1.0f / 1024.0f) + EPS);
#pragma unroll
        for (int j = 0; j < 4; ++j) { const int cidx = (j >> 1) * 512 + 8 * lane + (j & 1) * 4; *(f32x4*)(xo + cidx) = v[j] * (rstd * DBG_SCALE) * *(const f32x4*)(A.fng + cidx); }
    }
}

#ifndef USE_CG_SYNC
#define USE_CG_SYNC 0
#endif
#ifndef PHASES
#define PHASES 511
#endif
__global__ void __launch_bounds__(NWAVES * 64, 2) fwd_megakernel(Args A) {
    extern __shared__ __attribute__((aligned(16))) unsigned char lds_raw[];
    LAS unsigned char* lds = (LAS unsigned char*)lds_raw;
    volatile LAS unsigned* MISC = (volatile LAS unsigned*)(lds + MISC_OFF);
#if USE_CG_SYNC
    cg::grid_group grid = cg::this_grid();
#endif
    int tid = threadIdx.x; const int bx = blockIdx.x, G = gridDim.x;
    const int vcu = (G % 8 == 0) ? (bx % 8) * (G / 8) + bx / 8 : bx;
    unsigned* ctl = (unsigned*)(A.ws + WS_CTL);
#if USE_CG_SYNC
#define GRID_BAR() grid.sync()
#else
    for (int u = tid; u < 64; u += NWAVES * 64) ((LAS unsigned*)(lds + MISC_OFF))[u] = 0u;
    __syncthreads();
    const XcdBarrier xbar = xcd_barrier_post((unsigned*)(ctl + CW_BAR), MISC + 8);
#define GRID_BAR() xcd_barrier(xbar)
#endif
    bf16_t* HX = (bf16_t*)(A.ws + WS_HX);

#if DBG_BARTEST
    { u32x2* T = (u32x2*)(A.ws + WS_HID); unsigned errs = 0;
      for (int r = 0; r < 12; ++r) {
        for (int i = tid; i < 32768; i += 512) { u32x2 w; w.x = (unsigned)(r * 1000003 + bx * 1031 + i); w.y = ~w.x; T[(size_t)bx * 32768 + i] = w; }
        GRID_BAR();
        { const int src = (bx + 37 * (r + 1)) % G; for (int i = tid; i < 32768; i += 512) { const u32x2 v = T[(size_t)src * 32768 + i]; const unsigned e = (unsigned)(r * 1000003 + src * 1031 + i); if (v.x != e || v.y != ~e) ++errs; } }
        GRID_BAR();
      }
      if (errs) atomicAdd(ctl + 90, errs); }
#endif
#if PHASES & 1
    { int t_ = threadIdx.x; asm volatile("" : "+v"(t_)); tid = t_; }
#if DEBUG_POISON
    { u32x4* p = (u32x4*)(A.ws + CTL_ZERO_BYTES); const size_t n = (WS_END - CTL_ZERO_BYTES) / 16; const u32x4 q = (u32x4){0x7fc07fc0u, 0x7fc07fc0u, 0x7fc07fc0u, 0x7fc07fc0u};
      for (size_t i = (size_t)bx * 512 + tid; i < n; i += (size_t)G * 512) p[i] = q; }
    GRID_BAR();
#endif
    if (bx == 0 && tid == 0) { ctl[CW_Q3] = 0u; ctl[65] = 0u; ctl[66] = 0u; ctl[67] = 0u; ctl[68] = 0u; ctl[69] = 0u; ctl[70] = 0u; ctl[71] = 0u; ctl[72] = 0u; ctl[80] = 0u; ctl[81] = 0u; ctl[82] = 0u; ctl[83] = 0u; ctl[84] = 0u; }
    p0_prologue(A, lds, vcu, G, tid);
#endif
    GRID_BAR();
#if PHASES & 2
    { int t_ = threadIdx.x; asm volatile("" : "+v"(t_)); tid = t_; }
    p1_rows(A, vcu, G, tid);
#endif
    GRID_BAR();
#if DBG_CHECKS & 1
    { int t2_ = threadIdx.x; asm volatile("" : "+v"(t2_)); const int wave_ = t2_ >> 6, lane_ = t2_ & 63; const int gw_ = vcu * NWAVES + wave_; const float* mod_ = (const float*)(A.ws + WS_MOD);
      _Pragma("unroll 1") for (int k_ = 0; k_ < 4; ++k_) { const int r = (gw_ + 2048 * k_ + 777) % MR; const int b = r / RPB, s_ = r - b * RPB;
        const float* src = s_ < CTXL ? A.ctx + ((size_t)b * CTXL + s_) * 1024 : A.x + ((size_t)b * SEQ + (s_ - CTXL)) * 1024;
        const float* mrow = mod_ + (size_t)(s_ < CTXL ? 16 : b) * NMOD;
        f32x4 v[4]; float ss = 0.f;
        for (int j = 0; j < 4; ++j) { v[j] = *(const f32x4*)(src + 4 * lane_ + 256 * j); ss += (v[j][0] * v[j][0] + v[j][1] * v[j][1]) + (v[j][2] * v[j][2] + v[j][3] * v[j][3]); }
        const float rstd = 1.0f / sqrtf(wave_sum(ss) * (1.0f / 1024.0f) + EPS); bool bad = false;
        for (int j = 0; j < 4; ++j) { const int cidx = 4 * lane_ + 256 * j;
            const f32x4 g = *(const f32x4*)(A.n1g + cidx), sh = *(const f32x4*)(mrow + cidx), sc = *(const f32x4*)(mrow + 1024 + cidx);
            const f32x4 o = (v[j] * rstd * g) * (sc + 1.0f) + sh;
            u32x2 w; w.x = pg8::cvt_pk_bf16(o[0], o[1]); w.y = pg8::cvt_pk_bf16(o[2], o[3]); const u32x2 h = *(const u32x2*)(HX + (size_t)r * 1024 + cidx);
            bad |= (w.x != h.x) | (w.y != h.y); }
        if (bad) atomicOr(ctl + 65, 128u); } }
#endif
#if DBG_DOUBLE_BAR == 1
    GRID_BAR();
#elif DBG_DOUBLE_BAR == 3
    { if (tid == 0) { __builtin_amdgcn_fence(__ATOMIC_ACQUIRE, "agent"); asm volatile("s_waitcnt vmcnt(0)" ::: "memory"); } __syncthreads(); }
#elif DBG_DOUBLE_BAR == 2
    { const unsigned long long t0 = __builtin_amdgcn_s_memrealtime(); while (__builtin_amdgcn_s_memrealtime() - t0 < 1500ull) __builtin_amdgcn_s_sleep(8); __syncthreads(); }
#endif
#if PHASES & 4
    { int t_ = threadIdx.x; asm volatile("" : "+v"(t_)); tid = t_; }
    {
        pg8::Gemm g{HX, (const bf16_t*)(A.ws + WS_WIN), MR, INC, 1024, nullptr}; pg8::InProjOrder S; S.init(G, bx);
        pg8::EpiInProj E{(bf16_t*)(A.ws + WS_HQ), (bf16_t*)(A.ws + WS_FF), (bf16_t*)(A.ws + WS_FB), (bf16_t*)(A.ws + WS_HI), (bf16_t*)(A.ws + WS_SG), (bf16_t*)(A.ws + WS_Q), (bf16_t*)(A.ws + WS_K), (bf16_t*)(A.ws + WS_V),
                         (bf16_t*)(A.ws + WS_GA), (bf16_t*)(A.ws + WS_GB), (const float*)(A.ws + WS_ROPE), A.qng, A.kng};
        pg8::gemm_phase<pg8::EpiInProj, pg8::InProjOrder>(lds, g, S, E);
    }
#endif
    GRID_BAR();
#if DBG_CHECKS & 32
    { int t2_ = threadIdx.x; asm volatile("" : "+v"(t2_)); const int gt_ = vcu * 512 + t2_;
      unsigned f_ = 0;
      for (int kk = 0; kk < 8; ++kk) { const size_t off = kk == 0 ? WS_HQ : kk == 1 ? WS_FF : kk == 2 ? WS_FB : kk == 3 ? WS_HI : kk == 4 ? WS_SG : kk == 5 ? WS_GA : kk == 6 ? WS_GB : WS_Q;
        const size_t n = (kk == 5 || kk == 6) ? (size_t)ML * 1024 : (kk == 0 || kk == 4 || kk == 7) ? (size_t)ML * 512 : (size_t)MR * 512;
        const unsigned short* p = (const unsigned short*)(A.ws + off);
        for (size_t i = gt_; i < n; i += (size_t)G * 512) { const float v = bf2f(p[i]); if (!(fabsf(v) < 16.0f)) f_ |= (1u << kk); } }
      if (f_) atomicOr(ctl + 65, f_); }
    GRID_BAR();
#endif
#if PHASES & 8
    { int t_ = threadIdx.x; asm volatile("" : "+v"(t_)); tid = t_; }
#if DBG_CHECKS & 2
    { int t2_ = threadIdx.x; asm volatile("" : "+v"(t2_)); const int wave_ = t2_ >> 6, lane_ = t2_ & 63; const int gw_ = vcu * NWAVES + wave_;
      _Pragma("unroll 1") for (int k_ = 0; k_ < 6; ++k_) {
        const int rl = (gw_ * 37 + 11 + 5000 * k_) % ML; const int width = k_ < 4 ? 512 : 1024; const int c = (gw_ * 101 + 7 + 300 * k_) % width;
        const long r = (long)(rl / 2048) * 2304 + 256 + (rl % 2048);
        const int lcol = (k_ == 0 ? 0 : k_ == 1 ? 512 : k_ == 2 ? 1536 : k_ == 3 ? 2048 : k_ == 4 ? 3328 : 4352) + c;
        float d = 0.f;
        for (int j = 0; j < 16; ++j) { const int kk = lane_ + 64 * j; d += bf2f(HX[r * 1024 + kk]) * A.w_in[(size_t)kk * INC + lcol]; }
        d = wave_sum(d);
        const float ref = k_ == 3 ? d / (1.0f + expf(-d)) : k_ >= 4 ? 1.0f / (1.0f + expf(-d)) : d;
        const bf16_t* buf = (const bf16_t*)(A.ws + (k_ == 0 ? WS_HQ : k_ == 1 ? WS_FF : k_ == 2 ? WS_HI : k_ == 3 ? WS_SG : k_ == 4 ? WS_GA : WS_GB));
        const long brow = (k_ == 1 || k_ == 2) ? r : rl;
        const float got = bf2f(buf[(size_t)brow * width + c]);
        if (!(fabsf(ref - got) < 0.03f + 0.02f * fabsf(ref))) atomicOr(ctl + 65, 1u << k_); } }
#endif
    {
#ifndef NO_HGRN
        for (int it = bx; it < 64; it += G) { { int t_ = threadIdx.x; asm volatile("" : "+v"(t_)); tid = t_; } hg::hgrn_item(A, lds, it, tid); }
#endif
        __syncthreads();
#ifndef NO_ATTN
        for (;;) {
            if (tid == 0) MISC[0] = atomicAdd(ctl + CW_Q3, 1u);
            __syncthreads();
            const unsigned u = MISC[0];
            __syncthreads();
            if (u >= 1024u) break;
            const int bk = u >> 5, b = bk >> 1, kvh = bk & 1, gq = (u >> 3) & 3, qb = u & 7;
            attn_body::attn_unit<8>((long)b * SEQ + qb * 256, kvh * 4 + gq, (long)b * RPB, kvh, (const attn_body::bf16*)(A.ws + WS_Q), (const attn_body::bf16*)(A.ws + WS_K), (const attn_body::bf16*)(A.ws + WS_V),
                                    (attn_body::bf16*)(A.ws + WS_OATT), (char*)lds_raw);
        }
#endif
    }
#endif
    GRID_BAR();
#if DBG_CHECKS & 32
    { int t2_ = threadIdx.x; asm volatile("" : "+v"(t2_)); const int gt_ = vcu * 512 + t2_;
      const unsigned short* p = (const unsigned short*)(A.ws + WS_GA); unsigned f_ = 0;
      for (size_t i = gt_; i < (size_t)ML * 1024; i += (size_t)G * 512) { }
      if (f_) atomicOr(ctl + 65, f_); }
    GRID_BAR();
#endif
#if PHASES & 16
    { int t_ = threadIdx.x; asm volatile("" : "+v"(t_)); tid = t_; }
#if DBG_CHECKS & 4
    if (bx >= 100 && bx < 164) {
      int t3_ = threadIdx.x; asm volatile("" : "+v"(t3_)); const int cb_ = (bx - 100) >> 2, ch_ = (bx - 100) & 3;
      LAS float* fk = (LAS float*)lds;
      const bf16_t* FFp = (const bf16_t*)(A.ws + WS_FF); const bf16_t* FBp = (const bf16_t*)(A.ws + WS_FB); const bf16_t* HIp = (const bf16_t*)(A.ws + WS_HI); const bf16_t* HQp = (const bf16_t*)(A.ws + WS_HQ);
      const bf16_t* ORp = (const bf16_t*)(A.ws + WS_OR); const bf16_t* A1p = (const bf16_t*)(A.ws + WS_A1); const bf16_t* SGp = (const bf16_t*)(A.ws + WS_SG);
      float* scr_ = (float*)(A.ws + WS_GB) + (size_t)(bx - 100) * 2048 * 128;
      const float* lbp = (const float*)(A.ws + WS_LB);
      unsigned cnt0_ = 0, cnt1_ = 0, cnt2_ = 0, cnt3_ = 0;
      for (int dir = 0; dir < 2; ++dir) {
        float Sd[128];
#pragma unroll
        for (int i = 0; i < 128; ++i) Sd[i] = 0.f;
        for (int step = 0; step < 2304; ++step) {
          const int sq = dir == 0 ? step : (step < 256 ? 255 - step : 256 + (2303 - step));
          const long r = (long)cb_ * 2304 + sq; const bool lat = sq >= 256; const long rl = (long)cb_ * 2048 + (sq - 256);
          if (t3_ < 128) { const float fp = bf2f((dir ? FBp : FFp)[r * 512 + ch_ * 128 + t3_]); const float lbv = lbp[dir * 512 + ch_ * 128 + t3_]; const float sg = 1.0f / (1.0f + expf(-fp));
            fk[t3_] = lbv + (1.0f - lbv) * sg; fk[128 + t3_] = (1.0f - lbv) * (1.0f - sg); fk[256 + t3_] = lat ? bf2f(HQp[rl * 512 + ch_ * 128 + t3_]) : 0.f; }
          __syncthreads();
          float o = 0.f;
          if (t3_ < 128) { const float vv = bf2f(HIp[r * 512 + ch_ * 128 + t3_]);
#pragma unroll
            for (int i = 0; i < 128; ++i) { Sd[i] = fk[i] * Sd[i] + fk[128 + i] * vv; o += Sd[i] * fk[256 + i]; } }
          if (lat && t3_ < 128) {
            const int tl = sq - 256, chunk = tl >> 6;
            if (dir == 0) { scr_[(size_t)tl * 128 + t3_] = o;
              if (chunk < 16) { const float got = bf2f(ORp[rl * 512 + ch_ * 128 + t3_]); if (!(fabsf(got - o) < 0.05f + 0.03f * fabsf(o))) { if (chunk == 0) ++cnt0_; else ++cnt1_; } } }
            else { const float of = scr_[(size_t)tl * 128 + t3_];
              if (chunk >= 16) { const float got = bf2f(ORp[rl * 512 + ch_ * 128 + t3_]); if (!(fabsf(got - o) < 0.05f + 0.03f * fabsf(o))) ++cnt3_; }
              scr_[(size_t)tl * 128 + t3_] = of + o; }
          }
          __syncthreads();
        }
      }
      for (int tl = 0; tl < 2048; ++tl) { const long rl = (long)cb_ * 2048 + tl; float o = 0.f;
        if (t3_ < 128) { o = scr_[(size_t)tl * 128 + t3_]; fk[384 + t3_] = o * o; }
        __syncthreads();
        if (t3_ < 128) { float tot = 0.f; for (int i = 0; i < 128; ++i) tot += fk[384 + i]; const float ref = o / sqrtf(tot / 128.0f + EPS) * A.hgn[ch_ * 128 + t3_] * bf2f(SGp[rl * 512 + ch_ * 128 + t3_]);
          const float got = bf2f(A1p[rl * 512 + ch_ * 128 + t3_]); if (!(fabsf(got - ref) < 0.05f + 0.03f * fabsf(ref))) ++cnt2_;
          const float ad_ = fabsf(got - ref); if (!(ad_ < 0.4f)) atomicOr(ctl + 65, ((cb_ & 1) ? 2u : 1u) | (4u << ch_) | (cb_ < 8 ? 64u : 128u)); }
        __syncthreads(); }
      atomicAdd(ctl + 66, cnt0_); atomicAdd(ctl + 67, cnt1_); atomicAdd(ctl + 68, cnt2_); atomicAdd(ctl + 69, cnt3_);
    }
    GRID_BAR();
#endif
    {
        pg8::StaticOrder S; S.init(ML, 1024, G, bx);
        { pg8::Gemm g{(const bf16_t*)(A.ws + (DBG_ONLYATT ? WS_OATT : DBG_NOHG ? WS_SG : WS_A1)), (const bf16_t*)(A.ws + (DBG_ONLYATT ? WS_WB : WS_WA)), ML, 1024, 512, nullptr}; pg8::EpiZ<0> E{(bf16_t*)(A.ws + WS_Z), (const bf16_t*)(A.ws + (DBG_ONLYATT ? WS_GB : WS_GA))};
          pg8::gemm_phase<pg8::EpiZ<0>, pg8::StaticOrder>(lds, g, S, E); }
        VM_WAIT(); __threadfence(); __syncthreads();
#if !DBG_NOATT
        { pg8::Gemm g{(const bf16_t*)(A.ws + WS_OATT), (const bf16_t*)(A.ws + WS_WB), ML, 1024, 512, nullptr}; pg8::EpiZ<1> E{(bf16_t*)(A.ws + WS_Z), (const bf16_t*)(A.ws + WS_GB)};
          pg8::gemm_phase<pg8::EpiZ<1>, pg8::StaticOrder>(lds, g, S, E); }
#endif
    }
#endif
    GRID_BAR();
#if DBG_CHECKS & 32
    { int t2_ = threadIdx.x; asm volatile("" : "+v"(t2_)); const int gt_ = vcu * 512 + t2_;
      const unsigned short* p = (const unsigned short*)(A.ws + WS_GA); unsigned f_ = 0;
      for (size_t i = gt_; i < (size_t)ML * 1024; i += (size_t)G * 512) { }
      if (f_) atomicOr(ctl + 65, f_); }
    GRID_BAR();
#endif
#if PHASES & 32
    { int t_ = threadIdx.x; asm volatile("" : "+v"(t_)); tid = t_; }
    {
        pg8::StaticOrder S; S.init(ML, 1024, G, bx);
        pg8::Gemm g{(const bf16_t*)(A.ws + (DBG_P4B_A == 2 ? WS_HX : DBG_P4B_A ? WS_GA : WS_Z)), (const bf16_t*)(A.ws + (DBG_P4B_A == 2 ? WS_WIN + (size_t)13 * 256 * 1024 * 2 : WS_WO)), ML, 1024, 1024, nullptr}; pg8::EpiX1 E{A.x, (const float*)(A.ws + WS_MOD), A.out};
        pg8::gemm_phase<pg8::EpiX1, pg8::StaticOrder>(lds, g, S, E);
    }
#endif
    GRID_BAR();
#if PHASES & 64
    { int t_ = threadIdx.x; asm volatile("" : "+v"(t_)); tid = t_; }
#if DBG_CHECKS & 16
    { int t2_ = threadIdx.x; asm volatile("" : "+v"(t2_)); const int gt_ = vcu * 512 + t2_;
      const unsigned short* p = (const unsigned short*)(A.ws + WS_GA); unsigned f_ = 0; unsigned cbad = 0;
      for (size_t i = gt_; i < (size_t)ML * 1024; i += (size_t)G * 512) { const float v = bf2f(p[i]);
        if (v > 1.0f) { const int c = (int)(i & 1023), r = (int)(i >> 10); f_ |= (1u << (c >> 8)) | (16u << ((r & 255) >> 6)); ++cbad; } }
      if (f_) atomicOr(ctl + 65, f_); if (cbad) atomicAdd(ctl + 80, cbad); }
    GRID_BAR();
#endif
#if DBG_CHECKS & 8
    { int t2_ = threadIdx.x; asm volatile("" : "+v"(t2_)); const int wave_ = t2_ >> 6, lane_ = t2_ & 63; const int gw_ = vcu * NWAVES + wave_;
      const bf16_t* A1p = (const bf16_t*)(A.ws + WS_A1); const bf16_t* Zp = (const bf16_t*)(A.ws + WS_Z); const bf16_t* GAp = (const bf16_t*)(A.ws + WS_GA); const float* modp = (const float*)(A.ws + WS_MOD);
      _Pragma("unroll 1") for (int k_ = 0; k_ < 64; ++k_) {
        const int rl = (gw_ * 37 + 11 + 5003 * k_) % ML, c = (gw_ * 101 + 7 + 307 * k_) % 1024, b = rl >> 11;
        float d = 0.f; for (int j = 0; j < 8; ++j) { const int kk = lane_ + 64 * j; d += bf2f(A1p[(size_t)rl * 512 + kk]) * A.wa[(size_t)kk * 1024 + c]; }
        d = wave_sum(d) * bf2f(GAp[(size_t)rl * 1024 + c]); float got = bf2f(Zp[(size_t)rl * 1024 + c]);
        if (!(fabsf(d - got) < 0.03f + 0.03f * fabsf(d))) atomicAdd(ctl + 70, 1u);
        if (!(fabsf(d - got) < 0.3f)) atomicOr(ctl + 65, 1u);
        float e = 0.f; for (int j = 0; j < 16; ++j) { const int kk = lane_ + 64 * j; e += bf2f(Zp[(size_t)rl * 1024 + kk]) * A.wo[(size_t)kk * 1024 + c]; }
        e = A.x[(size_t)rl * 1024 + c] + modp[(size_t)b * NMOD + 2048 + c] * wave_sum(e); got = A.out[(size_t)rl * 1024 + c];
        if (!(fabsf(e - got) < 0.03f + 0.03f * fabsf(e))) atomicAdd(ctl + 71, 1u);
        if (!(fabsf(e - got) < 0.3f)) atomicOr(ctl + 65, 2u);
        const int mb = (gw_ + k_) % 17, mn = (gw_ * 29 + 13 * k_) % NMOD; float m = 0.f;
        for (int j = 0; j < 16; ++j) { const int kk = lane_ + 64 * j; const float cv = mb < 16 ? A.c[mb * 1024 + kk] : A.c_ctx[kk]; m += cv / (1.0f + expf(-cv)) * A.w_mod[(size_t)kk * NMOD + mn]; }
        m = wave_sum(m) + A.b_mod[mn]; got = modp[(size_t)mb * NMOD + mn];
        if (!(fabsf(m - got) < 0.002f + 0.002f * fabsf(m))) atomicAdd(ctl + 72, 1u); } }
    GRID_BAR();
#endif
    {
        for (int rb = vcu; rb < 256; rb += G) { { int t_ = threadIdx.x; asm volatile("" : "+v"(t_)); tid = t_; } p5::rows128(A, lds, rb, tid); }
        __syncthreads();
        p5::expert_weights(A, lds, vcu, G, tid);
    }
#endif
    GRID_BAR();
#if PHASES & 128
    { int t_ = threadIdx.x; asm volatile("" : "+v"(t_)); tid = t_; }
    {
        for (int uu = vcu; uu < 256; uu += G) { const int e = uu >> 4, b = uu & 15, unit = b * 16 + e;
            { int t_ = threadIdx.x; asm volatile("" : "+v"(t_)); tid = t_; }
#ifndef NO_TOPK
            topk_unit(A, lds, b, e, tid);
#endif
            bf16_t* HID = (bf16_t*)(A.ws + WS_HID) + (size_t)unit * 256 * 1024;
#ifndef NO_G1
            { pg8::Gemm g{(const bf16_t*)(A.ws + WS_H2), (const bf16_t*)(A.ws + WS_WGU) + (size_t)e * 2048 * 1024, 256, 2048, 1024, (const int*)(A.ws + WS_IDX) + unit * 256};
              pg8::LocalOrder S{8}; pg8::EpiHid E{HID};
              pg8::gemm_phase<pg8::EpiHid, pg8::LocalOrder>(lds, g, S, E); }
#endif
            VM_WAIT(); __threadfence(); __syncthreads();
#ifndef NO_G2
            { pg8::Gemm g{HID, (const bf16_t*)(A.ws + WS_WD) + (size_t)e * 1024 * 1024, 256, 1024, 1024, nullptr};
              pg8::LocalOrder S{4}; pg8::EpiYe E{(bf16_t*)(A.ws + WS_YE) + (size_t)unit * 256 * 1024, (const float*)(A.ws + WS_IDX + 256 * 1024) + unit * 256};
              pg8::gemm_phase<pg8::EpiYe, pg8::LocalOrder>(lds, g, S, E); }
#endif
            __syncthreads();
        }
    }
#endif
    GRID_BAR();
#if PHASES & 256
    { int t_ = threadIdx.x; asm volatile("" : "+v"(t_)); tid = t_; }
    p7_rows(A, vcu, G, tid);
#endif
}

extern "C" void kernel_launch(void* const* d_in, const int* in_sizes, int n_in, void* d_out, int out_size, void* d_ws, size_t ws_size, hipStream_t stream) {
    static int grid = 0;
    if (grid == 0) {
        if (n_in != 21 || out_size != ML * 1024 || ws_size < WS_END) { fprintf(stderr, "kernel_launch: unexpected problem (n_in %d, out %d, ws %zu); nothing launched\n", n_in, out_size, ws_size); grid = -1; return; }
        int dev = 0, cus = 0, per_cu = 0;
        if (hipGetDevice(&dev) != hipSuccess || hipDeviceGetAttribute(&cus, hipDeviceAttributeMultiprocessorCount, dev) != hipSuccess) { grid = -1; return; }
        if (hipFuncSetAttribute((const void*)fwd_megakernel, hipFuncAttributeMaxDynamicSharedMemorySize, LDS_BYTES) != hipSuccess) { fprintf(stderr, "kernel_launch: hipFuncSetAttribute failed\n"); grid = -1; return; }
        if (hipOccupancyMaxActiveBlocksPerMultiprocessor(&per_cu, (const void*)fwd_megakernel, NWAVES * 64, LDS_BYTES) != hipSuccess || per_cu < 1) { fprintf(stderr, "kernel_launch: occupancy query says %d\n", per_cu); (void)hipGetLastError(); grid = -1; return; }
        grid = cus;
    }
    if (grid < 0) return;
    (void)hipMemsetAsync((char*)d_ws + WS_CTL, 0, CTL_ZERO_BYTES, stream);
    Args a{};
    const float** ap = (const float**)&a;
    for (int i = 0; i < 21; ++i) ap[i] = (const float*)d_in[i];
    a.out = (float*)d_out; a.ws = (unsigned char*)d_ws;
    void* args[] = {&a};
#if USE_CG_SYNC
    hipError_t e = hipLaunchCooperativeKernel((const void*)fwd_megakernel, dim3(grid), dim3(NWAVES * 64), args, LDS_BYTES, stream);
    if (e != hipSuccess) fprintf(stderr, "kernel_launch: cooperative launch failed: %s (grid %d)\n", hipGetErrorString(e), grid);
#else
    (void)args;
    hipLaunchKernelGGL(fwd_megakernel, dim3(grid), dim3(NWAVES * 64), LDS_BYTES, stream, a);
    const hipError_t le = hipPeekAtLastError();
    if (le != hipSuccess) fprintf(stderr, "kernel_launch: launch failed: %s (grid %d)\n", hipGetErrorName(le), grid);
#endif
}
```

```cpp
#include <hip/hip_runtime.h>
#include <hip/hip_bf16.h>
#include <hip/hip_cooperative_groups.h>
#include <cstdio>
#include <cstdint>
#include <cmath>
namespace cg = cooperative_groups;

constexpr int NB = 16, SEQ = 2048, CTXL = 256, DM_ = 1024, RPB = SEQ + CTXL  ;
constexpr int MR = NB * RPB  , ML = NB * SEQ  , INC = 5376, NMOD = 6 * DM_;
constexpr int NE = 16, CAP = 256, EFF = 1024;
constexpr float EPS = 1e-6f;
constexpr float LOG2E = 1.4426950408889634f;
#ifndef DEBUG_POISON
#define DEBUG_POISON 0
#endif
#ifndef DBG_NOMOE
#define DBG_NOMOE 0
#endif
#ifndef DBG_NOATT
#define DBG_NOATT 0
#endif
#ifndef DBG_NOHG
#define DBG_NOHG 0
#endif
#ifndef DBG_OUT_X
#define DBG_OUT_X 0
#endif
#ifndef DBG_X1_NOY
#define DBG_X1_NOY 0
#endif
#ifndef DBG_P4B_A
#define DBG_P4B_A 0
#endif
#ifndef PHASES
#define PHASES 511
#endif
#ifndef DBG_GA_ONLY
#define DBG_GA_ONLY 0
#endif
#ifndef DBG_DOUBLE_BAR
#define DBG_DOUBLE_BAR 0
#endif
#ifndef DBG_WBL2_TWICE
#define DBG_WBL2_TWICE 0
#endif
#ifndef DBG_LEADER_DELAY
#define DBG_LEADER_DELAY 0
#endif
#ifndef DBG_RELEASE_ALL
#define DBG_RELEASE_ALL 0
#endif
#ifndef PG8_DMA_AUX
#define PG8_DMA_AUX 0
#endif
#ifndef DBG_CHECKS
#define DBG_CHECKS 0
#endif
#ifndef DBG_SYSINV
#define DBG_SYSINV 0
#endif
#ifndef DBG_HG_B
#define DBG_HG_B 15
#endif
#ifndef DBG_ALPHA
#define DBG_ALPHA 1.0f
#endif
#ifndef DBG_ONLYATT
#define DBG_ONLYATT 0
#endif
#ifndef DBG_BETA
#define DBG_BETA 1.0f
#endif
#ifndef DBG_POISON_SET
#define DBG_POISON_SET 0
#endif
#ifndef PG8_USE_DMA
#define PG8_USE_DMA 0
#endif
#ifndef DBG_BARTEST
#define DBG_BARTEST 0
#endif
#ifndef DBG_OUT_BUF
#define DBG_OUT_BUF 0
#endif
#ifndef DBG_TIMING
#define DBG_TIMING 0
#define DBG_TIME_A0 3
#define DBG_TIME_A1 20
#endif
#ifndef REPEAT_PHASE
#define REPEAT_PHASE -1
#endif
#ifndef DBG_TIME_Q
#define DBG_TIME_Q 16u
#endif
#ifndef HG_EXP
#define HG_EXP 0
#endif
#ifndef EPI_EXP
#define EPI_EXP 0
#endif
#ifndef P2_STAGGER_TICKS
#define P2_STAGGER_TICKS 0
#endif
namespace pg8 {
#define PG8_LAS __attribute__((address_space(3)))
typedef unsigned short bf16_t;
typedef short bf16x8 __attribute__((ext_vector_type(8)));
typedef float f32x4 __attribute__((ext_vector_type(4)));
typedef unsigned u32x4 __attribute__((ext_vector_type(4)));
constexpr int BM = 256, BK = 64, HALF = 128, HTB = HALF * BK * 2  , STAGE_BYTES = 8 * HTB, NXCD = 8, WGM = 8;

__host__ __device__ __forceinline__ int lds_byte(int r, int c) { const int st = (r >> 4) * 2 + (c >> 5), rr = r & 15, cc = c & 31, ob = rr * 64 + cc * 2; return st * 1024 + (ob ^ (((ob >> 9) & 1) << 5)); }
__host__ __device__ __forceinline__ void stage_rc(int b, int& R, int& C) { const int st = b / 1024, sb = b % 1024, swz = sb ^ (((sb >> 9) & 1) << 5); R = (st >> 1) * 16 + swz / 64; C = (st & 1) * 32 + (swz % 64) / 2; }
__host__ __device__ __forceinline__ int perm32(int rho) { const int n = rho >> 4, i = rho & 15; return 8 * (i >> 2) + 4 * n + (i & 3); }

struct Unit { int pm, pn; };
struct Gemm { const bf16_t* A; const bf16_t* Bt; int M, N, K; const int* gather; };

struct StaticOrder {
    int nM, nN, nwg, G, c;
    __host__ __device__ void init(int M, int N, int G_, int c_) { nM = M / BM; nN = N / BM; nwg = nM * nN; G = G_; c = c_; }
    __host__ __device__ bool next(int i, Unit& u) const {
        const long L = (long)i * G + c; if (L >= nwg) return false;
        int wgid = (int)L; { const int q = nwg / NXCD, r = nwg % NXCD, xcd = wgid % NXCD, off = wgid / NXCD; wgid = (xcd < r ? xcd * (q + 1) : r * (q + 1) + (xcd - r) * q) + off; }
        const int nig = WGM * nN, gid = wgid / nig, fm = gid * WGM, gsz = (nM - fm) < WGM ? (nM - fm) : WGM;
        u.pm = fm + ((wgid % nig) % gsz); u.pn = (wgid % nig) / gsz; return true;
    }
    __device__ __forceinline__ void a_ready(const Unit&) const {}
    __device__ __forceinline__ void done(const Unit&) const {}
};

typedef float f32x2_c __attribute__((ext_vector_type(2))); typedef __bf16 bf16x2_c __attribute__((ext_vector_type(2)));
__device__ __forceinline__ unsigned cvt_pk_bf16(float lo, float hi) { const f32x2_c v = {lo, hi}; return __builtin_bit_cast(unsigned, __builtin_convertvector(v, bf16x2_c)); }
__device__ __forceinline__ float bf_lo(unsigned u) { return __uint_as_float(u << 16); }
__device__ __forceinline__ float bf_hi(unsigned u) { return __uint_as_float(u & 0xffff0000u); }
__device__ __forceinline__ void st8(bf16_t* p, const f32x4 a, const f32x4 b) { u32x4 w; w.x = cvt_pk_bf16(a[0], a[1]); w.y = cvt_pk_bf16(a[2], a[3]); w.z = cvt_pk_bf16(b[0], b[1]); w.w = cvt_pk_bf16(b[2], b[3]); *(u32x4*)p = w; }
__device__ __forceinline__ void ld8(const bf16_t* p, f32x4& a, f32x4& b) { const u32x4 w = *(const u32x4*)p; a = (f32x4){bf_lo(w.x), bf_hi(w.x), bf_lo(w.y), bf_hi(w.y)}; b = (f32x4){bf_lo(w.z), bf_hi(w.z), bf_lo(w.w), bf_hi(w.w)}; }
__device__ __forceinline__ float fsigmoid(float x) { return __builtin_amdgcn_rcpf(1.0f + __builtin_amdgcn_exp2f(-1.4426950408889634f * x)); }
__device__ __forceinline__ f32x4 sig4(const f32x4 v) { return (f32x4){fsigmoid(v[0]), fsigmoid(v[1]), fsigmoid(v[2]), fsigmoid(v[3])}; }
__device__ __forceinline__ f32x4 silu4(const f32x4 v) { return v * sig4(v); }

__device__ __forceinline__ void st8x(bf16_t* p, const f32x4 a, const f32x4 b) { if (!(EPI_EXP & 2) || ((size_t)p & 1)) st8(p, a, b); else { asm volatile("" :: "v"(a), "v"(b)); } }
struct EpiInProj {
    static constexpr bool PERM = true, AFTER_DRAIN = false;
    unsigned char* ws;
    size_t oHQ, oFF, oFB, oHI, oSG, oQ, oK, oV, oGA, oGB, oROPE;
    const float *qg, *kg;
    template <int ACT> __device__ __forceinline__ void plain(const f32x4 (&acc)[2][2][4][2], bf16_t* base, long row0, int pitch, int col0) const {
#pragma unroll
        for (int ai = 0; ai < 2; ++ai)
#pragma unroll
            for (int m = 0; m < 4; ++m) { bf16_t* rowp = base + (row0 + ai * HALF + m * 16) * pitch + col0;
#pragma unroll
                for (int bj = 0; bj < 2; ++bj) { f32x4 v0 = acc[ai][bj][m][0], v1 = acc[ai][bj][m][1];
                    if (ACT == 1) { v0 = silu4(v0); v1 = silu4(v1); } if (ACT == 2) { v0 = sig4(v0); v1 = sig4(v1); }
                    st8x(rowp + bj * HALF, v0, v1); } }
    }
    __device__ __forceinline__ void gate8(const f32x4 (&acc)[2][2][4][2], unsigned char* base, long row0, int col0) const {
#pragma unroll
        for (int ai = 0; ai < 2; ++ai)
#pragma unroll
            for (int m = 0; m < 4; ++m) { unsigned char* rowp = base + (row0 + ai * HALF + m * 16) * 1024 + col0;
#pragma unroll
                for (int bj = 0; bj < 2; ++bj) { const f32x4 v0 = sig4(acc[ai][bj][m][0]) * 255.0f, v1 = sig4(acc[ai][bj][m][1]) * 255.0f;
                    unsigned w0 = 0, w1 = 0;
                    w0 = __builtin_amdgcn_cvt_pk_u8_f32(v0[0], 0, w0); w0 = __builtin_amdgcn_cvt_pk_u8_f32(v0[1], 1, w0); w0 = __builtin_amdgcn_cvt_pk_u8_f32(v0[2], 2, w0); w0 = __builtin_amdgcn_cvt_pk_u8_f32(v0[3], 3, w0);
                    w1 = __builtin_amdgcn_cvt_pk_u8_f32(v1[0], 0, w1); w1 = __builtin_amdgcn_cvt_pk_u8_f32(v1[1], 1, w1); w1 = __builtin_amdgcn_cvt_pk_u8_f32(v1[2], 2, w1); w1 = __builtin_amdgcn_cvt_pk_u8_f32(v1[3], 3, w1);
                    *(unsigned long long*)(rowp + bj * HALF) = (unsigned long long)w0 | ((unsigned long long)w1 << 32); } }
    }
    __device__ __forceinline__ void qk(const f32x4 (&acc)[2][2][4][2], bf16_t* base, long row0, int pitch, int col0, const float* gain, bool do_rope, int t0, float oscale, int fq) const {
        const float* rope = (const float*)(ws + oROPE);
        f32x4 gv[2][2];
#pragma unroll
        for (int bj = 0; bj < 2; ++bj)
#pragma unroll
            for (int n = 0; n < 2; ++n) gv[bj][n] = *(const f32x4*)(gain + 32 * bj + 16 * n + 4 * fq);
        f32x4 cc[4], sc[4], cr[2], sr[2];
        if (do_rope) {
#pragma unroll
            for (int m = 0; m < 4; ++m) { const int pos = (t0 + m * 16) & 63; cc[m] = *(const f32x4*)(rope + pos * 32 + 4 * fq); sc[m] = *(const f32x4*)(rope + pos * 32 + 16 + 4 * fq); }
#pragma unroll
            for (int ai = 0; ai < 2; ++ai) { const int pos = (t0 + ai * HALF) >> 6; cr[ai] = *(const f32x4*)(rope + pos * 32 + 4 * fq); sr[ai] = *(const f32x4*)(rope + pos * 32 + 16 + 4 * fq); }
        } else {
#pragma unroll
            for (int m = 0; m < 4; ++m) { cc[m] = (f32x4){1.f, 1.f, 1.f, 1.f}; sc[m] = (f32x4){0.f, 0.f, 0.f, 0.f}; }
#pragma unroll
            for (int ai = 0; ai < 2; ++ai) { cr[ai] = (f32x4){1.f, 1.f, 1.f, 1.f}; sr[ai] = (f32x4){0.f, 0.f, 0.f, 0.f}; }
        }
#pragma unroll
        for (int ai = 0; ai < 2; ++ai)
#pragma unroll
            for (int m = 0; m < 4; ++m) {
                float ss = 0.f;
#pragma unroll
                for (int bj = 0; bj < 2; ++bj)
#pragma unroll
                    for (int n = 0; n < 2; ++n) { const f32x4 x = acc[ai][bj][m][n]; ss += (x[0] * x[0] + x[1] * x[1]) + (x[2] * x[2] + x[3] * x[3]); }
                ss += __shfl_xor(ss, 16); ss += __shfl_xor(ss, 32);
                const float rstd = 1.0f / sqrtf(ss * (1.0f / 64.0f) + 1e-6f);
                bf16_t* rowp = base + (row0 + ai * HALF + m * 16) * pitch + col0;
#pragma unroll
                for (int bj = 0; bj < 2; ++bj) {
                    const f32x4 x1 = acc[ai][bj][m][0] * rstd * gv[bj][0], x2 = acc[ai][bj][m][1] * rstd * gv[bj][1];
                    const f32x4 c = bj ? cc[m] : cr[ai], s = bj ? sc[m] : sr[ai];
                    const f32x4 o1 = x1 * c - x2 * s, o2 = x2 * c + x1 * s;
                    st8x(rowp + bj * 32, o1 * oscale, o2 * oscale); }
            }
    }
    __device__ __forceinline__ void operator()(const f32x4 (&acc)[2][2][4][2], const Unit& u, int wr, int wc, int fr_, int fq_) const {
        int fr = fr_, fq = fq_; asm volatile("" : "+v"(fr), "+v"(fq));
        if (EPI_EXP & 1) return;
        const int pn = u.pn, bb = u.pm / 9, jt = u.pm - bb * 9;
        const int rloc = wr * 64 + fr;
        const long r0 = (long)u.pm * BM + rloc;
        const long rl0 = (long)bb * 2048 + (jt - 1) * 256 + rloc;
        const int c8 = wc * 32 + 8 * fq;
        if (pn < 2)        plain<0>(acc, (bf16_t*)(ws + oHQ), rl0, 512, pn * 256 + c8);
        else if (pn < 4)   plain<0>(acc, (bf16_t*)(ws + oFF), r0, 512, (pn - 2) * 256 + c8);
        else if (pn < 6)   plain<0>(acc, (bf16_t*)(ws + oFB), r0, 512, (pn - 4) * 256 + c8);
        else if (pn < 8)   plain<0>(acc, (bf16_t*)(ws + oHI), r0, 512, (pn - 6) * 256 + c8);
        else if (pn < 10)  plain<1>(acc, (bf16_t*)(ws + oSG), rl0, 512, (pn - 8) * 256 + c8);
        else if (pn < 12)  qk(acc, (bf16_t*)(ws + oQ), rl0, 512, ((pn - 10) * 4 + wc) * 64 + 8 * fq, qg, true, (jt - 1) * 256 + rloc, 0.125f * 1.4426950408889634f, fq);
        else if (pn == 12) {
            if (wc < 2)    qk(acc, (bf16_t*)(ws + oK), r0, 128, wc * 64 + 8 * fq, kg, jt >= 1, (jt - 1) * 256 + rloc, 1.0f, fq);
            else {
#pragma unroll
                for (int ai = 0; ai < 2; ++ai)
#pragma unroll
                    for (int m = 0; m < 4; ++m) { bf16_t* rowp = (bf16_t*)(ws + oV) + (r0 + ai * HALF + m * 16) * 128 + (wc - 2) * 64 + 8 * fq;
#pragma unroll
                        for (int bj = 0; bj < 2; ++bj) st8x(rowp + bj * 32, acc[ai][bj][m][0], acc[ai][bj][m][1]); }
            }
        }
        else if (pn < 17)  gate8(acc, ws + oGA, rl0, (pn - 13) * 256 + c8);
        else               gate8(acc, ws + oGB, rl0, (pn - 17) * 256 + c8);
    }
};

template <int SECOND> struct EpiZ {
    static constexpr bool PERM = true, AFTER_DRAIN = false;
    bf16_t* Z; const unsigned char* G;
    __device__ __forceinline__ void ld(int ai, int mh, long row0, int col0, unsigned long long (&gw)[2][2], u32x4 (&zw)[2][2]) const {
#pragma unroll
        for (int mm = 0; mm < 2; ++mm)
#pragma unroll
            for (int bj = 0; bj < 2; ++bj) { const long off = (row0 + ai * HALF + (2 * mh + mm) * 16) * 1024 + col0 + bj * HALF;
                gw[mm][bj] = *(const unsigned long long*)(G + off); if (SECOND) zw[mm][bj] = *(const u32x4*)(Z + off); }
    }
    __device__ __forceinline__ void proc(const f32x4 (&acc)[2][2][4][2], int ai, int mh, long row0, int col0, const unsigned long long (&gw)[2][2], const u32x4 (&zw)[2][2]) const {
#pragma unroll
        for (int mm = 0; mm < 2; ++mm)
#pragma unroll
            for (int bj = 0; bj < 2; ++bj) { const int m = 2 * mh + mm; const long off = (row0 + ai * HALF + m * 16) * 1024 + col0 + bj * HALF;
                const unsigned wl = (unsigned)gw[mm][bj], wh = (unsigned)(gw[mm][bj] >> 32);
                const f32x4 g0 = (f32x4){(float)(wl & 255u), (float)((wl >> 8) & 255u), (float)((wl >> 16) & 255u), (float)(wl >> 24)} * (1.0f / 255.0f), g1 = (f32x4){(float)(wh & 255u), (float)((wh >> 8) & 255u), (float)((wh >> 16) & 255u), (float)(wh >> 24)} * (1.0f / 255.0f);
                f32x4 v0 = acc[ai][bj][m][0] * g0, v1 = acc[ai][bj][m][1] * g1;
                if (SECOND) { const u32x4 z = zw[mm][bj]; v0 += (f32x4){bf_lo(z.x), bf_hi(z.x), bf_lo(z.y), bf_hi(z.y)}; v1 += (f32x4){bf_lo(z.z), bf_hi(z.z), bf_lo(z.w), bf_hi(z.w)}; }
                st8(Z + off, v0, v1); }
    }
    __device__ __forceinline__ void operator()(const f32x4 (&acc)[2][2][4][2], const Unit& u, int wr, int wc, int fr_, int fq_) const {
        int fr = fr_, fq = fq_; asm volatile("" : "+v"(fr), "+v"(fq));
        const long row0 = (long)u.pm * BM + wr * 64 + fr; const int col0 = u.pn * BM + wc * 32 + 8 * fq;
        unsigned long long gA[2][2], gB[2][2]; u32x4 zA[2][2], zB[2][2];
        ld(0, 0, row0, col0, gA, zA);
        ld(0, 1, row0, col0, gB, zB); proc(acc, 0, 0, row0, col0, gA, zA);
        ld(1, 0, row0, col0, gA, zA); proc(acc, 0, 1, row0, col0, gB, zB);
        ld(1, 1, row0, col0, gB, zB); proc(acc, 1, 0, row0, col0, gA, zA);
        proc(acc, 1, 1, row0, col0, gB, zB);
    }
};
struct EpiX1 {
    static constexpr bool PERM = false, AFTER_DRAIN = false;
    const float* x; const float* mod; bf16_t* out;
    __device__ __forceinline__ void ld(int ai, int mh, long row0, int col0, f32x4 (&xv)[2][2][2]) const {
#pragma unroll
        for (int mm = 0; mm < 2; ++mm)
#pragma unroll
            for (int bj = 0; bj < 2; ++bj)
#pragma unroll
                for (int n = 0; n < 2; ++n) xv[mm][bj][n] = *(const f32x4*)(x + (row0 + ai * HALF + (2 * mh + mm) * 16) * 1024 + col0 + bj * HALF + n * 16);
    }
    __device__ __forceinline__ void proc(const f32x4 (&acc)[2][2][4][2], int ai, int mh, long row0, int col0, const f32x4 (&xv)[2][2][2], const f32x4 (&gv)[2][2]) const {
#pragma unroll
        for (int mm = 0; mm < 2; ++mm)
#pragma unroll
            for (int bj = 0; bj < 2; ++bj)
#pragma unroll
                for (int n = 0; n < 2; ++n) { const int m = 2 * mh + mm; const f32x4 o = xv[mm][bj][n] + gv[bj][n] * acc[ai][bj][m][n];
                    unsigned w0 = cvt_pk_bf16(o[0], o[1]), w1 = cvt_pk_bf16(o[2], o[3]);
                    *(unsigned long long*)(out + (row0 + ai * HALF + m * 16) * 1024 + col0 + bj * HALF + n * 16) = (unsigned long long)w0 | ((unsigned long long)w1 << 32); }
    }
    __device__ __forceinline__ void operator()(const f32x4 (&acc)[2][2][4][2], const Unit& u, int wr, int wc, int fr_, int fq_) const {
        int fr = fr_, fq = fq_; asm volatile("" : "+v"(fr), "+v"(fq));
        const long row0 = (long)u.pm * BM + wr * 64 + fr; const int col0 = u.pn * BM + wc * 32 + 4 * fq; const int b = u.pm >> 3;
        f32x4 gv[2][2];
#pragma unroll
        for (int bj = 0; bj < 2; ++bj)
#pragma unroll
            for (int n = 0; n < 2; ++n) gv[bj][n] = *(const f32x4*)(mod + (size_t)b * 6144 + 2048 + col0 + bj * HALF + n * 16);
        f32x4 xA[2][2][2], xB[2][2][2];
        ld(0, 0, row0, col0, xA);
        ld(0, 1, row0, col0, xB); proc(acc, 0, 0, row0, col0, xA, gv);
        ld(1, 0, row0, col0, xA); proc(acc, 0, 1, row0, col0, xB, gv);
        ld(1, 1, row0, col0, xB); proc(acc, 1, 0, row0, col0, xA, gv);
        proc(acc, 1, 1, row0, col0, xB, gv);
    }
};
struct EpiHid {
    static constexpr bool PERM = true, AFTER_DRAIN = false;
    bf16_t* H;
    __device__ __forceinline__ void operator()(const f32x4 (&acc)[2][2][4][2], const Unit& u, int wr, int wc, int fr, int fq) const {
        const int row0 = wr * 64 + fr, col0 = u.pn * HALF + wc * 32 + 8 * fq;
#pragma unroll
        for (int ai = 0; ai < 2; ++ai)
#pragma unroll
            for (int m = 0; m < 4; ++m) st8(H + (size_t)(row0 + ai * HALF + m * 16) * 1024 + col0, silu4(acc[ai][0][m][0]) * acc[ai][1][m][0], silu4(acc[ai][0][m][1]) * acc[ai][1][m][1]);
    }
};
struct EpiHidQ {
    static constexpr bool PERM = true, AFTER_DRAIN = false;
    bf16_t* H; const float* scl; const float* tq;
    __device__ __forceinline__ static f32x4 cvt4(const f32x4 a) { return (f32x4){(float)__float_as_int(a[0]), (float)__float_as_int(a[1]), (float)__float_as_int(a[2]), (float)__float_as_int(a[3])}; }
    __device__ __forceinline__ void operator()(const f32x4 (&acc)[2][2][4][2], const Unit& u, int wr, int wc, int fr, int fq) const {
        const int row0 = wr * 64 + fr, col0 = u.pn * HALF + wc * 32 + 8 * fq;
        const float* tc = tq + u.pn * BM + wc * 32 + 8 * fq;
        const f32x4 cg0 = *(const f32x4*)(tc), cg1 = *(const f32x4*)(tc + 4), cu0 = *(const f32x4*)(tc + HALF), cu1 = *(const f32x4*)(tc + HALF + 4);
        float sr[2][4];
#pragma unroll
        for (int ai = 0; ai < 2; ++ai)
#pragma unroll
            for (int m = 0; m < 4; ++m) sr[ai][m] = scl[row0 + ai * HALF + m * 16];
#pragma unroll
        for (int ai = 0; ai < 2; ++ai)
#pragma unroll
            for (int m = 0; m < 4; ++m) { const float r = sr[ai][m];
                const f32x4 g0 = cvt4(acc[ai][0][m][0]) * (cg0 * r), g1 = cvt4(acc[ai][0][m][1]) * (cg1 * r), u0 = cvt4(acc[ai][1][m][0]) * (cu0 * r), u1 = cvt4(acc[ai][1][m][1]) * (cu1 * r);
                st8(H + (size_t)(row0 + ai * HALF + m * 16) * 1024 + col0, silu4(g0) * u0, silu4(g1) * u1); }
    }
};
struct EpiInProjQ {
    static constexpr bool PERM = true, AFTER_DRAIN = false;
    EpiInProj base; const float* rs; const float* cs;
    __device__ __forceinline__ void operator()(const f32x4 (&acc_)[2][2][4][2], const Unit& u, int wr, int wc, int fr_, int fq_) const {
        int fr = fr_, fq = fq_; asm volatile("" : "+v"(fr), "+v"(fq));
        f32x4 (&acc)[2][2][4][2] = const_cast<f32x4 (&)[2][2][4][2]>(acc_);
        const float* rp = rs + (size_t)u.pm * BM + wr * 64 + fr; const float* cp = cs + u.pn * BM + wc * 32 + 8 * fq;
        f32x4 c4[2][2]; float r8[2][4];
#pragma unroll
        for (int bj = 0; bj < 2; ++bj)
#pragma unroll
            for (int n = 0; n < 2; ++n) c4[bj][n] = *(const f32x4*)(cp + bj * HALF + 4 * n);
#pragma unroll
        for (int ai = 0; ai < 2; ++ai)
#pragma unroll
            for (int m = 0; m < 4; ++m) r8[ai][m] = rp[ai * HALF + m * 16];
#pragma unroll
        for (int ai = 0; ai < 2; ++ai)
#pragma unroll
            for (int bj = 0; bj < 2; ++bj)
#pragma unroll
                for (int m = 0; m < 4; ++m)
#pragma unroll
                    for (int n = 0; n < 2; ++n) acc[ai][bj][m][n] = EpiHidQ::cvt4(acc[ai][bj][m][n]) * (c4[bj][n] * r8[ai][m]);
        base(acc, u, wr, wc, fr, fq);
    }
};
constexpr float YE_F8_SCALE = 32.0f;
struct EpiYe {
    static constexpr bool PERM = true, AFTER_DRAIN = false;
    unsigned char* Y; const float* gate;
    __device__ __forceinline__ void operator()(const f32x4 (&acc)[2][2][4][2], const Unit& u, int wr, int wc, int fr, int fq) const {
        const int row0 = wr * 64 + fr, col0 = u.pn * BM + wc * 32 + 8 * fq;
        float gt[2][4];
#pragma unroll
        for (int ai = 0; ai < 2; ++ai)
#pragma unroll
            for (int m = 0; m < 4; ++m) gt[ai][m] = gate[row0 + ai * HALF + m * 16];
#pragma unroll
        for (int ai = 0; ai < 2; ++ai)
#pragma unroll
            for (int m = 0; m < 4; ++m) { const int r = row0 + ai * HALF + m * 16;
#pragma unroll
                for (int bj = 0; bj < 2; ++bj) { const f32x4 a = acc[ai][bj][m][0] * (gt[ai][m] * YE_F8_SCALE), b = acc[ai][bj][m][1] * (gt[ai][m] * YE_F8_SCALE);
                    int w0 = __builtin_amdgcn_cvt_pk_fp8_f32(a[0], a[1], 0, false); w0 = __builtin_amdgcn_cvt_pk_fp8_f32(a[2], a[3], w0, true);
                    int w1 = __builtin_amdgcn_cvt_pk_fp8_f32(b[0], b[1], 0, false); w1 = __builtin_amdgcn_cvt_pk_fp8_f32(b[2], b[3], w1, true);
                    *(unsigned long long*)(Y + (size_t)r * 1024 + col0 + bj * HALF) = (unsigned long long)(unsigned)w0 | ((unsigned long long)(unsigned)w1 << 32); } }
    }
};
struct EpiYeQ {
    static constexpr bool PERM = true, AFTER_DRAIN = false;
    unsigned char* Y; const float* gate; const float* rs; const float* td;
    __device__ __forceinline__ void operator()(const f32x4 (&acc)[2][2][4][2], const Unit& u, int wr, int wc, int fr, int fq) const {
        const int row0 = wr * 64 + fr, col0 = u.pn * BM + wc * 32 + 8 * fq;
        const float* tc = td + col0;
        f32x4 c4[2][2];
#pragma unroll
        for (int bj = 0; bj < 2; ++bj)
#pragma unroll
            for (int n = 0; n < 2; ++n) c4[bj][n] = *(const f32x4*)(tc + bj * HALF + 4 * n);
        float gt[2][4];
#pragma unroll
        for (int ai = 0; ai < 2; ++ai)
#pragma unroll
            for (int m = 0; m < 4; ++m) gt[ai][m] = gate[row0 + ai * HALF + m * 16] * rs[row0 + ai * HALF + m * 16] * YE_F8_SCALE;
#pragma unroll
        for (int ai = 0; ai < 2; ++ai)
#pragma unroll
            for (int m = 0; m < 4; ++m) { const int r = row0 + ai * HALF + m * 16;
#pragma unroll
                for (int bj = 0; bj < 2; ++bj) { f32x4 a = EpiHidQ::cvt4(acc[ai][bj][m][0]) * (c4[bj][0] * gt[ai][m]), b = EpiHidQ::cvt4(acc[ai][bj][m][1]) * (c4[bj][1] * gt[ai][m]);
#pragma unroll
                    for (int j = 0; j < 4; ++j) { a[j] = __builtin_amdgcn_fmed3f(a[j], -440.0f, 440.0f); b[j] = __builtin_amdgcn_fmed3f(b[j], -440.0f, 440.0f); }
                    int w0 = __builtin_amdgcn_cvt_pk_fp8_f32(a[0], a[1], 0, false); w0 = __builtin_amdgcn_cvt_pk_fp8_f32(a[2], a[3], w0, true);
                    int w1 = __builtin_amdgcn_cvt_pk_fp8_f32(b[0], b[1], 0, false); w1 = __builtin_amdgcn_cvt_pk_fp8_f32(b[2], b[3], w1, true);
                    *(unsigned long long*)(Y + (size_t)r * 1024 + col0 + bj * HALF) = (unsigned long long)(unsigned)w0 | ((unsigned long long)(unsigned)w1 << 32); } }
    }
};
struct InProjOrder {
    StaticOrder so;
    __device__ void init(int G_, int c_) { so.init(ML, INC, G_, c_); }
    __device__ bool next(int i, Unit& u) const {
#if DBG_GA_ONLY
        { const long L = (long)i * so.G + so.c; if (L >= 512) return false; u.pm = (int)(L >> 2); u.pn = 13 + (int)(L & 3); u.pm = (u.pm >> 3) * 9 + 1 + (u.pm & 7); return true; }
#endif
        if (so.next(i, u)) { u.pm = (u.pm >> 3) * 9 + 1 + (u.pm & 7); return true; }
        const long L = (long)i * so.G + so.c - so.nwg; if (L >= 16 * 7) return false;
        const int cb = (int)L / 7, k = (int)L % 7; u.pm = cb * 9; u.pn = k < 6 ? 2 + k : 12; return true;
    }
    __device__ __forceinline__ void a_ready(const Unit&) const {}
    __device__ __forceinline__ void done(const Unit&) const {}
};
struct LocalOrder {
    int n;
    __device__ bool next(int i, Unit& u) const { if (i >= n) return false; u.pm = 0; u.pn = i; return true; }
    __device__ __forceinline__ void a_ready(const Unit&) const {}
    __device__ __forceinline__ void done(const Unit&) const {}
};
typedef int i32x4_pg8 __attribute__((ext_vector_type(4)));
template <bool I8> __device__ __forceinline__ f32x4 mma16(const bf16x8 b, const bf16x8 a, const f32x4 c) {
    if constexpr (I8) return __builtin_bit_cast(f32x4, __builtin_amdgcn_mfma_i32_16x16x64_i8(__builtin_bit_cast(i32x4_pg8, b), __builtin_bit_cast(i32x4_pg8, a), __builtin_bit_cast(i32x4_pg8, c), 0, 0, 0));
    else return __builtin_amdgcn_mfma_f32_16x16x32_bf16(b, a, c, 0, 0, 0);
}
template <class Epi, class Sched, bool ALIGN_EPI = false, bool SP2 = false, bool I8 = false>
__device__ __forceinline__ void gemm_phase(PG8_LAS unsigned char* lds, const Gemm g, const Sched& S, const Epi& E) {
    int tid_ = threadIdx.x; asm volatile("" : "+v"(tid_));
    const int tid = tid_, wid = __builtin_amdgcn_readfirstlane(tid >> 6), lane = tid & 63, wr = wid >> 2, wc = wid & 3, fr = lane & 15, fq = lane >> 4;
    const int K = g.K, nt = K / BK;
    unsigned voffA[2], voffA1[2], voffB[2];
#pragma unroll
    for (int i = 0; i < 2; ++i) { int R, C; stage_rc(tid * 16 + i * 8192, R, C); const int Rb = Epi::PERM ? ((R & ~31) + perm32(R & 31)) : R;
        if (g.gather) { voffA[i] = ((unsigned)g.gather[R] * (unsigned)K + (unsigned)C) * 2u; voffA1[i] = ((unsigned)g.gather[R + HALF] * (unsigned)K + (unsigned)C) * 2u; }
        else { voffA[i] = (unsigned)(R * K + C) * 2u; voffA1[i] = voffA[i] + (unsigned)(HALF * K * 2); }
        voffB[i] = (unsigned)(Rb * K + C) * 2u; }
    const size_t kstep = (size_t)(BK * 2);
    const size_t hstep = (size_t)HALF * K * 2;
    const size_t tstep = 2 * hstep;
    const unsigned ldsw = (unsigned)wid * 1024u;
    const int aoff = lds_byte(wr * 64 + fr, fq * 8), boff = lds_byte(wc * 32 + fr, fq * 8);
#define PG8_SA(b, h) (((b) * 2 + (h)) * HTB)
#define PG8_SB(b, h) ((4 + (b) * 2 + (h)) * HTB)
#define PG8_STAGE(bufoff, gbase, voff) do { _Pragma("unroll") for (int _i = 0; _i < 2; ++_i) \
        __builtin_amdgcn_global_load_lds((const unsigned*)((const char*)(gbase) + (voff)[_i]), (PG8_LAS unsigned*)(lds + (bufoff) + ldsw + _i * 8192), 16, 0, PG8_DMA_AUX); } while (0)
#define PG8_LDA(dst, b, h) do { _Pragma("unroll") for (int m = 0; m < 4; ++m) _Pragma("unroll") for (int k = 0; k < 2; ++k) dst[m][k] = *(const PG8_LAS bf16x8*)(lds + PG8_SA(b, h) + aoff + m * 2048 + k * 1024); } while (0)
#define PG8_LDB(dst, b, h) do { _Pragma("unroll") for (int n = 0; n < 2; ++n) _Pragma("unroll") for (int k = 0; k < 2; ++k) dst[n][k] = *(const PG8_LAS bf16x8*)(lds + PG8_SB(b, h) + boff + n * 2048 + k * 1024); } while (0)
#define PG8_MMA(ai, bj, At, Bt) do { __builtin_amdgcn_s_setprio(1); _Pragma("unroll") for (int m = 0; m < 4; ++m) _Pragma("unroll") for (int n = 0; n < 2; ++n) _Pragma("unroll") for (int k = 0; k < 2; ++k) \
        acc[ai][bj][m][n] = mma16<I8>(Bt[n][k], At[m][k], acc[ai][bj][m][n]); __builtin_amdgcn_s_setprio(0); } while (0)
#define PG8_WAIT_V(n) asm volatile("s_waitcnt vmcnt(" #n ")" ::: "memory")
#define PG8_WAIT_L(n) asm volatile("s_waitcnt lgkmcnt(" #n ")" ::: "memory")
#define PG8_BAR __builtin_amdgcn_s_barrier()
#define PG8_SCHED __builtin_amdgcn_sched_barrier(0)
    Unit cur, nxt; int ui = 0;
    if (!S.next(0, cur)) return;
    f32x4 acc[2][2][4][2];
#pragma unroll
    for (int a = 0; a < 2; ++a)
#pragma unroll
        for (int b = 0; b < 2; ++b)
#pragma unroll
            for (int m = 0; m < 4; ++m)
#pragma unroll
                for (int n = 0; n < 2; ++n) acc[a][b][m][n] = (f32x4){0.f, 0.f, 0.f, 0.f};
    bf16x8 At[4][2], B0[2][2], B1[2][2];
    const char* cA = (const char*)g.A + (size_t)cur.pm * tstep; const char* cB = (const char*)g.Bt + (size_t)cur.pn * tstep;
    S.a_ready(cur);
    if constexpr (SP2) {
        PG8_STAGE(PG8_SB(0, 0), cB, voffB); PG8_STAGE(PG8_SB(0, 1), cB + hstep, voffB); PG8_STAGE(PG8_SA(0, 0), cA, voffA); PG8_STAGE(PG8_SA(0, 1), cA, voffA1);
        if (wr == 1) PG8_BAR;
        PG8_WAIT_V(2); PG8_BAR;
        PG8_STAGE(PG8_SB(1, 0), cB + kstep, voffB); PG8_STAGE(PG8_SA(1, 0), cA + kstep, voffA); PG8_STAGE(PG8_SB(1, 1), cB + hstep + kstep, voffB);
        PG8_WAIT_V(6); PG8_BAR;
    } else {
        PG8_STAGE(PG8_SB(0, 0), cB, voffB); PG8_STAGE(PG8_SA(0, 0), cA, voffA); PG8_STAGE(PG8_SB(0, 1), cB + hstep, voffB); PG8_STAGE(PG8_SA(0, 1), cA, voffA1);
        if (wr == 1) PG8_BAR;
        PG8_WAIT_V(4); PG8_BAR;
        PG8_STAGE(PG8_SB(1, 0), cB + kstep, voffB); PG8_STAGE(PG8_SA(1, 0), cA + kstep, voffA); PG8_STAGE(PG8_SB(1, 1), cB + hstep + kstep, voffB);
        PG8_WAIT_V(6); PG8_BAR;
    }
    for (;;) {
        const bool has_next = S.next(ui + 1, nxt);
        const char* nA = has_next ? (const char*)g.A + (size_t)nxt.pm * tstep : cA; const char* nB = has_next ? (const char*)g.Bt + (size_t)nxt.pn * tstep : cB;
        for (int t = 0; t < nt; t += 2) {
            const bool last = (t == nt - 2);
            const char* a1 = cA + (size_t)(t + 1) * kstep;
            const char* a2 = last ? nA : cA + (size_t)(t + 2) * kstep; const char* b2 = last ? nB : cB + (size_t)(t + 2) * kstep;
            const char* a3 = a2 + kstep; const char* b3 = b2 + kstep;
            if (last && has_next) S.a_ready(nxt);
            if constexpr (SP2) {
            PG8_LDB(B0, 0, 0); PG8_LDB(B1, 0, 1); PG8_SCHED; PG8_LDA(At, 0, 0); PG8_STAGE(PG8_SA(1, 1), a1, voffA1);
            PG8_WAIT_V(8); PG8_WAIT_L(0); PG8_BAR; PG8_MMA(0, 0, At, B0); PG8_MMA(0, 1, At, B1); PG8_BAR; PG8_SCHED;
            PG8_LDA(At, 0, 1); PG8_STAGE(PG8_SB(0, 0), b2, voffB); PG8_STAGE(PG8_SB(0, 1), b2 + hstep, voffB); PG8_STAGE(PG8_SA(0, 0), a2, voffA);
            PG8_WAIT_V(8); PG8_WAIT_L(0); PG8_BAR; PG8_MMA(1, 0, At, B0); PG8_MMA(1, 1, At, B1); PG8_BAR; PG8_SCHED;
            PG8_LDB(B0, 1, 0); PG8_LDB(B1, 1, 1); PG8_SCHED; PG8_LDA(At, 1, 0); PG8_STAGE(PG8_SA(0, 1), a2, voffA1);
            PG8_WAIT_V(8); PG8_WAIT_L(0); PG8_BAR; PG8_MMA(0, 0, At, B0); PG8_MMA(0, 1, At, B1); PG8_BAR; PG8_SCHED;
            PG8_LDA(At, 1, 1); PG8_STAGE(PG8_SB(1, 0), b3, voffB); PG8_STAGE(PG8_SB(1, 1), b3 + hstep, voffB); PG8_STAGE(PG8_SA(1, 0), a3, voffA);
            PG8_WAIT_V(8); PG8_WAIT_L(0); PG8_BAR; PG8_MMA(1, 0, At, B0); PG8_MMA(1, 1, At, B1); PG8_BAR; PG8_SCHED;
            } else {
            PG8_LDB(B0, 0, 0); PG8_SCHED; PG8_LDA(At, 0, 0); PG8_STAGE(PG8_SA(1, 1), a1, voffA1);
            PG8_WAIT_L(8); PG8_BAR; PG8_WAIT_L(0); PG8_MMA(0, 0, At, B0); PG8_BAR; PG8_SCHED;
            PG8_LDB(B1, 0, 1); PG8_STAGE(PG8_SB(0, 0), b2, voffB);
            PG8_BAR; PG8_WAIT_L(0); PG8_MMA(0, 1, At, B1); PG8_BAR;
            PG8_LDA(At, 0, 1); PG8_STAGE(PG8_SA(0, 0), a2, voffA);
            PG8_BAR; PG8_WAIT_L(0); PG8_MMA(1, 0, At, B0); PG8_BAR; PG8_SCHED;
            PG8_STAGE(PG8_SB(0, 1), b2 + hstep, voffB);
            PG8_WAIT_V(6); PG8_BAR; PG8_MMA(1, 1, At, B1); PG8_BAR;
            PG8_LDB(B0, 1, 0); PG8_SCHED; PG8_LDA(At, 1, 0); PG8_STAGE(PG8_SA(0, 1), a2, voffA1);
            PG8_WAIT_L(8); PG8_BAR; PG8_WAIT_L(0); PG8_MMA(0, 0, At, B0); PG8_BAR; PG8_SCHED;
            PG8_LDB(B1, 1, 1); PG8_STAGE(PG8_SB(1, 0), b3, voffB);
            PG8_BAR; PG8_WAIT_L(0); PG8_MMA(0, 1, At, B1); PG8_BAR;
            PG8_LDA(At, 1, 1); PG8_STAGE(PG8_SA(1, 0), a3, voffA);
            PG8_BAR; PG8_WAIT_L(0); PG8_MMA(1, 0, At, B0); PG8_BAR; PG8_SCHED;
            PG8_STAGE(PG8_SB(1, 1), b3 + hstep, voffB);
            PG8_WAIT_V(6); PG8_BAR; PG8_MMA(1, 1, At, B1); PG8_BAR;
            }
        }
        if constexpr (ALIGN_EPI) { if (wr == 0) PG8_BAR; }
        if constexpr (!Epi::AFTER_DRAIN) { E(acc, cur, wr, wc, fr, fq); S.done(cur); }
        if (!has_next) break;
#pragma unroll
        for (int a = 0; a < 2; ++a)
#pragma unroll
            for (int b = 0; b < 2; ++b)
#pragma unroll
                for (int m = 0; m < 4; ++m)
#pragma unroll
                    for (int n = 0; n < 2; ++n) acc[a][b][m][n] = (f32x4){0.f, 0.f, 0.f, 0.f};
        cur = nxt; cA = nA; cB = nB; ++ui;
        if constexpr (ALIGN_EPI) { if (wr == 1) PG8_BAR; }
    }
    PG8_WAIT_V(0);
    if constexpr (!ALIGN_EPI) { if (wr == 0) PG8_BAR; }
    PG8_BAR;
    if constexpr (Epi::AFTER_DRAIN) { E.fused(acc, cur, wr, wc, fr, fq, lds, wid, lane); S.done(cur); }
#undef PG8_SA
#undef PG8_SB
#undef PG8_STAGE
#undef PG8_LDA
#undef PG8_LDB
#undef PG8_MMA
#undef PG8_WAIT_V
#undef PG8_WAIT_L
#undef PG8_BAR
#undef PG8_SCHED
}
}
#include <hip/hip_bf16.h>
#include <cmath>
namespace attn_body {
using bf16=__hip_bfloat16;
using bf16x8=__attribute__((ext_vector_type(8)))short;
using s16x4=__attribute__((ext_vector_type(4)))short;
using f32x16=__attribute__((ext_vector_type(16)))float;
using u32x4=__attribute__((ext_vector_type(4)))unsigned;
constexpr int D=64,QP=512,KP=128,NKT=36;
constexpr int NW=8,QBLK=32,QB=QBLK*NW,KVBLK=64;
__device__ __forceinline__ int crow(int r,int hi){return (r&3)+8*(r>>2)+4*hi;}
#define SBAR() __builtin_amdgcn_sched_barrier(0)
constexpr int NSLOT=3, SLOTB=8192;
constexpr int LDS_K=0, LDS_V=NSLOT*SLOTB, LDS_WS=2*NSLOT*SLOTB, LDS_OST=LDS_WS+NW*64*4, LDS_BYTES=LDS_OST+NW*4096;
constexpr float C2=0.125f*1.4426950408889634f;
__device__ __forceinline__ void glds16(const void*gsrc,unsigned lds_dst){unsigned keep;
  asm volatile("s_mov_b32 %0, m0\n\ts_mov_b32 m0, %2\n\ts_nop 0\n\tglobal_load_lds_dwordx4 %1, off\n\ts_mov_b32 m0, %0":"=&s"(keep):"v"(gsrc),"s"(lds_dst):"memory");}
__device__ __forceinline__ float max3f(float a,float b,float c){float r;asm("v_max3_f32 %0, %1, %2, %3":"=v"(r):"v"(a),"v"(b),"v"(c));return r;}
__device__ __forceinline__ float max2f(float a,float b){float r;asm("v_max_f32_e32 %0, %1, %2":"=v"(r):"v"(a),"v"(b));return r;}
__device__ __forceinline__ float fadd_s(float a,float b){float r;asm("v_add_f32_e32 %0, %1, %2":"=v"(r):"v"(a),"v"(b));return r;}
__device__ __forceinline__ float fsub_s(float a,float b){float r;asm("v_sub_f32_e32 %0, %1, %2":"=v"(r):"v"(a),"v"(b));return r;}
typedef float f32x2_t __attribute__((ext_vector_type(2))); typedef __bf16 bf16x2_t __attribute__((ext_vector_type(2)));
__device__ __forceinline__ unsigned cvtpk_s(float lo,float hi){f32x2_t v={lo,hi};bf16x2_t b=__builtin_convertvector(v,bf16x2_t);return __builtin_bit_cast(unsigned,b);}
#define WAIT_BAR(N) asm volatile("s_waitcnt vmcnt(" #N ") lgkmcnt(0)\n\ts_barrier":::"memory")

__device__ __forceinline__ void qkt(f32x16&p0,f32x16&p1,const char*Kslot,const bf16x8*qr,const f32x16&negm,int r32,int hi){
  const char*kb=Kslot+hi*1024+r32*16;
  #pragma unroll
  for(int d0=0;d0<4;++d0){
    const bf16x8 b0=*reinterpret_cast<const bf16x8*>(kb+d0*2048);
    const bf16x8 b1=*reinterpret_cast<const bf16x8*>(kb+d0*2048+512);
    if(d0==0){p0=__builtin_amdgcn_mfma_f32_32x32x16_bf16(b0,qr[0],negm,0,0,0);p1=__builtin_amdgcn_mfma_f32_32x32x16_bf16(b1,qr[0],negm,0,0,0);}
    else{p0=__builtin_amdgcn_mfma_f32_32x32x16_bf16(b0,qr[d0],p0,0,0,0);p1=__builtin_amdgcn_mfma_f32_32x32x16_bf16(b1,qr[d0],p1,0,0,0);}}
}
typedef __attribute__((address_space(3))) const char* lds_cptr;
typedef short v4i16_t __attribute__((ext_vector_type(4)));
__device__ __forceinline__ void kload8(bf16x8*kf,lds_cptr kp){
  kf[0]=*(const __attribute__((address_space(3))) bf16x8*)(kp);      kf[1]=*(const __attribute__((address_space(3))) bf16x8*)(kp+512);
  kf[2]=*(const __attribute__((address_space(3))) bf16x8*)(kp+2048); kf[3]=*(const __attribute__((address_space(3))) bf16x8*)(kp+2560);
  kf[4]=*(const __attribute__((address_space(3))) bf16x8*)(kp+4096); kf[5]=*(const __attribute__((address_space(3))) bf16x8*)(kp+4608);
  kf[6]=*(const __attribute__((address_space(3))) bf16x8*)(kp+6144); kf[7]=*(const __attribute__((address_space(3))) bf16x8*)(kp+6656);
}
__device__ __forceinline__ void kload2(bf16x8*kf,lds_cptr kp,int j){ kf[2*j]=*(const __attribute__((address_space(3))) bf16x8*)(kp+j*2048); kf[2*j+1]=*(const __attribute__((address_space(3))) bf16x8*)(kp+j*2048+512); }
__device__ __forceinline__ s16x4 vtr(lds_cptr p){ return __builtin_bit_cast(s16x4,__builtin_amdgcn_ds_read_tr16_b64_v4i16((__attribute__((address_space(3))) v4i16_t*)p)); }
__device__ __forceinline__ float rowmax(const f32x16&p0,const f32x16&p1){
  float a=max3f(p0[0],p0[1],p1[0]),b=max3f(p0[2],p0[3],p1[1]);a=max3f(a,p1[2],p1[3]);
  #pragma unroll
  for(int r=4;r<16;r+=4){a=max3f(a,p0[r],p0[r+1]);b=max3f(b,p0[r+2],p0[r+3]);a=max3f(a,p1[r],p1[r+1]);b=max3f(b,p1[r+2],p1[r+3]);}
  const float m=max2f(a,b);
  auto rr=__builtin_amdgcn_permlane32_swap(__float_as_uint(m),__float_as_uint(m),false,false);
  return max2f(__uint_as_float(rr[0]),__uint_as_float(rr[1]));
}
__device__ __forceinline__ void pv(f32x16*o,int vb,bf16x8 pa0,bf16x8 pa1,bf16x8 pa2,bf16x8 pa3){
  #pragma unroll
  for(int d0=0;d0<2;++d0){s16x4 lo[4],hi[4];
    #pragma unroll
    for(int ks=0;ks<4;++ks){
      asm volatile("ds_read_b64_tr_b16 %0,%1 offset:%c2":"=&v"(lo[ks]):"v"(vb),"i"(d0*4096+ks*1024):"memory");
      asm volatile("ds_read_b64_tr_b16 %0,%1 offset:%c2":"=&v"(hi[ks]):"v"(vb),"i"(d0*4096+ks*1024+512):"memory");}
    asm volatile("s_waitcnt lgkmcnt(0)":::"memory");SBAR();
    #define PK(k) (bf16x8){lo[k][0],lo[k][1],lo[k][2],lo[k][3],hi[k][0],hi[k][1],hi[k][2],hi[k][3]}
    o[d0]=__builtin_amdgcn_mfma_f32_32x32x16_bf16(pa0,PK(0),o[d0],0,0,0);
    o[d0]=__builtin_amdgcn_mfma_f32_32x32x16_bf16(pa1,PK(1),o[d0],0,0,0);
    o[d0]=__builtin_amdgcn_mfma_f32_32x32x16_bf16(pa2,PK(2),o[d0],0,0,0);
    o[d0]=__builtin_amdgcn_mfma_f32_32x32x16_bf16(pa3,PK(3),o[d0],0,0,0);
    #undef PK
  }
}

#ifndef ATTN_STORE16
#define ATTN_STORE16(p,v) (*(u32x4*)(p)=(v))
#endif
template<int THRL,bool FIXED> __device__ __forceinline__ void attn_unit(long qrow0,int h,long kvrow0,int kvh,const bf16*Q,const bf16*__restrict__ K,const bf16*__restrict__ V,bf16*O,char*shm,float mfix){
  int tid_=threadIdx.x; asm volatile("":"+v"(tid_)); const int tid=tid_,lane=tid&63,r32=lane&31,hi=lane>>5; const int wid=__builtin_amdgcn_readfirstlane(tid>>6);
  const bf16*Qw=Q+(qrow0+wid*QBLK)*QP+h*D;
  const bf16*Kh=K+kvrow0*KP+kvh*D,*Vh=V+kvrow0*KP+kvh*D;
  const unsigned lds0=(unsigned)(uintptr_t)shm;
  float*wsf=(float*)(shm+LDS_WS)+wid*64;
  const bf16*ksrc=Kh+(long)lane*KP+wid*8;
  const bf16*vsrc=Vh+(long)(16*(wid&3)+(lane>>2))*KP+(wid>>2)*32+(lane&3)*8;
  const unsigned kdst=lds0+LDS_K+wid*1024, vdst=lds0+LDS_V+wid*1024;
  #define DMA_K(t,slot) glds16(ksrc+(long)(t)*KVBLK*KP,(unsigned)__builtin_amdgcn_readfirstlane(kdst+(slot)))
  #define DMA_V(t,slot) glds16(vsrc+(long)(t)*KVBLK*KP,(unsigned)__builtin_amdgcn_readfirstlane(vdst+(slot)))
  const int vb0=(int)(lds0+LDS_V)+((lane>>4)&1)*32+(lane&3)*8+(4*hi+((lane&15)>>2))*64;
  const char*Kbase=shm+LDS_K; bf16x8 kf[8];
  const lds_cptr shm3=(lds_cptr)shm; const lds_cptr kp0=shm3+LDS_K+hi*1024+r32*16; const lds_cptr vp0=shm3+LDS_V+((lane>>4)&1)*32+(lane&3)*8+(4*hi+((lane&15)>>2))*64;
  constexpr int NT=NKT;
  DMA_K(0,0);DMA_V(0,0);DMA_K(1,SLOTB);
  bf16x8 qr[4];
  #pragma unroll
  for(int d0=0;d0<4;++d0)qr[d0]=*reinterpret_cast<const bf16x8*>(&Qw[(long)r32*QP+d0*16+hi*8]);
  float mhat=0.f,l_reg=0.f;f32x16 o[2];o[0]=f32x16{};o[1]=f32x16{};f32x16 negm;
  #pragma unroll
  for(int r=0;r<16;++r)negm[r]=FIXED?-mfix:0.f;
  asm volatile("":"+v"(negm));
  #define CMASK(P0,P1,t) do{}while(0)
  bool resc=false;
  #define START(P0,P1) do{ if(!FIXED){ const float rm=rowmax(P0,P1); resc=false; \
    { const float dl=rm; mhat=fadd_s(mhat,dl); \
      _Pragma("unroll") for(int r=0;r<16;++r){P0[r]=fsub_s(P0[r],dl);P1[r]=fsub_s(P1[r],dl);} \
      _Pragma("unroll") for(int r=0;r<16;++r)negm[r]=-mhat; asm volatile("":"+v"(negm)); } } \
    _Pragma("unroll") for(int r=0;r<16;++r)P0[r]=__builtin_amdgcn_exp2f(P0[r]); }while(0)
  #define RESC() do{ if(resc){ asm volatile("s_waitcnt lgkmcnt(0)":::"memory"); \
      _Pragma("unroll") for(int d_=0;d_<2;++d_) _Pragma("unroll") for(int r=0;r<16;++r)o[d_][r]*=wsf[crow(r,hi)]; } }while(0)
  f32x16 pA0,pA1,pB0,pB1;
  int sl_prev=0,sl_cur=0,sl_next=SLOTB;
  #define ROT() do{sl_prev=sl_cur;sl_cur=sl_next;sl_next=(sl_next==(NSLOT-1)*SLOTB)?0:sl_next+SLOTB;}while(0)
  DMA_K(2,2*SLOTB);
  WAIT_BAR(3);
  qkt(pA0,pA1,Kbase,qr,negm,r32,hi);asm volatile("s_nop 15\n\ts_nop 7":"+v"(pA0),"+v"(pA1));CMASK(pA0,pA1,0);
  START(pA0,pA1);
  _Pragma("unroll") for(int r=0;r<16;++r)pA1[r]=__builtin_amdgcn_exp2f(pA1[r]);
  WAIT_BAR(0);
  DMA_K(3,0);DMA_V(1,SLOTB);
  ROT();
  kload8(kf,kp0+sl_cur);
  WAIT_BAR(2);
  s16x4 vlo[8],vhi[8]; u32x4 pw0,pw1,pw2,pw3;
  #define PKW(P,B) cvtpk_s(P[B],P[B+1])
  #define PAF(k) __builtin_bit_cast(bf16x8,pw##k)
  #define VFR(i) (bf16x8){vlo[i][0],vlo[i][1],vlo[i][2],vlo[i][3],vhi[i][0],vhi[i][1],vhi[i][2],vhi[i][3]}
  #define PIN(x) asm volatile("":"+v"(x))
  #define MX3(a,b,c) __builtin_fmaxf(__builtin_fmaxf((a),(b)),(c))
  #define GAPA(MF,A0,A1,A2,A3,W0,W1,PW) do{ MF; sacc+=A0; sacc+=A1; sacc+=A2; sacc+=A3; PIN(sacc); W0; W1; PIN(PW); SBAR(); }while(0)
  #define EX(v) __builtin_amdgcn_exp2f(v)
  #define GAPB(MF,X,B) do{ MF; X[B]=EX(X[B]); X[B+1]=EX(X[B+1]); X[B+2]=EX(X[B+2]); X[B+3]=EX(X[B+3]); PIN(X); SBAR(); }while(0)
  #define VRD(i) do{ vlo[i]=vtr(vp_+(((i)>>2)*4096+((i)&3)*1024)); vhi[i]=vtr(vp_+(((i)>>2)*4096+((i)&3)*1024+512)); }while(0)
  #define KRD(G,j) do{ if(G){ kload2(kf,kp0+sl_next,j); SBAR(); } }while(0)
  #define STEP(C0,C1,P0,P1,t,GK,GV,GL) do{ SBAR(); \
    const lds_cptr vp_=vp0+sl_prev; \
    VRD(0); SBAR(); float sacc=(P0[0]+P0[1]); \
    GAPA(C0=__builtin_amdgcn_mfma_f32_32x32x16_bf16(kf[0],qr[0],negm,0,0,0), P0[2],P0[3],P0[4],P0[5],     pw0[0]=PKW(P0,0), pw0[1]=PKW(P0,2), pw0); \
    VRD(4); SBAR(); GAPA(C1=__builtin_amdgcn_mfma_f32_32x32x16_bf16(kf[1],qr[0],negm,0,0,0), P0[6],P0[7],P0[8],P0[9],     pw0[2]=PKW(P0,4), pw0[3]=PKW(P0,6), pw0); \
    VRD(1); SBAR(); GAPA(C0=__builtin_amdgcn_mfma_f32_32x32x16_bf16(kf[2],qr[1],C0,0,0,0),   P0[10],P0[11],P0[12],P0[13], pw1[0]=PKW(P0,8), pw1[1]=PKW(P0,10), pw1); \
    VRD(5); SBAR(); GAPA(C1=__builtin_amdgcn_mfma_f32_32x32x16_bf16(kf[3],qr[1],C1,0,0,0),   P0[14],P0[15],P1[0],P1[1],   pw1[2]=PKW(P0,12),pw1[3]=PKW(P0,14), pw1); \
    VRD(2); SBAR(); GAPA(C0=__builtin_amdgcn_mfma_f32_32x32x16_bf16(kf[4],qr[2],C0,0,0,0),   P1[2],P1[3],P1[4],P1[5],     pw2[0]=PKW(P1,0), pw2[1]=PKW(P1,2), pw2); \
    VRD(6); SBAR(); GAPA(C1=__builtin_amdgcn_mfma_f32_32x32x16_bf16(kf[5],qr[2],C1,0,0,0),   P1[6],P1[7],P1[8],P1[9],     pw2[2]=PKW(P1,4), pw2[3]=PKW(P1,6), pw2); \
    VRD(3); SBAR(); GAPA(C0=__builtin_amdgcn_mfma_f32_32x32x16_bf16(kf[6],qr[3],C0,0,0,0),   P1[10],P1[11],P1[12],P1[13], pw3[0]=PKW(P1,8), pw3[1]=PKW(P1,10), pw3); \
    VRD(7); SBAR(); GAPA(C1=__builtin_amdgcn_mfma_f32_32x32x16_bf16(kf[7],qr[3],C1,0,0,0),   P1[14],P1[15],0.f,0.f,       pw3[2]=PKW(P1,12),pw3[3]=PKW(P1,14), pw3); \
    l_reg+=sacc; \
    if(GK){DMA_K((t)+3,sl_cur);} if(GV){DMA_V((t)+1,sl_next);} \
    CMASK(C0,C1,t); \
    if(!FIXED){ float a=MX3(C0[0],C0[1],C1[0]),b=MX3(C0[2],C0[3],C1[1]); a=MX3(a,C1[2],C1[3]); \
      _Pragma("unroll") for(int r=4;r<16;r+=4){a=MX3(a,C0[r],C0[r+1]);b=MX3(b,C0[r+2],C0[r+3]);a=MX3(a,C1[r],C1[r+1]);b=MX3(b,C1[r+2],C1[r+3]);} \
      float rm=__builtin_fmaxf(a,b); { auto rr=__builtin_amdgcn_permlane32_swap(__float_as_uint(rm),__float_as_uint(rm),false,false); rm=__builtin_fmaxf(__uint_as_float(rr[0]),__uint_as_float(rr[1])); } \
      resc=false; \
      if(__builtin_expect(__any(rm>(float)THRL),0)){ const float dl=__builtin_fmaxf(rm,0.f); mhat+=dl; \
        _Pragma("unroll") for(int r=0;r<16;++r){C0[r]-=dl;C1[r]-=dl;} \
        _Pragma("unroll") for(int r=0;r<16;++r)negm[r]=-mhat; asm volatile("":"+v"(negm)); \
        const float f=__builtin_amdgcn_exp2f(-dl); l_reg*=f; if(hi==0)wsf[r32]=f; resc=true; } } \
    SBAR(); \
    GAPB(o[0]=__builtin_amdgcn_mfma_f32_32x32x16_bf16(PAF(0),VFR(0),o[0],0,0,0), C0,0); \
    GAPB(o[1]=__builtin_amdgcn_mfma_f32_32x32x16_bf16(PAF(0),VFR(4),o[1],0,0,0), C0,4); \
    KRD(GL,0); GAPB(o[0]=__builtin_amdgcn_mfma_f32_32x32x16_bf16(PAF(1),VFR(1),o[0],0,0,0), C0,8); \
    KRD(GL,1); GAPB(o[1]=__builtin_amdgcn_mfma_f32_32x32x16_bf16(PAF(1),VFR(5),o[1],0,0,0), C0,12); \
    KRD(GL,2); GAPB(o[0]=__builtin_amdgcn_mfma_f32_32x32x16_bf16(PAF(2),VFR(2),o[0],0,0,0), C1,0); \
    KRD(GL,3); GAPB(o[1]=__builtin_amdgcn_mfma_f32_32x32x16_bf16(PAF(2),VFR(6),o[1],0,0,0), C1,4); \
    GAPB(o[0]=__builtin_amdgcn_mfma_f32_32x32x16_bf16(PAF(3),VFR(3),o[0],0,0,0), C1,8); \
    GAPB(o[1]=__builtin_amdgcn_mfma_f32_32x32x16_bf16(PAF(3),VFR(7),o[1],0,0,0), C1,12); \
    }while(0)
  int t=1;
  #undef CMASK
  #define CMASK(P0,P1,t) do{}while(0)
  for(;t+5<NT;t+=2){
    STEP(pB0,pB1,pA0,pA1,t,true,true,true);     WAIT_BAR(2); RESC(); ROT();
    STEP(pA0,pA1,pB0,pB1,t+1,true,true,true);   WAIT_BAR(2); RESC(); ROT();
  }
  #undef CMASK
  #define CMASK(P0,P1,t) do{}while(0)
  #define ENDW(tt) do{ if((tt)+3<NT){WAIT_BAR(2);} else if((tt)+2<NT){WAIT_BAR(1);} else {WAIT_BAR(0);} }while(0)
  for(;t+1<NT;t+=2){
    STEP(pB0,pB1,pA0,pA1,t,(t+3<NT),(t+1<NT),(t+1<NT));       ENDW(t);   RESC(); ROT();
    STEP(pA0,pA1,pB0,pB1,t+1,(t+4<NT),(t+2<NT),(t+2<NT));     ENDW(t+1); RESC(); ROT();
  }
  STEP(pB0,pB1,pA0,pA1,NT-1,false,false,false); RESC();
  { float sacc=pB0[0]+pB0[1]; _Pragma("unroll") for(int r=2;r<16;++r)sacc+=pB0[r]; _Pragma("unroll") for(int r=0;r<16;++r)sacc+=pB1[r]; l_reg+=sacc;
    pw0=(u32x4){PKW(pB0,0),PKW(pB0,2),PKW(pB0,4),PKW(pB0,6)};pw1=(u32x4){PKW(pB0,8),PKW(pB0,10),PKW(pB0,12),PKW(pB0,14)};pw2=(u32x4){PKW(pB1,0),PKW(pB1,2),PKW(pB1,4),PKW(pB1,6)};pw3=(u32x4){PKW(pB1,8),PKW(pB1,10),PKW(pB1,12),PKW(pB1,14)};
    SBAR(); pv(o,vb0+sl_cur,PAF(0),PAF(1),PAF(2),PAF(3)); }
  #undef PKW
  #undef PAF
  #undef VFR
  #undef PIN
  #undef MX3
  #undef GAPA
  #undef GAPB
  #undef EX
  #undef VRD
  #undef KRD
  #undef STEP
  #undef ENDW
  {auto rr=__builtin_amdgcn_permlane32_swap(__float_as_uint(l_reg),__float_as_uint(l_reg),false,false);l_reg=__uint_as_float(rr[0])+__uint_as_float(rr[1]);}
  if(hi==0)wsf[32+r32]=l_reg;asm volatile("s_waitcnt lgkmcnt(0)":::"memory");
  float rli[16];
  #pragma unroll
  for(int r=0;r<16;++r)rli[r]=__builtin_amdgcn_rcpf(wsf[32+crow(r,hi)]);
  bf16*Ow=O+(qrow0+wid*QBLK)*QP+h*D;
  { bf16*stg=(bf16*)(shm+LDS_OST)+wid*2048;
    #pragma unroll
    for(int r=0;r<16;++r){const int orow=crow(r,hi);
      #pragma unroll
      for(int d0=0;d0<2;++d0)stg[orow*64+d0*32+r32]=__float2bfloat16(o[d0][r]*rli[r]);}
    asm volatile("s_waitcnt lgkmcnt(0)":::"memory");
    #pragma unroll
    for(int i=0;i<4;++i){const int row=i*8+(lane>>3),ch=lane&7; const u32x4 v=*(const u32x4*)(stg+row*64+ch*8); ATTN_STORE16(Ow+(long)row*QP+ch*8,v);} }
  asm volatile("s_waitcnt lgkmcnt(0)\n\ts_barrier":::"memory");
  #undef DMA_K
  #undef DMA_V
  #undef CMASK
  #undef START
  #undef RESC
  #undef ROT
}
constexpr int ATTN_LDS_BYTES=LDS_BYTES;
#undef SBAR
#undef WAIT_BAR
}
constexpr int NWAVES = 8;
using pg8::bf16_t; using pg8::bf16x8; using pg8::f32x4; using pg8::u32x4;
typedef unsigned u32x2 __attribute__((ext_vector_type(2)));
#define LAS __attribute__((address_space(3)))
#define GAS __attribute__((address_space(1)))
#define RLX_AGENT __ATOMIC_RELAXED, __HIP_MEMORY_SCOPE_AGENT
#define LDS_WAIT() asm volatile("s_waitcnt lgkmcnt(0)" ::: "memory")
#define VM_WAIT() asm volatile("s_waitcnt vmcnt(0)" ::: "memory")

constexpr size_t MiB = 1u << 20;
constexpr size_t WS_CTL = 0, CTL_ZERO_BYTES = 64 * 1024;
constexpr size_t WS_MOD = 1 * MiB;
constexpr size_t WS_LB = WS_MOD + 512 * 1024;
constexpr size_t WS_ROPE = WS_LB + 8 * 1024;
constexpr size_t WS_WIN = 2 * MiB;
constexpr size_t WS_WINS = 10 * MiB;
constexpr int CW_CMAX = 10240;
constexpr size_t WS_WA = 13 * MiB, WS_WB = 14 * MiB, WS_WO = 15 * MiB;
constexpr size_t WS_WGU = 17 * MiB, WS_WD = 81 * MiB;
constexpr size_t WS_HX = 17 * MiB;
constexpr size_t WS_A1 = 17 * MiB, WS_OATT = 49 * MiB, WS_OR = 81 * MiB;
constexpr size_t WS_HQ = 113 * MiB, WS_FF = 145 * MiB, WS_FB = 181 * MiB, WS_HI = 217 * MiB, WS_SG = 253 * MiB, WS_Q = 285 * MiB, WS_K = 317 * MiB, WS_V = 326 * MiB;
constexpr size_t WS_GA = 335 * MiB, WS_GB = 399 * MiB;
constexpr size_t WS_Z = 113 * MiB;
constexpr size_t WS_H2 = 177 * MiB;
constexpr size_t WS_AFF = 241 * MiB;
constexpr size_t WS_HS = 209 * MiB;
constexpr size_t WS_TQ = 17 * MiB + 48 * MiB;
constexpr size_t WS_TD = 81 * MiB + 24 * MiB;
constexpr size_t WS_HIDQ = 113 * MiB;
constexpr size_t WS_SCL2 = 243 * MiB + 768 * 1024;
constexpr size_t WS_SCL = 243 * MiB + 512 * 1024;
constexpr size_t WS_IDX = 243 * MiB;
constexpr size_t WS_SLOT = 244 * MiB;
constexpr size_t WS_X1B = 246 * MiB;
constexpr size_t WS_YE = 374 * MiB;
constexpr size_t WS_END = 502 * MiB;
constexpr int CW_Q3 = 64;
constexpr int CW_MFIX = 96;
constexpr int CW_BAR = 1024;

constexpr int RING_BYTES = 131072, MISC_OFF = RING_BYTES, LDS_BYTES = 147456;

#define PB_HX(A)   ((unsigned char*)(A).out)
#define PB_HXS(A)  ((float*)((unsigned char*)(A).out + 100 * MiB))
#define PB_A1(A)   ((unsigned char*)(A).out)
#define PB_OATT(A) ((unsigned char*)(A).out + 32 * MiB)
#define PB_OR(A)   ((unsigned char*)(A).out + 64 * MiB)
#define PB_HID(A)  ((unsigned char*)(A).out)
struct Args {
    const float *x, *c, *ctx, *c_ctx, *w_mod, *b_mod, *n1g, *n2g, *w_in, *lbl, *hgn, *qng, *kng, *wa, *wb, *wo, *wr, *weg, *weu, *wed, *fng;
    float* out; unsigned char* ws;
};

#define XB_TMO      128
#define XB_XCNT(j)  (256  + 64 * (j))
#define XB_XSUB(j)  (1280 + 64 * (j))
#define XB_XGEN(j)  (2304 + 64 * (j))
#define XB_TOP      3328
#define XB_TOPGEN   3392
#define XCD_BAR_WORDS 3456
#define XB_SPIN_CAP (1u << 18)
#ifndef XB_SCOPE
#define XB_SCOPE "agent"
#endif

__device__ __forceinline__ unsigned xb_ld(unsigned* p)              { return __hip_atomic_load(p, __ATOMIC_RELAXED, __HIP_MEMORY_SCOPE_AGENT); }
__device__ __forceinline__ unsigned xb_add(unsigned* p, unsigned v) { return __hip_atomic_fetch_add(p, v, __ATOMIC_RELAXED, __HIP_MEMORY_SCOPE_AGENT); }
__device__ __forceinline__ unsigned xb_xcc_id() { return (unsigned)__builtin_amdgcn_s_getreg((3 << 11) | 20) & 0xFu; }
#define XB_SPIN(cond, bar) do { unsigned _sp = 0; while (cond) { __builtin_amdgcn_s_sleep(1); \
    if ((++_sp & 255u) == 0u) { if (xb_ld(&(bar)[XB_TMO])) break; if (_sp > XB_SPIN_CAP) { atomicAdd(&(bar)[XB_TMO], 1u); break; } } } } while (0)

struct XcdBarrier {
    unsigned* bar; unsigned x;
    volatile LAS unsigned* st;
};

__device__ __forceinline__ XcdBarrier xcd_barrier_post(unsigned* bar, volatile LAS unsigned* st) {
    XcdBarrier b; b.bar = bar; b.x = xb_xcc_id(); b.st = st;
    if (threadIdx.x == 0) (void)xb_add(&bar[XB_XCNT(b.x)], 1u);
    return b;
}
__device__ __forceinline__ void xcd_barrier_complete(unsigned* bar, unsigned x, unsigned& nloc, unsigned& nx) {
    const unsigned G = gridDim.x * gridDim.y * gridDim.z;
    unsigned sum, cnt, mine, sp = 0u;
    for (;;) {
        sum = 0u; cnt = 0u; mine = 0u;
#pragma unroll
        for (unsigned j = 0; j < 16; ++j) { const unsigned c = xb_ld(&bar[XB_XCNT(j)]); sum += c; cnt += (c > 0u) ? 1u : 0u; mine = (j == x) ? c : mine; }
        if (sum == G) break;
        __builtin_amdgcn_s_sleep(1);
        if ((++sp & 255u) == 0u) { if (xb_ld(&bar[XB_TMO])) break; if (sp > XB_SPIN_CAP) { atomicAdd(&bar[XB_TMO], 1u); break; } }
    }
    nloc = mine > 0u ? mine : 1u; nx = cnt > 0u ? cnt : 1u;
}

__device__ __forceinline__ void xcd_barrier(const XcdBarrier& b) {
    asm volatile("s_waitcnt vmcnt(0)" ::: "memory");
    __syncthreads();
    if (threadIdx.x == 0) {
        unsigned* bar = b.bar;
        __builtin_amdgcn_s_waitcnt(0);
        unsigned nloc = b.st[0], nx = b.st[1];
        if (nloc == 0u) { xcd_barrier_complete(bar, b.x, nloc, nx); b.st[0] = nloc; b.st[1] = nx; }
#if DBG_RELEASE_ALL
        __builtin_amdgcn_fence(__ATOMIC_RELEASE, "agent"); asm volatile("s_waitcnt vmcnt(0)" ::: "memory");
#endif
        const unsigned old = xb_add(&bar[XB_XSUB(b.x)], 1u);
        const unsigned gen = old / nloc;
        if (old + 1u == (gen + 1u) * nloc) {
#if DBG_LEADER_DELAY
            { const unsigned long long t0_ = __builtin_amdgcn_s_memrealtime(); while (__builtin_amdgcn_s_memrealtime() - t0_ < (unsigned long long)DBG_LEADER_DELAY) __builtin_amdgcn_s_sleep(2); }
#endif
            __builtin_amdgcn_fence(__ATOMIC_RELEASE, XB_SCOPE);
            asm volatile("s_waitcnt vmcnt(0)" ::: "memory");
#if DBG_WBL2_TWICE
            { const unsigned long long t0_ = __builtin_amdgcn_s_memrealtime(); while (__builtin_amdgcn_s_memrealtime() - t0_ < 150ull) __builtin_amdgcn_s_sleep(2); }
            asm volatile("buffer_wbl2 sc1\n\ts_waitcnt vmcnt(0)" ::: "memory");
#endif
            const unsigned og = xb_add(&bar[XB_TOP], 1u);
            const unsigned tg = og / nx;
            if (og + 1u == (tg + 1u) * nx) xb_add(&bar[XB_TOPGEN], 1u);
            else XB_SPIN(xb_ld(&bar[XB_TOPGEN]) == tg, bar);
            __builtin_amdgcn_fence(__ATOMIC_ACQUIRE, XB_SCOPE);
            xb_add(&bar[XB_XGEN(b.x)], 1u);
            asm volatile("s_waitcnt vmcnt(0)" ::: "memory");
        } else {
            XB_SPIN(xb_ld(&bar[XB_XGEN(b.x)]) == gen, bar);
            __builtin_amdgcn_fence(__ATOMIC_ACQUIRE, XB_SCOPE);
            asm volatile("s_waitcnt vmcnt(0)" ::: "memory");
        }
    }
    __syncthreads();
}

__device__ __forceinline__ float wave_sum(float v) {
#pragma unroll
    for (int o = 1; o < 64; o <<= 1) v += __shfl_xor(v, o);
    return v;
}
__device__ __forceinline__ unsigned f2bf(float f) { unsigned u = __builtin_bit_cast(unsigned, f); return (u + 0x7fffu + ((u >> 16) & 1u)) >> 16; }
__device__ __forceinline__ unsigned pk2(float lo, float hi) { return f2bf(lo) | (f2bf(hi) << 16); }
__device__ __forceinline__ float bf2f(unsigned short h) { return __uint_as_float((unsigned)h << 16); }

template <bool QKPERM>
__device__ __forceinline__ void transpose_item_q8(const float* W, int Nsrc, int n0, int k0, float inv, unsigned char* WQ, long drow0, LAS float* scr, int lane) {
    float tv[32];
#pragma unroll
    for (int i = 0; i < 32; ++i) tv[i] = W[(size_t)(k0 + 2 * i + (lane >> 5)) * Nsrc + n0 + (lane & 31)];
#pragma unroll
    for (int i = 0; i < 32; ++i) scr[(2 * i + (lane >> 5)) * 33 + (lane & 31)] = __builtin_rintf(tv[i] * inv);
    LDS_WAIT(); asm volatile("" ::: "memory");
    const int c = lane & 7;
#pragma unroll
    for (int j = 0; j < 4; ++j) { const int n = (lane >> 3) + 8 * j;
        const int ns = QKPERM ? (16 * ((n & 7) >> 2) + 4 * (n >> 3) + (n & 3)) : n;
        const LAS float* s = scr + (8 * c) * 33 + ns;
        const unsigned w0 = ((unsigned)(int)s[0 * 33] & 255u) | (((unsigned)(int)s[1 * 33] & 255u) << 8) | (((unsigned)(int)s[2 * 33] & 255u) << 16) | ((unsigned)(int)s[3 * 33] << 24);
        const unsigned w1 = ((unsigned)(int)s[4 * 33] & 255u) | (((unsigned)(int)s[5 * 33] & 255u) << 8) | (((unsigned)(int)s[6 * 33] & 255u) << 16) | ((unsigned)(int)s[7 * 33] << 24);
        u32x2 o; o.x = w0; o.y = w1; *(u32x2*)(WQ + (size_t)(drow0 + n) * 1024 + k0 + 8 * c) = o; }
    LDS_WAIT(); asm volatile("" ::: "memory");
}
template <bool QKPERM>
__device__ __forceinline__ void transpose_item(const float* W, int K, int Nsrc, int n0, int k0, bf16_t* WT, long drow0, LAS float* scr, int lane) {
    float tv[32];
#pragma unroll
    for (int i = 0; i < 32; ++i) tv[i] = W[(size_t)(k0 + 2 * i + (lane >> 5)) * Nsrc + n0 + (lane & 31)];
#pragma unroll
    for (int i = 0; i < 32; ++i) scr[(2 * i + (lane >> 5)) * 33 + (lane & 31)] = tv[i];
    LDS_WAIT(); asm volatile("" ::: "memory");
    const int c = lane & 7;
#pragma unroll
    for (int j = 0; j < 4; ++j) { const int n = (lane >> 3) + 8 * j;
        const int ns = QKPERM ? (16 * ((n & 7) >> 2) + 4 * (n >> 3) + (n & 3)) : n;
        const LAS float* s = scr + (8 * c) * 33 + ns;
        u32x4 o; o.x = pk2(s[0 * 33], s[1 * 33]); o.y = pk2(s[2 * 33], s[3 * 33]); o.z = pk2(s[4 * 33], s[5 * 33]); o.w = pk2(s[6 * 33], s[7 * 33]);
        *(u32x4*)(WT + (size_t)(drow0 + n) * K + k0 + 8 * c) = o; }
    LDS_WAIT(); asm volatile("" ::: "memory");
}
__device__ __forceinline__ void p0_adaln_item(const Args& A, LAS unsigned char* lds, int item, int tid) {
    LAS float* sc = (LAS float*)lds;
    LAS float* red = (LAS float*)(lds + 17 * 1024 * 4);
    const int wave = tid >> 6, lane = tid & 63, col = lane & 31, kp = lane >> 5;
    const float* wp = A.w_mod + (size_t)(wave * 128 + kp * 64) * NMOD + item * 32 + col;
    float w[64];
#pragma unroll
    for (int kk = 0; kk < 64; ++kk) w[kk] = wp[(size_t)kk * NMOD];
    for (int i = tid; i < 17 * 1024; i += 512) { const int b = i >> 10, k = i & 1023; const float v = b < 16 ? A.c[b * 1024 + k] : A.c_ctx[k]; sc[i] = v * pg8::fsigmoid(v); }
    __syncthreads();
    float acc[17];
#pragma unroll
    for (int b = 0; b < 17; ++b) acc[b] = 0.f;
#pragma unroll
    for (int kk = 0; kk < 64; kk += 4) {
#pragma unroll
        for (int b = 0; b < 17; ++b) { const f32x4 s4 = *(const LAS f32x4*)(sc + b * 1024 + wave * 128 + kp * 64 + kk); acc[b] += (s4[0] * w[kk] + s4[1] * w[kk + 1]) + (s4[2] * w[kk + 2] + s4[3] * w[kk + 3]); } }
#pragma unroll
    for (int b = 0; b < 17; ++b) red[((wave * 2 + kp) * 17 + b) * 32 + col] = acc[b];
    __syncthreads();
    float* mod = (float*)(A.ws + WS_MOD);
    for (int i = tid; i < 17 * 32; i += 512) { const int b = i >> 5, cidx = i & 31; float s = 0.f;
#pragma unroll
        for (int w = 0; w < 16; ++w) s += red[(w * 17 + b) * 32 + cidx];
        mod[b * NMOD + item * 32 + cidx] = s + A.b_mod[item * 32 + cidx]; }
    __syncthreads();
}
__device__ __forceinline__ int win_src(int g32, bool& qk) {
    const int pn = g32 >> 3, bj = (g32 >> 2) & 1, wc = g32 & 3;
    if (pn == 10 || pn == 11) { qk = true; return 2560 + (pn - 10) * 256 + wc * 64 + 32 * bj; }
    if (pn == 12 && wc < 2) { qk = true; return 3072 + wc * 64 + 32 * bj; }
    qk = false;
    if (pn == 12) return 3200 + (wc - 2) * 64 + 32 * bj;
    return g32 * 32;
}
template <int PART>
__device__ __forceinline__ void p0_prologue(const Args& A, LAS unsigned char* lds, int vcu, int G, int tid) {
    const int wave = tid >> 6, lane = tid & 63;
    if (PART == 0) {
    for (int it = vcu; it < NMOD / 32; it += G) p0_adaln_item(A, lds, it, tid);
    if (vcu == G - 1) {
        float* lb = (float*)(A.ws + WS_LB); float* rope = (float*)(A.ws + WS_ROPE);
        for (int i = tid; i < 1024; i += 512) { const int d = i >> 9, k = i & 511; const float l0 = A.lbl[(d * 2 + 0) * 512 + k], l1 = A.lbl[(d * 2 + 1) * 512 + k]; lb[i] = 1.0f / (1.0f + expf(l1 - l0)); }
        for (int i = tid; i < 64 * 16; i += 512) { const int pos = i >> 4, f = i & 15; const float inv = powf(10000.0f, -(float)(2 * f) / 32.0f); const float ang = (float)pos * inv; rope[pos * 32 + f] = cosf(ang); rope[pos * 32 + 16 + f] = sinf(ang); }
        if (tid < 64) { float mq = fabsf(A.qng[tid]), mk = fabsf(A.kng[tid]);
#pragma unroll
            for (int o = 32; o > 0; o >>= 1) { mq = fmaxf(mq, __shfl_xor(mq, o)); mk = fmaxf(mk, __shfl_xor(mk, o)); }
            if (tid == 0) ((float*)(A.ws + WS_CTL))[CW_MFIX] = 64.0f * 0.125f * LOG2E * 1.02f * mq * mk + 0.5f; }
    }
    { unsigned* cmax = (unsigned*)(A.ws + WS_CTL) + CW_CMAX; const int gwm = vcu * NWAVES + wave, NGWM = G * NWAVES;
      for (int it = gwm; it < 16 * (INC / 32); it += NGWM) { const int kb = it / (INC / 32), g32 = it % (INC / 32); bool qk; const int n0 = win_src(g32, qk);
          float m = 0.f;
          float tv[32];
#pragma unroll
          for (int i = 0; i < 32; ++i) tv[i] = A.w_in[(size_t)(64 * kb + 2 * i + (lane >> 5)) * INC + n0 + (lane & 31)];
#pragma unroll
          for (int i = 0; i < 32; ++i) m = fmaxf(m, fabsf(tv[i]));
          m = fmaxf(m, __shfl_xor(m, 32));
          if (lane < 32) atomicMax(cmax + g32 * 32 + lane, __float_as_uint(m)); } }
    return; }
    LAS float* scr = (LAS float*)(lds + wave * 8704);
    const int gw = vcu * NWAVES + wave, NGW = G * NWAVES;
    constexpr int I_IN = 16 * (INC / 32), I_A = 8 * 32, I_O = 16 * 32;
    constexpr int NIT = I_IN + 2 * I_A + I_O;
    bf16_t* WinT = (bf16_t*)(A.ws + WS_WIN); bf16_t* WaT = (bf16_t*)(A.ws + WS_WA); bf16_t* WbT = (bf16_t*)(A.ws + WS_WB); bf16_t* WoT = (bf16_t*)(A.ws + WS_WO);
    const int it0 = gw, itstep = NGW, itend = NIT;
    for (int it = it0; it < itend; it += itstep) {
        int r = it;
        if (r < I_IN) { const int kb = r / (INC / 32), g32 = r % (INC / 32);
            bool qk; const int n0 = win_src(g32, qk);
            const unsigned* cmax = (const unsigned*)(A.ws + WS_CTL) + CW_CMAX;
            const float am = fmaxf(__uint_as_float(__hip_atomic_load(cmax + g32 * 32 + (lane & 31), RLX_AGENT)), 1e-30f), inv = 127.0f / am;
            if (kb == 0 && lane < 32) { const int n = lane, ns = qk ? (16 * ((n & 7) >> 2) + 4 * (n >> 3) + (n & 3)) : n;
                ((float*)(A.ws + WS_WINS))[g32 * 32 + n] = fmaxf(__uint_as_float(__hip_atomic_load(cmax + g32 * 32 + ns, RLX_AGENT)), 1e-30f) * (1.0f / 127.0f); }
            if (qk) transpose_item_q8<true>(A.w_in, INC, n0, 64 * kb, inv, A.ws + WS_WIN, (long)g32 * 32, scr, lane);
            else transpose_item_q8<false>(A.w_in, INC, n0, 64 * kb, inv, A.ws + WS_WIN, (long)g32 * 32, scr, lane);
            continue; }
        r -= I_IN;
        if (r < I_A) { transpose_item<false>(A.wa, 512, 1024, (r & 31) * 32, 64 * (r >> 5), WaT, (long)(r & 31) * 32, scr, lane); continue; } r -= I_A;
        if (r < I_A) { transpose_item<false>(A.wb, 512, 1024, (r & 31) * 32, 64 * (r >> 5), WbT, (long)(r & 31) * 32, scr, lane); continue; } r -= I_A;
        transpose_item<false>(A.wo, 1024, 1024, (r & 31) * 32, 64 * (r >> 5), WoT, (long)(r & 31) * 32, scr, lane);
    }
}

__device__ __forceinline__ void p1_finish(unsigned char* HXQ, float* HXS, int r, int lane, const f32x4 (&v)[4], const f32x4 (&gs)[4], const f32x4 (&sh)[4]) {
    float ss = 0.f;
#pragma unroll
    for (int j = 0; j < 4; ++j) ss += (v[j][0] * v[j][0] + v[j][1] * v[j][1]) + (v[j][2] * v[j][2] + v[j][3] * v[j][3]);
    const float rstd = 1.0f / sqrtf(wave_sum(ss) * (1.0f / 1024.0f) + EPS);
    f32x4 o[4]; float amax = 0.f;
#pragma unroll
    for (int j = 0; j < 4; ++j) { o[j] = (v[j] * rstd) * gs[j] + sh[j]; amax = fmaxf(fmaxf(amax, fmaxf(fabsf(o[j][0]), fabsf(o[j][1]))), fmaxf(fabsf(o[j][2]), fabsf(o[j][3]))); }
#pragma unroll
    for (int o_ = 1; o_ < 64; o_ <<= 1) amax = fmaxf(amax, __shfl_xor(amax, o_));
    const float am = amax > 1e-30f ? amax : 1e-30f, inv = 127.0f / am;
    if (lane == 0) HXS[r] = am * (1.0f / 127.0f);
#pragma unroll
    for (int j = 0; j < 4; ++j) { const int cidx = 4 * lane + 256 * j; const f32x4 q = o[j] * inv;
        const int q0 = (int)__builtin_rintf(q[0]), q1 = (int)__builtin_rintf(q[1]), q2 = (int)__builtin_rintf(q[2]), q3 = (int)__builtin_rintf(q[3]);
        *(unsigned*)(HXQ + (size_t)r * 1024 + cidx) = ((unsigned)q0 & 255u) | (((unsigned)q1 & 255u) << 8) | (((unsigned)q2 & 255u) << 16) | ((unsigned)q3 << 24); }
}
__device__ __forceinline__ void p1_rows(const Args& A, int vcu, int G, int tid) {
    const int wave = tid >> 6, lane = tid & 63; const int gw = vcu * NWAVES + wave, NGW = G * NWAVES;
    const float* mod = (const float*)(A.ws + WS_MOD); unsigned char* HXQ = (unsigned char*)(PB_HX(A)); float* HXS = PB_HXS(A);
    auto src_of = [&](int r) -> const float* { const int b = r / RPB, s = r - b * RPB; return s < CTXL ? A.ctx + ((size_t)b * CTXL + s) * 1024 : A.x + ((size_t)b * SEQ + (s - CTXL)) * 1024; };
    auto cls_of = [&](int r) -> int { const int b = r / RPB, s = r - b * RPB; return s < CTXL ? 16 : b; };
    const int RPW = (MR + NGW - 1) / NGW; const int r0 = gw * RPW, r1 = r0 + RPW < MR ? r0 + RPW : MR;
    if (r0 < r1) {
        f32x4 gs[4], sh[4]; int ccur = -1;
        auto consts = [&](int r) { const int c = cls_of(r);
            if (c != ccur) { ccur = c; const float* mrow = mod + (size_t)c * NMOD;
#pragma unroll
                for (int j = 0; j < 4; ++j) { const int cidx = 4 * lane + 256 * j; sh[j] = *(const f32x4*)(mrow + cidx); gs[j] = *(const f32x4*)(A.n1g + cidx) * (*(const f32x4*)(mrow + 1024 + cidx) + 1.0f); }
                asm volatile("" : "+v"(gs[0]), "+v"(gs[1]), "+v"(gs[2]), "+v"(gs[3]), "+v"(sh[0]), "+v"(sh[1]), "+v"(sh[2]), "+v"(sh[3])); } };
        f32x4 n0[4], n1[4];
        { const float* src = src_of(r0);
#pragma unroll
          for (int j = 0; j < 4; ++j) n0[j] = *(const f32x4*)(src + 4 * lane + 256 * j); }
        for (int r = r0; r < r1; r += 2) {
            { const float* src = src_of(r + 1 < r1 ? r + 1 : r1 - 1);
#pragma unroll
              for (int j = 0; j < 4; ++j) n1[j] = *(const f32x4*)(src + 4 * lane + 256 * j); }
            consts(r); p1_finish(HXQ, HXS, r, lane, n0, gs, sh);
            { const float* src = src_of(r + 2 < r1 ? r + 2 : r1 - 1);
#pragma unroll
              for (int j = 0; j < 4; ++j) n0[j] = *(const f32x4*)(src + 4 * lane + 256 * j); }
            if (r + 1 < r1) { consts(r + 1); p1_finish(HXQ, HXS, r + 1, lane, n1, gs, sh); }
        }
    }
}

namespace hg {
constexpr int QS = 0, KD = 17408, KE = 34816, KHT = 52224, VT = 70656, PP = 89088, TT = 98304, EQ = 100352, EG = 102400, DK = 103936, SSQ = 104448, LBS = 106496  , GNS = 107008  , Q0 = 107520  , TT8 = 124928  , END = 129024;
constexpr int RS = 272  , TS = 144  ;
constexpr int CW_HG = 8192;
typedef float f32x4 __attribute__((ext_vector_type(4)));
__device__ __forceinline__ bf16x8 pack8(const f32x4 a, const f32x4 b) { u32x4 w; w.x = pg8::cvt_pk_bf16(a[0], a[1]); w.y = pg8::cvt_pk_bf16(a[2], a[3]); w.z = pg8::cvt_pk_bf16(b[0], b[1]); w.w = pg8::cvt_pk_bf16(b[2], b[3]); return __builtin_bit_cast(bf16x8, w); }
__device__ __forceinline__ void unpack8(const u32x4 w, f32x4& a, f32x4& b) { a = (f32x4){pg8::bf_lo(w.x), pg8::bf_hi(w.x), pg8::bf_lo(w.y), pg8::bf_hi(w.y)}; b = (f32x4){pg8::bf_lo(w.z), pg8::bf_hi(w.z), pg8::bf_lo(w.w), pg8::bf_hi(w.w)}; }

constexpr unsigned long long OR_SENTINEL = 0x7fff7fff7fff7fffull;
struct Inputs { unsigned f2[8], q2[8]; u32x4 vv[2]; };

template <bool BWD>
__device__ __forceinline__ void load_inputs(const Args& A, int b, int h, int c, int tid, Inputs& I) {
    const bool latent = c >= 4;
    const long rbase = (long)b * RPB + 64 * c, rlbase = (long)b * SEQ + 64 * (c - 4);
    const bf16_t* F = (const bf16_t*)(A.ws + (BWD ? WS_FB : WS_FF)) + (rbase * 512 + h * 128); const bf16_t* HI = (const bf16_t*)(A.ws + WS_HI) + (rbase * 512 + h * 128);
    const bf16_t* HQ = (const bf16_t*)(A.ws + WS_HQ) + ((latent ? rlbase : 0) * 512 + h * 128);
    const int w8 = __builtin_amdgcn_readfirstlane(tid >> 6); const unsigned voff = (unsigned)(4 * (tid & 63));
#pragma unroll
    for (int e = 0; e < 8; ++e) { const int rho = BWD ? 63 - (8 * w8 + e) : 8 * w8 + e;
        I.f2[e] = *(const unsigned*)((const char*)(F + rho * 512) + voff); I.q2[e] = *(const unsigned*)((const char*)(HQ + rho * 512) + voff); }
    const int sig = tid & 63; const unsigned voffv = (unsigned)((BWD ? 63 - sig : sig) * 1024 + (tid >> 6) * 16);
#pragma unroll
    for (int it = 0; it < 2; ++it) I.vv[it] = *(const u32x4*)((const char*)(HI + 64 * it) + voffv);
}

struct Prep { float kd[2][8], qs[2][8]; float PT[2]; u32x4 vv[2]; };
struct Mid { float kdl[2][8], qsl[2][8]; float T8[2]; u32x4 vv[2]; };
__device__ __forceinline__ void s1_math(LAS unsigned char* lds, Inputs& N, int tid, Mid& M) {
#pragma unroll
    for (int e = 0; e < 8; ++e) asm volatile("" : "+v"(N.f2[e]), "+v"(N.q2[e]));
    asm volatile("" : "+v"(N.vv[0]), "+v"(N.vv[1]));
    const int kp = tid & 63, w8 = tid >> 6;
    const pg8::f32x2_c lb2 = *(const LAS pg8::f32x2_c*)(lds + LBS + 8 * kp);
#pragma unroll
    for (int c = 0; c < 2; ++c) { const float lbv = lb2[c], oml = 1.0f - lbv; float pc = 1.0f;
#pragma unroll
        for (int e = 0; e < 8; ++e) { const float fp = c ? pg8::bf_hi(N.f2[e]) : pg8::bf_lo(N.f2[e]), q = c ? pg8::bf_hi(N.q2[e]) : pg8::bf_lo(N.q2[e]);
            const float f = lbv + oml * pg8::fsigmoid(fp);
            pc *= f; M.kdl[c][e] = (1.0f - f) * __builtin_amdgcn_rcpf(pc); M.qsl[c][e] = q * pc; }
        M.T8[c] = pc; }
    *(LAS pg8::f32x2_c*)(lds + TT8 + (w8 * 128 + 2 * kp) * 4) = (pg8::f32x2_c){M.T8[0], M.T8[1]};
    M.vv[0] = N.vv[0]; M.vv[1] = N.vv[1];
}
__device__ __forceinline__ void s1_store(LAS unsigned char* lds, const Mid& M, bool latent, int tid, Prep& P) {
    const int kp = tid & 63, w8 = __builtin_amdgcn_readfirstlane(tid >> 6);
    const pg8::f32x2_c o2 = *(const LAS pg8::f32x2_c*)(lds + TT8 + ((w8 ^ 1) * 128 + 2 * kp) * 4);
#pragma unroll
    for (int c = 0; c < 2; ++c) { P.PT[c] = M.T8[c] * o2[c];
        if (w8 & 1) { const float pre = o2[c], ipre = __builtin_amdgcn_rcpf(pre);
#pragma unroll
            for (int e = 0; e < 8; ++e) { P.kd[c][e] = M.kdl[c][e] * ipre; P.qs[c][e] = M.qsl[c][e] * pre; } }
        else {
#pragma unroll
            for (int e = 0; e < 8; ++e) { P.kd[c][e] = M.kdl[c][e]; P.qs[c][e] = M.qsl[c][e]; } } }
    P.vv[0] = M.vv[0]; P.vv[1] = M.vv[1];
    if (latent) {
#pragma unroll
        for (int e = 0; e < 8; ++e) { const int tau = 8 * w8 + e;
            *(LAS unsigned*)(lds + QS + tau * RS + 4 * kp) = pg8::cvt_pk_bf16(P.qs[0][e], P.qs[1][e]);
            *(LAS unsigned*)(lds + KD + tau * RS + 4 * kp) = pg8::cvt_pk_bf16(P.kd[0][e], P.kd[1][e]);
            *(LAS unsigned*)(lds + KE + tau * RS + 4 * kp) = pg8::cvt_pk_bf16(P.kd[0][e] * P.PT[0], P.kd[1][e] * P.PT[1]); }
    }
    if (!(w8 & 1)) *(LAS pg8::f32x2_c*)(lds + TT + ((w8 >> 1) * 128 + 2 * kp) * 4) = (pg8::f32x2_c){P.PT[0], P.PT[1]};
}
template <bool BWD, bool SECOND>
__device__ __forceinline__ void chunk_step(const Args& A, LAS unsigned char* lds, int b, int h, int c, f32x4 (&S)[8], Prep& P, Inputs& N, bool next_latent, int cpref, int tid_in) {
    int tid = tid_in; asm volatile("" : "+v"(tid));
    const int wave = __builtin_amdgcn_readfirstlane(tid >> 6), lane = tid & 63, l15 = lane & 15, g = lane >> 4;
    const bool latent = SECOND || c >= 4; constexpr bool second = SECOND;
    const long rlbase = (long)b * SEQ + 64 * (c - 4);
    const int k = tid & 127, part = tid >> 7;
    __syncthreads();
    {
        const int kp = tid & 63, w8 = wave, sb = w8 >> 1;
        const pg8::f32x2_c T0 = *(const LAS pg8::f32x2_c*)(lds + TT + (0 * 128 + 2 * kp) * 4), T1 = *(const LAS pg8::f32x2_c*)(lds + TT + (1 * 128 + 2 * kp) * 4),
                           T2 = *(const LAS pg8::f32x2_c*)(lds + TT + (2 * 128 + 2 * kp) * 4), T3 = *(const LAS pg8::f32x2_c*)(lds + TT + (3 * 128 + 2 * kp) * 4);
#pragma unroll
        for (int c = 0; c < 2; ++c) {
            const float khs = P.PT[c] * (sb == 0 ? T1[c] * T2[c] * T3[c] : sb == 1 ? T2[c] * T3[c] : sb == 2 ? T3[c] : 1.0f);
            u32x4 w0;
            w0.x = pg8::cvt_pk_bf16(P.kd[c][0] * khs, P.kd[c][1] * khs); w0.y = pg8::cvt_pk_bf16(P.kd[c][2] * khs, P.kd[c][3] * khs); w0.z = pg8::cvt_pk_bf16(P.kd[c][4] * khs, P.kd[c][5] * khs); w0.w = pg8::cvt_pk_bf16(P.kd[c][6] * khs, P.kd[c][7] * khs);
            *(LAS u32x4*)(lds + KHT + (2 * kp + c) * TS + 16 * w8) = w0; }
        if (latent) {
            const float eq0 = sb == 0 ? 1.0f : sb == 1 ? T0[0] : sb == 2 ? T0[0] * T1[0] : T0[0] * T1[0] * T2[0], eq1 = sb == 0 ? 1.0f : sb == 1 ? T0[1] : sb == 2 ? T0[1] * T1[1] : T0[1] * T1[1] * T2[1];
#pragma unroll
            for (int e = 0; e < 8; ++e) *(LAS unsigned*)(lds + Q0 + (8 * w8 + e) * RS + 4 * kp) = pg8::cvt_pk_bf16(P.qs[0][e] * eq0, P.qs[1][e] * eq1);
        }
        if (w8 == 0) *(LAS pg8::f32x2_c*)(lds + DK + 8 * kp) = (pg8::f32x2_c){(T0[0] * T1[0]) * (T2[0] * T3[0]), (T0[1] * T1[1]) * (T2[1] * T3[1])};
#pragma unroll
        for (int it = 0; it < 2; ++it) { const int idx = tid + 512 * it, sig = idx & 63, dv0 = (idx >> 6) * 8; const u32x4 w = P.vv[it];
            LAS unsigned short* vt = (LAS unsigned short*)(lds + VT + dv0 * TS + 2 * sig);
            vt[0 * (TS / 2)] = (unsigned short)(w.x & 0xffff); vt[1 * (TS / 2)] = (unsigned short)(w.x >> 16); vt[2 * (TS / 2)] = (unsigned short)(w.y & 0xffff); vt[3 * (TS / 2)] = (unsigned short)(w.y >> 16);
            vt[4 * (TS / 2)] = (unsigned short)(w.z & 0xffff); vt[5 * (TS / 2)] = (unsigned short)(w.z >> 16); vt[6 * (TS / 2)] = (unsigned short)(w.w & 0xffff); vt[7 * (TS / 2)] = (unsigned short)(w.w >> 16); }
    }
    Mid Q;
    s1_math(lds, N, tid, Q);
    load_inputs<BWD>(A, b, h, cpref, tid, N);
    if (latent) {
        for (int pi = wave; pi < 10; pi += 8) {
            const int bi = pi < 4 ? pi : pi < 7 ? pi - 3 : pi < 9 ? pi - 5 : 3;
            const int bjx = pi < 4 ? pi : pi < 7 ? pi - 4 : pi < 9 ? pi - 7 : 0;
            f32x4 cacc = (f32x4){0.f, 0.f, 0.f, 0.f};
            const int egsel = (bi == 2 && bjx == 0) ? 0 : (bi == 3 && bjx == 1) ? 1 : (bi == 3 && bjx == 0) ? 2 : -1;
            u32x4 aw[4], bw[4];
#pragma unroll
            for (int s = 0; s < 4; ++s) { aw[s] = *(const LAS u32x4*)(lds + QS + (16 * bi + l15) * RS + (32 * s + 8 * g) * 2);
                bw[s] = *(const LAS u32x4*)(lds + (bi == bjx ? KD : KE) + (16 * bjx + l15) * RS + (32 * s + 8 * g) * 2); }
            if (egsel >= 0) {
                const int t1 = egsel == 1 ? 2 : 1;
                f32x4 e0[4], e1[4];
#pragma unroll
                for (int s = 0; s < 4; ++s) { e0[s] = *(const LAS f32x4*)(lds + TT + (t1 * 128 + 32 * s + 8 * g) * 4); e1[s] = *(const LAS f32x4*)(lds + TT + (t1 * 128 + 32 * s + 8 * g + 4) * 4); }
                if (egsel == 2) {
#pragma unroll
                    for (int s = 0; s < 4; ++s) { e0[s] = e0[s] * *(const LAS f32x4*)(lds + TT + (2 * 128 + 32 * s + 8 * g) * 4); e1[s] = e1[s] * *(const LAS f32x4*)(lds + TT + (2 * 128 + 32 * s + 8 * g + 4) * 4); }
                }
#pragma unroll
                for (int s = 0; s < 4; ++s) { f32x4 a0, a1; unpack8(aw[s], a0, a1); aw[s] = __builtin_bit_cast(u32x4, pack8(a0 * e0[s], a1 * e1[s])); }
            }
#pragma unroll
            for (int s = 0; s < 4; ++s) cacc = __builtin_amdgcn_mfma_f32_16x16x32_bf16(__builtin_bit_cast(bf16x8, aw[s]), __builtin_bit_cast(bf16x8, bw[s]), cacc, 0, 0, 0);
#pragma unroll
            for (int r = 0; r < 4; ++r) { const int tl = 4 * g + r; float v = cacc[r]; if (bi == bjx && l15 > tl) v = 0.f;
                *(LAS unsigned short*)(lds + PP + (16 * bi + tl) * TS + 2 * (16 * bjx + l15)) = (unsigned short)pg8::cvt_pk_bf16(v, 0.f); }
        }
    }
    __syncthreads();
    bf16_t* ORb = (bf16_t*)(PB_OR(A)) + (rlbase * 512 + h * 128 + 16 * wave);
    unsigned long long pw[4]; u32x2 sgw[4];
    if (latent && second) {
        const bf16_t* SG = (const bf16_t*)(A.ws + WS_SG) + (rlbase * 512 + h * 128 + 16 * wave);
#pragma unroll
        for (int m = 0; m < 4; ++m) { const int tau = 16 * m + l15, rho = BWD ? 63 - tau : tau;
            pw[m] = __hip_atomic_load((unsigned long long*)(ORb + (unsigned)(rho * 512 + 4 * g)), RLX_AGENT); sgw[m] = *(const u32x2*)(SG + (unsigned)(rho * 512 + 4 * g)); }
    }
    bf16x8 vf[2];
#pragma unroll
    for (int s = 0; s < 2; ++s) vf[s] = *(const LAS bf16x8*)(lds + VT + (16 * wave + l15) * TS + (32 * s + 8 * g) * 2);
    f32x4 oT[4];
#pragma unroll
    for (int m = 0; m < 4; ++m) oT[m] = (f32x4){0.f, 0.f, 0.f, 0.f};
#define HG_RD_BQ(s) do { _Pragma("unroll") for (int m = 0; m < 4; ++m) { \
            const u32x2 q0w = *(const LAS u32x2*)(lds + Q0 + (16 * m + l15) * RS + (32 * (s) + 4 * g) * 2), q1w = *(const LAS u32x2*)(lds + Q0 + (16 * m + l15) * RS + (32 * (s) + 16 + 4 * g) * 2); \
            bq[(s) & 1][m].x = q0w.x; bq[(s) & 1][m].y = q0w.y; bq[(s) & 1][m].z = q1w.x; bq[(s) & 1][m].w = q1w.y; } } while (0)
#define HG_MM_BQ(s) do { const bf16x8 sf = pack8(S[2 * (s)], S[2 * (s) + 1]); _Pragma("unroll") for (int m = 0; m < 4; ++m) oT[m] = __builtin_amdgcn_mfma_f32_16x16x32_bf16(sf, __builtin_bit_cast(bf16x8, bq[(s) & 1][m]), oT[m], 0, 0, 0); } while (0)
#define HG_RD_KF(t) do { dk4[(t) & 3] = *(const LAS f32x4*)(lds + DK + (16 * (t) + 4 * g) * 4); _Pragma("unroll") for (int s_ = 0; s_ < 2; ++s_) kf[(t) & 3][s_] = *(const LAS bf16x8*)(lds + KHT + (16 * (t) + l15) * TS + (32 * s_ + 8 * g) * 2); } while (0)
#define HG_MM_KF(t) do { S[t] = S[t] * dk4[(t) & 3]; _Pragma("unroll") for (int s_ = 0; s_ < 2; ++s_) S[t] = __builtin_amdgcn_mfma_f32_16x16x32_bf16(kf[(t) & 3][s_], vf[s_], S[t], 0, 0, 0); } while (0)
    {
        f32x4 dk4[4]; bf16x8 kf[4][2];
        if (latent) {
            bf16x8 pf[4][2]; u32x4 bq[2][4];
#pragma unroll
            for (int m = 0; m < 4; ++m)
#pragma unroll
                for (int s = 0; s < 2; ++s) pf[m][s] = *(const LAS bf16x8*)(lds + PP + (16 * m + l15) * TS + (32 * s + 8 * g) * 2);
            HG_RD_BQ(0); HG_RD_BQ(1);
            __builtin_amdgcn_sched_barrier(0);
#pragma unroll
            for (int m = 0; m < 4; ++m)
#pragma unroll
                for (int s = 0; s < 2; ++s) oT[m] = __builtin_amdgcn_mfma_f32_16x16x32_bf16(vf[s], pf[m][s], oT[m], 0, 0, 0);
            HG_MM_BQ(0);
            __builtin_amdgcn_sched_barrier(0);
            HG_RD_BQ(2); HG_MM_BQ(1);
            __builtin_amdgcn_sched_barrier(0);
            HG_RD_BQ(3); HG_MM_BQ(2);
            __builtin_amdgcn_sched_barrier(0);
            HG_RD_KF(0); HG_RD_KF(1); HG_MM_BQ(3);
            __builtin_amdgcn_sched_barrier(0);
        } else { HG_RD_KF(0); HG_RD_KF(1); __builtin_amdgcn_sched_barrier(0); }
        HG_RD_KF(2); HG_RD_KF(3); HG_MM_KF(0); HG_MM_KF(1);
        __builtin_amdgcn_sched_barrier(0);
        HG_RD_KF(4); HG_RD_KF(5); HG_MM_KF(2); HG_MM_KF(3);
        __builtin_amdgcn_sched_barrier(0);
        HG_RD_KF(6); HG_RD_KF(7); HG_MM_KF(4); HG_MM_KF(5);
        __builtin_amdgcn_sched_barrier(0);
        HG_MM_KF(6); HG_MM_KF(7);
    }
#undef HG_RD_BQ
#undef HG_MM_BQ
#undef HG_RD_KF
#undef HG_MM_KF
    if (second) asm volatile("" : "+v"(pw[0]), "+v"(pw[1]), "+v"(pw[2]), "+v"(pw[3]), "+v"(S[7]), "+v"(oT[3]));
    if (latent) {
        if (!second) {
#pragma unroll
            for (int m = 0; m < 4; ++m) { const int tau = 16 * m + l15, rho = BWD ? 63 - tau : tau;
                const unsigned long long w = (unsigned long long)pg8::cvt_pk_bf16(oT[m][0], oT[m][1]) | ((unsigned long long)pg8::cvt_pk_bf16(oT[m][2], oT[m][3]) << 32);
                __hip_atomic_store((unsigned long long*)(ORb + (unsigned)(rho * 512 + 4 * g)), w, RLX_AGENT); }
        } else {
#pragma unroll
            for (int m = 0; m < 4; ++m) { const int tau = 16 * m + l15, rho_ = BWD ? 63 - tau : tau;
                for (unsigned sp = 0; pw[m] == OR_SENTINEL && sp < (1u << 20); ++sp) { __builtin_amdgcn_s_sleep(1); pw[m] = __hip_atomic_load((unsigned long long*)(ORb + (unsigned)(rho_ * 512 + 4 * g)), RLX_AGENT); }
                const unsigned lo = (unsigned)pw[m], hi = (unsigned)(pw[m] >> 32);
                oT[m] += (f32x4){pg8::bf_lo(lo), pg8::bf_hi(lo), pg8::bf_lo(hi), pg8::bf_hi(hi)};
                float ss = (oT[m][0] * oT[m][0] + oT[m][1] * oT[m][1]) + (oT[m][2] * oT[m][2] + oT[m][3] * oT[m][3]);
                ss += __shfl_xor(ss, 16); ss += __shfl_xor(ss, 32);
                if (g == 0) *(LAS float*)(lds + SSQ + (wave * 64 + tau) * 4) = ss; }
        }
    }
    if (latent && second) {
        __syncthreads();
        bf16_t* A1 = (bf16_t*)(PB_A1(A)) + (rlbase * 512 + h * 128 + 16 * wave);
        const f32x4 gn = *(const LAS f32x4*)(lds + GNS + (16 * wave + 4 * g) * 4);
#pragma unroll
        for (int m = 0; m < 4; ++m) { const int tau = 16 * m + l15, rho = BWD ? 63 - tau : tau; float tot = 0.f;
#pragma unroll
            for (int w = 0; w < 8; ++w) tot += *(LAS float*)(lds + SSQ + (w * 64 + tau) * 4);
            const float rstd = 1.0f / sqrtf(tot * (1.0f / 128.0f) + EPS);
            const f32x4 sg4 = (f32x4){pg8::bf_lo(sgw[m].x), pg8::bf_hi(sgw[m].x), pg8::bf_lo(sgw[m].y), pg8::bf_hi(sgw[m].y)};
            const f32x4 o = oT[m] * rstd * gn * sg4;
            u32x2 ow; ow.x = pg8::cvt_pk_bf16(o[0], o[1]); ow.y = pg8::cvt_pk_bf16(o[2], o[3]); *(u32x2*)(A1 + (unsigned)(rho * 512 + 4 * g)) = ow; }
    }
    s1_store(lds, Q, next_latent, tid, P);
}
template <bool BWD>
__device__ __forceinline__ void run_dir(const Args& A, LAS unsigned char* lds, int pair, int tid) {
    const int b = pair >> 2, h = pair & 3;
    if (tid < 128) { *(LAS float*)(lds + LBS + 4 * tid) = ((const float*)(A.ws + WS_LB))[(BWD ? 512 : 0) + h * 128 + tid]; *(LAS float*)(lds + GNS + 4 * tid) = A.hgn[h * 128 + tid]; }
    __syncthreads();
    f32x4 S[8];
#pragma unroll
    for (int t = 0; t < 8; ++t) S[t] = (f32x4){0.f, 0.f, 0.f, 0.f};
    {
      unsigned long long* orp = (unsigned long long*)((bf16_t*)(PB_OR(A)) + (((long)b * SEQ + (BWD ? 1024 : 0)) * 512 + h * 128));
      for (int i = tid; i < 1024 * 32; i += 512) __hip_atomic_store(orp + (size_t)(i >> 5) * 128 + (i & 31), OR_SENTINEL, RLX_AGENT); }
    auto chunk_of = [](int j) -> int { const int jj = j < 36 ? j : 35; return BWD ? (jj < 4 ? 3 - jj : 39 - jj) : jj; };
    Inputs nxt; Prep P;
    load_inputs<BWD>(A, b, h, chunk_of(0), tid, nxt);
    { Mid M0; s1_math(lds, nxt, tid, M0);
      load_inputs<BWD>(A, b, h, chunk_of(1), tid, nxt);
      __syncthreads();
      s1_store(lds, M0, false, tid, P); }
    for (int j = 0; j < 20; ++j) chunk_step<BWD, false>(A, lds, b, h, chunk_of(j), S, P, nxt, j + 1 >= 4, chunk_of(j + 2), tid);
    for (int j = 20; j < 36; ++j) chunk_step<BWD, true>(A, lds, b, h, chunk_of(j), S, P, nxt, true, chunk_of(j + 2), tid);
}
__device__ __forceinline__ void hgrn_item(const Args& A, LAS unsigned char* lds, int item, int tid) {
    for (int i = tid; i < (hg::TT - hg::PP) / 4; i += 512) *(LAS unsigned*)(lds + hg::PP + 4 * i) = 0u;
    __syncthreads();
    if (item & 1) run_dir<true>(A, lds, item >> 1, tid); else run_dir<false>(A, lds, item >> 1, tid);
}
}
namespace p5 {
constexpr int RSB = 2064  , WPTH = 0, WPTL = 16 * RSB  , GM = 2 * 16 * RSB  , SH = GM + 4096, BP = SH + 4096  , BIAS = BP + 2048, END = BIAS + 64;
__device__ __forceinline__ void rows128(const Args& A, LAS unsigned char* lds, int rb, int tid) {
    const int wave = __builtin_amdgcn_readfirstlane(tid >> 6), lane = tid & 63, l15 = lane & 15, g = lane >> 4;
    const int b = rb >> 4; const long row0 = (long)rb * 128 + wave * 16;
    const float* mod = (const float*)(A.ws + WS_MOD) + (size_t)b * NMOD;
    const bf16_t* x1 = (const bf16_t*)(A.ws + WS_X1B);
    { const int k = 2 * tid; const pg8::f32x2_c n2 = *(const pg8::f32x2_c*)(A.n2g + k), sc2 = *(const pg8::f32x2_c*)(mod + 4096 + k), sh2 = *(const pg8::f32x2_c*)(mod + 3072 + k);
      const float gm0 = n2[0] * (1.0f + sc2[0]), gm1 = n2[1] * (1.0f + sc2[1]);
      *(LAS pg8::f32x2_c*)(lds + GM + 4 * k) = (pg8::f32x2_c){gm0, gm1}; *(LAS pg8::f32x2_c*)(lds + SH + 4 * k) = sh2;
#pragma unroll
      for (int q = 0; q < 4; ++q) { const f32x4 w0 = *(const f32x4*)(A.wr + (size_t)k * 16 + 4 * q), w1 = *(const f32x4*)(A.wr + (size_t)(k + 1) * 16 + 4 * q);
#pragma unroll
          for (int j = 0; j < 4; ++j) { const float v0 = gm0 * w0[j], v1 = gm1 * w1[j]; const unsigned hi = pg8::cvt_pk_bf16(v0, v1);
              const unsigned lo = pg8::cvt_pk_bf16(v0 - pg8::bf_lo(hi), v1 - pg8::bf_hi(hi));
              *(LAS unsigned*)(lds + WPTH + (4 * q + j) * RSB + 2 * k) = hi; *(LAS unsigned*)(lds + WPTL + (4 * q + j) * RSB + 2 * k) = lo; } } }
    { const int e = tid & 15, kp = tid >> 4; float s = 0.f;
#pragma unroll
      for (int h = 0; h < 2; ++h) { float sv[16], wv[16];
#pragma unroll
          for (int i = 0; i < 16; ++i) { sv[i] = mod[3072 + kp * 32 + 16 * h + i]; wv[i] = A.wr[(size_t)(kp * 32 + 16 * h + i) * 16 + e]; }
#pragma unroll
          for (int i = 0; i < 16; ++i) s += sv[i] * wv[i]; }
      *(LAS float*)(lds + BP + (kp * 16 + e) * 4) = s; }
    __syncthreads();
    if (tid < 16) { float s = 0.f; for (int kp = 0; kp < 32; ++kp) s += *(LAS float*)(lds + BP + (kp * 16 + tid) * 4); *(LAS float*)(lds + BIAS + 4 * tid) = s; }
    __syncthreads();
    f32x4 acc = (f32x4){0.f, 0.f, 0.f, 0.f}; float ss = 0.f;
    { const bf16_t* xr = x1 + (row0 + l15) * 1024 + 8 * g;
      u32x4 xw[8];
#pragma unroll
      for (int it = 0; it < 8; ++it) xw[it] = *(const u32x4*)(xr + 32 * it);
#pragma unroll
      for (int it = 0; it < 32; ++it) {
        const bf16x8 bh = *(const LAS bf16x8*)(lds + WPTH + l15 * RSB + (32 * it + 8 * g) * 2), bl = *(const LAS bf16x8*)(lds + WPTL + l15 * RSB + (32 * it + 8 * g) * 2);
        const u32x4 w = xw[it & 7];
        if (it + 8 < 32) xw[it & 7] = *(const u32x4*)(xr + 32 * (it + 8));
        const bf16x8 a = __builtin_bit_cast(bf16x8, w);
        acc = __builtin_amdgcn_mfma_f32_16x16x32_bf16(a, bh, acc, 0, 0, 0); acc = __builtin_amdgcn_mfma_f32_16x16x32_bf16(a, bl, acc, 0, 0, 0);
        const float x0 = pg8::bf_lo(w.x), x1f = pg8::bf_hi(w.x), x2 = pg8::bf_lo(w.y), x3 = pg8::bf_hi(w.y), x4 = pg8::bf_lo(w.z), x5 = pg8::bf_hi(w.z), x6 = pg8::bf_lo(w.w), x7 = pg8::bf_hi(w.w);
        ss += ((x0 * x0 + x1f * x1f) + (x2 * x2 + x3 * x3)) + ((x4 * x4 + x5 * x5) + (x6 * x6 + x7 * x7));
        if ((it & 3) == 3) __builtin_amdgcn_sched_barrier(0);
      } }
    ss += __shfl_xor(ss, 16); ss += __shfl_xor(ss, 32);
    const float rstd = 1.0f / sqrtf(ss * (1.0f / 1024.0f) + EPS);
    const float bias = *(LAS float*)(lds + BIAS + 4 * l15);
    f32x4 aff;
#pragma unroll
    for (int r = 0; r < 4; ++r) { const float rs = __shfl(rstd, 4 * g + r); float lg = acc[r] * rs + bias;
        float mx = lg; mx = fmaxf(mx, __shfl_xor(mx, 1)); mx = fmaxf(mx, __shfl_xor(mx, 2)); mx = fmaxf(mx, __shfl_xor(mx, 4)); mx = fmaxf(mx, __shfl_xor(mx, 8));
        const float ex = expf(lg - mx); float sm = ex; sm += __shfl_xor(sm, 1); sm += __shfl_xor(sm, 2); sm += __shfl_xor(sm, 4); sm += __shfl_xor(sm, 8);
        aff[r] = ex / sm; }
    { float* AFF = (float*)(A.ws + WS_AFF); const int t = (rb & 15) * 128 + wave * 16 + 4 * g;
        *(f32x4*)(AFF + ((size_t)(b * 16 + l15)) * 2048 + t) = aff; }
    unsigned char* H2Q = A.ws + WS_H2; float* HS = (float*)(A.ws + WS_HS);
    for (int i0 = 0; i0 < 16; i0 += 4) {
        f32x4 v[4][4];
#pragma unroll
        for (int ii = 0; ii < 4; ++ii)
#pragma unroll
            for (int j = 0; j < 4; ++j) { const u32x2 w = *(const u32x2*)(x1 + (row0 + i0 + ii) * 1024 + 4 * lane + 256 * j); v[ii][j] = (f32x4){pg8::bf_lo(w.x), pg8::bf_hi(w.x), pg8::bf_lo(w.y), pg8::bf_hi(w.y)}; }
#pragma unroll
        for (int ii = 0; ii < 4; ++ii) { const float rs = __shfl(rstd, i0 + ii); float amax = 0.f;
#pragma unroll
            for (int j = 0; j < 4; ++j) { const int cidx = 4 * lane + 256 * j;
                const f32x4 gmv = *(const LAS f32x4*)(lds + GM + 4 * cidx), shv = *(const LAS f32x4*)(lds + SH + 4 * cidx);
                const f32x4 o = v[ii][j] * rs * gmv + shv; v[ii][j] = o;
                amax = fmaxf(fmaxf(amax, fmaxf(fabsf(o[0]), fabsf(o[1]))), fmaxf(fabsf(o[2]), fabsf(o[3]))); }
#pragma unroll
            for (int o_ = 1; o_ < 64; o_ <<= 1) amax = fmaxf(amax, __shfl_xor(amax, o_));
            const float am = amax > 1e-30f ? amax : 1e-30f, inv = 127.0f / am;
            if (lane == 0) HS[row0 + i0 + ii] = am * (1.0f / 127.0f);
#pragma unroll
            for (int j = 0; j < 4; ++j) { const f32x4 o = v[ii][j] * inv;
                const int q0 = (int)__builtin_rintf(o[0]), q1 = (int)__builtin_rintf(o[1]), q2 = (int)__builtin_rintf(o[2]), q3 = (int)__builtin_rintf(o[3]);
                *(unsigned*)(H2Q + (size_t)(row0 + i0 + ii) * 1024 + 4 * lane + 256 * j) = ((unsigned)q0 & 255u) | (((unsigned)q1 & 255u) << 8) | (((unsigned)q2 & 255u) << 16) | ((unsigned)q3 << 24); } } }
    __syncthreads();
}
__device__ __forceinline__ void ew_q8(const float* Wcol, unsigned char* WQ, float* TQp, LAS float* scr, int lane) {
    const int n4 = lane & 7, kr = lane >> 3;
    const float* W = Wcol + 4 * n4 + (size_t)kr * 1024;
    f32x4 ta[8], tb[8], tc[8], td[8];
#define EWQ_LD(t, kb) do { const float* w_ = W + (size_t)(64 * ((kb) < 16 ? (kb) : 15)) * 1024; _Pragma("unroll") for (int i = 0; i < 8; ++i) (t)[i] = *(const f32x4*)(w_ + (size_t)(8 * i) * 1024); } while (0)
#define EWQ_MAX(t) do { _Pragma("unroll") for (int i = 0; i < 8; ++i) { am4[0] = fmaxf(am4[0], fabsf((t)[i][0])); am4[1] = fmaxf(am4[1], fabsf((t)[i][1])); am4[2] = fmaxf(am4[2], fabsf((t)[i][2])); am4[3] = fmaxf(am4[3], fabsf((t)[i][3])); } } while (0)
    f32x4 am4 = (f32x4){0.f, 0.f, 0.f, 0.f};
    EWQ_LD(ta, 0); EWQ_LD(tb, 1); EWQ_LD(tc, 2); EWQ_LD(td, 3);
    for (int kb = 0; kb < 12; kb += 4) { EWQ_MAX(ta); EWQ_LD(ta, kb + 4); EWQ_MAX(tb); EWQ_LD(tb, kb + 5); EWQ_MAX(tc); EWQ_LD(tc, kb + 6); EWQ_MAX(td); EWQ_LD(td, kb + 7); }
    EWQ_MAX(ta); EWQ_MAX(tb); EWQ_MAX(tc); EWQ_MAX(td);
#pragma unroll
    for (int j = 0; j < 4; ++j) { float a = am4[j]; a = fmaxf(a, __shfl_xor(a, 8)); a = fmaxf(a, __shfl_xor(a, 16)); a = fmaxf(a, __shfl_xor(a, 32)); am4[j] = a > 1e-30f ? a : 1e-30f; }
    const f32x4 inv4 = (f32x4){127.0f / am4[0], 127.0f / am4[1], 127.0f / am4[2], 127.0f / am4[3]};
    if (lane < 8) *(f32x4*)(TQp + 4 * n4) = am4 * (1.0f / 127.0f);
#define EWQ_FIN(t, kb) do { _Pragma("unroll") for (int i = 0; i < 8; ++i) { const f32x4 q_ = (t)[i] * inv4; LAS float* d_ = scr + (kr + 8 * i) * 33 + 4 * n4; \
            d_[0] = __builtin_rintf(q_[0]); d_[1] = __builtin_rintf(q_[1]); d_[2] = __builtin_rintf(q_[2]); d_[3] = __builtin_rintf(q_[3]); } \
        LDS_WAIT(); asm volatile("" ::: "memory"); \
        { const int c = lane & 7; _Pragma("unroll") for (int j = 0; j < 4; ++j) { const int n = (lane >> 3) + 8 * j; const LAS float* s = scr + (8 * c) * 33 + n; \
            const unsigned w0 = ((unsigned)(int)s[0 * 33] & 255u) | (((unsigned)(int)s[1 * 33] & 255u) << 8) | (((unsigned)(int)s[2 * 33] & 255u) << 16) | ((unsigned)(int)s[3 * 33] << 24); \
            const unsigned w1 = ((unsigned)(int)s[4 * 33] & 255u) | (((unsigned)(int)s[5 * 33] & 255u) << 8) | (((unsigned)(int)s[6 * 33] & 255u) << 16) | ((unsigned)(int)s[7 * 33] << 24); \
            u32x2 o; o.x = w0; o.y = w1; *(u32x2*)(WQ + (size_t)n * 1024 + 64 * (kb) + 8 * c) = o; } } \
        LDS_WAIT(); asm volatile("" ::: "memory"); } while (0)
    EWQ_LD(ta, 0); EWQ_LD(tb, 1); EWQ_LD(tc, 2); EWQ_LD(td, 3);
    for (int kb = 0; kb < 12; kb += 4) { EWQ_FIN(ta, kb); EWQ_LD(ta, kb + 4); EWQ_FIN(tb, kb + 1); EWQ_LD(tb, kb + 5); EWQ_FIN(tc, kb + 2); EWQ_LD(tc, kb + 6); EWQ_FIN(td, kb + 3); EWQ_LD(td, kb + 7); }
    EWQ_FIN(ta, 12); EWQ_FIN(tb, 13); EWQ_FIN(tc, 14); EWQ_FIN(td, 15);
#undef EWQ_LD
#undef EWQ_MAX
#undef EWQ_FIN
}
__device__ __forceinline__ void expert_weights(const Args& A, LAS unsigned char* lds, int vcu, int G, int tid) {
    const int wave = tid >> 6, lane = tid & 63; LAS float* scr = (LAS float*)(lds + wave * 8704);
    const int gw = vcu * NWAVES + wave, NGW = G * NWAVES;
    for (int it = gw; it < 16 * 64 + 16 * 32; it += NGW) {
        if (it < 16 * 64) { const int e = it >> 6, gi = it & 63, pn = gi >> 3, half = (gi >> 2) & 1, q = gi & 3;
            ew_q8((half ? A.weu : A.weg) + (size_t)e * 1024 * 1024 + 128 * pn + 32 * q, A.ws + WS_WGU + ((size_t)e * 2048 + gi * 32) * 1024, (float*)(A.ws + WS_TQ) + e * 2048 + gi * 32, scr, lane); }
        else { const int r = it - 16 * 64, e = r >> 5, gi = r & 31;
            ew_q8(A.wed + (size_t)e * 1024 * 1024 + 32 * gi, A.ws + WS_WD + ((size_t)e * 1024 + gi * 32) * 1024, (float*)(A.ws + WS_TD) + e * 1024 + gi * 32, scr, lane); } }
}
}

__device__ __forceinline__ unsigned block_exscan(unsigned v, LAS unsigned* scr, int tid, unsigned* total) {
    const int lane = tid & 63, wave = tid >> 6; unsigned inc = v;
#pragma unroll
    for (int o = 1; o < 64; o <<= 1) { const unsigned t = __shfl_up(inc, o); if (lane >= o) inc += t; }
    if (lane == 63) scr[wave] = inc;
    __syncthreads();
    unsigned base = 0, tot = 0;
#pragma unroll
    for (int w = 0; w < 8; ++w) { const unsigned x = scr[w]; if (w < wave) base += x; tot += x; }
    __syncthreads();
    *total = tot; return base + inc - v;
}
__device__ __forceinline__ void topk_unit(const Args& A, LAS unsigned char* lds, int b, int e, int tid) {
    LAS unsigned* hist = (LAS unsigned*)lds;
    LAS unsigned* ctlw = (LAS unsigned*)(lds + 1024);
    const float* AFF = (const float*)(A.ws + WS_AFF) + (size_t)(b * 16 + e) * 2048;
    const f32x4 v4 = *(const f32x4*)(AFF + 4 * tid);
    unsigned key[4];
#pragma unroll
    for (int i = 0; i < 4; ++i) key[i] = __float_as_uint(v4[i]);
    unsigned prefix = 0, need = 256;
#pragma unroll 1
    for (int pass = 0; pass < 4; ++pass) { const int shift = 24 - 8 * pass;
        if (tid < 256) hist[tid] = 0u;
        __syncthreads();
#pragma unroll
        for (int i = 0; i < 4; ++i) if (pass == 0 || (key[i] >> (shift + 8)) == prefix) (void)__hip_atomic_fetch_add(&hist[(key[i] >> shift) & 255u], 1u, __ATOMIC_RELAXED, __HIP_MEMORY_SCOPE_WORKGROUP);
        __syncthreads();
        if (tid < 64) {
            const unsigned h0 = hist[4 * tid], h1 = hist[4 * tid + 1], h2 = hist[4 * tid + 2], h3 = hist[4 * tid + 3]; const unsigned mine = h0 + h1 + h2 + h3;
            unsigned suf = mine;
#pragma unroll
            for (int o = 1; o < 64; o <<= 1) { const unsigned t = __shfl_down(suf, o); if (tid + o < 64) suf += t; }
            const unsigned above = suf - mine;
            if (above < need && suf >= need) {
                unsigned cum = above; int bin = 4 * tid + 3;
                if (cum + h3 >= need) { } else { cum += h3; bin = 4 * tid + 2; if (cum + h2 >= need) { } else { cum += h2; bin = 4 * tid + 1; if (cum + h1 >= need) { } else { cum += h1; bin = 4 * tid; } } }
                ctlw[8] = (prefix << 8) | (unsigned)bin; ctlw[9] = need - cum; } }
        __syncthreads();
        prefix = ctlw[8]; need = ctlw[9];
        __syncthreads();
    }
    unsigned eqc = 0;
#pragma unroll
    for (int i = 0; i < 4; ++i) eqc += (key[i] == prefix) ? 1u : 0u;
    unsigned tot; unsigned eqbase = block_exscan(eqc, ctlw, tid, &tot);
    unsigned sel = 0; bool take[4];
#pragma unroll
    for (int i = 0; i < 4; ++i) { take[i] = key[i] > prefix; if (key[i] == prefix) { take[i] = eqbase < need; ++eqbase; } sel += take[i] ? 1u : 0u; }
    unsigned slot = block_exscan(sel, ctlw, tid, &tot);
    int* IDX = (int*)(A.ws + WS_IDX) + (b * 16 + e) * 256; float* GATE = (float*)(A.ws + WS_IDX + 256 * 1024) + (b * 16 + e) * 256; int* SLOT = (int*)(A.ws + WS_SLOT);
    float* SCL = (float*)(A.ws + WS_SCL) + (b * 16 + e) * 256; const float* HS = (const float*)(A.ws + WS_HS);
#pragma unroll
    for (int i = 0; i < 4; ++i) { const int t = 4 * tid + i; int sl = -1;
        if (take[i]) { sl = (int)slot; ++slot; IDX[sl] = b * 2048 + t; GATE[sl] = v4[i]; SCL[sl] = HS[b * 2048 + t]; }
        SLOT[(size_t)(b * 2048 + t) * 16 + e] = sl; }
    VM_WAIT();
    __syncthreads();
}

struct P7Row { u32x4 x[2]; u32x2 y[4][2]; int ne; unsigned rest; };
typedef int i32x4_p7 __attribute__((ext_vector_type(4)));
__device__ __forceinline__ int p7_slot_of(const i32x4_p7 sl, int i, int e) {
    const int c = e & 3; const int v = c == 0 ? sl.x : c == 1 ? sl.y : c == 2 ? sl.z : sl.w;
    return __builtin_amdgcn_readlane(v, 4 * i + (e >> 2));
}
__device__ __forceinline__ unsigned p7_mask_of(const unsigned long long (&bc)[4], int i) {
    unsigned m = 0;
#pragma unroll
    for (int c = 0; c < 4; ++c) { const unsigned n = (unsigned)(bc[c] >> (4 * i)) & 15u; m |= ((n & 1u) | ((n & 2u) << 3) | ((n & 4u) << 6) | ((n & 8u) << 9)) << c; }
    return m;
}
__device__ __forceinline__ void p7_issue(const bf16_t* X1B, const unsigned char* YE, int r, const i32x4_p7 sl, const unsigned long long (&bc)[4], int i, int lane, P7Row& R) {
    const int b = r >> 11;
#pragma unroll
    for (int j = 0; j < 2; ++j) R.x[j] = *(const u32x4*)(X1B + (size_t)r * 1024 + j * 512 + 8 * lane);
    unsigned m = p7_mask_of(bc, i); int ne = 0;
#pragma unroll
    for (int q = 0; q < 4; ++q) { const unsigned char* yr = YE;
        if (m) { const int e = __builtin_ctz(m); m &= m - 1; yr = YE + ((size_t)(b * 16 + e) * 256 + p7_slot_of(sl, i, e)) * 1024; ne = q + 1; }
        if (!DBG_TIMING) { R.y[q][0] = *(const u32x2*)(yr + 8 * lane); R.y[q][1] = *(const u32x2*)(yr + 512 + 8 * lane); } }
    R.ne = DBG_TIMING ? 0 : ne; R.rest = DBG_TIMING ? 0u : m;
}
__device__ __forceinline__ void p7_f8acc(const u32x2 w, f32x4& a0, f32x4& a1) {
    const pg8::f32x2_c p0 = __builtin_amdgcn_cvt_pk_f32_fp8((int)w.x, false), p1 = __builtin_amdgcn_cvt_pk_f32_fp8((int)w.x, true), p2 = __builtin_amdgcn_cvt_pk_f32_fp8((int)w.y, false), p3 = __builtin_amdgcn_cvt_pk_f32_fp8((int)w.y, true);
    a0 += (f32x4){p0[0], p0[1], p1[0], p1[1]}; a1 += (f32x4){p2[0], p2[1], p3[0], p3[1]};
}
__device__ __forceinline__ void p7_finish(const Args& A, const unsigned char* YE, int r, const i32x4_p7 sl, int i, int lane, const P7Row& R, const f32x4 (&g2)[4], const f32x4 (&fg)[4], float scale) {
    const int b = r >> 11;
    f32x4 acc[4];
#pragma unroll
    for (int j = 0; j < 4; ++j) acc[j] = (f32x4){0.f, 0.f, 0.f, 0.f};
#pragma unroll
    for (int q = 0; q < 4; ++q) if (q < R.ne) { p7_f8acc(R.y[q][0], acc[0], acc[1]); p7_f8acc(R.y[q][1], acc[2], acc[3]); }
    for (unsigned m = R.rest; m;) { const int e = __builtin_ctz(m); m &= m - 1;
        const unsigned char* yr = YE + ((size_t)(b * 16 + e) * 256 + p7_slot_of(sl, i, e)) * 1024;
        p7_f8acc(*(const u32x2*)(yr + 8 * lane), acc[0], acc[1]); p7_f8acc(*(const u32x2*)(yr + 512 + 8 * lane), acc[2], acc[3]); }
#pragma unroll
    for (int j = 0; j < 4; ++j) acc[j] = acc[j] * (1.0f / pg8::YE_F8_SCALE);
    f32x4 xv[4];
#pragma unroll
    for (int j = 0; j < 2; ++j) { const u32x4 w = R.x[j]; xv[2 * j] = (f32x4){pg8::bf_lo(w.x), pg8::bf_hi(w.x), pg8::bf_lo(w.y), pg8::bf_hi(w.y)}; xv[2 * j + 1] = (f32x4){pg8::bf_lo(w.z), pg8::bf_hi(w.z), pg8::bf_lo(w.w), pg8::bf_hi(w.w)}; }
    float* xo = A.out + (size_t)r * 1024; f32x4 v[4]; float ss = 0.f;
#pragma unroll
    for (int j = 0; j < 4; ++j) { const int cidx = (j >> 1) * 512 + 8 * lane + (j & 1) * 4;
        v[j] = xv[j] + g2[j] * acc[j]; ss += (v[j][0] * v[j][0] + v[j][1] * v[j][1]) + (v[j][2] * v[j][2] + v[j][3] * v[j][3]); }
    const float rstd = 1.0f / sqrtf(wave_sum(ss) * (1.0f / 1024.0f) + EPS);
#pragma unroll
    for (int j = 0; j < 4; ++j) { const int cidx = (j >> 1) * 512 + 8 * lane + (j & 1) * 4; *(f32x4*)(xo + cidx) = v[j] * (rstd * scale) * fg[j]; }
}
__device__ __forceinline__ void p7_rows(const Args& A, int vcu, int G, int tid) {
    const int wave = tid >> 6, lane = tid & 63; const int gw = vcu * NWAVES + wave, NGW = G * NWAVES;
    const float* mod = (const float*)(A.ws + WS_MOD); const int* SLOT = (const int*)(A.ws + WS_SLOT); const unsigned char* YE = A.ws + WS_YE; const bf16_t* X1B = (const bf16_t*)(A.ws + WS_X1B);
#if DBG_TIMING
    const unsigned tsa_ = __hip_atomic_load((unsigned*)(A.ws + WS_CTL) + 100 + DBG_TIME_A0, RLX_AGENT), tsb_ = __hip_atomic_load((unsigned*)(A.ws + WS_CTL) + 100 + DBG_TIME_A1, RLX_AGENT);
    const float DBG_SCALE = 1.0f + (float)((tsb_ - tsa_) / (100u * DBG_TIME_Q));
#else
    const float DBG_SCALE = 1.0f;
#endif
    const int RPW = (((ML + NGW - 1) / NGW) + 15) & ~15;
    const int r0 = gw * RPW, r1 = r0 + RPW < ML ? r0 + RPW : ML;
    f32x4 fg[4], g2[4]; int bcur = -1;
#pragma unroll
    for (int j = 0; j < 4; ++j) { fg[j] = *(const f32x4*)(A.fng + (j >> 1) * 512 + 8 * lane + (j & 1) * 4); g2[j] = fg[j]; }
    asm volatile("" : "+v"(fg[0]), "+v"(fg[1]), "+v"(fg[2]), "+v"(fg[3]));
    for (int rg = r0; rg < r1; rg += 16) {
        const int nr = r1 - rg < 16 ? r1 - rg : 16, b = rg >> 11;
        if (b != bcur) { bcur = b;
#pragma unroll
            for (int j = 0; j < 4; ++j) g2[j] = *(const f32x4*)(mod + (size_t)b * NMOD + 5120 + (j >> 1) * 512 + 8 * lane + (j & 1) * 4);
            asm volatile("" : "+v"(g2[0]), "+v"(g2[1]), "+v"(g2[2]), "+v"(g2[3])); }
        i32x4_p7 sl = *(const i32x4_p7*)(SLOT + (size_t)rg * 16 + 4 * lane);
        asm volatile("" : "+v"(sl));
        unsigned long long bc[4]; bc[0] = __ballot(sl.x >= 0); bc[1] = __ballot(sl.y >= 0); bc[2] = __ballot(sl.z >= 0); bc[3] = __ballot(sl.w >= 0);
        P7Row B0, B1;
        p7_issue(X1B, YE, rg, sl, bc, 0, lane, B0);
        for (int i = 0; i < nr; i += 2) {
            { const int i1 = i + 1 < nr ? i + 1 : nr - 1; p7_issue(X1B, YE, rg + i1, sl, bc, i1, lane, B1); }
            p7_finish(A, YE, rg + i, sl, i, lane, B0, g2, fg, DBG_SCALE);
            { const int i2 = i + 2 < nr ? i + 2 : nr - 1; p7_issue(X1B, YE, rg + i2, sl, bc, i2, lane, B0); }
            if (i + 1 < nr) p7_finish(A, YE, rg + i + 1, sl, i + 1, lane, B1, g2, fg, DBG_SCALE);
        }
    }
}

#ifndef DBG_TIMING
#define DBG_TIMING 0
#endif
typedef const __attribute__((address_space(4))) Args* KArgsPtr;
__global__ void __launch_bounds__(NWAVES * 64, 2) fwd_megakernel(Args A_) {
    KArgsPtr ap = (KArgsPtr)__builtin_amdgcn_kernarg_segment_ptr(); asm volatile("" : "+s"(ap));
#define A (*(const Args*)ap)
    extern __shared__ __attribute__((aligned(16))) unsigned char lds_raw[];
    LAS unsigned char* lds = (LAS unsigned char*)lds_raw;
    volatile LAS unsigned* MISC = (volatile LAS unsigned*)(lds + MISC_OFF);
    int tid = threadIdx.x; const int bx = blockIdx.x, G = gridDim.x;
    const int vcu = (G % 8 == 0) ? (bx % 8) * (G / 8) + bx / 8 : bx;
    unsigned* ctl = (unsigned*)(A.ws + WS_CTL);
    for (int u = tid; u < 64; u += NWAVES * 64) ((LAS unsigned*)(lds + MISC_OFF))[u] = 0u;
    __syncthreads();
    const XcdBarrier xbar = xcd_barrier_post((unsigned*)(ctl + CW_BAR), MISC + 8);
#define GRID_BAR() xcd_barrier(xbar)
#define RELAUNDER() do { int t_ = threadIdx.x; asm volatile("" : "+v"(t_)); tid = t_; KArgsPtr p_ = (KArgsPtr)__builtin_amdgcn_kernarg_segment_ptr(); asm volatile("" : "+s"(p_)); ap = p_; } while (0)
#if DBG_TIMING
#define STAMP(k) do { if (bx == 0) ctl[100 + (k)] = (unsigned)__builtin_amdgcn_s_memrealtime(); } while (0)
#else
#define STAMP(k) do { } while (0)
#endif
    STAMP(0);
    RELAUNDER();
    p0_prologue<0>(A, lds, vcu, G, tid);
    GRID_BAR(); STAMP(1);
    RELAUNDER();
    p1_rows(A, vcu, G, tid);
    RELAUNDER();
    p0_prologue<1>(A, lds, vcu, G, tid);
    GRID_BAR(); STAMP(2);
    RELAUNDER();
    {
        pg8::Gemm g{(const bf16_t*)(PB_HX(A)), (const bf16_t*)(A.ws + WS_WIN), MR, INC, 512  , nullptr}; pg8::InProjOrder S; S.init(G, bx);
        pg8::EpiInProjQ E{{A.ws, WS_HQ, WS_FF, WS_FB, WS_HI, WS_SG, WS_Q, WS_K, WS_V, WS_GA, WS_GB, WS_ROPE, A.qng, A.kng}, (const float*)PB_HXS(A), (const float*)(A.ws + WS_WINS)};
        pg8::gemm_phase<pg8::EpiInProjQ, pg8::InProjOrder, true, true, true>(lds, g, S, E);
    }
    GRID_BAR(); STAMP(3);
    RELAUNDER();
    {
        if (bx < 128) { for (int it = bx; it < 128; it += G) { RELAUNDER(); hg::hgrn_item(A, lds, it, tid); } }
        else p5::expert_weights(A, lds, bx - 128, G - 128, tid);
        STAMP(20);
        __syncthreads();
        const float att_mfix = __uint_as_float(__builtin_amdgcn_readfirstlane(__hip_atomic_load(ctl + CW_MFIX, RLX_AGENT)));
#define ATT_QUEUE(FIX, MF) for (;;) { \
            if (tid == 0) MISC[0] = atomicAdd(ctl + CW_Q3, 1u); \
            __syncthreads(); \
            const unsigned u = MISC[0]; \
            __syncthreads(); \
            if (u >= 1024u) break; \
            const int bk = u >> 5, b = bk >> 1, kvh = bk & 1, gq = (u >> 3) & 3, qb = u & 7; \
            attn_body::attn_unit<8, FIX>((long)b * SEQ + qb * 256, kvh * 4 + gq, (long)b * RPB, kvh, (const attn_body::bf16*)(A.ws + WS_Q), (const attn_body::bf16*)(A.ws + WS_K), (const attn_body::bf16*)(A.ws + WS_V), \
                                    (attn_body::bf16*)(PB_OATT(A)), (char*)lds_raw, MF); }
        if (att_mfix <= 60.0f) { ATT_QUEUE(true, att_mfix) } else { ATT_QUEUE(false, 0.f) }
#undef ATT_QUEUE
    }
    GRID_BAR(); STAMP(4);
    RELAUNDER();
    {
        pg8::StaticOrder S; S.init(ML, 1024, G, bx);
        { pg8::Gemm g{(const bf16_t*)(PB_A1(A)), (const bf16_t*)(A.ws + WS_WA), ML, 1024, 512, nullptr}; pg8::EpiZ<0> E{(bf16_t*)(A.ws + WS_Z), A.ws + WS_GA};
          pg8::gemm_phase<pg8::EpiZ<0>, pg8::StaticOrder, true, true>(lds, g, S, E); }
        VM_WAIT(); __syncthreads();
        { pg8::Gemm g{(const bf16_t*)(PB_OATT(A)), (const bf16_t*)(A.ws + WS_WB), ML, 1024, 512, nullptr}; pg8::EpiZ<1> E{(bf16_t*)(A.ws + WS_Z), A.ws + WS_GB};
          pg8::gemm_phase<pg8::EpiZ<1>, pg8::StaticOrder, true, true>(lds, g, S, E); }
    }
    GRID_BAR(); STAMP(5);
    RELAUNDER();
    {
        pg8::StaticOrder S; S.init(ML, 1024, G, bx);
        pg8::Gemm g{(const bf16_t*)(A.ws + WS_Z), (const bf16_t*)(A.ws + WS_WO), ML, 1024, 1024, nullptr}; pg8::EpiX1 E{A.x, (const float*)(A.ws + WS_MOD), (bf16_t*)(A.ws + WS_X1B)};
        pg8::gemm_phase<pg8::EpiX1, pg8::StaticOrder, true, true>(lds, g, S, E);
    }
    GRID_BAR(); STAMP(6);
    RELAUNDER();
    for (int rb = vcu; rb < 256; rb += G) { RELAUNDER(); p5::rows128(A, lds, rb, tid); }
    GRID_BAR(); STAMP(7);
    RELAUNDER();
    for (int uu = vcu; uu < 256; uu += G) { const int e = uu >> 4, b = uu & 15, unit = b * 16 + e;
        RELAUNDER();
        topk_unit(A, lds, b, e, tid);
        bf16_t* HID = (bf16_t*)(PB_HID(A)) + (size_t)unit * 256 * 1024;
        { pg8::Gemm g{(const bf16_t*)(A.ws + WS_H2), (const bf16_t*)(A.ws + WS_WGU) + (size_t)e * 2048 * 512, 256, 2048, 512  , (const int*)(A.ws + WS_IDX) + unit * 256};
          pg8::LocalOrder S{8}; pg8::EpiHidQ E{HID, (const float*)(A.ws + WS_SCL) + unit * 256, (const float*)(A.ws + WS_TQ) + e * 2048};
          pg8::gemm_phase<pg8::EpiHidQ, pg8::LocalOrder, true, true, true>(lds, g, S, E); }
        VM_WAIT(); __syncthreads();
        { unsigned char* HQ = A.ws + WS_HIDQ + (size_t)unit * 256 * 1024; float* S2 = (float*)(A.ws + WS_SCL2) + unit * 256; const int wv = tid >> 6, ln = tid & 63;
          for (int r0 = wv * 32; r0 < wv * 32 + 32; r0 += 8) {
              u32x4 w[8][2];
#pragma unroll
              for (int ii = 0; ii < 8; ++ii) { w[ii][0] = *(const u32x4*)(HID + (size_t)(r0 + ii) * 1024 + 16 * ln); w[ii][1] = *(const u32x4*)(HID + (size_t)(r0 + ii) * 1024 + 16 * ln + 8); }
#pragma unroll
              for (int ii = 0; ii < 8; ++ii) { f32x4 v[4];
                  v[0] = (f32x4){pg8::bf_lo(w[ii][0].x), pg8::bf_hi(w[ii][0].x), pg8::bf_lo(w[ii][0].y), pg8::bf_hi(w[ii][0].y)}; v[1] = (f32x4){pg8::bf_lo(w[ii][0].z), pg8::bf_hi(w[ii][0].z), pg8::bf_lo(w[ii][0].w), pg8::bf_hi(w[ii][0].w)};
                  v[2] = (f32x4){pg8::bf_lo(w[ii][1].x), pg8::bf_hi(w[ii][1].x), pg8::bf_lo(w[ii][1].y), pg8::bf_hi(w[ii][1].y)}; v[3] = (f32x4){pg8::bf_lo(w[ii][1].z), pg8::bf_hi(w[ii][1].z), pg8::bf_lo(w[ii][1].w), pg8::bf_hi(w[ii][1].w)};
                  float amax = 0.f;
#pragma unroll
                  for (int j = 0; j < 4; ++j) amax = fmaxf(fmaxf(amax, fmaxf(fabsf(v[j][0]), fabsf(v[j][1]))), fmaxf(fabsf(v[j][2]), fabsf(v[j][3])));
#pragma unroll
                  for (int o_ = 1; o_ < 64; o_ <<= 1) amax = fmaxf(amax, __shfl_xor(amax, o_));
                  const float am = amax > 1e-30f ? amax : 1e-30f, inv = 127.0f / am;
                  if (ln == 0) S2[r0 + ii] = am * (1.0f / 127.0f);
                  u32x4 o;
#pragma unroll
                  for (int j = 0; j < 4; ++j) { const f32x4 q = v[j] * inv;
                      const unsigned pk = ((unsigned)(int)__builtin_rintf(q[0]) & 255u) | (((unsigned)(int)__builtin_rintf(q[1]) & 255u) << 8) | (((unsigned)(int)__builtin_rintf(q[2]) & 255u) << 16) | ((unsigned)(int)__builtin_rintf(q[3]) << 24);
                      if (j == 0) o.x = pk; else if (j == 1) o.y = pk; else if (j == 2) o.z = pk; else o.w = pk; }
                  *(u32x4*)(HQ + (size_t)(r0 + ii) * 1024 + 16 * ln) = o; } } }
        VM_WAIT(); __syncthreads();
        { pg8::Gemm g{(const bf16_t*)(A.ws + WS_HIDQ) + (size_t)unit * 256 * 512, (const bf16_t*)(A.ws + WS_WD) + (size_t)e * 1024 * 512, 256, 1024, 512  , nullptr};
          pg8::LocalOrder S{4}; pg8::EpiYeQ E{A.ws + WS_YE + (size_t)unit * 256 * 1024, (const float*)(A.ws + WS_IDX + 256 * 1024) + unit * 256, (const float*)(A.ws + WS_SCL2) + unit * 256, (const float*)(A.ws + WS_TD) + e * 1024};
          pg8::gemm_phase<pg8::EpiYeQ, pg8::LocalOrder, true, true, true>(lds, g, S, E); }
        __syncthreads();
    }
    GRID_BAR(); STAMP(8);
#if DBG_TIMING
    GRID_BAR();
#endif
    RELAUNDER();
    p7_rows(A, vcu, G, tid);
}
#undef A

extern "C" void kernel_launch(void* const* d_in, const int* in_sizes, int n_in, void* d_out, int out_size, void* d_ws, size_t ws_size, hipStream_t stream) {
    static int grid = 0;
    if (grid == 0) {
        if (n_in != 21 || out_size != ML * 1024 || ws_size < WS_END) { fprintf(stderr, "kernel_launch: unexpected problem (n_in %d, out %d, ws %zu); nothing launched\n", n_in, out_size, ws_size); grid = -1; return; }
        int dev = 0, cus = 0, per_cu = 0;
        if (hipGetDevice(&dev) != hipSuccess || hipDeviceGetAttribute(&cus, hipDeviceAttributeMultiprocessorCount, dev) != hipSuccess) { grid = -1; return; }
        if (hipFuncSetAttribute((const void*)fwd_megakernel, hipFuncAttributeMaxDynamicSharedMemorySize, LDS_BYTES) != hipSuccess) { fprintf(stderr, "kernel_launch: hipFuncSetAttribute failed\n"); grid = -1; return; }
        if (hipOccupancyMaxActiveBlocksPerMultiprocessor(&per_cu, (const void*)fwd_megakernel, NWAVES * 64, LDS_BYTES) != hipSuccess || per_cu < 1) { fprintf(stderr, "kernel_launch: occupancy query says %d\n", per_cu); (void)hipGetLastError(); grid = -1; return; }
        grid = cus;
    }
    if (grid < 0) return;
    (void)hipMemsetAsync((char*)d_ws + WS_CTL, 0, CTL_ZERO_BYTES, stream);
    Args a{};
    const float** ap = (const float**)&a;
    for (int i = 0; i < 21; ++i) ap[i] = (const float*)d_in[i];
    a.out = (float*)d_out; a.ws = (unsigned char*)d_ws;
    hipLaunchKernelGGL(fwd_megakernel, dim3(grid), dim3(NWAVES * 64), LDS_BYTES, stream, a);
    const hipError_t le = hipPeekAtLastError();
    if (le != hipSuccess) fprintf(stderr, "kernel_launch: launch failed: %s (grid %d)\n", hipGetErrorName(le), grid);
}
```

```cpp
#include <hip/hip_runtime.h>
#include <hip/hip_bf16.h>
#include <hip/hip_cooperative_groups.h>
#include <cstdio>
#include <cstdint>
#include <cmath>
namespace cg = cooperative_groups;

constexpr int NB = 16, SEQ = 2048, CTXL = 256, DM_ = 1024, RPB = SEQ + CTXL  ;
constexpr int MR = NB * RPB  , ML = NB * SEQ  , INC = 5376, NMOD = 6 * DM_;
constexpr int NE = 16, CAP = 256, EFF = 1024;
constexpr float EPS = 1e-6f;
constexpr float LOG2E = 1.4426950408889634f;
#ifndef DEBUG_POISON
#define DEBUG_POISON 0
#endif
#ifndef DBG_NOMOE
#define DBG_NOMOE 0
#endif
#ifndef DBG_NOATT
#define DBG_NOATT 0
#endif
#ifndef DBG_NOHG
#define DBG_NOHG 0
#endif
#ifndef DBG_OUT_X
#define DBG_OUT_X 0
#endif
#ifndef DBG_X1_NOY
#define DBG_X1_NOY 0
#endif
#ifndef DBG_P4B_A
#define DBG_P4B_A 0
#endif
#ifndef PHASES
#define PHASES 511
#endif
#ifndef DBG_GA_ONLY
#define DBG_GA_ONLY 0
#endif
#ifndef DBG_DOUBLE_BAR
#define DBG_DOUBLE_BAR 0
#endif
#ifndef DBG_WBL2_TWICE
#define DBG_WBL2_TWICE 0
#endif
#ifndef DBG_LEADER_DELAY
#define DBG_LEADER_DELAY 0
#endif
#ifndef DBG_RELEASE_ALL
#define DBG_RELEASE_ALL 0
#endif
#ifndef PG8_DMA_AUX
#define PG8_DMA_AUX 0
#endif
#ifndef DBG_CHECKS
#define DBG_CHECKS 0
#endif
#ifndef DBG_SYSINV
#define DBG_SYSINV 0
#endif
#ifndef DBG_HG_B
#define DBG_HG_B 15
#endif
#ifndef DBG_ALPHA
#define DBG_ALPHA 1.0f
#endif
#ifndef DBG_ONLYATT
#define DBG_ONLYATT 0
#endif
#ifndef DBG_BETA
#define DBG_BETA 1.0f
#endif
#ifndef DBG_POISON_SET
#define DBG_POISON_SET 0
#endif
#ifndef PG8_USE_DMA
#define PG8_USE_DMA 0
#endif
#ifndef DBG_BARTEST
#define DBG_BARTEST 0
#endif
#ifndef DBG_OUT_BUF
#define DBG_OUT_BUF 0
#endif
#ifndef DBG_TIMING
#define DBG_TIMING 0
#define DBG_TIME_A0 3
#define DBG_TIME_A1 20
#endif
#ifndef REPEAT_PHASE
#define REPEAT_PHASE -1
#endif
#ifndef DBG_TIME_Q
#define DBG_TIME_Q 16u
#endif
#ifndef HG_EXP
#define HG_EXP 0
#endif
#ifndef EPI_EXP
#define EPI_EXP 0
#endif
#ifndef P2_STAGGER_TICKS
#define P2_STAGGER_TICKS 0
#endif
namespace pg8 {
#define PG8_LAS __attribute__((address_space(3)))
typedef unsigned short bf16_t;
typedef short bf16x8 __attribute__((ext_vector_type(8)));
typedef float f32x4 __attribute__((ext_vector_type(4)));
typedef unsigned u32x4 __attribute__((ext_vector_type(4)));
constexpr int BM = 256, BK = 64, HALF = 128, HTB = HALF * BK * 2  , STAGE_BYTES = 8 * HTB, NXCD = 8, WGM = 8;

__host__ __device__ __forceinline__ int lds_byte(int r, int c) { const int st = (r >> 4) * 2 + (c >> 5), rr = r & 15, cc = c & 31, ob = rr * 64 + cc * 2; return st * 1024 + (ob ^ (((ob >> 9) & 1) << 5)); }
__host__ __device__ __forceinline__ void stage_rc(int b, int& R, int& C) { const int st = b / 1024, sb = b % 1024, swz = sb ^ (((sb >> 9) & 1) << 5); R = (st >> 1) * 16 + swz / 64; C = (st & 1) * 32 + (swz % 64) / 2; }
__host__ __device__ __forceinline__ int perm32(int rho) { const int n = rho >> 4, i = rho & 15; return 8 * (i >> 2) + 4 * n + (i & 3); }

struct Unit { int pm, pn; };
struct Gemm { const bf16_t* A; const bf16_t* Bt; int M, N, K; const int* gather; };

struct StaticOrder {
    int nM, nN, nwg, G, c;
    __host__ __device__ void init(int M, int N, int G_, int c_) { nM = M / BM; nN = N / BM; nwg = nM * nN; G = G_; c = c_; }
    __host__ __device__ bool next(int i, Unit& u) const {
        const long L = (long)i * G + c; if (L >= nwg) return false;
        int wgid = (int)L; { const int q = nwg / NXCD, r = nwg % NXCD, xcd = wgid % NXCD, off = wgid / NXCD; wgid = (xcd < r ? xcd * (q + 1) : r * (q + 1) + (xcd - r) * q) + off; }
        const int nig = WGM * nN, gid = wgid / nig, fm = gid * WGM, gsz = (nM - fm) < WGM ? (nM - fm) : WGM;
        u.pm = fm + ((wgid % nig) % gsz); u.pn = (wgid % nig) / gsz; return true;
    }
    __device__ __forceinline__ void a_ready(const Unit&) const {}
    __device__ __forceinline__ void done(const Unit&) const {}
};

typedef float f32x2_c __attribute__((ext_vector_type(2))); typedef __bf16 bf16x2_c __attribute__((ext_vector_type(2)));
__device__ __forceinline__ unsigned cvt_pk_bf16(float lo, float hi) { const f32x2_c v = {lo, hi}; return __builtin_bit_cast(unsigned, __builtin_convertvector(v, bf16x2_c)); }
__device__ __forceinline__ float bf_lo(unsigned u) { return __uint_as_float(u << 16); }
__device__ __forceinline__ float bf_hi(unsigned u) { return __uint_as_float(u & 0xffff0000u); }
__device__ __forceinline__ void st8(bf16_t* p, const f32x4 a, const f32x4 b) { u32x4 w; w.x = cvt_pk_bf16(a[0], a[1]); w.y = cvt_pk_bf16(a[2], a[3]); w.z = cvt_pk_bf16(b[0], b[1]); w.w = cvt_pk_bf16(b[2], b[3]); *(u32x4*)p = w; }
__device__ __forceinline__ void ld8(const bf16_t* p, f32x4& a, f32x4& b) { const u32x4 w = *(const u32x4*)p; a = (f32x4){bf_lo(w.x), bf_hi(w.x), bf_lo(w.y), bf_hi(w.y)}; b = (f32x4){bf_lo(w.z), bf_hi(w.z), bf_lo(w.w), bf_hi(w.w)}; }
__device__ __forceinline__ float fsigmoid(float x) { return __builtin_amdgcn_rcpf(1.0f + __builtin_amdgcn_exp2f(-1.4426950408889634f * x)); }
__device__ __forceinline__ f32x4 sig4(const f32x4 v) { return (f32x4){fsigmoid(v[0]), fsigmoid(v[1]), fsigmoid(v[2]), fsigmoid(v[3])}; }
__device__ __forceinline__ f32x4 silu4(const f32x4 v) { return v * sig4(v); }

__device__ __forceinline__ void st8x(bf16_t* p, const f32x4 a, const f32x4 b) { if (!(EPI_EXP & 2) || ((size_t)p & 1)) st8(p, a, b); else { asm volatile("" :: "v"(a), "v"(b)); } }
struct EpiInProj {
    static constexpr bool PERM = true, AFTER_DRAIN = false;
    unsigned char* ws;
    size_t oHQ, oFF, oFB, oHI, oSG, oQ, oK, oV, oGA, oGB, oROPE;
    const float *qg, *kg;
    template <int ACT> __device__ __forceinline__ void plain(const f32x4 (&acc)[2][2][4][2], bf16_t* base, long row0, int pitch, int col0) const {
#pragma unroll
        for (int ai = 0; ai < 2; ++ai)
#pragma unroll
            for (int m = 0; m < 4; ++m) { bf16_t* rowp = base + (row0 + ai * HALF + m * 16) * pitch + col0;
#pragma unroll
                for (int bj = 0; bj < 2; ++bj) { f32x4 v0 = acc[ai][bj][m][0], v1 = acc[ai][bj][m][1];
                    if (ACT == 1) { v0 = silu4(v0); v1 = silu4(v1); } if (ACT == 2) { v0 = sig4(v0); v1 = sig4(v1); }
                    st8x(rowp + bj * HALF, v0, v1); } }
    }
    __device__ __forceinline__ void gate8(const f32x4 (&acc)[2][2][4][2], unsigned char* base, long row0, int col0) const {
#pragma unroll
        for (int ai = 0; ai < 2; ++ai)
#pragma unroll
            for (int m = 0; m < 4; ++m) { unsigned char* rowp = base + (row0 + ai * HALF + m * 16) * 1024 + col0;
#pragma unroll
                for (int bj = 0; bj < 2; ++bj) { const f32x4 v0 = sig4(acc[ai][bj][m][0]) * 255.0f, v1 = sig4(acc[ai][bj][m][1]) * 255.0f;
                    unsigned w0 = 0, w1 = 0;
                    w0 = __builtin_amdgcn_cvt_pk_u8_f32(v0[0], 0, w0); w0 = __builtin_amdgcn_cvt_pk_u8_f32(v0[1], 1, w0); w0 = __builtin_amdgcn_cvt_pk_u8_f32(v0[2], 2, w0); w0 = __builtin_amdgcn_cvt_pk_u8_f32(v0[3], 3, w0);
                    w1 = __builtin_amdgcn_cvt_pk_u8_f32(v1[0], 0, w1); w1 = __builtin_amdgcn_cvt_pk_u8_f32(v1[1], 1, w1); w1 = __builtin_amdgcn_cvt_pk_u8_f32(v1[2], 2, w1); w1 = __builtin_amdgcn_cvt_pk_u8_f32(v1[3], 3, w1);
                    *(unsigned long long*)(rowp + bj * HALF) = (unsigned long long)w0 | ((unsigned long long)w1 << 32); } }
    }
    __device__ __forceinline__ void qk(const f32x4 (&acc)[2][2][4][2], bf16_t* base, long row0, int pitch, int col0, const float* gain, bool do_rope, int t0, float oscale, int fq) const {
        const float* rope = (const float*)(ws + oROPE);
        f32x4 gv[2][2];
#pragma unroll
        for (int bj = 0; bj < 2; ++bj)
#pragma unroll
            for (int n = 0; n < 2; ++n) gv[bj][n] = *(const f32x4*)(gain + 32 * bj + 16 * n + 4 * fq);
        f32x4 cc[4], sc[4], cr[2], sr[2];
        if (do_rope) {
#pragma unroll
            for (int m = 0; m < 4; ++m) { const int pos = (t0 + m * 16) & 63; cc[m] = *(const f32x4*)(rope + pos * 32 + 4 * fq); sc[m] = *(const f32x4*)(rope + pos * 32 + 16 + 4 * fq); }
#pragma unroll
            for (int ai = 0; ai < 2; ++ai) { const int pos = (t0 + ai * HALF) >> 6; cr[ai] = *(const f32x4*)(rope + pos * 32 + 4 * fq); sr[ai] = *(const f32x4*)(rope + pos * 32 + 16 + 4 * fq); }
        } else {
#pragma unroll
            for (int m = 0; m < 4; ++m) { cc[m] = (f32x4){1.f, 1.f, 1.f, 1.f}; sc[m] = (f32x4){0.f, 0.f, 0.f, 0.f}; }
#pragma unroll
            for (int ai = 0; ai < 2; ++ai) { cr[ai] = (f32x4){1.f, 1.f, 1.f, 1.f}; sr[ai] = (f32x4){0.f, 0.f, 0.f, 0.f}; }
        }
#pragma unroll
        for (int ai = 0; ai < 2; ++ai)
#pragma unroll
            for (int m = 0; m < 4; ++m) {
                float ss = 0.f;
#pragma unroll
                for (int bj = 0; bj < 2; ++bj)
#pragma unroll
                    for (int n = 0; n < 2; ++n) { const f32x4 x = acc[ai][bj][m][n]; ss += (x[0] * x[0] + x[1] * x[1]) + (x[2] * x[2] + x[3] * x[3]); }
                ss += __shfl_xor(ss, 16); ss += __shfl_xor(ss, 32);
                const float rstd = 1.0f / sqrtf(ss * (1.0f / 64.0f) + 1e-6f);
                bf16_t* rowp = base + (row0 + ai * HALF + m * 16) * pitch + col0;
#pragma unroll
                for (int bj = 0; bj < 2; ++bj) {
                    const f32x4 x1 = acc[ai][bj][m][0] * rstd * gv[bj][0], x2 = acc[ai][bj][m][1] * rstd * gv[bj][1];
                    const f32x4 c = bj ? cc[m] : cr[ai], s = bj ? sc[m] : sr[ai];
                    const f32x4 o1 = x1 * c - x2 * s, o2 = x2 * c + x1 * s;
                    st8x(rowp + bj * 32, o1 * oscale, o2 * oscale); }
            }
    }
    __device__ __forceinline__ void operator()(const f32x4 (&acc)[2][2][4][2], const Unit& u, int wr, int wc, int fr_, int fq_) const {
        int fr = fr_, fq = fq_; asm volatile("" : "+v"(fr), "+v"(fq));
        if (EPI_EXP & 1) return;
        const int pn = u.pn, bb = u.pm / 9, jt = u.pm - bb * 9;
        const int rloc = wr * 64 + fr;
        const long r0 = (long)u.pm * BM + rloc;
        const long rl0 = (long)bb * 2048 + (jt - 1) * 256 + rloc;
        const int c8 = wc * 32 + 8 * fq;
        if (pn < 2)        plain<0>(acc, (bf16_t*)(ws + oHQ), rl0, 512, pn * 256 + c8);
        else if (pn < 4)   plain<0>(acc, (bf16_t*)(ws + oFF), r0, 512, (pn - 2) * 256 + c8);
        else if (pn < 6)   plain<0>(acc, (bf16_t*)(ws + oFB), r0, 512, (pn - 4) * 256 + c8);
        else if (pn < 8)   plain<0>(acc, (bf16_t*)(ws + oHI), r0, 512, (pn - 6) * 256 + c8);
        else if (pn < 10)  plain<1>(acc, (bf16_t*)(ws + oSG), rl0, 512, (pn - 8) * 256 + c8);
        else if (pn < 12)  qk(acc, (bf16_t*)(ws + oQ), rl0, 512, ((pn - 10) * 4 + wc) * 64 + 8 * fq, qg, true, (jt - 1) * 256 + rloc, 0.125f * 1.4426950408889634f, fq);
        else if (pn == 12) {
            if (wc < 2)    qk(acc, (bf16_t*)(ws + oK), r0, 128, wc * 64 + 8 * fq, kg, jt >= 1, (jt - 1) * 256 + rloc, 1.0f, fq);
            else {
#pragma unroll
                for (int ai = 0; ai < 2; ++ai)
#pragma unroll
                    for (int m = 0; m < 4; ++m) { bf16_t* rowp = (bf16_t*)(ws + oV) + (r0 + ai * HALF + m * 16) * 128 + (wc - 2) * 64 + 8 * fq;
#pragma unroll
                        for (int bj = 0; bj < 2; ++bj) st8x(rowp + bj * 32, acc[ai][bj][m][0], acc[ai][bj][m][1]); }
            }
        }
        else if (pn < 17)  gate8(acc, ws + oGA, rl0, (pn - 13) * 256 + c8);
        else               gate8(acc, ws + oGB, rl0, (pn - 17) * 256 + c8);
    }
};

template <int SECOND> struct EpiZ {
    static constexpr bool PERM = true, AFTER_DRAIN = false;
    bf16_t* Z; const unsigned char* G;
    __device__ __forceinline__ void ld(int ai, int mh, long row0, int col0, unsigned long long (&gw)[2][2], u32x4 (&zw)[2][2]) const {
#pragma unroll
        for (int mm = 0; mm < 2; ++mm)
#pragma unroll
            for (int bj = 0; bj < 2; ++bj) { const long off = (row0 + ai * HALF + (2 * mh + mm) * 16) * 1024 + col0 + bj * HALF;
                gw[mm][bj] = *(const unsigned long long*)(G + off); if (SECOND) zw[mm][bj] = *(const u32x4*)(Z + off); }
    }
    __device__ __forceinline__ void proc(const f32x4 (&acc)[2][2][4][2], int ai, int mh, long row0, int col0, const unsigned long long (&gw)[2][2], const u32x4 (&zw)[2][2]) const {
#pragma unroll
        for (int mm = 0; mm < 2; ++mm)
#pragma unroll
            for (int bj = 0; bj < 2; ++bj) { const int m = 2 * mh + mm; const long off = (row0 + ai * HALF + m * 16) * 1024 + col0 + bj * HALF;
                const unsigned wl = (unsigned)gw[mm][bj], wh = (unsigned)(gw[mm][bj] >> 32);
                const f32x4 g0 = (f32x4){(float)(wl & 255u), (float)((wl >> 8) & 255u), (float)((wl >> 16) & 255u), (float)(wl >> 24)} * (1.0f / 255.0f), g1 = (f32x4){(float)(wh & 255u), (float)((wh >> 8) & 255u), (float)((wh >> 16) & 255u), (float)(wh >> 24)} * (1.0f / 255.0f);
                f32x4 v0 = acc[ai][bj][m][0] * g0, v1 = acc[ai][bj][m][1] * g1;
                if (SECOND) { const u32x4 z = zw[mm][bj]; v0 += (f32x4){bf_lo(z.x), bf_hi(z.x), bf_lo(z.y), bf_hi(z.y)}; v1 += (f32x4){bf_lo(z.z), bf_hi(z.z), bf_lo(z.w), bf_hi(z.w)}; }
                st8(Z + off, v0, v1); }
    }
    __device__ __forceinline__ void operator()(const f32x4 (&acc)[2][2][4][2], const Unit& u, int wr, int wc, int fr_, int fq_) const {
        int fr = fr_, fq = fq_; asm volatile("" : "+v"(fr), "+v"(fq));
        const long row0 = (long)u.pm * BM + wr * 64 + fr; const int col0 = u.pn * BM + wc * 32 + 8 * fq;
        unsigned long long gA[2][2], gB[2][2]; u32x4 zA[2][2], zB[2][2];
        ld(0, 0, row0, col0, gA, zA);
        ld(0, 1, row0, col0, gB, zB); proc(acc, 0, 0, row0, col0, gA, zA);
        ld(1, 0, row0, col0, gA, zA); proc(acc, 0, 1, row0, col0, gB, zB);
        ld(1, 1, row0, col0, gB, zB); proc(acc, 1, 0, row0, col0, gA, zA);
        proc(acc, 1, 1, row0, col0, gB, zB);
    }
};
struct EpiX1 {
    static constexpr bool PERM = false, AFTER_DRAIN = false;
    const float* x; const float* mod; bf16_t* out;
    __device__ __forceinline__ void ld(int ai, int mh, long row0, int col0, f32x4 (&xv)[2][2][2]) const {
#pragma unroll
        for (int mm = 0; mm < 2; ++mm)
#pragma unroll
            for (int bj = 0; bj < 2; ++bj)
#pragma unroll
                for (int n = 0; n < 2; ++n) xv[mm][bj][n] = *(const f32x4*)(x + (row0 + ai * HALF + (2 * mh + mm) * 16) * 1024 + col0 + bj * HALF + n * 16);
    }
    __device__ __forceinline__ void proc(const f32x4 (&acc)[2][2][4][2], int ai, int mh, long row0, int col0, const f32x4 (&xv)[2][2][2], const f32x4 (&gv)[2][2]) const {
#pragma unroll
        for (int mm = 0; mm < 2; ++mm)
#pragma unroll
            for (int bj = 0; bj < 2; ++bj)
#pragma unroll
                for (int n = 0; n < 2; ++n) { const int m = 2 * mh + mm; const f32x4 o = xv[mm][bj][n] + gv[bj][n] * acc[ai][bj][m][n];
                    unsigned w0 = cvt_pk_bf16(o[0], o[1]), w1 = cvt_pk_bf16(o[2], o[3]);
                    *(unsigned long long*)(out + (row0 + ai * HALF + m * 16) * 1024 + col0 + bj * HALF + n * 16) = (unsigned long long)w0 | ((unsigned long long)w1 << 32); }
    }
    __device__ __forceinline__ void operator()(const f32x4 (&acc)[2][2][4][2], const Unit& u, int wr, int wc, int fr_, int fq_) const {
        int fr = fr_, fq = fq_; asm volatile("" : "+v"(fr), "+v"(fq));
        const long row0 = (long)u.pm * BM + wr * 64 + fr; const int col0 = u.pn * BM + wc * 32 + 4 * fq; const int b = u.pm >> 3;
        f32x4 gv[2][2];
#pragma unroll
        for (int bj = 0; bj < 2; ++bj)
#pragma unroll
            for (int n = 0; n < 2; ++n) gv[bj][n] = *(const f32x4*)(mod + (size_t)b * 6144 + 2048 + col0 + bj * HALF + n * 16);
        f32x4 xA[2][2][2], xB[2][2][2];
        ld(0, 0, row0, col0, xA);
        ld(0, 1, row0, col0, xB); proc(acc, 0, 0, row0, col0, xA, gv);
        ld(1, 0, row0, col0, xA); proc(acc, 0, 1, row0, col0, xB, gv);
        ld(1, 1, row0, col0, xB); proc(acc, 1, 0, row0, col0, xA, gv);
        proc(acc, 1, 1, row0, col0, xB, gv);
    }
};
struct EpiHid {
    static constexpr bool PERM = true, AFTER_DRAIN = false;
    bf16_t* H;
    __device__ __forceinline__ void operator()(const f32x4 (&acc)[2][2][4][2], const Unit& u, int wr, int wc, int fr, int fq) const {
        const int row0 = wr * 64 + fr, col0 = u.pn * HALF + wc * 32 + 8 * fq;
#pragma unroll
        for (int ai = 0; ai < 2; ++ai)
#pragma unroll
            for (int m = 0; m < 4; ++m) st8(H + (size_t)(row0 + ai * HALF + m * 16) * 1024 + col0, silu4(acc[ai][0][m][0]) * acc[ai][1][m][0], silu4(acc[ai][0][m][1]) * acc[ai][1][m][1]);
    }
};
struct EpiHidQ {
    static constexpr bool PERM = true, AFTER_DRAIN = false;
    bf16_t* H; const float* scl; const float* tq;
    __device__ __forceinline__ static f32x4 cvt4(const f32x4 a) { return (f32x4){(float)__float_as_int(a[0]), (float)__float_as_int(a[1]), (float)__float_as_int(a[2]), (float)__float_as_int(a[3])}; }
    __device__ __forceinline__ void operator()(const f32x4 (&acc)[2][2][4][2], const Unit& u, int wr, int wc, int fr, int fq) const {
        const int row0 = wr * 64 + fr, col0 = u.pn * HALF + wc * 32 + 8 * fq;
        const float* tc = tq + u.pn * BM + wc * 32 + 8 * fq;
        const f32x4 cg0 = *(const f32x4*)(tc), cg1 = *(const f32x4*)(tc + 4), cu0 = *(const f32x4*)(tc + HALF), cu1 = *(const f32x4*)(tc + HALF + 4);
        float sr[2][4];
#pragma unroll
        for (int ai = 0; ai < 2; ++ai)
#pragma unroll
            for (int m = 0; m < 4; ++m) sr[ai][m] = scl[row0 + ai * HALF + m * 16];
#pragma unroll
        for (int ai = 0; ai < 2; ++ai)
#pragma unroll
            for (int m = 0; m < 4; ++m) { const float r = sr[ai][m];
                const f32x4 g0 = cvt4(acc[ai][0][m][0]) * (cg0 * r), g1 = cvt4(acc[ai][0][m][1]) * (cg1 * r), u0 = cvt4(acc[ai][1][m][0]) * (cu0 * r), u1 = cvt4(acc[ai][1][m][1]) * (cu1 * r);
                st8(H + (size_t)(row0 + ai * HALF + m * 16) * 1024 + col0, silu4(g0) * u0, silu4(g1) * u1); }
    }
};
struct EpiInProjQ {
    static constexpr bool PERM = true, AFTER_DRAIN = false;
    EpiInProj base; const float* rs; const float* cs;
    __device__ __forceinline__ void operator()(const f32x4 (&acc_)[2][2][4][2], const Unit& u, int wr, int wc, int fr_, int fq_) const {
        int fr = fr_, fq = fq_; asm volatile("" : "+v"(fr), "+v"(fq));
        f32x4 (&acc)[2][2][4][2] = const_cast<f32x4 (&)[2][2][4][2]>(acc_);
        const float* rp = rs + (size_t)u.pm * BM + wr * 64 + fr; const float* cp = cs + u.pn * BM + wc * 32 + 8 * fq;
        f32x4 c4[2][2]; float r8[2][4];
#pragma unroll
        for (int bj = 0; bj < 2; ++bj)
#pragma unroll
            for (int n = 0; n < 2; ++n) c4[bj][n] = *(const f32x4*)(cp + bj * HALF + 4 * n);
#pragma unroll
        for (int ai = 0; ai < 2; ++ai)
#pragma unroll
            for (int m = 0; m < 4; ++m) r8[ai][m] = rp[ai * HALF + m * 16];
#pragma unroll
        for (int ai = 0; ai < 2; ++ai)
#pragma unroll
            for (int bj = 0; bj < 2; ++bj)
#pragma unroll
                for (int m = 0; m < 4; ++m)
#pragma unroll
                    for (int n = 0; n < 2; ++n) acc[ai][bj][m][n] = EpiHidQ::cvt4(acc[ai][bj][m][n]) * (c4[bj][n] * r8[ai][m]);
        base(acc, u, wr, wc, fr, fq);
    }
};
constexpr float YE_F8_SCALE = 32.0f;
struct EpiYe {
    static constexpr bool PERM = true, AFTER_DRAIN = false;
    unsigned char* Y; const float* gate;
    __device__ __forceinline__ void operator()(const f32x4 (&acc)[2][2][4][2], const Unit& u, int wr, int wc, int fr, int fq) const {
        const int row0 = wr * 64 + fr, col0 = u.pn * BM + wc * 32 + 8 * fq;
        float gt[2][4];
#pragma unroll
        for (int ai = 0; ai < 2; ++ai)
#pragma unroll
            for (int m = 0; m < 4; ++m) gt[ai][m] = gate[row0 + ai * HALF + m * 16];
#pragma unroll
        for (int ai = 0; ai < 2; ++ai)
#pragma unroll
            for (int m = 0; m < 4; ++m) { const int r = row0 + ai * HALF + m * 16;
#pragma unroll
                for (int bj = 0; bj < 2; ++bj) { const f32x4 a = acc[ai][bj][m][0] * (gt[ai][m] * YE_F8_SCALE), b = acc[ai][bj][m][1] * (gt[ai][m] * YE_F8_SCALE);
                    int w0 = __builtin_amdgcn_cvt_pk_fp8_f32(a[0], a[1], 0, false); w0 = __builtin_amdgcn_cvt_pk_fp8_f32(a[2], a[3], w0, true);
                    int w1 = __builtin_amdgcn_cvt_pk_fp8_f32(b[0], b[1], 0, false); w1 = __builtin_amdgcn_cvt_pk_fp8_f32(b[2], b[3], w1, true);
                    *(unsigned long long*)(Y + (size_t)r * 1024 + col0 + bj * HALF) = (unsigned long long)(unsigned)w0 | ((unsigned long long)(unsigned)w1 << 32); } }
    }
};
struct EpiYeQ {
    static constexpr bool PERM = true, AFTER_DRAIN = false;
    unsigned char* Y; const float* gate; const float* rs; const float* td;
    __device__ __forceinline__ void operator()(const f32x4 (&acc)[2][2][4][2], const Unit& u, int wr, int wc, int fr, int fq) const {
        const int row0 = wr * 64 + fr, col0 = u.pn * BM + wc * 32 + 8 * fq;
        const float* tc = td + col0;
        f32x4 c4[2][2];
#pragma unroll
        for (int bj = 0; bj < 2; ++bj)
#pragma unroll
            for (int n = 0; n < 2; ++n) c4[bj][n] = *(const f32x4*)(tc + bj * HALF + 4 * n);
        float gt[2][4];
#pragma unroll
        for (int ai = 0; ai < 2; ++ai)
#pragma unroll
            for (int m = 0; m < 4; ++m) gt[ai][m] = gate[row0 + ai * HALF + m * 16] * rs[row0 + ai * HALF + m * 16] * YE_F8_SCALE;
#pragma unroll
        for (int ai = 0; ai < 2; ++ai)
#pragma unroll
            for (int m = 0; m < 4; ++m) { const int r = row0 + ai * HALF + m * 16;
#pragma unroll
                for (int bj = 0; bj < 2; ++bj) { f32x4 a = EpiHidQ::cvt4(acc[ai][bj][m][0]) * (c4[bj][0] * gt[ai][m]), b = EpiHidQ::cvt4(acc[ai][bj][m][1]) * (c4[bj][1] * gt[ai][m]);
#pragma unroll
                    for (int j = 0; j < 4; ++j) { a[j] = __builtin_amdgcn_fmed3f(a[j], -440.0f, 440.0f); b[j] = __builtin_amdgcn_fmed3f(b[j], -440.0f, 440.0f); }
                    int w0 = __builtin_amdgcn_cvt_pk_fp8_f32(a[0], a[1], 0, false); w0 = __builtin_amdgcn_cvt_pk_fp8_f32(a[2], a[3], w0, true);
                    int w1 = __builtin_amdgcn_cvt_pk_fp8_f32(b[0], b[1], 0, false); w1 = __builtin_amdgcn_cvt_pk_fp8_f32(b[2], b[3], w1, true);
                    *(unsigned long long*)(Y + (size_t)r * 1024 + col0 + bj * HALF) = (unsigned long long)(unsigned)w0 | ((unsigned long long)(unsigned)w1 << 32); } }
    }
};
struct InProjOrder {
    StaticOrder so;
    __device__ void init(int G_, int c_) { so.init(ML, INC, G_, c_); }
    __device__ bool next(int i, Unit& u) const {
#if DBG_GA_ONLY
        { const long L = (long)i * so.G + so.c; if (L >= 512) return false; u.pm = (int)(L >> 2); u.pn = 13 + (int)(L & 3); u.pm = (u.pm >> 3) * 9 + 1 + (u.pm & 7); return true; }
#endif
        if (so.next(i, u)) { u.pm = (u.pm >> 3) * 9 + 1 + (u.pm & 7); return true; }
        const long L = (long)i * so.G + so.c - so.nwg; if (L >= 16 * 7) return false;
        const int cb = (int)L / 7, k = (int)L % 7; u.pm = cb * 9; u.pn = k < 6 ? 2 + k : 12; return true;
    }
    __device__ __forceinline__ void a_ready(const Unit&) const {}
    __device__ __forceinline__ void done(const Unit&) const {}
};
struct LocalOrder {
    int n;
    __device__ bool next(int i, Unit& u) const { if (i >= n) return false; u.pm = 0; u.pn = i; return true; }
    __device__ __forceinline__ void a_ready(const Unit&) const {}
    __device__ __forceinline__ void done(const Unit&) const {}
};
typedef int i32x4_pg8 __attribute__((ext_vector_type(4)));
template <bool I8> __device__ __forceinline__ f32x4 mma16(const bf16x8 b, const bf16x8 a, const f32x4 c) {
    if constexpr (I8) return __builtin_bit_cast(f32x4, __builtin_amdgcn_mfma_i32_16x16x64_i8(__builtin_bit_cast(i32x4_pg8, b), __builtin_bit_cast(i32x4_pg8, a), __builtin_bit_cast(i32x4_pg8, c), 0, 0, 0));
    else return __builtin_amdgcn_mfma_f32_16x16x32_bf16(b, a, c, 0, 0, 0);
}
template <class Epi, class Sched, bool ALIGN_EPI = false, bool SP2 = false, bool I8 = false>
__device__ __forceinline__ void gemm_phase(PG8_LAS unsigned char* lds, const Gemm g, const Sched& S, const Epi& E) {
    int tid_ = threadIdx.x; asm volatile("" : "+v"(tid_));
    const int tid = tid_, wid = __builtin_amdgcn_readfirstlane(tid >> 6), lane = tid & 63, wr = wid >> 2, wc = wid & 3, fr = lane & 15, fq = lane >> 4;
    const int K = g.K, nt = K / BK;
    unsigned voffA[2], voffA1[2], voffB[2];
#pragma unroll
    for (int i = 0; i < 2; ++i) { int R, C; stage_rc(tid * 16 + i * 8192, R, C); const int Rb = Epi::PERM ? ((R & ~31) + perm32(R & 31)) : R;
        if (g.gather) { voffA[i] = ((unsigned)g.gather[R] * (unsigned)K + (unsigned)C) * 2u; voffA1[i] = ((unsigned)g.gather[R + HALF] * (unsigned)K + (unsigned)C) * 2u; }
        else { voffA[i] = (unsigned)(R * K + C) * 2u; voffA1[i] = voffA[i] + (unsigned)(HALF * K * 2); }
        voffB[i] = (unsigned)(Rb * K + C) * 2u; }
    const size_t kstep = (size_t)(BK * 2);
    const size_t hstep = (size_t)HALF * K * 2;
    const size_t tstep = 2 * hstep;
    const unsigned ldsw = (unsigned)wid * 1024u;
    const int aoff = lds_byte(wr * 64 + fr, fq * 8), boff = lds_byte(wc * 32 + fr, fq * 8);
#define PG8_SA(b, h) (((b) * 2 + (h)) * HTB)
#define PG8_SB(b, h) ((4 + (b) * 2 + (h)) * HTB)
#define PG8_STAGE(bufoff, gbase, voff) do { _Pragma("unroll") for (int _i = 0; _i < 2; ++_i) \
        __builtin_amdgcn_global_load_lds((const unsigned*)((const char*)(gbase) + (voff)[_i]), (PG8_LAS unsigned*)(lds + (bufoff) + ldsw + _i * 8192), 16, 0, PG8_DMA_AUX); } while (0)
#define PG8_LDA(dst, b, h) do { _Pragma("unroll") for (int m = 0; m < 4; ++m) _Pragma("unroll") for (int k = 0; k < 2; ++k) dst[m][k] = *(const PG8_LAS bf16x8*)(lds + PG8_SA(b, h) + aoff + m * 2048 + k * 1024); } while (0)
#define PG8_LDB(dst, b, h) do { _Pragma("unroll") for (int n = 0; n < 2; ++n) _Pragma("unroll") for (int k = 0; k < 2; ++k) dst[n][k] = *(const PG8_LAS bf16x8*)(lds + PG8_SB(b, h) + boff + n * 2048 + k * 1024); } while (0)
#define PG8_MMA(ai, bj, At, Bt) do { __builtin_amdgcn_s_setprio(1); _Pragma("unroll") for (int m = 0; m < 4; ++m) _Pragma("unroll") for (int n = 0; n < 2; ++n) _Pragma("unroll") for (int k = 0; k < 2; ++k) \
        acc[ai][bj][m][n] = mma16<I8>(Bt[n][k], At[m][k], acc[ai][bj][m][n]); __builtin_amdgcn_s_setprio(0); } while (0)
#define PG8_WAIT_V(n) asm volatile("s_waitcnt vmcnt(" #n ")" ::: "memory")
#define PG8_WAIT_L(n) asm volatile("s_waitcnt lgkmcnt(" #n ")" ::: "memory")
#define PG8_BAR __builtin_amdgcn_s_barrier()
#define PG8_SCHED __builtin_amdgcn_sched_barrier(0)
    Unit cur, nxt; int ui = 0;
    if (!S.next(0, cur)) return;
    f32x4 acc[2][2][4][2];
#pragma unroll
    for (int a = 0; a < 2; ++a)
#pragma unroll
        for (int b = 0; b < 2; ++b)
#pragma unroll
            for (int m = 0; m < 4; ++m)
#pragma unroll
                for (int n = 0; n < 2; ++n) acc[a][b][m][n] = (f32x4){0.f, 0.f, 0.f, 0.f};
    bf16x8 At[4][2], B0[2][2], B1[2][2];
    const char* cA = (const char*)g.A + (size_t)cur.pm * tstep; const char* cB = (const char*)g.Bt + (size_t)cur.pn * tstep;
    S.a_ready(cur);
    if constexpr (SP2) {
        PG8_STAGE(PG8_SB(0, 0), cB, voffB); PG8_STAGE(PG8_SB(0, 1), cB + hstep, voffB); PG8_STAGE(PG8_SA(0, 0), cA, voffA); PG8_STAGE(PG8_SA(0, 1), cA, voffA1);
        if (wr == 1) PG8_BAR;
        PG8_WAIT_V(2); PG8_BAR;
        PG8_STAGE(PG8_SB(1, 0), cB + kstep, voffB); PG8_STAGE(PG8_SA(1, 0), cA + kstep, voffA); PG8_STAGE(PG8_SB(1, 1), cB + hstep + kstep, voffB);
        PG8_WAIT_V(6); PG8_BAR;
    } else {
        PG8_STAGE(PG8_SB(0, 0), cB, voffB); PG8_STAGE(PG8_SA(0, 0), cA, voffA); PG8_STAGE(PG8_SB(0, 1), cB + hstep, voffB); PG8_STAGE(PG8_SA(0, 1), cA, voffA1);
        if (wr == 1) PG8_BAR;
        PG8_WAIT_V(4); PG8_BAR;
        PG8_STAGE(PG8_SB(1, 0), cB + kstep, voffB); PG8_STAGE(PG8_SA(1, 0), cA + kstep, voffA); PG8_STAGE(PG8_SB(1, 1), cB + hstep + kstep, voffB);
        PG8_WAIT_V(6); PG8_BAR;
    }
    for (;;) {
        const bool has_next = S.next(ui + 1, nxt);
        const char* nA = has_next ? (const char*)g.A + (size_t)nxt.pm * tstep : cA; const char* nB = has_next ? (const char*)g.Bt + (size_t)nxt.pn * tstep : cB;
        for (int t = 0; t < nt; t += 2) {
            const bool last = (t == nt - 2);
            const char* a1 = cA + (size_t)(t + 1) * kstep;
            const char* a2 = last ? nA : cA + (size_t)(t + 2) * kstep; const char* b2 = last ? nB : cB + (size_t)(t + 2) * kstep;
            const char* a3 = a2 + kstep; const char* b3 = b2 + kstep;
            if (last && has_next) S.a_ready(nxt);
            if constexpr (SP2) {
            PG8_LDB(B0, 0, 0); PG8_LDB(B1, 0, 1); PG8_SCHED; PG8_LDA(At, 0, 0); PG8_STAGE(PG8_SA(1, 1), a1, voffA1);
            PG8_WAIT_V(8); PG8_WAIT_L(0); PG8_BAR; PG8_MMA(0, 0, At, B0); PG8_MMA(0, 1, At, B1); PG8_BAR; PG8_SCHED;
            PG8_LDA(At, 0, 1); PG8_STAGE(PG8_SB(0, 0), b2, voffB); PG8_STAGE(PG8_SB(0, 1), b2 + hstep, voffB); PG8_STAGE(PG8_SA(0, 0), a2, voffA);
            PG8_WAIT_V(8); PG8_WAIT_L(0); PG8_BAR; PG8_MMA(1, 0, At, B0); PG8_MMA(1, 1, At, B1); PG8_BAR; PG8_SCHED;
            PG8_LDB(B0, 1, 0); PG8_LDB(B1, 1, 1); PG8_SCHED; PG8_LDA(At, 1, 0); PG8_STAGE(PG8_SA(0, 1), a2, voffA1);
            PG8_WAIT_V(8); PG8_WAIT_L(0); PG8_BAR; PG8_MMA(0, 0, At, B0); PG8_MMA(0, 1, At, B1); PG8_BAR; PG8_SCHED;
            PG8_LDA(At, 1, 1); PG8_STAGE(PG8_SB(1, 0), b3, voffB); PG8_STAGE(PG8_SB(1, 1), b3 + hstep, voffB); PG8_STAGE(PG8_SA(1, 0), a3, voffA);
            PG8_WAIT_V(8); PG8_WAIT_L(0); PG8_BAR; PG8_MMA(1, 0, At, B0); PG8_MMA(1, 1, At, B1); PG8_BAR; PG8_SCHED;
            } else {
            PG8_LDB(B0, 0, 0); PG8_SCHED; PG8_LDA(At, 0, 0); PG8_STAGE(PG8_SA(1, 1), a1, voffA1);
            PG8_WAIT_L(8); PG8_BAR; PG8_WAIT_L(0); PG8_MMA(0, 0, At, B0); PG8_BAR; PG8_SCHED;
            PG8_LDB(B1, 0, 1); PG8_STAGE(PG8_SB(0, 0), b2, voffB);
            PG8_BAR; PG8_WAIT_L(0); PG8_MMA(0, 1, At, B1); PG8_BAR;
            PG8_LDA(At, 0, 1); PG8_STAGE(PG8_SA(0, 0), a2, voffA);
            PG8_BAR; PG8_WAIT_L(0); PG8_MMA(1, 0, At, B0); PG8_BAR; PG8_SCHED;
            PG8_STAGE(PG8_SB(0, 1), b2 + hstep, voffB);
            PG8_WAIT_V(6); PG8_BAR; PG8_MMA(1, 1, At, B1); PG8_BAR;
            PG8_LDB(B0, 1, 0); PG8_SCHED; PG8_LDA(At, 1, 0); PG8_STAGE(PG8_SA(0, 1), a2, voffA1);
            PG8_WAIT_L(8); PG8_BAR; PG8_WAIT_L(0); PG8_MMA(0, 0, At, B0); PG8_BAR; PG8_SCHED;
            PG8_LDB(B1, 1, 1); PG8_STAGE(PG8_SB(1, 0), b3, voffB);
            PG8_BAR; PG8_WAIT_L(0); PG8_MMA(0, 1, At, B1); PG8_BAR;
            PG8_LDA(At, 1, 1); PG8_STAGE(PG8_SA(1, 0), a3, voffA);
            PG8_BAR; PG8_WAIT_L(0); PG8_MMA(1, 0, At, B0); PG8_BAR; PG8_SCHED;
            PG8_STAGE(PG8_SB(1, 1), b3 + hstep, voffB);
            PG8_WAIT_V(6); PG8_BAR; PG8_MMA(1, 1, At, B1); PG8_BAR;
            }
        }
        if constexpr (ALIGN_EPI) { if (wr == 0) PG8_BAR; }
        if constexpr (!Epi::AFTER_DRAIN) { E(acc, cur, wr, wc, fr, fq); S.done(cur); }
        if (!has_next) break;
#pragma unroll
        for (int a = 0; a < 2; ++a)
#pragma unroll
            for (int b = 0; b < 2; ++b)
#pragma unroll
                for (int m = 0; m < 4; ++m)
#pragma unroll
                    for (int n = 0; n < 2; ++n) acc[a][b][m][n] = (f32x4){0.f, 0.f, 0.f, 0.f};
        cur = nxt; cA = nA; cB = nB; ++ui;
        if constexpr (ALIGN_EPI) { if (wr == 1) PG8_BAR; }
    }
    PG8_WAIT_V(0);
    if constexpr (!ALIGN_EPI) { if (wr == 0) PG8_BAR; }
    PG8_BAR;
    if constexpr (Epi::AFTER_DRAIN) { E.fused(acc, cur, wr, wc, fr, fq, lds, wid, lane); S.done(cur); }
#undef PG8_SA
#undef PG8_SB
#undef PG8_STAGE
#undef PG8_LDA
#undef PG8_LDB
#undef PG8_MMA
#undef PG8_WAIT_V
#undef PG8_WAIT_L
#undef PG8_BAR
#undef PG8_SCHED
}
}
#include <hip/hip_bf16.h>
#include <cmath>
namespace attn_body {
using bf16=__hip_bfloat16;
using bf16x8=__attribute__((ext_vector_type(8)))short;
using s16x4=__attribute__((ext_vector_type(4)))short;
using f32x16=__attribute__((ext_vector_type(16)))float;
using u32x4=__attribute__((ext_vector_type(4)))unsigned;
constexpr int D=64,QP=512,KP=128,NKT=36;
constexpr int NW=8,QBLK=32,QB=QBLK*NW,KVBLK=64;
__device__ __forceinline__ int crow(int r,int hi){return (r&3)+8*(r>>2)+4*hi;}
#define SBAR() __builtin_amdgcn_sched_barrier(0)
constexpr int NSLOT=3, SLOTB=8192;
constexpr int LDS_K=0, LDS_V=NSLOT*SLOTB, LDS_WS=2*NSLOT*SLOTB, LDS_OST=LDS_WS+NW*64*4, LDS_BYTES=LDS_OST+NW*4096;
constexpr float C2=0.125f*1.4426950408889634f;
__device__ __forceinline__ void glds16(const void*gsrc,unsigned lds_dst){unsigned keep;
  asm volatile("s_mov_b32 %0, m0\n\ts_mov_b32 m0, %2\n\ts_nop 0\n\tglobal_load_lds_dwordx4 %1, off\n\ts_mov_b32 m0, %0":"=&s"(keep):"v"(gsrc),"s"(lds_dst):"memory");}
__device__ __forceinline__ float max3f(float a,float b,float c){float r;asm("v_max3_f32 %0, %1, %2, %3":"=v"(r):"v"(a),"v"(b),"v"(c));return r;}
__device__ __forceinline__ float max2f(float a,float b){float r;asm("v_max_f32_e32 %0, %1, %2":"=v"(r):"v"(a),"v"(b));return r;}
__device__ __forceinline__ float fadd_s(float a,float b){float r;asm("v_add_f32_e32 %0, %1, %2":"=v"(r):"v"(a),"v"(b));return r;}
__device__ __forceinline__ float fsub_s(float a,float b){float r;asm("v_sub_f32_e32 %0, %1, %2":"=v"(r):"v"(a),"v"(b));return r;}
typedef float f32x2_t __attribute__((ext_vector_type(2))); typedef __bf16 bf16x2_t __attribute__((ext_vector_type(2)));
__device__ __forceinline__ unsigned cvtpk_s(float lo,float hi){f32x2_t v={lo,hi};bf16x2_t b=__builtin_convertvector(v,bf16x2_t);return __builtin_bit_cast(unsigned,b);}
#define WAIT_BAR(N) asm volatile("s_waitcnt vmcnt(" #N ") lgkmcnt(0)\n\ts_barrier":::"memory")

__device__ __forceinline__ void qkt(f32x16&p0,f32x16&p1,const char*Kslot,const bf16x8*qr,const f32x16&negm,int r32,int hi){
  const char*kb=Kslot+hi*1024+r32*16;
  #pragma unroll
  for(int d0=0;d0<4;++d0){
    const bf16x8 b0=*reinterpret_cast<const bf16x8*>(kb+d0*2048);
    const bf16x8 b1=*reinterpret_cast<const bf16x8*>(kb+d0*2048+512);
    if(d0==0){p0=__builtin_amdgcn_mfma_f32_32x32x16_bf16(b0,qr[0],negm,0,0,0);p1=__builtin_amdgcn_mfma_f32_32x32x16_bf16(b1,qr[0],negm,0,0,0);}
    else{p0=__builtin_amdgcn_mfma_f32_32x32x16_bf16(b0,qr[d0],p0,0,0,0);p1=__builtin_amdgcn_mfma_f32_32x32x16_bf16(b1,qr[d0],p1,0,0,0);}}
}
typedef __attribute__((address_space(3))) const char* lds_cptr;
typedef short v4i16_t __attribute__((ext_vector_type(4)));
__device__ __forceinline__ void kload8(bf16x8*kf,lds_cptr kp){
  kf[0]=*(const __attribute__((address_space(3))) bf16x8*)(kp);      kf[1]=*(const __attribute__((address_space(3))) bf16x8*)(kp+512);
  kf[2]=*(const __attribute__((address_space(3))) bf16x8*)(kp+2048); kf[3]=*(const __attribute__((address_space(3))) bf16x8*)(kp+2560);
  kf[4]=*(const __attribute__((address_space(3))) bf16x8*)(kp+4096); kf[5]=*(const __attribute__((address_space(3))) bf16x8*)(kp+4608);
  kf[6]=*(const __attribute__((address_space(3))) bf16x8*)(kp+6144); kf[7]=*(const __attribute__((address_space(3))) bf16x8*)(kp+6656);
}
__device__ __forceinline__ void kload2(bf16x8*kf,lds_cptr kp,int j){ kf[2*j]=*(const __attribute__((address_space(3))) bf16x8*)(kp+j*2048); kf[2*j+1]=*(const __attribute__((address_space(3))) bf16x8*)(kp+j*2048+512); }
__device__ __forceinline__ s16x4 vtr(lds_cptr p){ return __builtin_bit_cast(s16x4,__builtin_amdgcn_ds_read_tr16_b64_v4i16((__attribute__((address_space(3))) v4i16_t*)p)); }
__device__ __forceinline__ float rowmax(const f32x16&p0,const f32x16&p1){
  float a=max3f(p0[0],p0[1],p1[0]),b=max3f(p0[2],p0[3],p1[1]);a=max3f(a,p1[2],p1[3]);
  #pragma unroll
  for(int r=4;r<16;r+=4){a=max3f(a,p0[r],p0[r+1]);b=max3f(b,p0[r+2],p0[r+3]);a=max3f(a,p1[r],p1[r+1]);b=max3f(b,p1[r+2],p1[r+3]);}
  const float m=max2f(a,b);
  auto rr=__builtin_amdgcn_permlane32_swap(__float_as_uint(m),__float_as_uint(m),false,false);
  return max2f(__uint_as_float(rr[0]),__uint_as_float(rr[1]));
}
__device__ __forceinline__ void pv(f32x16*o,int vb,bf16x8 pa0,bf16x8 pa1,bf16x8 pa2,bf16x8 pa3){
  #pragma unroll
  for(int d0=0;d0<2;++d0){s16x4 lo[4],hi[4];
    #pragma unroll
    for(int ks=0;ks<4;++ks){
      asm volatile("ds_read_b64_tr_b16 %0,%1 offset:%c2":"=&v"(lo[ks]):"v"(vb),"i"(d0*4096+ks*1024):"memory");
      asm volatile("ds_read_b64_tr_b16 %0,%1 offset:%c2":"=&v"(hi[ks]):"v"(vb),"i"(d0*4096+ks*1024+512):"memory");}
    asm volatile("s_waitcnt lgkmcnt(0)":::"memory");SBAR();
    #define PK(k) (bf16x8){lo[k][0],lo[k][1],lo[k][2],lo[k][3],hi[k][0],hi[k][1],hi[k][2],hi[k][3]}
    o[d0]=__builtin_amdgcn_mfma_f32_32x32x16_bf16(pa0,PK(0),o[d0],0,0,0);
    o[d0]=__builtin_amdgcn_mfma_f32_32x32x16_bf16(pa1,PK(1),o[d0],0,0,0);
    o[d0]=__builtin_amdgcn_mfma_f32_32x32x16_bf16(pa2,PK(2),o[d0],0,0,0);
    o[d0]=__builtin_amdgcn_mfma_f32_32x32x16_bf16(pa3,PK(3),o[d0],0,0,0);
    #undef PK
  }
}

#ifndef ATTN_STORE16
#define ATTN_STORE16(p,v) (*(u32x4*)(p)=(v))
#endif
template<int THRL,bool FIXED> __device__ __forceinline__ void attn_unit(long qrow0,int h,long kvrow0,int kvh,const bf16*Q,const bf16*__restrict__ K,const bf16*__restrict__ V,bf16*O,char*shm,float mfix){
  int tid_=threadIdx.x; asm volatile("":"+v"(tid_)); const int tid=tid_,lane=tid&63,r32=lane&31,hi=lane>>5; const int wid=__builtin_amdgcn_readfirstlane(tid>>6);
  const bf16*Qw=Q+(qrow0+wid*QBLK)*QP+h*D;
  const bf16*Kh=K+kvrow0*KP+kvh*D,*Vh=V+kvrow0*KP+kvh*D;
  const unsigned lds0=(unsigned)(uintptr_t)shm;
  float*wsf=(float*)(shm+LDS_WS)+wid*64;
  const bf16*ksrc=Kh+(long)lane*KP+wid*8;
  const bf16*vsrc=Vh+(long)(16*(wid&3)+(lane>>2))*KP+(wid>>2)*32+(lane&3)*8;
  const unsigned kdst=lds0+LDS_K+wid*1024, vdst=lds0+LDS_V+wid*1024;
  #define DMA_K(t,slot) glds16(ksrc+(long)(t)*KVBLK*KP,(unsigned)__builtin_amdgcn_readfirstlane(kdst+(slot)))
  #define DMA_V(t,slot) glds16(vsrc+(long)(t)*KVBLK*KP,(unsigned)__builtin_amdgcn_readfirstlane(vdst+(slot)))
  const int vb0=(int)(lds0+LDS_V)+((lane>>4)&1)*32+(lane&3)*8+(4*hi+((lane&15)>>2))*64;
  const char*Kbase=shm+LDS_K; bf16x8 kf[8];
  const lds_cptr shm3=(lds_cptr)shm; const lds_cptr kp0=shm3+LDS_K+hi*1024+r32*16; const lds_cptr vp0=shm3+LDS_V+((lane>>4)&1)*32+(lane&3)*8+(4*hi+((lane&15)>>2))*64;
  constexpr int NT=NKT;
  DMA_K(0,0);DMA_V(0,0);DMA_K(1,SLOTB);
  bf16x8 qr[4];
  #pragma unroll
  for(int d0=0;d0<4;++d0)qr[d0]=*reinterpret_cast<const bf16x8*>(&Qw[(long)r32*QP+d0*16+hi*8]);
  float mhat=0.f,l_reg=0.f;f32x16 o[2];o[0]=f32x16{};o[1]=f32x16{};f32x16 negm;
  #pragma unroll
  for(int r=0;r<16;++r)negm[r]=FIXED?-mfix:0.f;
  asm volatile("":"+v"(negm));
  #define CMASK(P0,P1,t) do{}while(0)
  bool resc=false;
  #define START(P0,P1) do{ if(!FIXED){ const float rm=rowmax(P0,P1); resc=false; \
    { const float dl=rm; mhat=fadd_s(mhat,dl); \
      _Pragma("unroll") for(int r=0;r<16;++r){P0[r]=fsub_s(P0[r],dl);P1[r]=fsub_s(P1[r],dl);} \
      _Pragma("unroll") for(int r=0;r<16;++r)negm[r]=-mhat; asm volatile("":"+v"(negm)); } } \
    _Pragma("unroll") for(int r=0;r<16;++r)P0[r]=__builtin_amdgcn_exp2f(P0[r]); }while(0)
  #define RESC() do{ if(resc){ asm volatile("s_waitcnt lgkmcnt(0)":::"memory"); \
      _Pragma("unroll") for(int d_=0;d_<2;++d_) _Pragma("unroll") for(int r=0;r<16;++r)o[d_][r]*=wsf[crow(r,hi)]; } }while(0)
  f32x16 pA0,pA1,pB0,pB1;
  int sl_prev=0,sl_cur=0,sl_next=SLOTB;
  #define ROT() do{sl_prev=sl_cur;sl_cur=sl_next;sl_next=(sl_next==(NSLOT-1)*SLOTB)?0:sl_next+SLOTB;}while(0)
  DMA_K(2,2*SLOTB);
  WAIT_BAR(3);
  qkt(pA0,pA1,Kbase,qr,negm,r32,hi);asm volatile("s_nop 15\n\ts_nop 7":"+v"(pA0),"+v"(pA1));CMASK(pA0,pA1,0);
  START(pA0,pA1);
  _Pragma("unroll") for(int r=0;r<16;++r)pA1[r]=__builtin_amdgcn_exp2f(pA1[r]);
  WAIT_BAR(0);
  DMA_K(3,0);DMA_V(1,SLOTB);
  ROT();
  kload8(kf,kp0+sl_cur);
  WAIT_BAR(2);
  s16x4 vlo[8],vhi[8]; u32x4 pw0,pw1,pw2,pw3;
  #define PKW(P,B) cvtpk_s(P[B],P[B+1])
  #define PAF(k) __builtin_bit_cast(bf16x8,pw##k)
  #define VFR(i) (bf16x8){vlo[i][0],vlo[i][1],vlo[i][2],vlo[i][3],vhi[i][0],vhi[i][1],vhi[i][2],vhi[i][3]}
  #define PIN(x) asm volatile("":"+v"(x))
  #define MX3(a,b,c) __builtin_fmaxf(__builtin_fmaxf((a),(b)),(c))
  #define GAPA(MF,A0,A1,A2,A3,W0,W1,PW) do{ MF; sacc+=A0; sacc+=A1; sacc+=A2; sacc+=A3; PIN(sacc); W0; W1; PIN(PW); SBAR(); }while(0)
  #define EX(v) __builtin_amdgcn_exp2f(v)
  #define GAPB(MF,X,B) do{ MF; X[B]=EX(X[B]); X[B+1]=EX(X[B+1]); X[B+2]=EX(X[B+2]); X[B+3]=EX(X[B+3]); PIN(X); SBAR(); }while(0)
  #define VRD(i) do{ vlo[i]=vtr(vp_+(((i)>>2)*4096+((i)&3)*1024)); vhi[i]=vtr(vp_+(((i)>>2)*4096+((i)&3)*1024+512)); }while(0)
  #define KRD(G,j) do{ if(G){ kload2(kf,kp0+sl_next,j); SBAR(); } }while(0)
  #define STEP(C0,C1,P0,P1,t,GK,GV,GL) do{ SBAR(); \
    const lds_cptr vp_=vp0+sl_prev; \
    VRD(0); SBAR(); float sacc=(P0[0]+P0[1]); \
    GAPA(C0=__builtin_amdgcn_mfma_f32_32x32x16_bf16(kf[0],qr[0],negm,0,0,0), P0[2],P0[3],P0[4],P0[5],     pw0[0]=PKW(P0,0), pw0[1]=PKW(P0,2), pw0); \
    VRD(4); SBAR(); GAPA(C1=__builtin_amdgcn_mfma_f32_32x32x16_bf16(kf[1],qr[0],negm,0,0,0), P0[6],P0[7],P0[8],P0[9],     pw0[2]=PKW(P0,4), pw0[3]=PKW(P0,6), pw0); \
    VRD(1); SBAR(); GAPA(C0=__builtin_amdgcn_mfma_f32_32x32x16_bf16(kf[2],qr[1],C0,0,0,0),   P0[10],P0[11],P0[12],P0[13], pw1[0]=PKW(P0,8), pw1[1]=PKW(P0,10), pw1); \
    VRD(5); SBAR(); GAPA(C1=__builtin_amdgcn_mfma_f32_32x32x16_bf16(kf[3],qr[1],C1,0,0,0),   P0[14],P0[15],P1[0],P1[1],   pw1[2]=PKW(P0,12),pw1[3]=PKW(P0,14), pw1); \
    VRD(2); SBAR(); GAPA(C0=__builtin_amdgcn_mfma_f32_32x32x16_bf16(kf[4],qr[2],C0,0,0,0),   P1[2],P1[3],P1[4],P1[5],     pw2[0]=PKW(P1,0), pw2[1]=PKW(P1,2), pw2); \
    VRD(6); SBAR(); GAPA(C1=__builtin_amdgcn_mfma_f32_32x32x16_bf16(kf[5],qr[2],C1,0,0,0),   P1[6],P1[7],P1[8],P1[9],     pw2[2]=PKW(P1,4), pw2[3]=PKW(P1,6), pw2); \
    VRD(3); SBAR(); GAPA(C0=__builtin_amdgcn_mfma_f32_32x32x16_bf16(kf[6],qr[3],C0,0,0,0),   P1[10],P1[11],P1[12],P1[13], pw3[0]=PKW(P1,8), pw3[1]=PKW(P1,10), pw3); \
    VRD(7); SBAR(); GAPA(C1=__builtin_amdgcn_mfma_f32_32x32x16_bf16(kf[7],qr[3],C1,0,0,0),   P1[14],P1[15],0.f,0.f,       pw3[2]=PKW(P1,12),pw3[3]=PKW(P1,14), pw3); \
    l_reg+=sacc; \
    if(GK){DMA_K((t)+3,sl_cur);} if(GV){DMA_V((t)+1,sl_next);} \
    CMASK(C0,C1,t); \
    if(!FIXED){ float a=MX3(C0[0],C0[1],C1[0]),b=MX3(C0[2],C0[3],C1[1]); a=MX3(a,C1[2],C1[3]); \
      _Pragma("unroll") for(int r=4;r<16;r+=4){a=MX3(a,C0[r],C0[r+1]);b=MX3(b,C0[r+2],C0[r+3]);a=MX3(a,C1[r],C1[r+1]);b=MX3(b,C1[r+2],C1[r+3]);} \
      float rm=__builtin_fmaxf(a,b); { auto rr=__builtin_amdgcn_permlane32_swap(__float_as_uint(rm),__float_as_uint(rm),false,false); rm=__builtin_fmaxf(__uint_as_float(rr[0]),__uint_as_float(rr[1])); } \
      resc=false; \
      if(__builtin_expect(__any(rm>(float)THRL),0)){ const float dl=__builtin_fmaxf(rm,0.f); mhat+=dl; \
        _Pragma("unroll") for(int r=0;r<16;++r){C0[r]-=dl;C1[r]-=dl;} \
        _Pragma("unroll") for(int r=0;r<16;++r)negm[r]=-mhat; asm volatile("":"+v"(negm)); \
        const float f=__builtin_amdgcn_exp2f(-dl); l_reg*=f; if(hi==0)wsf[r32]=f; resc=true; } } \
    SBAR(); \
    GAPB(o[0]=__builtin_amdgcn_mfma_f32_32x32x16_bf16(PAF(0),VFR(0),o[0],0,0,0), C0,0); \
    GAPB(o[1]=__builtin_amdgcn_mfma_f32_32x32x16_bf16(PAF(0),VFR(4),o[1],0,0,0), C0,4); \
    KRD(GL,0); GAPB(o[0]=__builtin_amdgcn_mfma_f32_32x32x16_bf16(PAF(1),VFR(1),o[0],0,0,0), C0,8); \
    KRD(GL,1); GAPB(o[1]=__builtin_amdgcn_mfma_f32_32x32x16_bf16(PAF(1),VFR(5),o[1],0,0,0), C0,12); \
    KRD(GL,2); GAPB(o[0]=__builtin_amdgcn_mfma_f32_32x32x16_bf16(PAF(2),VFR(2),o[0],0,0,0), C1,0); \
    KRD(GL,3); GAPB(o[1]=__builtin_amdgcn_mfma_f32_32x32x16_bf16(PAF(2),VFR(6),o[1],0,0,0), C1,4); \
    GAPB(o[0]=__builtin_amdgcn_mfma_f32_32x32x16_bf16(PAF(3),VFR(3),o[0],0,0,0), C1,8); \
    GAPB(o[1]=__builtin_amdgcn_mfma_f32_32x32x16_bf16(PAF(3),VFR(7),o[1],0,0,0), C1,12); \
    }while(0)
  int t=1;
  #undef CMASK
  #define CMASK(P0,P1,t) do{}while(0)
  for(;t+5<NT;t+=2){
    STEP(pB0,pB1,pA0,pA1,t,true,true,true);     WAIT_BAR(2); RESC(); ROT();
    STEP(pA0,pA1,pB0,pB1,t+1,true,true,true);   WAIT_BAR(2); RESC(); ROT();
  }
  #undef CMASK
  #define CMASK(P0,P1,t) do{}while(0)
  #define ENDW(tt) do{ if((tt)+3<NT){WAIT_BAR(2);} else if((tt)+2<NT){WAIT_BAR(1);} else {WAIT_BAR(0);} }while(0)
  for(;t+1<NT;t+=2){
    STEP(pB0,pB1,pA0,pA1,t,(t+3<NT),(t+1<NT),(t+1<NT));       ENDW(t);   RESC(); ROT();
    STEP(pA0,pA1,pB0,pB1,t+1,(t+4<NT),(t+2<NT),(t+2<NT));     ENDW(t+1); RESC(); ROT();
  }
  STEP(pB0,pB1,pA0,pA1,NT-1,false,false,false); RESC();
  { float sacc=pB0[0]+pB0[1]; _Pragma("unroll") for(int r=2;r<16;++r)sacc+=pB0[r]; _Pragma("unroll") for(int r=0;r<16;++r)sacc+=pB1[r]; l_reg+=sacc;
    pw0=(u32x4){PKW(pB0,0),PKW(pB0,2),PKW(pB0,4),PKW(pB0,6)};pw1=(u32x4){PKW(pB0,8),PKW(pB0,10),PKW(pB0,12),PKW(pB0,14)};pw2=(u32x4){PKW(pB1,0),PKW(pB1,2),PKW(pB1,4),PKW(pB1,6)};pw3=(u32x4){PKW(pB1,8),PKW(pB1,10),PKW(pB1,12),PKW(pB1,14)};
    SBAR(); pv(o,vb0+sl_cur,PAF(0),PAF(1),PAF(2),PAF(3)); }
  #undef PKW
  #undef PAF
  #undef VFR
  #undef PIN
  #undef MX3
  #undef GAPA
  #undef GAPB
  #undef EX
  #undef VRD
  #undef KRD
  #undef STEP
  #undef ENDW
  {auto rr=__builtin_amdgcn_permlane32_swap(__float_as_uint(l_reg),__float_as_uint(l_reg),false,false);l_reg=__uint_as_float(rr[0])+__uint_as_float(rr[1]);}
  if(hi==0)wsf[32+r32]=l_reg;asm volatile("s_waitcnt lgkmcnt(0)":::"memory");
  float rli[16];
  #pragma unroll
  for(int r=0;r<16;++r)rli[r]=__builtin_amdgcn_rcpf(wsf[32+crow(r,hi)]);
  bf16*Ow=O+(qrow0+wid*QBLK)*QP+h*D;
  { bf16*stg=(bf16*)(shm+LDS_OST)+wid*2048;
    #pragma unroll
    for(int r=0;r<16;++r){const int orow=crow(r,hi);
      #pragma unroll
      for(int d0=0;d0<2;++d0)stg[orow*64+d0*32+r32]=__float2bfloat16(o[d0][r]*rli[r]);}
    asm volatile("s_waitcnt lgkmcnt(0)":::"memory");
    #pragma unroll
    for(int i=0;i<4;++i){const int row=i*8+(lane>>3),ch=lane&7; const u32x4 v=*(const u32x4*)(stg+row*64+ch*8); ATTN_STORE16(Ow+(long)row*QP+ch*8,v);} }
  asm volatile("s_waitcnt lgkmcnt(0)\n\ts_barrier":::"memory");
  #undef DMA_K
  #undef DMA_V
  #undef CMASK
  #undef START
  #undef RESC
  #undef ROT
}
constexpr int ATTN_LDS_BYTES=LDS_BYTES;
#undef SBAR
#undef WAIT_BAR
}
constexpr int NWAVES = 8;
using pg8::bf16_t; using pg8::bf16x8; using pg8::f32x4; using pg8::u32x4;
typedef unsigned u32x2 __attribute__((ext_vector_type(2)));
#define LAS __attribute__((address_space(3)))
#define GAS __attribute__((address_space(1)))
#define RLX_AGENT __ATOMIC_RELAXED, __HIP_MEMORY_SCOPE_AGENT
#define LDS_WAIT() asm volatile("s_waitcnt lgkmcnt(0)" ::: "memory")
#define VM_WAIT() asm volatile("s_waitcnt vmcnt(0)" ::: "memory")

constexpr size_t MiB = 1u << 20;
constexpr size_t WS_CTL = 0, CTL_ZERO_BYTES = 64 * 1024;
constexpr size_t WS_MOD = 1 * MiB;
constexpr size_t WS_LB = WS_MOD + 512 * 1024;
constexpr size_t WS_ROPE = WS_LB + 8 * 1024;
constexpr size_t WS_WIN = 2 * MiB;
constexpr size_t WS_WINS = 10 * MiB;
constexpr int CW_CMAX = 10240;
constexpr size_t WS_WA = 13 * MiB, WS_WB = 14 * MiB, WS_WO = 15 * MiB;
constexpr size_t WS_WGU = 17 * MiB, WS_WD = 81 * MiB;
constexpr size_t WS_HX = 17 * MiB;
constexpr size_t WS_A1 = 17 * MiB, WS_OATT = 49 * MiB, WS_OR = 81 * MiB;
constexpr size_t WS_HQ = 113 * MiB, WS_FF = 145 * MiB, WS_FB = 181 * MiB, WS_HI = 217 * MiB, WS_SG = 253 * MiB, WS_Q = 285 * MiB, WS_K = 317 * MiB, WS_V = 326 * MiB;
constexpr size_t WS_GA = 335 * MiB, WS_GB = 399 * MiB;
constexpr size_t WS_Z = 113 * MiB;
constexpr size_t WS_H2 = 177 * MiB;
constexpr size_t WS_AFF = 241 * MiB;
constexpr size_t WS_HS = 209 * MiB;
constexpr size_t WS_TQ = 17 * MiB + 48 * MiB;
constexpr size_t WS_TD = 81 * MiB + 24 * MiB;
constexpr size_t WS_HIDQ = 113 * MiB;
constexpr size_t WS_SCL2 = 243 * MiB + 768 * 1024;
constexpr size_t WS_SCL = 243 * MiB + 512 * 1024;
constexpr size_t WS_IDX = 243 * MiB;
constexpr size_t WS_SLOT = 244 * MiB;
constexpr size_t WS_X1B = 246 * MiB;
constexpr size_t WS_YE = 374 * MiB;
constexpr size_t WS_END = 502 * MiB;
constexpr int CW_Q3 = 64;
constexpr int CW_MFIX = 96;
constexpr int CW_BAR = 1024;

constexpr int RING_BYTES = 131072, MISC_OFF = RING_BYTES, LDS_BYTES = 147456;

#define PB_HX(A)   ((unsigned char*)(A).out)
#define PB_HXS(A)  ((float*)((unsigned char*)(A).out + 100 * MiB))
#define PB_A1(A)   ((unsigned char*)(A).out)
#define PB_OATT(A) ((unsigned char*)(A).out + 32 * MiB)
#define PB_OR(A)   ((unsigned char*)(A).out + 64 * MiB)
#define PB_HID(A)  ((unsigned char*)(A).out)
struct Args {
    const float *x, *c, *ctx, *c_ctx, *w_mod, *b_mod, *n1g, *n2g, *w_in, *lbl, *hgn, *qng, *kng, *wa, *wb, *wo, *wr, *weg, *weu, *wed, *fng;
    float* out; unsigned char* ws;
};

#define XB_TMO      128
#define XB_XCNT(j)  (256  + 64 * (j))
#define XB_XSUB(j)  (1280 + 64 * (j))
#define XB_XGEN(j)  (2304 + 64 * (j))
#define XB_TOP      3328
#define XB_TOPGEN   3392
#define XCD_BAR_WORDS 3456
#define XB_SPIN_CAP (1u << 18)
#ifndef XB_SCOPE
#define XB_SCOPE "agent"
#endif

__device__ __forceinline__ unsigned xb_ld(unsigned* p)              { return __hip_atomic_load(p, __ATOMIC_RELAXED, __HIP_MEMORY_SCOPE_AGENT); }
__device__ __forceinline__ unsigned xb_add(unsigned* p, unsigned v) { return __hip_atomic_fetch_add(p, v, __ATOMIC_RELAXED, __HIP_MEMORY_SCOPE_AGENT); }
__device__ __forceinline__ unsigned xb_xcc_id() { return (unsigned)__builtin_amdgcn_s_getreg((3 << 11) | 20) & 0xFu; }
#define XB_SPIN(cond, bar) do { unsigned _sp = 0; while (cond) { __builtin_amdgcn_s_sleep(1); \
    if ((++_sp & 255u) == 0u) { if (xb_ld(&(bar)[XB_TMO])) break; if (_sp > XB_SPIN_CAP) { atomicAdd(&(bar)[XB_TMO], 1u); break; } } } } while (0)

struct XcdBarrier {
    unsigned* bar; unsigned x;
    volatile LAS unsigned* st;
};

__device__ __forceinline__ XcdBarrier xcd_barrier_post(unsigned* bar, volatile LAS unsigned* st) {
    XcdBarrier b; b.bar = bar; b.x = xb_xcc_id(); b.st = st;
    if (threadIdx.x == 0) (void)xb_add(&bar[XB_XCNT(b.x)], 1u);
    return b;
}
__device__ __forceinline__ void xcd_barrier_complete(unsigned* bar, unsigned x, unsigned& nloc, unsigned& nx) {
    const unsigned G = gridDim.x * gridDim.y * gridDim.z;
    unsigned sum, cnt, mine, sp = 0u;
    for (;;) {
        sum = 0u; cnt = 0u; mine = 0u;
#pragma unroll
        for (unsigned j = 0; j < 16; ++j) { const unsigned c = xb_ld(&bar[XB_XCNT(j)]); sum += c; cnt += (c > 0u) ? 1u : 0u; mine = (j == x) ? c : mine; }
        if (sum == G) break;
        __builtin_amdgcn_s_sleep(1);
        if ((++sp & 255u) == 0u) { if (xb_ld(&bar[XB_TMO])) break; if (sp > XB_SPIN_CAP) { atomicAdd(&bar[XB_TMO], 1u); break; } }
    }
    nloc = mine > 0u ? mine : 1u; nx = cnt > 0u ? cnt : 1u;
}

__device__ __forceinline__ void xcd_barrier(const XcdBarrier& b) {
    asm volatile("s_waitcnt vmcnt(0)" ::: "memory");
    __syncthreads();
    if (threadIdx.x == 0) {
        unsigned* bar = b.bar;
        __builtin_amdgcn_s_waitcnt(0);
        unsigned nloc = b.st[0], nx = b.st[1];
        if (nloc == 0u) { xcd_barrier_complete(bar, b.x, nloc, nx); b.st[0] = nloc; b.st[1] = nx; }
#if DBG_RELEASE_ALL
        __builtin_amdgcn_fence(__ATOMIC_RELEASE, "agent"); asm volatile("s_waitcnt vmcnt(0)" ::: "memory");
#endif
        const unsigned old = xb_add(&bar[XB_XSUB(b.x)], 1u);
        const unsigned gen = old / nloc;
        if (old + 1u == (gen + 1u) * nloc) {
#if DBG_LEADER_DELAY
            { const unsigned long long t0_ = __builtin_amdgcn_s_memrealtime(); while (__builtin_amdgcn_s_memrealtime() - t0_ < (unsigned long long)DBG_LEADER_DELAY) __builtin_amdgcn_s_sleep(2); }
#endif
            __builtin_amdgcn_fence(__ATOMIC_RELEASE, XB_SCOPE);
            asm volatile("s_waitcnt vmcnt(0)" ::: "memory");
#if DBG_WBL2_TWICE
            { const unsigned long long t0_ = __builtin_amdgcn_s_memrealtime(); while (__builtin_amdgcn_s_memrealtime() - t0_ < 150ull) __builtin_amdgcn_s_sleep(2); }
            asm volatile("buffer_wbl2 sc1\n\ts_waitcnt vmcnt(0)" ::: "memory");
#endif
            const unsigned og = xb_add(&bar[XB_TOP], 1u);
            const unsigned tg = og / nx;
            if (og + 1u == (tg + 1u) * nx) xb_add(&bar[XB_TOPGEN], 1u);
            else XB_SPIN(xb_ld(&bar[XB_TOPGEN]) == tg, bar);
            __builtin_amdgcn_fence(__ATOMIC_ACQUIRE, XB_SCOPE);
            xb_add(&bar[XB_XGEN(b.x)], 1u);
            asm volatile("s_waitcnt vmcnt(0)" ::: "memory");
        } else {
            XB_SPIN(xb_ld(&bar[XB_XGEN(b.x)]) == gen, bar);
            __builtin_amdgcn_fence(__ATOMIC_ACQUIRE, XB_SCOPE);
            asm volatile("s_waitcnt vmcnt(0)" ::: "memory");
        }
    }
    __syncthreads();
}

__device__ __forceinline__ float wave_sum(float v) {
#pragma unroll
    for (int o = 1; o < 64; o <<= 1) v += __shfl_xor(v, o);
    return v;
}
__device__ __forceinline__ unsigned f2bf(float f) { unsigned u = __builtin_bit_cast(unsigned, f); return (u + 0x7fffu + ((u >> 16) & 1u)) >> 16; }
__device__ __forceinline__ unsigned pk2(float lo, float hi) { return f2bf(lo) | (f2bf(hi) << 16); }
__device__ __forceinline__ float bf2f(unsigned short h) { return __uint_as_float((unsigned)h << 16); }

template <bool QKPERM>
__device__ __forceinline__ void transpose_item_q8(const float* W, int Nsrc, int n0, int k0, float inv, unsigned char* WQ, long drow0, LAS float* scr, int lane) {
    float tv[32];
#pragma unroll
    for (int i = 0; i < 32; ++i) tv[i] = W[(size_t)(k0 + 2 * i + (lane >> 5)) * Nsrc + n0 + (lane & 31)];
#pragma unroll
    for (int i = 0; i < 32; ++i) scr[(2 * i + (lane >> 5)) * 33 + (lane & 31)] = __builtin_rintf(tv[i] * inv);
    LDS_WAIT(); asm volatile("" ::: "memory");
    const int c = lane & 7;
#pragma unroll
    for (int j = 0; j < 4; ++j) { const int n = (lane >> 3) + 8 * j;
        const int ns = QKPERM ? (16 * ((n & 7) >> 2) + 4 * (n >> 3) + (n & 3)) : n;
        const LAS float* s = scr + (8 * c) * 33 + ns;
        const unsigned w0 = ((unsigned)(int)s[0 * 33] & 255u) | (((unsigned)(int)s[1 * 33] & 255u) << 8) | (((unsigned)(int)s[2 * 33] & 255u) << 16) | ((unsigned)(int)s[3 * 33] << 24);
        const unsigned w1 = ((unsigned)(int)s[4 * 33] & 255u) | (((unsigned)(int)s[5 * 33] & 255u) << 8) | (((unsigned)(int)s[6 * 33] & 255u) << 16) | ((unsigned)(int)s[7 * 33] << 24);
        u32x2 o; o.x = w0; o.y = w1; *(u32x2*)(WQ + (size_t)(drow0 + n) * 1024 + k0 + 8 * c) = o; }
    LDS_WAIT(); asm volatile("" ::: "memory");
}
template <bool QKPERM>
__device__ __forceinline__ void transpose_item(const float* W, int K, int Nsrc, int n0, int k0, bf16_t* WT, long drow0, LAS float* scr, int lane) {
    float tv[32];
#pragma unroll
    for (int i = 0; i < 32; ++i) tv[i] = W[(size_t)(k0 + 2 * i + (lane >> 5)) * Nsrc + n0 + (lane & 31)];
#pragma unroll
    for (int i = 0; i < 32; ++i) scr[(2 * i + (lane >> 5)) * 33 + (lane & 31)] = tv[i];
    LDS_WAIT(); asm volatile("" ::: "memory");
    const int c = lane & 7;
#pragma unroll
    for (int j = 0; j < 4; ++j) { const int n = (lane >> 3) + 8 * j;
        const int ns = QKPERM ? (16 * ((n & 7) >> 2) + 4 * (n >> 3) + (n & 3)) : n;
        const LAS float* s = scr + (8 * c) * 33 + ns;
        u32x4 o; o.x = pk2(s[0 * 33], s[1 * 33]); o.y = pk2(s[2 * 33], s[3 * 33]); o.z = pk2(s[4 * 33], s[5 * 33]); o.w = pk2(s[6 * 33], s[7 * 33]);
        *(u32x4*)(WT + (size_t)(drow0 + n) * K + k0 + 8 * c) = o; }
    LDS_WAIT(); asm volatile("" ::: "memory");
}
__device__ __forceinline__ void p0_adaln_item(const Args& A, LAS unsigned char* lds, int item, int tid) {
    LAS float* sc = (LAS float*)lds;
    LAS float* red = (LAS float*)(lds + 17 * 1024 * 4);
    const int wave = tid >> 6, lane = tid & 63, col = lane & 31, kp = lane >> 5;
    const float* wp = A.w_mod + (size_t)(wave * 128 + kp * 64) * NMOD + item * 32 + col;
    float w[64];
#pragma unroll
    for (int kk = 0; kk < 64; ++kk) w[kk] = wp[(size_t)kk * NMOD];
    for (int i = tid; i < 17 * 1024; i += 512) { const int b = i >> 10, k = i & 1023; const float v = b < 16 ? A.c[b * 1024 + k] : A.c_ctx[k]; sc[i] = v * pg8::fsigmoid(v); }
    __syncthreads();
    float acc[17];
#pragma unroll
    for (int b = 0; b < 17; ++b) acc[b] = 0.f;
#pragma unroll
    for (int kk = 0; kk < 64; kk += 4) {
#pragma unroll
        for (int b = 0; b < 17; ++b) { const f32x4 s4 = *(const LAS f32x4*)(sc + b * 1024 + wave * 128 + kp * 64 + kk); acc[b] += (s4[0] * w[kk] + s4[1] * w[kk + 1]) + (s4[2] * w[kk + 2] + s4[3] * w[kk + 3]); } }
#pragma unroll
    for (int b = 0; b < 17; ++b) red[((wave * 2 + kp) * 17 + b) * 32 + col] = acc[b];
    __syncthreads();
    float* mod = (float*)(A.ws + WS_MOD);
    for (int i = tid; i < 17 * 32; i += 512) { const int b = i >> 5, cidx = i & 31; float s = 0.f;
#pragma unroll
        for (int w = 0; w < 16; ++w) s += red[(w * 17 + b) * 32 + cidx];
        mod[b * NMOD + item * 32 + cidx] = s + A.b_mod[item * 32 + cidx]; }
    __syncthreads();
}
__device__ __forceinline__ int win_src(int g32, bool& qk) {
    const int pn = g32 >> 3, bj = (g32 >> 2) & 1, wc = g32 & 3;
    if (pn == 10 || pn == 11) { qk = true; return 2560 + (pn - 10) * 256 + wc * 64 + 32 * bj; }
    if (pn == 12 && wc < 2) { qk = true; return 3072 + wc * 64 + 32 * bj; }
    qk = false;
    if (pn == 12) return 3200 + (wc - 2) * 64 + 32 * bj;
    return g32 * 32;
}
template <int PART>
__device__ __forceinline__ void p0_prologue(const Args& A, LAS unsigned char* lds, int vcu, int G, int tid) {
    const int wave = tid >> 6, lane = tid & 63;
    if (PART == 0) {
    for (int it = vcu; it < NMOD / 32; it += G) p0_adaln_item(A, lds, it, tid);
    if (vcu == G - 1) {
        float* lb = (float*)(A.ws + WS_LB); float* rope = (float*)(A.ws + WS_ROPE);
        for (int i = tid; i < 1024; i += 512) { const int d = i >> 9, k = i & 511; const float l0 = A.lbl[(d * 2 + 0) * 512 + k], l1 = A.lbl[(d * 2 + 1) * 512 + k]; lb[i] = 1.0f / (1.0f + expf(l1 - l0)); }
        for (int i = tid; i < 64 * 16; i += 512) { const int pos = i >> 4, f = i & 15; const float inv = powf(10000.0f, -(float)(2 * f) / 32.0f); const float ang = (float)pos * inv; rope[pos * 32 + f] = cosf(ang); rope[pos * 32 + 16 + f] = sinf(ang); }
        if (tid < 64) { float mq = fabsf(A.qng[tid]), mk = fabsf(A.kng[tid]);
#pragma unroll
            for (int o = 32; o > 0; o >>= 1) { mq = fmaxf(mq, __shfl_xor(mq, o)); mk = fmaxf(mk, __shfl_xor(mk, o)); }
            if (tid == 0) ((float*)(A.ws + WS_CTL))[CW_MFIX] = 64.0f * 0.125f * LOG2E * 1.02f * mq * mk + 0.5f; }
    }
    { unsigned* cmax = (unsigned*)(A.ws + WS_CTL) + CW_CMAX; const int gwm = vcu * NWAVES + wave, NGWM = G * NWAVES;
      for (int it = gwm; it < 16 * (INC / 32); it += NGWM) { const int kb = it / (INC / 32), g32 = it % (INC / 32); bool qk; const int n0 = win_src(g32, qk);
          float m = 0.f;
          float tv[32];
#pragma unroll
          for (int i = 0; i < 32; ++i) tv[i] = A.w_in[(size_t)(64 * kb + 2 * i + (lane >> 5)) * INC + n0 + (lane & 31)];
#pragma unroll
          for (int i = 0; i < 32; ++i) m = fmaxf(m, fabsf(tv[i]));
          m = fmaxf(m, __shfl_xor(m, 32));
          if (lane < 32) atomicMax(cmax + g32 * 32 + lane, __float_as_uint(m)); } }
    return; }
    LAS float* scr = (LAS float*)(lds + wave * 8704);
    const int gw = vcu * NWAVES + wave, NGW = G * NWAVES;
    constexpr int I_IN = 16 * (INC / 32), I_A = 8 * 32, I_O = 16 * 32;
    constexpr int NIT = I_IN + 2 * I_A + I_O;
    bf16_t* WinT = (bf16_t*)(A.ws + WS_WIN); bf16_t* WaT = (bf16_t*)(A.ws + WS_WA); bf16_t* WbT = (bf16_t*)(A.ws + WS_WB); bf16_t* WoT = (bf16_t*)(A.ws + WS_WO);
    const int it0 = gw, itstep = NGW, itend = NIT;
    for (int it = it0; it < itend; it += itstep) {
        int r = it;
        if (r < I_IN) { const int kb = r / (INC / 32), g32 = r % (INC / 32);
            bool qk; const int n0 = win_src(g32, qk);
            const unsigned* cmax = (const unsigned*)(A.ws + WS_CTL) + CW_CMAX;
            const float am = fmaxf(__uint_as_float(__hip_atomic_load(cmax + g32 * 32 + (lane & 31), RLX_AGENT)), 1e-30f), inv = 127.0f / am;
            if (kb == 0 && lane < 32) { const int n = lane, ns = qk ? (16 * ((n & 7) >> 2) + 4 * (n >> 3) + (n & 3)) : n;
                ((float*)(A.ws + WS_WINS))[g32 * 32 + n] = fmaxf(__uint_as_float(__hip_atomic_load(cmax + g32 * 32 + ns, RLX_AGENT)), 1e-30f) * (1.0f / 127.0f); }
            if (qk) transpose_item_q8<true>(A.w_in, INC, n0, 64 * kb, inv, A.ws + WS_WIN, (long)g32 * 32, scr, lane);
            else transpose_item_q8<false>(A.w_in, INC, n0, 64 * kb, inv, A.ws + WS_WIN, (long)g32 * 32, scr, lane);
            continue; }
        r -= I_IN;
        if (r < I_A) { transpose_item<false>(A.wa, 512, 1024, (r & 31) * 32, 64 * (r >> 5), WaT, (long)(r & 31) * 32, scr, lane); continue; } r -= I_A;
        if (r < I_A) { transpose_item<false>(A.wb, 512, 1024, (r & 31) * 32, 64 * (r >> 5), WbT, (long)(r & 31) * 32, scr, lane); continue; } r -= I_A;
        transpose_item<false>(A.wo, 1024, 1024, (r & 31) * 32, 64 * (r >> 5), WoT, (long)(r & 31) * 32, scr, lane);
    }
}

__device__ __forceinline__ void p1_finish(unsigned char* HXQ, float* HXS, int r, int lane, const f32x4 (&v)[4], const f32x4 (&gs)[4], const f32x4 (&sh)[4]) {
    float ss = 0.f;
#pragma unroll
    for (int j = 0; j < 4; ++j) ss += (v[j][0] * v[j][0] + v[j][1] * v[j][1]) + (v[j][2] * v[j][2] + v[j][3] * v[j][3]);
    const float rstd = 1.0f / sqrtf(wave_sum(ss) * (1.0f / 1024.0f) + EPS);
    f32x4 o[4]; float amax = 0.f;
#pragma unroll
    for (int j = 0; j < 4; ++j) { o[j] = (v[j] * rstd) * gs[j] + sh[j]; amax = fmaxf(fmaxf(amax, fmaxf(fabsf(o[j][0]), fabsf(o[j][1]))), fmaxf(fabsf(o[j][2]), fabsf(o[j][3]))); }
#pragma unroll
    for (int o_ = 1; o_ < 64; o_ <<= 1) amax = fmaxf(amax, __shfl_xor(amax, o_));
    const float am = amax > 1e-30f ? amax : 1e-30f, inv = 127.0f / am;
    if (lane == 0) HXS[r] = am * (1.0f / 127.0f);
#pragma unroll
    for (int j = 0; j < 4; ++j) { const int cidx = 4 * lane + 256 * j; const f32x4 q = o[j] * inv;
        const int q0 = (int)__builtin_rintf(q[0]), q1 = (int)__builtin_rintf(q[1]), q2 = (int)__builtin_rintf(q[2]), q3 = (int)__builtin_rintf(q[3]);
        *(unsigned*)(HXQ + (size_t)r * 1024 + cidx) = ((unsigned)q0 & 255u) | (((unsigned)q1 & 255u) << 8) | (((unsigned)q2 & 255u) << 16) | ((unsigned)q3 << 24); }
}
__device__ __forceinline__ void p1_rows(const Args& A, int vcu, int G, int tid) {
    const int wave = tid >> 6, lane = tid & 63; const int gw = vcu * NWAVES + wave, NGW = G * NWAVES;
    const float* mod = (const float*)(A.ws + WS_MOD); unsigned char* HXQ = (unsigned char*)(PB_HX(A)); float* HXS = PB_HXS(A);
    auto src_of = [&](int r) -> const float* { const int b = r / RPB, s = r - b * RPB; return s < CTXL ? A.ctx + ((size_t)b * CTXL + s) * 1024 : A.x + ((size_t)b * SEQ + (s - CTXL)) * 1024; };
    auto cls_of = [&](int r) -> int { const int b = r / RPB, s = r - b * RPB; return s < CTXL ? 16 : b; };
    const int RPW = (MR + NGW - 1) / NGW; const int r0 = gw * RPW, r1 = r0 + RPW < MR ? r0 + RPW : MR;
    if (r0 < r1) {
        f32x4 gs[4], sh[4]; int ccur = -1;
        auto consts = [&](int r) { const int c = cls_of(r);
            if (c != ccur) { ccur = c; const float* mrow = mod + (size_t)c * NMOD;
#pragma unroll
                for (int j = 0; j < 4; ++j) { const int cidx = 4 * lane + 256 * j; sh[j] = *(const f32x4*)(mrow + cidx); gs[j] = *(const f32x4*)(A.n1g + cidx) * (*(const f32x4*)(mrow + 1024 + cidx) + 1.0f); }
                asm volatile("" : "+v"(gs[0]), "+v"(gs[1]), "+v"(gs[2]), "+v"(gs[3]), "+v"(sh[0]), "+v"(sh[1]), "+v"(sh[2]), "+v"(sh[3])); } };
        f32x4 n0[4], n1[4];
        { const float* src = src_of(r0);
#pragma unroll
          for (int j = 0; j < 4; ++j) n0[j] = *(const f32x4*)(src + 4 * lane + 256 * j); }
        for (int r = r0; r < r1; r += 2) {
            { const float* src = src_of(r + 1 < r1 ? r + 1 : r1 - 1);
#pragma unroll
              for (int j = 0; j < 4; ++j) n1[j] = *(const f32x4*)(src + 4 * lane + 256 * j); }
            consts(r); p1_finish(HXQ, HXS, r, lane, n0, gs, sh);
            { const float* src = src_of(r + 2 < r1 ? r + 2 : r1 - 1);
#pragma unroll
              for (int j = 0; j < 4; ++j) n0[j] = *(const f32x4*)(src + 4 * lane + 256 * j); }
            if (r + 1 < r1) { consts(r + 1); p1_finish(HXQ, HXS, r + 1, lane, n1, gs, sh); }
        }
    }
}

namespace hg {
constexpr int QS = 0, KD = 17408, KE = 34816, KHT = 52224, VT = 70656, PP = 89088, TT = 98304, EQ = 100352, EG = 102400, DK = 103936, SSQ = 104448, LBS = 106496  , GNS = 107008  , Q0 = 107520  , TT8 = 124928  , END = 129024;
constexpr int RS = 272  , TS = 144  ;
constexpr int CW_HG = 8192;
typedef float f32x4 __attribute__((ext_vector_type(4)));
__device__ __forceinline__ bf16x8 pack8(const f32x4 a, const f32x4 b) { u32x4 w; w.x = pg8::cvt_pk_bf16(a[0], a[1]); w.y = pg8::cvt_pk_bf16(a[2], a[3]); w.z = pg8::cvt_pk_bf16(b[0], b[1]); w.w = pg8::cvt_pk_bf16(b[2], b[3]); return __builtin_bit_cast(bf16x8, w); }
__device__ __forceinline__ void unpack8(const u32x4 w, f32x4& a, f32x4& b) { a = (f32x4){pg8::bf_lo(w.x), pg8::bf_hi(w.x), pg8::bf_lo(w.y), pg8::bf_hi(w.y)}; b = (f32x4){pg8::bf_lo(w.z), pg8::bf_hi(w.z), pg8::bf_lo(w.w), pg8::bf_hi(w.w)}; }

constexpr unsigned long long OR_SENTINEL = 0x7fff7fff7fff7fffull;
struct Inputs { unsigned f2[8], q2[8]; u32x4 vv[2]; };

template <bool BWD>
__device__ __forceinline__ void load_inputs(const Args& A, int b, int h, int c, int tid, Inputs& I) {
    const bool latent = c >= 4;
    const long rbase = (long)b * RPB + 64 * c, rlbase = (long)b * SEQ + 64 * (c - 4);
    const bf16_t* F = (const bf16_t*)(A.ws + (BWD ? WS_FB : WS_FF)) + (rbase * 512 + h * 128); const bf16_t* HI = (const bf16_t*)(A.ws + WS_HI) + (rbase * 512 + h * 128);
    const bf16_t* HQ = (const bf16_t*)(A.ws + WS_HQ) + ((latent ? rlbase : 0) * 512 + h * 128);
    const int w8 = __builtin_amdgcn_readfirstlane(tid >> 6); const unsigned voff = (unsigned)(4 * (tid & 63));
#pragma unroll
    for (int e = 0; e < 8; ++e) { const int rho = BWD ? 63 - (8 * w8 + e) : 8 * w8 + e;
        I.f2[e] = *(const unsigned*)((const char*)(F + rho * 512) + voff); I.q2[e] = *(const unsigned*)((const char*)(HQ + rho * 512) + voff); }
    const int sig = tid & 63; const unsigned voffv = (unsigned)((BWD ? 63 - sig : sig) * 1024 + (tid >> 6) * 16);
#pragma unroll
    for (int it = 0; it < 2; ++it) I.vv[it] = *(const u32x4*)((const char*)(HI + 64 * it) + voffv);
}

struct Prep { float kd[2][8], qs[2][8]; float PT[2]; u32x4 vv[2]; };
struct Mid { float kdl[2][8], qsl[2][8]; float T8[2]; u32x4 vv[2]; };
__device__ __forceinline__ void s1_math(LAS unsigned char* lds, Inputs& N, int tid, Mid& M) {
#pragma unroll
    for (int e = 0; e < 8; ++e) asm volatile("" : "+v"(N.f2[e]), "+v"(N.q2[e]));
    asm volatile("" : "+v"(N.vv[0]), "+v"(N.vv[1]));
    const int kp = tid & 63, w8 = tid >> 6;
    const pg8::f32x2_c lb2 = *(const LAS pg8::f32x2_c*)(lds + LBS + 8 * kp);
#pragma unroll
    for (int c = 0; c < 2; ++c) { const float lbv = lb2[c], oml = 1.0f - lbv; float pc = 1.0f;
#pragma unroll
        for (int e = 0; e < 8; ++e) { const float fp = c ? pg8::bf_hi(N.f2[e]) : pg8::bf_lo(N.f2[e]), q = c ? pg8::bf_hi(N.q2[e]) : pg8::bf_lo(N.q2[e]);
            const float f = lbv + oml * pg8::fsigmoid(fp);
            pc *= f; M.kdl[c][e] = (1.0f - f) * __builtin_amdgcn_rcpf(pc); M.qsl[c][e] = q * pc; }
        M.T8[c] = pc; }
    *(LAS pg8::f32x2_c*)(lds + TT8 + (w8 * 128 + 2 * kp) * 4) = (pg8::f32x2_c){M.T8[0], M.T8[1]};
    M.vv[0] = N.vv[0]; M.vv[1] = N.vv[1];
}
__device__ __forceinline__ void s1_store(LAS unsigned char* lds, const Mid& M, bool latent, int tid, Prep& P) {
    const int kp = tid & 63, w8 = __builtin_amdgcn_readfirstlane(tid >> 6);
    const pg8::f32x2_c o2 = *(const LAS pg8::f32x2_c*)(lds + TT8 + ((w8 ^ 1) * 128 + 2 * kp) * 4);
#pragma unroll
    for (int c = 0; c < 2; ++c) { P.PT[c] = M.T8[c] * o2[c];
        if (w8 & 1) { const float pre = o2[c], ipre = __builtin_amdgcn_rcpf(pre);
#pragma unroll
            for (int e = 0; e < 8; ++e) { P.kd[c][e] = M.kdl[c][e] * ipre; P.qs[c][e] = M.qsl[c][e] * pre; } }
        else {
#pragma unroll
            for (int e = 0; e < 8; ++e) { P.kd[c][e] = M.kdl[c][e]; P.qs[c][e] = M.qsl[c][e]; } } }
    P.vv[0] = M.vv[0]; P.vv[1] = M.vv[1];
    if (latent) {
#pragma unroll
        for (int e = 0; e < 8; ++e) { const int tau = 8 * w8 + e;
            *(LAS unsigned*)(lds + QS + tau * RS + 4 * kp) = pg8::cvt_pk_bf16(P.qs[0][e], P.qs[1][e]);
            *(LAS unsigned*)(lds + KD + tau * RS + 4 * kp) = pg8::cvt_pk_bf16(P.kd[0][e], P.kd[1][e]);
            *(LAS unsigned*)(lds + KE + tau * RS + 4 * kp) = pg8::cvt_pk_bf16(P.kd[0][e] * P.PT[0], P.kd[1][e] * P.PT[1]); }
    }
    if (!(w8 & 1)) *(LAS pg8::f32x2_c*)(lds + TT + ((w8 >> 1) * 128 + 2 * kp) * 4) = (pg8::f32x2_c){P.PT[0], P.PT[1]};
}
template <bool BWD, bool SECOND>
__device__ __forceinline__ void chunk_step(const Args& A, LAS unsigned char* lds, int b, int h, int c, f32x4 (&S)[8], Prep& P, Inputs& N, bool next_latent, int cpref, int tid_in) {
    int tid = tid_in; asm volatile("" : "+v"(tid));
    const int wave = __builtin_amdgcn_readfirstlane(tid >> 6), lane = tid & 63, l15 = lane & 15, g = lane >> 4;
    const bool latent = SECOND || c >= 4; constexpr bool second = SECOND;
    const long rlbase = (long)b * SEQ + 64 * (c - 4);
    const int k = tid & 127, part = tid >> 7;
    __syncthreads();
    {
        const int kp = tid & 63, w8 = wave, sb = w8 >> 1;
        const pg8::f32x2_c T0 = *(const LAS pg8::f32x2_c*)(lds + TT + (0 * 128 + 2 * kp) * 4), T1 = *(const LAS pg8::f32x2_c*)(lds + TT + (1 * 128 + 2 * kp) * 4),
                           T2 = *(const LAS pg8::f32x2_c*)(lds + TT + (2 * 128 + 2 * kp) * 4), T3 = *(const LAS pg8::f32x2_c*)(lds + TT + (3 * 128 + 2 * kp) * 4);
#pragma unroll
        for (int c = 0; c < 2; ++c) {
            const float khs = P.PT[c] * (sb == 0 ? T1[c] * T2[c] * T3[c] : sb == 1 ? T2[c] * T3[c] : sb == 2 ? T3[c] : 1.0f);
            u32x4 w0;
            w0.x = pg8::cvt_pk_bf16(P.kd[c][0] * khs, P.kd[c][1] * khs); w0.y = pg8::cvt_pk_bf16(P.kd[c][2] * khs, P.kd[c][3] * khs); w0.z = pg8::cvt_pk_bf16(P.kd[c][4] * khs, P.kd[c][5] * khs); w0.w = pg8::cvt_pk_bf16(P.kd[c][6] * khs, P.kd[c][7] * khs);
            *(LAS u32x4*)(lds + KHT + (2 * kp + c) * TS + 16 * w8) = w0; }
        if (latent) {
            const float eq0 = sb == 0 ? 1.0f : sb == 1 ? T0[0] : sb == 2 ? T0[0] * T1[0] : T0[0] * T1[0] * T2[0], eq1 = sb == 0 ? 1.0f : sb == 1 ? T0[1] : sb == 2 ? T0[1] * T1[1] : T0[1] * T1[1] * T2[1];
#pragma unroll
            for (int e = 0; e < 8; ++e) *(LAS unsigned*)(lds + Q0 + (8 * w8 + e) * RS + 4 * kp) = pg8::cvt_pk_bf16(P.qs[0][e] * eq0, P.qs[1][e] * eq1);
        }
        if (w8 == 0) *(LAS pg8::f32x2_c*)(lds + DK + 8 * kp) = (pg8::f32x2_c){(T0[0] * T1[0]) * (T2[0] * T3[0]), (T0[1] * T1[1]) * (T2[1] * T3[1])};
#pragma unroll
        for (int it = 0; it < 2; ++it) { const int idx = tid + 512 * it, sig = idx & 63, dv0 = (idx >> 6) * 8; const u32x4 w = P.vv[it];
            LAS unsigned short* vt = (LAS unsigned short*)(lds + VT + dv0 * TS + 2 * sig);
            vt[0 * (TS / 2)] = (unsigned short)(w.x & 0xffff); vt[1 * (TS / 2)] = (unsigned short)(w.x >> 16); vt[2 * (TS / 2)] = (unsigned short)(w.y & 0xffff); vt[3 * (TS / 2)] = (unsigned short)(w.y >> 16);
            vt[4 * (TS / 2)] = (unsigned short)(w.z & 0xffff); vt[5 * (TS / 2)] = (unsigned short)(w.z >> 16); vt[6 * (TS / 2)] = (unsigned short)(w.w & 0xffff); vt[7 * (TS / 2)] = (unsigned short)(w.w >> 16); }
    }
    Mid Q;
    s1_math(lds, N, tid, Q);
    load_inputs<BWD>(A, b, h, cpref, tid, N);
    if (latent) {
        for (int pi = wave; pi < 10; pi += 8) {
            const int bi = pi < 4 ? pi : pi < 7 ? pi - 3 : pi < 9 ? pi - 5 : 3;
            const int bjx = pi < 4 ? pi : pi < 7 ? pi - 4 : pi < 9 ? pi - 7 : 0;
            f32x4 cacc = (f32x4){0.f, 0.f, 0.f, 0.f};
            const int egsel = (bi == 2 && bjx == 0) ? 0 : (bi == 3 && bjx == 1) ? 1 : (bi == 3 && bjx == 0) ? 2 : -1;
            u32x4 aw[4], bw[4];
#pragma unroll
            for (int s = 0; s < 4; ++s) { aw[s] = *(const LAS u32x4*)(lds + QS + (16 * bi + l15) * RS + (32 * s + 8 * g) * 2);
                bw[s] = *(const LAS u32x4*)(lds + (bi == bjx ? KD : KE) + (16 * bjx + l15) * RS + (32 * s + 8 * g) * 2); }
            if (egsel >= 0) {
                const int t1 = egsel == 1 ? 2 : 1;
                f32x4 e0[4], e1[4];
#pragma unroll
                for (int s = 0; s < 4; ++s) { e0[s] = *(const LAS f32x4*)(lds + TT + (t1 * 128 + 32 * s + 8 * g) * 4); e1[s] = *(const LAS f32x4*)(lds + TT + (t1 * 128 + 32 * s + 8 * g + 4) * 4); }
                if (egsel == 2) {
#pragma unroll
                    for (int s = 0; s < 4; ++s) { e0[s] = e0[s] * *(const LAS f32x4*)(lds + TT + (2 * 128 + 32 * s + 8 * g) * 4); e1[s] = e1[s] * *(const LAS f32x4*)(lds + TT + (2 * 128 + 32 * s + 8 * g + 4) * 4); }
                }
#pragma unroll
                for (int s = 0; s < 4; ++s) { f32x4 a0, a1; unpack8(aw[s], a0, a1); aw[s] = __builtin_bit_cast(u32x4, pack8(a0 * e0[s], a1 * e1[s])); }
            }
#pragma unroll
            for (int s = 0; s < 4; ++s) cacc = __builtin_amdgcn_mfma_f32_16x16x32_bf16(__builtin_bit_cast(bf16x8, aw[s]), __builtin_bit_cast(bf16x8, bw[s]), cacc, 0, 0, 0);
#pragma unroll
            for (int r = 0; r < 4; ++r) { const int tl = 4 * g + r; float v = cacc[r]; if (bi == bjx && l15 > tl) v = 0.f;
                *(LAS unsigned short*)(lds + PP + (16 * bi + tl) * TS + 2 * (16 * bjx + l15)) = (unsigned short)pg8::cvt_pk_bf16(v, 0.f); }
        }
    }
    __syncthreads();
    bf16_t* ORb = (bf16_t*)(PB_OR(A)) + (rlbase * 512 + h * 128 + 16 * wave);
    unsigned long long pw[4]; u32x2 sgw[4];
    if (latent && second) {
        const bf16_t* SG = (const bf16_t*)(A.ws + WS_SG) + (rlbase * 512 + h * 128 + 16 * wave);
#pragma unroll
        for (int m = 0; m < 4; ++m) { const int tau = 16 * m + l15, rho = BWD ? 63 - tau : tau;
            pw[m] = __hip_atomic_load((unsigned long long*)(ORb + (unsigned)(rho * 512 + 4 * g)), RLX_AGENT); sgw[m] = *(const u32x2*)(SG + (unsigned)(rho * 512 + 4 * g)); }
    }
    bf16x8 vf[2];
#pragma unroll
    for (int s = 0; s < 2; ++s) vf[s] = *(const LAS bf16x8*)(lds + VT + (16 * wave + l15) * TS + (32 * s + 8 * g) * 2);
    f32x4 oT[4];
#pragma unroll
    for (int m = 0; m < 4; ++m) oT[m] = (f32x4){0.f, 0.f, 0.f, 0.f};
#define HG_RD_BQ(s) do { _Pragma("unroll") for (int m = 0; m < 4; ++m) { \
            const u32x2 q0w = *(const LAS u32x2*)(lds + Q0 + (16 * m + l15) * RS + (32 * (s) + 4 * g) * 2), q1w = *(const LAS u32x2*)(lds + Q0 + (16 * m + l15) * RS + (32 * (s) + 16 + 4 * g) * 2); \
            bq[(s) & 1][m].x = q0w.x; bq[(s) & 1][m].y = q0w.y; bq[(s) & 1][m].z = q1w.x; bq[(s) & 1][m].w = q1w.y; } } while (0)
#define HG_MM_BQ(s) do { const bf16x8 sf = pack8(S[2 * (s)], S[2 * (s) + 1]); _Pragma("unroll") for (int m = 0; m < 4; ++m) oT[m] = __builtin_amdgcn_mfma_f32_16x16x32_bf16(sf, __builtin_bit_cast(bf16x8, bq[(s) & 1][m]), oT[m], 0, 0, 0); } while (0)
#define HG_RD_KF(t) do { dk4[(t) & 3] = *(const LAS f32x4*)(lds + DK + (16 * (t) + 4 * g) * 4); _Pragma("unroll") for (int s_ = 0; s_ < 2; ++s_) kf[(t) & 3][s_] = *(const LAS bf16x8*)(lds + KHT + (16 * (t) + l15) * TS + (32 * s_ + 8 * g) * 2); } while (0)
#define HG_MM_KF(t) do { S[t] = S[t] * dk4[(t) & 3]; _Pragma("unroll") for (int s_ = 0; s_ < 2; ++s_) S[t] = __builtin_amdgcn_mfma_f32_16x16x32_bf16(kf[(t) & 3][s_], vf[s_], S[t], 0, 0, 0); } while (0)
    {
        f32x4 dk4[4]; bf16x8 kf[4][2];
        if (latent) {
            bf16x8 pf[4][2]; u32x4 bq[2][4];
#pragma unroll
            for (int m = 0; m < 4; ++m)
#pragma unroll
                for (int s = 0; s < 2; ++s) pf[m][s] = *(const LAS bf16x8*)(lds + PP + (16 * m + l15) * TS + (32 * s + 8 * g) * 2);
            HG_RD_BQ(0); HG_RD_BQ(1);
            __builtin_amdgcn_sched_barrier(0);
#pragma unroll
            for (int m = 0; m < 4; ++m)
#pragma unroll
                for (int s = 0; s < 2; ++s) oT[m] = __builtin_amdgcn_mfma_f32_16x16x32_bf16(vf[s], pf[m][s], oT[m], 0, 0, 0);
            HG_MM_BQ(0);
            __builtin_amdgcn_sched_barrier(0);
            HG_RD_BQ(2); HG_MM_BQ(1);
            __builtin_amdgcn_sched_barrier(0);
            HG_RD_BQ(3); HG_MM_BQ(2);
            __builtin_amdgcn_sched_barrier(0);
            HG_RD_KF(0); HG_RD_KF(1); HG_MM_BQ(3);
            __builtin_amdgcn_sched_barrier(0);
        } else { HG_RD_KF(0); HG_RD_KF(1); __builtin_amdgcn_sched_barrier(0); }
        HG_RD_KF(2); HG_RD_KF(3); HG_MM_KF(0); HG_MM_KF(1);
        __builtin_amdgcn_sched_barrier(0);
        HG_RD_KF(4); HG_RD_KF(5); HG_MM_KF(2); HG_MM_KF(3);
        __builtin_amdgcn_sched_barrier(0);
        HG_RD_KF(6); HG_RD_KF(7); HG_MM_KF(4); HG_MM_KF(5);
        __builtin_amdgcn_sched_barrier(0);
        HG_MM_KF(6); HG_MM_KF(7);
    }
#undef HG_RD_BQ
#undef HG_MM_BQ
#undef HG_RD_KF
#undef HG_MM_KF
    if (second) asm volatile("" : "+v"(pw[0]), "+v"(pw[1]), "+v"(pw[2]), "+v"(pw[3]), "+v"(S[7]), "+v"(oT[3]));
    if (latent) {
        if (!second) {
#pragma unroll
            for (int m = 0; m < 4; ++m) { const int tau = 16 * m + l15, rho = BWD ? 63 - tau : tau;
                const unsigned long long w = (unsigned long long)pg8::cvt_pk_bf16(oT[m][0], oT[m][1]) | ((unsigned long long)pg8::cvt_pk_bf16(oT[m][2], oT[m][3]) << 32);
                __hip_atomic_store((unsigned long long*)(ORb + (unsigned)(rho * 512 + 4 * g)), w, RLX_AGENT); }
        } else {
#pragma unroll
            for (int m = 0; m < 4; ++m) { const int tau = 16 * m + l15, rho_ = BWD ? 63 - tau : tau;
                for (unsigned sp = 0; pw[m] == OR_SENTINEL && sp < (1u << 20); ++sp) { __builtin_amdgcn_s_sleep(1); pw[m] = __hip_atomic_load((unsigned long long*)(ORb + (unsigned)(rho_ * 512 + 4 * g)), RLX_AGENT); }
                const unsigned lo = (unsigned)pw[m], hi = (unsigned)(pw[m] >> 32);
                oT[m] += (f32x4){pg8::bf_lo(lo), pg8::bf_hi(lo), pg8::bf_lo(hi), pg8::bf_hi(hi)};
                float ss = (oT[m][0] * oT[m][0] + oT[m][1] * oT[m][1]) + (oT[m][2] * oT[m][2] + oT[m][3] * oT[m][3]);
                ss += __shfl_xor(ss, 16); ss += __shfl_xor(ss, 32);
                if (g == 0) *(LAS float*)(lds + SSQ + (wave * 64 + tau) * 4) = ss; }
        }
    }
    if (latent && second) {
        __syncthreads();
        bf16_t* A1 = (bf16_t*)(PB_A1(A)) + (rlbase * 512 + h * 128 + 16 * wave);
        const f32x4 gn = *(const LAS f32x4*)(lds + GNS + (16 * wave + 4 * g) * 4);
#pragma unroll
        for (int m = 0; m < 4; ++m) { const int tau = 16 * m + l15, rho = BWD ? 63 - tau : tau; float tot = 0.f;
#pragma unroll
            for (int w = 0; w < 8; ++w) tot += *(LAS float*)(lds + SSQ + (w * 64 + tau) * 4);
            const float rstd = 1.0f / sqrtf(tot * (1.0f / 128.0f) + EPS);
            const f32x4 sg4 = (f32x4){pg8::bf_lo(sgw[m].x), pg8::bf_hi(sgw[m].x), pg8::bf_lo(sgw[m].y), pg8::bf_hi(sgw[m].y)};
            const f32x4 o = oT[m] * rstd * gn * sg4;
            u32x2 ow; ow.x = pg8::cvt_pk_bf16(o[0], o[1]); ow.y = pg8::cvt_pk_bf16(o[2], o[3]); *(u32x2*)(A1 + (unsigned)(rho * 512 + 4 * g)) = ow; }
    }
    s1_store(lds, Q, next_latent, tid, P);
}
template <bool BWD>
__device__ __forceinline__ void run_dir(const Args& A, LAS unsigned char* lds, int pair, int tid) {
    const int b = pair >> 2, h = pair & 3;
    if (tid < 128) { *(LAS float*)(lds + LBS + 4 * tid) = ((const float*)(A.ws + WS_LB))[(BWD ? 512 : 0) + h * 128 + tid]; *(LAS float*)(lds + GNS + 4 * tid) = A.hgn[h * 128 + tid]; }
    __syncthreads();
    f32x4 S[8];
#pragma unroll
    for (int t = 0; t < 8; ++t) S[t] = (f32x4){0.f, 0.f, 0.f, 0.f};
    {
      unsigned long long* orp = (unsigned long long*)((bf16_t*)(PB_OR(A)) + (((long)b * SEQ + (BWD ? 1024 : 0)) * 512 + h * 128));
      for (int i = tid; i < 1024 * 32; i += 512) __hip_atomic_store(orp + (size_t)(i >> 5) * 128 + (i & 31), OR_SENTINEL, RLX_AGENT); }
    auto chunk_of = [](int j) -> int { const int jj = j < 36 ? j : 35; return BWD ? (jj < 4 ? 3 - jj : 39 - jj) : jj; };
    Inputs nxt; Prep P;
    load_inputs<BWD>(A, b, h, chunk_of(0), tid, nxt);
    { Mid M0; s1_math(lds, nxt, tid, M0);
      load_inputs<BWD>(A, b, h, chunk_of(1), tid, nxt);
      __syncthreads();
      s1_store(lds, M0, false, tid, P); }
    for (int j = 0; j < 20; ++j) chunk_step<BWD, false>(A, lds, b, h, chunk_of(j), S, P, nxt, j + 1 >= 4, chunk_of(j + 2), tid);
    for (int j = 20; j < 36; ++j) chunk_step<BWD, true>(A, lds, b, h, chunk_of(j), S, P, nxt, true, chunk_of(j + 2), tid);
}
__device__ __forceinline__ void hgrn_item(const Args& A, LAS unsigned char* lds, int item, int tid) {
    for (int i = tid; i < (hg::TT - hg::PP) / 4; i += 512) *(LAS unsigned*)(lds + hg::PP + 4 * i) = 0u;
    __syncthreads();
    if (item & 1) run_dir<true>(A, lds, item >> 1, tid); else run_dir<false>(A, lds, item >> 1, tid);
}
}
namespace p5 {
constexpr int RSB = 2064  , WPTH = 0, WPTL = 16 * RSB  , GM = 2 * 16 * RSB  , SH = GM + 4096, BP = SH + 4096  , BIAS = BP + 2048, END = BIAS + 64;
__device__ __forceinline__ void rows128(const Args& A, LAS unsigned char* lds, int rb, int tid) {
    const int wave = __builtin_amdgcn_readfirstlane(tid >> 6), lane = tid & 63, l15 = lane & 15, g = lane >> 4;
    const int b = rb >> 4; const long row0 = (long)rb * 128 + wave * 16;
    const float* mod = (const float*)(A.ws + WS_MOD) + (size_t)b * NMOD;
    const bf16_t* x1 = (const bf16_t*)(A.ws + WS_X1B);
    { const int k = 2 * tid; const pg8::f32x2_c n2 = *(const pg8::f32x2_c*)(A.n2g + k), sc2 = *(const pg8::f32x2_c*)(mod + 4096 + k), sh2 = *(const pg8::f32x2_c*)(mod + 3072 + k);
      const float gm0 = n2[0] * (1.0f + sc2[0]), gm1 = n2[1] * (1.0f + sc2[1]);
      *(LAS pg8::f32x2_c*)(lds + GM + 4 * k) = (pg8::f32x2_c){gm0, gm1}; *(LAS pg8::f32x2_c*)(lds + SH + 4 * k) = sh2;
#pragma unroll
      for (int q = 0; q < 4; ++q) { const f32x4 w0 = *(const f32x4*)(A.wr + (size_t)k * 16 + 4 * q), w1 = *(const f32x4*)(A.wr + (size_t)(k + 1) * 16 + 4 * q);
#pragma unroll
          for (int j = 0; j < 4; ++j) { const float v0 = gm0 * w0[j], v1 = gm1 * w1[j]; const unsigned hi = pg8::cvt_pk_bf16(v0, v1);
              const unsigned lo = pg8::cvt_pk_bf16(v0 - pg8::bf_lo(hi), v1 - pg8::bf_hi(hi));
              *(LAS unsigned*)(lds + WPTH + (4 * q + j) * RSB + 2 * k) = hi; *(LAS unsigned*)(lds + WPTL + (4 * q + j) * RSB + 2 * k) = lo; } } }
    { const int e = tid & 15, kp = tid >> 4; float s = 0.f;
#pragma unroll
      for (int h = 0; h < 2; ++h) { float sv[16], wv[16];
#pragma unroll
          for (int i = 0; i < 16; ++i) { sv[i] = mod[3072 + kp * 32 + 16 * h + i]; wv[i] = A.wr[(size_t)(kp * 32 + 16 * h + i) * 16 + e]; }
#pragma unroll
          for (int i = 0; i < 16; ++i) s += sv[i] * wv[i]; }
      *(LAS float*)(lds + BP + (kp * 16 + e) * 4) = s; }
    __syncthreads();
    if (tid < 16) { float s = 0.f; for (int kp = 0; kp < 32; ++kp) s += *(LAS float*)(lds + BP + (kp * 16 + tid) * 4); *(LAS float*)(lds + BIAS + 4 * tid) = s; }
    __syncthreads();
    f32x4 acc = (f32x4){0.f, 0.f, 0.f, 0.f}; float ss = 0.f;
    { const bf16_t* xr = x1 + (row0 + l15) * 1024 + 8 * g;
      u32x4 xw[8];
#pragma unroll
      for (int it = 0; it < 8; ++it) xw[it] = *(const u32x4*)(xr + 32 * it);
#pragma unroll
      for (int it = 0; it < 32; ++it) {
        const bf16x8 bh = *(const LAS bf16x8*)(lds + WPTH + l15 * RSB + (32 * it + 8 * g) * 2), bl = *(const LAS bf16x8*)(lds + WPTL + l15 * RSB + (32 * it + 8 * g) * 2);
        const u32x4 w = xw[it & 7];
        if (it + 8 < 32) xw[it & 7] = *(const u32x4*)(xr + 32 * (it + 8));
        const bf16x8 a = __builtin_bit_cast(bf16x8, w);
        acc = __builtin_amdgcn_mfma_f32_16x16x32_bf16(a, bh, acc, 0, 0, 0); acc = __builtin_amdgcn_mfma_f32_16x16x32_bf16(a, bl, acc, 0, 0, 0);
        const float x0 = pg8::bf_lo(w.x), x1f = pg8::bf_hi(w.x), x2 = pg8::bf_lo(w.y), x3 = pg8::bf_hi(w.y), x4 = pg8::bf_lo(w.z), x5 = pg8::bf_hi(w.z), x6 = pg8::bf_lo(w.w), x7 = pg8::bf_hi(w.w);
        ss += ((x0 * x0 + x1f * x1f) + (x2 * x2 + x3 * x3)) + ((x4 * x4 + x5 * x5) + (x6 * x6 + x7 * x7));
        if ((it & 3) == 3) __builtin_amdgcn_sched_barrier(0);
      } }
    ss += __shfl_xor(ss, 16); ss += __shfl_xor(ss, 32);
    const float rstd = 1.0f / sqrtf(ss * (1.0f / 1024.0f) + EPS);
    const float bias = *(LAS float*)(lds + BIAS + 4 * l15);
    f32x4 aff;
#pragma unroll
    for (int r = 0; r < 4; ++r) { const float rs = __shfl(rstd, 4 * g + r); float lg = acc[r] * rs + bias;
        float mx = lg; mx = fmaxf(mx, __shfl_xor(mx, 1)); mx = fmaxf(mx, __shfl_xor(mx, 2)); mx = fmaxf(mx, __shfl_xor(mx, 4)); mx = fmaxf(mx, __shfl_xor(mx, 8));
        const float ex = expf(lg - mx); float sm = ex; sm += __shfl_xor(sm, 1); sm += __shfl_xor(sm, 2); sm += __shfl_xor(sm, 4); sm += __shfl_xor(sm, 8);
        aff[r] = ex / sm; }
    { float* AFF = (float*)(A.ws + WS_AFF); const int t = (rb & 15) * 128 + wave * 16 + 4 * g;
        *(f32x4*)(AFF + ((size_t)(b * 16 + l15)) * 2048 + t) = aff; }
    unsigned char* H2Q = A.ws + WS_H2; float* HS = (float*)(A.ws + WS_HS);
    for (int i0 = 0; i0 < 16; i0 += 4) {
        f32x4 v[4][4];
#pragma unroll
        for (int ii = 0; ii < 4; ++ii)
#pragma unroll
            for (int j = 0; j < 4; ++j) { const u32x2 w = *(const u32x2*)(x1 + (row0 + i0 + ii) * 1024 + 4 * lane + 256 * j); v[ii][j] = (f32x4){pg8::bf_lo(w.x), pg8::bf_hi(w.x), pg8::bf_lo(w.y), pg8::bf_hi(w.y)}; }
#pragma unroll
        for (int ii = 0; ii < 4; ++ii) { const float rs = __shfl(rstd, i0 + ii); float amax = 0.f;
#pragma unroll
            for (int j = 0; j < 4; ++j) { const int cidx = 4 * lane + 256 * j;
                const f32x4 gmv = *(const LAS f32x4*)(lds + GM + 4 * cidx), shv = *(const LAS f32x4*)(lds + SH + 4 * cidx);
                const f32x4 o = v[ii][j] * rs * gmv + shv; v[ii][j] = o;
                amax = fmaxf(fmaxf(amax, fmaxf(fabsf(o[0]), fabsf(o[1]))), fmaxf(fabsf(o[2]), fabsf(o[3]))); }
#pragma unroll
            for (int o_ = 1; o_ < 64; o_ <<= 1) amax = fmaxf(amax, __shfl_xor(amax, o_));
            const float am = amax > 1e-30f ? amax : 1e-30f, inv = 127.0f / am;
            if (lane == 0) HS[row0 + i0 + ii] = am * (1.0f / 127.0f);
#pragma unroll
            for (int j = 0; j < 4; ++j) { const f32x4 o = v[ii][j] * inv;
                const int q0 = (int)__builtin_rintf(o[0]), q1 = (int)__builtin_rintf(o[1]), q2 = (int)__builtin_rintf(o[2]), q3 = (int)__builtin_rintf(o[3]);
                *(unsigned*)(H2Q + (size_t)(row0 + i0 + ii) * 1024 + 4 * lane + 256 * j) = ((unsigned)q0 & 255u) | (((unsigned)q1 & 255u) << 8) | (((unsigned)q2 & 255u) << 16) | ((unsigned)q3 << 24); } } }
    __syncthreads();
}
__device__ __forceinline__ void ew_q8(const float* Wcol, unsigned char* WQ, float* TQp, LAS float* scr, int lane) {
    const int n4 = lane & 7, kr = lane >> 3;
    const float* W = Wcol + 4 * n4 + (size_t)kr * 1024;
    f32x4 ta[8], tb[8], tc[8], td[8];
#define EWQ_LD(t, kb) do { const float* w_ = W + (size_t)(64 * ((kb) < 16 ? (kb) : 15)) * 1024; _Pragma("unroll") for (int i = 0; i < 8; ++i) (t)[i] = *(const f32x4*)(w_ + (size_t)(8 * i) * 1024); } while (0)
#define EWQ_MAX(t) do { _Pragma("unroll") for (int i = 0; i < 8; ++i) { am4[0] = fmaxf(am4[0], fabsf((t)[i][0])); am4[1] = fmaxf(am4[1], fabsf((t)[i][1])); am4[2] = fmaxf(am4[2], fabsf((t)[i][2])); am4[3] = fmaxf(am4[3], fabsf((t)[i][3])); } } while (0)
    f32x4 am4 = (f32x4){0.f, 0.f, 0.f, 0.f};
    EWQ_LD(ta, 0); EWQ_LD(tb, 1); EWQ_LD(tc, 2); EWQ_LD(td, 3);
    for (int kb = 0; kb < 12; kb += 4) { EWQ_MAX(ta); EWQ_LD(ta, kb + 4); EWQ_MAX(tb); EWQ_LD(tb, kb + 5); EWQ_MAX(tc); EWQ_LD(tc, kb + 6); EWQ_MAX(td); EWQ_LD(td, kb + 7); }
    EWQ_MAX(ta); EWQ_MAX(tb); EWQ_MAX(tc); EWQ_MAX(td);
#pragma unroll
    for (int j = 0; j < 4; ++j) { float a = am4[j]; a = fmaxf(a, __shfl_xor(a, 8)); a = fmaxf(a, __shfl_xor(a, 16)); a = fmaxf(a, __shfl_xor(a, 32)); am4[j] = a > 1e-30f ? a : 1e-30f; }
    const f32x4 inv4 = (f32x4){127.0f / am4[0], 127.0f / am4[1], 127.0f / am4[2], 127.0f / am4[3]};
    if (lane < 8) *(f32x4*)(TQp + 4 * n4) = am4 * (1.0f / 127.0f);
#define EWQ_FIN(t, kb) do { _Pragma("unroll") for (int i = 0; i < 8; ++i) { const f32x4 q_ = (t)[i] * inv4; LAS float* d_ = scr + (kr + 8 * i) * 33 + 4 * n4; \
            d_[0] = __builtin_rintf(q_[0]); d_[1] = __builtin_rintf(q_[1]); d_[2] = __builtin_rintf(q_[2]); d_[3] = __builtin_rintf(q_[3]); } \
        LDS_WAIT(); asm volatile("" ::: "memory"); \
        { const int c = lane & 7; _Pragma("unroll") for (int j = 0; j < 4; ++j) { const int n = (lane >> 3) + 8 * j; const LAS float* s = scr + (8 * c) * 33 + n; \
            const unsigned w0 = ((unsigned)(int)s[0 * 33] & 255u) | (((unsigned)(int)s[1 * 33] & 255u) << 8) | (((unsigned)(int)s[2 * 33] & 255u) << 16) | ((unsigned)(int)s[3 * 33] << 24); \
            const unsigned w1 = ((unsigned)(int)s[4 * 33] & 255u) | (((unsigned)(int)s[5 * 33] & 255u) << 8) | (((unsigned)(int)s[6 * 33] & 255u) << 16) | ((unsigned)(int)s[7 * 33] << 24); \
            u32x2 o; o.x = w0; o.y = w1; *(u32x2*)(WQ + (size_t)n * 1024 + 64 * (kb) + 8 * c) = o; } } \
        LDS_WAIT(); asm volatile("" ::: "memory"); } while (0)
    EWQ_FIN(ta, 12); EWQ_LD(ta, 0); EWQ_FIN(tb, 13); EWQ_LD(tb, 1); EWQ_FIN(tc, 14); EWQ_LD(tc, 2); EWQ_FIN(td, 15); EWQ_LD(td, 3);
    for (int kb = 0; kb < 8; kb += 4) { EWQ_FIN(ta, kb); EWQ_LD(ta, kb + 4); EWQ_FIN(tb, kb + 1); EWQ_LD(tb, kb + 5); EWQ_FIN(tc, kb + 2); EWQ_LD(tc, kb + 6); EWQ_FIN(td, kb + 3); EWQ_LD(td, kb + 7); }
    EWQ_FIN(ta, 8); EWQ_FIN(tb, 9); EWQ_FIN(tc, 10); EWQ_FIN(td, 11);
#undef EWQ_LD
#undef EWQ_MAX
#undef EWQ_FIN
}
__device__ __forceinline__ void expert_weights(const Args& A, LAS unsigned char* lds, int vcu, int G, int tid) {
    const int wave = tid >> 6, lane = tid & 63; LAS float* scr = (LAS float*)(lds + wave * 8704);
    const int gw = vcu * NWAVES + wave, NGW = G * NWAVES;
    for (int it = gw; it < 16 * 64 + 16 * 32; it += NGW) {
        if (it < 16 * 64) { const int e = it >> 6, gi = it & 63, pn = gi >> 3, half = (gi >> 2) & 1, q = gi & 3;
            ew_q8((half ? A.weu : A.weg) + (size_t)e * 1024 * 1024 + 128 * pn + 32 * q, A.ws + WS_WGU + ((size_t)e * 2048 + gi * 32) * 1024, (float*)(A.ws + WS_TQ) + e * 2048 + gi * 32, scr, lane); }
        else { const int r = it - 16 * 64, e = r >> 5, gi = r & 31;
            ew_q8(A.wed + (size_t)e * 1024 * 1024 + 32 * gi, A.ws + WS_WD + ((size_t)e * 1024 + gi * 32) * 1024, (float*)(A.ws + WS_TD) + e * 1024 + gi * 32, scr, lane); } }
}
}

__device__ __forceinline__ unsigned block_exscan(unsigned v, LAS unsigned* scr, int tid, unsigned* total) {
    const int lane = tid & 63, wave = tid >> 6; unsigned inc = v;
#pragma unroll
    for (int o = 1; o < 64; o <<= 1) { const unsigned t = __shfl_up(inc, o); if (lane >= o) inc += t; }
    if (lane == 63) scr[wave] = inc;
    __syncthreads();
    unsigned base = 0, tot = 0;
#pragma unroll
    for (int w = 0; w < 8; ++w) { const unsigned x = scr[w]; if (w < wave) base += x; tot += x; }
    __syncthreads();
    *total = tot; return base + inc - v;
}
__device__ __forceinline__ void topk_unit(const Args& A, LAS unsigned char* lds, int b, int e, int tid) {
    LAS unsigned* hist = (LAS unsigned*)lds;
    LAS unsigned* ctlw = (LAS unsigned*)(lds + 1024);
    const float* AFF = (const float*)(A.ws + WS_AFF) + (size_t)(b * 16 + e) * 2048;
    const f32x4 v4 = *(const f32x4*)(AFF + 4 * tid);
    unsigned key[4];
#pragma unroll
    for (int i = 0; i < 4; ++i) key[i] = __float_as_uint(v4[i]);
    unsigned prefix = 0, need = 256;
#pragma unroll 1
    for (int pass = 0; pass < 4; ++pass) { const int shift = 24 - 8 * pass;
        if (tid < 256) hist[tid] = 0u;
        __syncthreads();
#pragma unroll
        for (int i = 0; i < 4; ++i) if (pass == 0 || (key[i] >> (shift + 8)) == prefix) (void)__hip_atomic_fetch_add(&hist[(key[i] >> shift) & 255u], 1u, __ATOMIC_RELAXED, __HIP_MEMORY_SCOPE_WORKGROUP);
        __syncthreads();
        if (tid < 64) {
            const unsigned h0 = hist[4 * tid], h1 = hist[4 * tid + 1], h2 = hist[4 * tid + 2], h3 = hist[4 * tid + 3]; const unsigned mine = h0 + h1 + h2 + h3;
            unsigned suf = mine;
#pragma unroll
            for (int o = 1; o < 64; o <<= 1) { const unsigned t = __shfl_down(suf, o); if (tid + o < 64) suf += t; }
            const unsigned above = suf - mine;
            if (above < need && suf >= need) {
                unsigned cum = above; int bin = 4 * tid + 3;
                if (cum + h3 >= need) { } else { cum += h3; bin = 4 * tid + 2; if (cum + h2 >= need) { } else { cum += h2; bin = 4 * tid + 1; if (cum + h1 >= need) { } else { cum += h1; bin = 4 * tid; } } }
                ctlw[8] = (prefix << 8) | (unsigned)bin; ctlw[9] = need - cum; } }
        __syncthreads();
        prefix = ctlw[8]; need = ctlw[9];
        __syncthreads();
    }
    unsigned eqc = 0;
#pragma unroll
    for (int i = 0; i < 4; ++i) eqc += (key[i] == prefix) ? 1u : 0u;
    unsigned tot; unsigned eqbase = block_exscan(eqc, ctlw, tid, &tot);
    unsigned sel = 0; bool take[4];
#pragma unroll
    for (int i = 0; i < 4; ++i) { take[i] = key[i] > prefix; if (key[i] == prefix) { take[i] = eqbase < need; ++eqbase; } sel += take[i] ? 1u : 0u; }
    unsigned slot = block_exscan(sel, ctlw, tid, &tot);
    int* IDX = (int*)(A.ws + WS_IDX) + (b * 16 + e) * 256; float* GATE = (float*)(A.ws + WS_IDX + 256 * 1024) + (b * 16 + e) * 256; int* SLOT = (int*)(A.ws + WS_SLOT);
    float* SCL = (float*)(A.ws + WS_SCL) + (b * 16 + e) * 256; const float* HS = (const float*)(A.ws + WS_HS);
#pragma unroll
    for (int i = 0; i < 4; ++i) { const int t = 4 * tid + i; int sl = -1;
        if (take[i]) { sl = (int)slot; ++slot; IDX[sl] = b * 2048 + t; GATE[sl] = v4[i]; SCL[sl] = HS[b * 2048 + t]; }
        SLOT[(size_t)(b * 2048 + t) * 16 + e] = sl; }
    VM_WAIT();
    __syncthreads();
}

struct P7Row { u32x4 x[2]; u32x2 y[4][2]; int ne; unsigned rest; };
typedef int i32x4_p7 __attribute__((ext_vector_type(4)));
__device__ __forceinline__ int p7_slot_of(const i32x4_p7 sl, int i, int e) {
    const int c = e & 3; const int v = c == 0 ? sl.x : c == 1 ? sl.y : c == 2 ? sl.z : sl.w;
    return __builtin_amdgcn_readlane(v, 4 * i + (e >> 2));
}
__device__ __forceinline__ unsigned p7_mask_of(const unsigned long long (&bc)[4], int i) {
    unsigned m = 0;
#pragma unroll
    for (int c = 0; c < 4; ++c) { const unsigned n = (unsigned)(bc[c] >> (4 * i)) & 15u; m |= ((n & 1u) | ((n & 2u) << 3) | ((n & 4u) << 6) | ((n & 8u) << 9)) << c; }
    return m;
}
__device__ __forceinline__ void p7_issue(const bf16_t* X1B, const unsigned char* YE, int r, const i32x4_p7 sl, const unsigned long long (&bc)[4], int i, int lane, P7Row& R) {
    const int b = r >> 11;
#pragma unroll
    for (int j = 0; j < 2; ++j) R.x[j] = *(const u32x4*)(X1B + (size_t)r * 1024 + j * 512 + 8 * lane);
    unsigned m = p7_mask_of(bc, i); int ne = 0;
#pragma unroll
    for (int q = 0; q < 4; ++q) { const unsigned char* yr = YE;
        if (m) { const int e = __builtin_ctz(m); m &= m - 1; yr = YE + ((size_t)(b * 16 + e) * 256 + p7_slot_of(sl, i, e)) * 1024; ne = q + 1; }
        if (!DBG_TIMING) { R.y[q][0] = *(const u32x2*)(yr + 8 * lane); R.y[q][1] = *(const u32x2*)(yr + 512 + 8 * lane); } }
    R.ne = DBG_TIMING ? 0 : ne; R.rest = DBG_TIMING ? 0u : m;
}
__device__ __forceinline__ void p7_f8acc(const u32x2 w, f32x4& a0, f32x4& a1) {
    const pg8::f32x2_c p0 = __builtin_amdgcn_cvt_pk_f32_fp8((int)w.x, false), p1 = __builtin_amdgcn_cvt_pk_f32_fp8((int)w.x, true), p2 = __builtin_amdgcn_cvt_pk_f32_fp8((int)w.y, false), p3 = __builtin_amdgcn_cvt_pk_f32_fp8((int)w.y, true);
    a0 += (f32x4){p0[0], p0[1], p1[0], p1[1]}; a1 += (f32x4){p2[0], p2[1], p3[0], p3[1]};
}
__device__ __forceinline__ void p7_finish(const Args& A, const unsigned char* YE, int r, const i32x4_p7 sl, int i, int lane, const P7Row& R, const f32x4 (&g2)[4], const f32x4 (&fg)[4], float scale) {
    const int b = r >> 11;
    f32x4 acc[4];
#pragma unroll
    for (int j = 0; j < 4; ++j) acc[j] = (f32x4){0.f, 0.f, 0.f, 0.f};
#pragma unroll
    for (int q = 0; q < 4; ++q) if (q < R.ne) { p7_f8acc(R.y[q][0], acc[0], acc[1]); p7_f8acc(R.y[q][1], acc[2], acc[3]); }
    for (unsigned m = R.rest; m;) { const int e = __builtin_ctz(m); m &= m - 1;
        const unsigned char* yr = YE + ((size_t)(b * 16 + e) * 256 + p7_slot_of(sl, i, e)) * 1024;
        p7_f8acc(*(const u32x2*)(yr + 8 * lane), acc[0], acc[1]); p7_f8acc(*(const u32x2*)(yr + 512 + 8 * lane), acc[2], acc[3]); }
#pragma unroll
    for (int j = 0; j < 4; ++j) acc[j] = acc[j] * (1.0f / pg8::YE_F8_SCALE);
    f32x4 xv[4];
#pragma unroll
    for (int j = 0; j < 2; ++j) { const u32x4 w = R.x[j]; xv[2 * j] = (f32x4){pg8::bf_lo(w.x), pg8::bf_hi(w.x), pg8::bf_lo(w.y), pg8::bf_hi(w.y)}; xv[2 * j + 1] = (f32x4){pg8::bf_lo(w.z), pg8::bf_hi(w.z), pg8::bf_lo(w.w), pg8::bf_hi(w.w)}; }
    float* xo = A.out + (size_t)r * 1024; f32x4 v[4]; float ss = 0.f;
#pragma unroll
    for (int j = 0; j < 4; ++j) { const int cidx = (j >> 1) * 512 + 8 * lane + (j & 1) * 4;
        v[j] = xv[j] + g2[j] * acc[j]; ss += (v[j][0] * v[j][0] + v[j][1] * v[j][1]) + (v[j][2] * v[j][2] + v[j][3] * v[j][3]); }
    const float rstd = 1.0f / sqrtf(wave_sum(ss) * (1.0f / 1024.0f) + EPS);
#pragma unroll
    for (int j = 0; j < 4; ++j) { const int cidx = (j >> 1) * 512 + 8 * lane + (j & 1) * 4; *(f32x4*)(xo + cidx) = v[j] * (rstd * scale) * fg[j]; }
}
__device__ __forceinline__ void p7_rows(const Args& A, int vcu, int G, int tid) {
    const int wave = tid >> 6, lane = tid & 63; const int gw = vcu * NWAVES + wave, NGW = G * NWAVES;
    const float* mod = (const float*)(A.ws + WS_MOD); const int* SLOT = (const int*)(A.ws + WS_SLOT); const unsigned char* YE = A.ws + WS_YE; const bf16_t* X1B = (const bf16_t*)(A.ws + WS_X1B);
#if DBG_TIMING
    const unsigned tsa_ = __hip_atomic_load((unsigned*)(A.ws + WS_CTL) + 100 + DBG_TIME_A0, RLX_AGENT), tsb_ = __hip_atomic_load((unsigned*)(A.ws + WS_CTL) + 100 + DBG_TIME_A1, RLX_AGENT);
    const float DBG_SCALE = 1.0f + (float)((tsb_ - tsa_) / (100u * DBG_TIME_Q));
#else
    const float DBG_SCALE = 1.0f;
#endif
    const int RPW = (((ML + NGW - 1) / NGW) + 15) & ~15;
    const int r0 = gw * RPW, r1 = r0 + RPW < ML ? r0 + RPW : ML;
    f32x4 fg[4], g2[4]; int bcur = -1;
#pragma unroll
    for (int j = 0; j < 4; ++j) { fg[j] = *(const f32x4*)(A.fng + (j >> 1) * 512 + 8 * lane + (j & 1) * 4); g2[j] = fg[j]; }
    asm volatile("" : "+v"(fg[0]), "+v"(fg[1]), "+v"(fg[2]), "+v"(fg[3]));
    for (int rg = r0; rg < r1; rg += 16) {
        const int nr = r1 - rg < 16 ? r1 - rg : 16, b = rg >> 11;
        if (b != bcur) { bcur = b;
#pragma unroll
            for (int j = 0; j < 4; ++j) g2[j] = *(const f32x4*)(mod + (size_t)b * NMOD + 5120 + (j >> 1) * 512 + 8 * lane + (j & 1) * 4);
            asm volatile("" : "+v"(g2[0]), "+v"(g2[1]), "+v"(g2[2]), "+v"(g2[3])); }
        i32x4_p7 sl = *(const i32x4_p7*)(SLOT + (size_t)rg * 16 + 4 * lane);
        asm volatile("" : "+v"(sl));
        unsigned long long bc[4]; bc[0] = __ballot(sl.x >= 0); bc[1] = __ballot(sl.y >= 0); bc[2] = __ballot(sl.z >= 0); bc[3] = __ballot(sl.w >= 0);
        P7Row B0, B1;
        p7_issue(X1B, YE, rg, sl, bc, 0, lane, B0);
        for (int i = 0; i < nr; i += 2) {
            { const int i1 = i + 1 < nr ? i + 1 : nr - 1; p7_issue(X1B, YE, rg + i1, sl, bc, i1, lane, B1); }
            p7_finish(A, YE, rg + i, sl, i, lane, B0, g2, fg, DBG_SCALE);
            { const int i2 = i + 2 < nr ? i + 2 : nr - 1; p7_issue(X1B, YE, rg + i2, sl, bc, i2, lane, B0); }
            if (i + 1 < nr) p7_finish(A, YE, rg + i + 1, sl, i + 1, lane, B1, g2, fg, DBG_SCALE);
        }
    }
}

#ifndef DBG_TIMING
#define DBG_TIMING 0
#endif
typedef const __attribute__((address_space(4))) Args* KArgsPtr;
__global__ void __launch_bounds__(NWAVES * 64, 2) fwd_megakernel(Args A_) {
    KArgsPtr ap = (KArgsPtr)__builtin_amdgcn_kernarg_segment_ptr(); asm volatile("" : "+s"(ap));
#define A (*(const Args*)ap)
    extern __shared__ __attribute__((aligned(16))) unsigned char lds_raw[];
    LAS unsigned char* lds = (LAS unsigned char*)lds_raw;
    volatile LAS unsigned* MISC = (volatile LAS unsigned*)(lds + MISC_OFF);
    int tid = threadIdx.x; const int bx = blockIdx.x, G = gridDim.x;
    const int vcu = (G % 8 == 0) ? (bx % 8) * (G / 8) + bx / 8 : bx;
    unsigned* ctl = (unsigned*)(A.ws + WS_CTL);
    for (int u = tid; u < 64; u += NWAVES * 64) ((LAS unsigned*)(lds + MISC_OFF))[u] = 0u;
    __syncthreads();
    const XcdBarrier xbar = xcd_barrier_post((unsigned*)(ctl + CW_BAR), MISC + 8);
#define GRID_BAR() xcd_barrier(xbar)
#define RELAUNDER() do { int t_ = threadIdx.x; asm volatile("" : "+v"(t_)); tid = t_; KArgsPtr p_ = (KArgsPtr)__builtin_amdgcn_kernarg_segment_ptr(); asm volatile("" : "+s"(p_)); ap = p_; } while (0)
#if DBG_TIMING
#define STAMP(k) do { if (bx == 0) ctl[100 + (k)] = (unsigned)__builtin_amdgcn_s_memrealtime(); } while (0)
#else
#define STAMP(k) do { } while (0)
#endif
    STAMP(0);
    RELAUNDER();
    p0_prologue<0>(A, lds, vcu, G, tid);
    GRID_BAR(); STAMP(1);
    RELAUNDER();
    p1_rows(A, vcu, G, tid);
    RELAUNDER();
    p0_prologue<1>(A, lds, vcu, G, tid);
    GRID_BAR(); STAMP(2);
    RELAUNDER();
    {
        pg8::Gemm g{(const bf16_t*)(PB_HX(A)), (const bf16_t*)(A.ws + WS_WIN), MR, INC, 512  , nullptr}; pg8::InProjOrder S; S.init(G, bx);
        pg8::EpiInProjQ E{{A.ws, WS_HQ, WS_FF, WS_FB, WS_HI, WS_SG, WS_Q, WS_K, WS_V, WS_GA, WS_GB, WS_ROPE, A.qng, A.kng}, (const float*)PB_HXS(A), (const float*)(A.ws + WS_WINS)};
        pg8::gemm_phase<pg8::EpiInProjQ, pg8::InProjOrder, true, true, true>(lds, g, S, E);
    }
    GRID_BAR(); STAMP(3);
    RELAUNDER();
    {
        if (bx < 128) { for (int it = bx; it < 128; it += G) { RELAUNDER(); hg::hgrn_item(A, lds, it, tid); } }
        else p5::expert_weights(A, lds, bx - 128, G - 128, tid);
        STAMP(20);
        __syncthreads();
        const float att_mfix = __uint_as_float(__builtin_amdgcn_readfirstlane(__hip_atomic_load(ctl + CW_MFIX, RLX_AGENT)));
#define ATT_QUEUE(FIX, MF) for (;;) { \
            if (tid == 0) MISC[0] = atomicAdd(ctl + CW_Q3, 1u); \
            __syncthreads(); \
            const unsigned u = MISC[0]; \
            __syncthreads(); \
            if (u >= 1024u) break; \
            const int bk = u >> 5, b = bk >> 1, kvh = bk & 1, gq = (u >> 3) & 3, qb = u & 7; \
            attn_body::attn_unit<8, FIX>((long)b * SEQ + qb * 256, kvh * 4 + gq, (long)b * RPB, kvh, (const attn_body::bf16*)(A.ws + WS_Q), (const attn_body::bf16*)(A.ws + WS_K), (const attn_body::bf16*)(A.ws + WS_V), \
                                    (attn_body::bf16*)(PB_OATT(A)), (char*)lds_raw, MF); }
        if (att_mfix <= 60.0f) { ATT_QUEUE(true, att_mfix) } else { ATT_QUEUE(false, 0.f) }
#undef ATT_QUEUE
    }
    GRID_BAR(); STAMP(4);
    RELAUNDER();
    {
        pg8::StaticOrder S; S.init(ML, 1024, G, bx);
        { pg8::Gemm g{(const bf16_t*)(PB_A1(A)), (const bf16_t*)(A.ws + WS_WA), ML, 1024, 512, nullptr}; pg8::EpiZ<0> E{(bf16_t*)(A.ws + WS_Z), A.ws + WS_GA};
          pg8::gemm_phase<pg8::EpiZ<0>, pg8::StaticOrder, true, true>(lds, g, S, E); }
        VM_WAIT(); __syncthreads();
        { pg8::Gemm g{(const bf16_t*)(PB_OATT(A)), (const bf16_t*)(A.ws + WS_WB), ML, 1024, 512, nullptr}; pg8::EpiZ<1> E{(bf16_t*)(A.ws + WS_Z), A.ws + WS_GB};
          pg8::gemm_phase<pg8::EpiZ<1>, pg8::StaticOrder, true, true>(lds, g, S, E); }
    }
    GRID_BAR(); STAMP(5);
    RELAUNDER();
    {
        pg8::StaticOrder S; S.init(ML, 1024, G, bx);
        pg8::Gemm g{(const bf16_t*)(A.ws + WS_Z), (const bf16_t*)(A.ws + WS_WO), ML, 1024, 1024, nullptr}; pg8::EpiX1 E{A.x, (const float*)(A.ws + WS_MOD), (bf16_t*)(A.ws + WS_X1B)};
        pg8::gemm_phase<pg8::EpiX1, pg8::StaticOrder, true, true>(lds, g, S, E);
    }
    GRID_BAR(); STAMP(6);
    RELAUNDER();
    for (int rb = vcu; rb < 256; rb += G) { RELAUNDER(); p5::rows128(A, lds, rb, tid); }
    GRID_BAR(); STAMP(7);
    RELAUNDER();
    for (int uu = vcu; uu < 256; uu += G) { const int e = uu >> 4, b = uu & 15, unit = b * 16 + e;
        RELAUNDER();
        topk_unit(A, lds, b, e, tid);
        bf16_t* HID = (bf16_t*)(PB_HID(A)) + (size_t)unit * 256 * 1024;
        { pg8::Gemm g{(const bf16_t*)(A.ws + WS_H2), (const bf16_t*)(A.ws + WS_WGU) + (size_t)e * 2048 * 512, 256, 2048, 512  , (const int*)(A.ws + WS_IDX) + unit * 256};
          pg8::LocalOrder S{8}; pg8::EpiHidQ E{HID, (const float*)(A.ws + WS_SCL) + unit * 256, (const float*)(A.ws + WS_TQ) + e * 2048};
          pg8::gemm_phase<pg8::EpiHidQ, pg8::LocalOrder, true, true, true>(lds, g, S, E); }
        VM_WAIT(); __syncthreads();
        { unsigned char* HQ = A.ws + WS_HIDQ + (size_t)unit * 256 * 1024; float* S2 = (float*)(A.ws + WS_SCL2) + unit * 256; const int wv = tid >> 6, ln = tid & 63;
          for (int r0 = wv * 32; r0 < wv * 32 + 32; r0 += 8) {
              u32x4 w[8][2];
#pragma unroll
              for (int ii = 0; ii < 8; ++ii) { w[ii][0] = *(const u32x4*)(HID + (size_t)(r0 + ii) * 1024 + 16 * ln); w[ii][1] = *(const u32x4*)(HID + (size_t)(r0 + ii) * 1024 + 16 * ln + 8); }
#pragma unroll
              for (int ii = 0; ii < 8; ++ii) { f32x4 v[4];
                  v[0] = (f32x4){pg8::bf_lo(w[ii][0].x), pg8::bf_hi(w[ii][0].x), pg8::bf_lo(w[ii][0].y), pg8::bf_hi(w[ii][0].y)}; v[1] = (f32x4){pg8::bf_lo(w[ii][0].z), pg8::bf_hi(w[ii][0].z), pg8::bf_lo(w[ii][0].w), pg8::bf_hi(w[ii][0].w)};
                  v[2] = (f32x4){pg8::bf_lo(w[ii][1].x), pg8::bf_hi(w[ii][1].x), pg8::bf_lo(w[ii][1].y), pg8::bf_hi(w[ii][1].y)}; v[3] = (f32x4){pg8::bf_lo(w[ii][1].z), pg8::bf_hi(w[ii][1].z), pg8::bf_lo(w[ii][1].w), pg8::bf_hi(w[ii][1].w)};
                  float amax = 0.f;
#pragma unroll
                  for (int j = 0; j < 4; ++j) amax = fmaxf(fmaxf(amax, fmaxf(fabsf(v[j][0]), fabsf(v[j][1]))), fmaxf(fabsf(v[j][2]), fabsf(v[j][3])));
#pragma unroll
                  for (int o_ = 1; o_ < 64; o_ <<= 1) amax = fmaxf(amax, __shfl_xor(amax, o_));
                  const float am = amax > 1e-30f ? amax : 1e-30f, inv = 127.0f / am;
                  if (ln == 0) S2[r0 + ii] = am * (1.0f / 127.0f);
                  u32x4 o;
#pragma unroll
                  for (int j = 0; j < 4; ++j) { const f32x4 q = v[j] * inv;
                      const unsigned pk = ((unsigned)(int)__builtin_rintf(q[0]) & 255u) | (((unsigned)(int)__builtin_rintf(q[1]) & 255u) << 8) | (((unsigned)(int)__builtin_rintf(q[2]) & 255u) << 16) | ((unsigned)(int)__builtin_rintf(q[3]) << 24);
                      if (j == 0) o.x = pk; else if (j == 1) o.y = pk; else if (j == 2) o.z = pk; else o.w = pk; }
                  *(u32x4*)(HQ + (size_t)(r0 + ii) * 1024 + 16 * ln) = o; } } }
        VM_WAIT(); __syncthreads();
        { pg8::Gemm g{(const bf16_t*)(A.ws + WS_HIDQ) + (size_t)unit * 256 * 512, (const bf16_t*)(A.ws + WS_WD) + (size_t)e * 1024 * 512, 256, 1024, 512  , nullptr};
          pg8::LocalOrder S{4}; pg8::EpiYeQ E{A.ws + WS_YE + (size_t)unit * 256 * 1024, (const float*)(A.ws + WS_IDX + 256 * 1024) + unit * 256, (const float*)(A.ws + WS_SCL2) + unit * 256, (const float*)(A.ws + WS_TD) + e * 1024};
          pg8::gemm_phase<pg8::EpiYeQ, pg8::LocalOrder, true, true, true>(lds, g, S, E); }
        __syncthreads();
    }
    GRID_BAR(); STAMP(8);
#if DBG_TIMING
    GRID_BAR();
#endif
    RELAUNDER();
    p7_rows(A, vcu, G, tid);
}
#undef A

extern "C" void kernel_launch(void* const* d_in, const int* in_sizes, int n_in, void* d_out, int out_size, void* d_ws, size_t ws_size, hipStream_t stream) {
    static int grid = 0;
    if (grid == 0) {
        if (n_in != 21 || out_size != ML * 1024 || ws_size < WS_END) { fprintf(stderr, "kernel_launch: unexpected problem (n_in %d, out %d, ws %zu); nothing launched\n", n_in, out_size, ws_size); grid = -1; return; }
        int dev = 0, cus = 0, per_cu = 0;
        if (hipGetDevice(&dev) != hipSuccess || hipDeviceGetAttribute(&cus, hipDeviceAttributeMultiprocessorCount, dev) != hipSuccess) { grid = -1; return; }
        if (hipFuncSetAttribute((const void*)fwd_megakernel, hipFuncAttributeMaxDynamicSharedMemorySize, LDS_BYTES) != hipSuccess) { fprintf(stderr, "kernel_launch: hipFuncSetAttribute failed\n"); grid = -1; return; }
        if (hipOccupancyMaxActiveBlocksPerMultiprocessor(&per_cu, (const void*)fwd_megakernel, NWAVES * 64, LDS_BYTES) != hipSuccess || per_cu < 1) { fprintf(stderr, "kernel_launch: occupancy query says %d\n", per_cu); (void)hipGetLastError(); grid = -1; return; }
        grid = cus;
    }
    if (grid < 0) return;
    (void)hipMemsetAsync((char*)d_ws + WS_CTL, 0, CTL_ZERO_BYTES, stream);
    Args a{};
    const float** ap = (const float**)&a;
    for (int i = 0; i < 21; ++i) ap[i] = (const float*)d_in[i];
    a.out = (float*)d_out; a.ws = (unsigned char*)d_ws;
    hipLaunchKernelGGL(fwd_megakernel, dim3(grid), dim3(NWAVES * 64), LDS_BYTES, stream, a);
    const hipError_t le = hipPeekAtLastError();
    if (le != hipSuccess) fprintf(stderr, "kernel_launch: launch failed: %s (grid %d)\n", hipGetErrorName(le), grid);
}
```

```cpp
#include <hip/hip_runtime.h>
#include <hip/hip_bf16.h>
#include <hip/hip_cooperative_groups.h>
#include <cstdio>
#include <cstdint>
#include <cmath>
namespace cg = cooperative_groups;

constexpr int NB = 16, SEQ = 2048, CTXL = 256, DM_ = 1024, RPB = SEQ + CTXL  ;
constexpr int MR = NB * RPB  , ML = NB * SEQ  , INC = 5376, NMOD = 6 * DM_;
constexpr int NE = 16, CAP = 256, EFF = 1024;
constexpr float EPS = 1e-6f;
constexpr float LOG2E = 1.4426950408889634f;
#ifndef DEBUG_POISON
#define DEBUG_POISON 0
#endif
#ifndef DBG_NOMOE
#define DBG_NOMOE 0
#endif
#ifndef DBG_NOATT
#define DBG_NOATT 0
#endif
#ifndef DBG_NOHG
#define DBG_NOHG 0
#endif
#ifndef DBG_OUT_X
#define DBG_OUT_X 0
#endif
#ifndef DBG_X1_NOY
#define DBG_X1_NOY 0
#endif
#ifndef DBG_P4B_A
#define DBG_P4B_A 0
#endif
#ifndef PHASES
#define PHASES 511
#endif
#ifndef DBG_GA_ONLY
#define DBG_GA_ONLY 0
#endif
#ifndef DBG_DOUBLE_BAR
#define DBG_DOUBLE_BAR 0
#endif
#ifndef DBG_WBL2_TWICE
#define DBG_WBL2_TWICE 0
#endif
#ifndef DBG_LEADER_DELAY
#define DBG_LEADER_DELAY 0
#endif
#ifndef DBG_RELEASE_ALL
#define DBG_RELEASE_ALL 0
#endif
#ifndef PG8_DMA_AUX
#define PG8_DMA_AUX 0
#endif
#ifndef DBG_CHECKS
#define DBG_CHECKS 0
#endif
#ifndef DBG_SYSINV
#define DBG_SYSINV 0
#endif
#ifndef DBG_HG_B
#define DBG_HG_B 15
#endif
#ifndef DBG_ALPHA
#define DBG_ALPHA 1.0f
#endif
#ifndef DBG_ONLYATT
#define DBG_ONLYATT 0
#endif
#ifndef DBG_BETA
#define DBG_BETA 1.0f
#endif
#ifndef DBG_POISON_SET
#define DBG_POISON_SET 0
#endif
#ifndef PG8_USE_DMA
#define PG8_USE_DMA 0
#endif
#ifndef DBG_BARTEST
#define DBG_BARTEST 0
#endif
#ifndef DBG_OUT_BUF
#define DBG_OUT_BUF 0
#endif
#ifndef DBG_TIMING
#define DBG_TIMING 0
#define DBG_TIME_A0 3
#define DBG_TIME_A1 20
#endif
#ifndef REPEAT_PHASE
#define REPEAT_PHASE -1
#endif
#ifndef DBG_TIME_Q
#define DBG_TIME_Q 16u
#endif
#ifndef HG_EXP
#define HG_EXP 0
#endif
#ifndef EPI_EXP
#define EPI_EXP 0
#endif
#ifndef P2_STAGGER_TICKS
#define P2_STAGGER_TICKS 0
#endif
namespace pg8 {
#define PG8_LAS __attribute__((address_space(3)))
typedef unsigned short bf16_t;
typedef short bf16x8 __attribute__((ext_vector_type(8)));
typedef float f32x4 __attribute__((ext_vector_type(4)));
typedef unsigned u32x4 __attribute__((ext_vector_type(4)));
constexpr int BM = 256, BK = 64, HALF = 128, HTB = HALF * BK * 2  , STAGE_BYTES = 8 * HTB, NXCD = 8, WGM = 8;

__host__ __device__ __forceinline__ int lds_byte(int r, int c) { const int st = (r >> 4) * 2 + (c >> 5), rr = r & 15, cc = c & 31, ob = rr * 64 + cc * 2; return st * 1024 + (ob ^ (((ob >> 9) & 1) << 5)); }
__host__ __device__ __forceinline__ void stage_rc(int b, int& R, int& C) { const int st = b / 1024, sb = b % 1024, swz = sb ^ (((sb >> 9) & 1) << 5); R = (st >> 1) * 16 + swz / 64; C = (st & 1) * 32 + (swz % 64) / 2; }
__host__ __device__ __forceinline__ int perm32(int rho) { const int n = rho >> 4, i = rho & 15; return 8 * (i >> 2) + 4 * n + (i & 3); }

struct Unit { int pm, pn; };
struct Gemm { const bf16_t* A; const bf16_t* Bt; int M, N, K; const int* gather; };

struct StaticOrder {
    int nM, nN, nwg, G, c;
    __host__ __device__ void init(int M, int N, int G_, int c_) { nM = M / BM; nN = N / BM; nwg = nM * nN; G = G_; c = c_; }
    __host__ __device__ bool next(int i, Unit& u) const {
        const long L = (long)i * G + c; if (L >= nwg) return false;
        int wgid = (int)L; { const int q = nwg / NXCD, r = nwg % NXCD, xcd = wgid % NXCD, off = wgid / NXCD; wgid = (xcd < r ? xcd * (q + 1) : r * (q + 1) + (xcd - r) * q) + off; }
        const int nig = WGM * nN, gid = wgid / nig, fm = gid * WGM, gsz = (nM - fm) < WGM ? (nM - fm) : WGM;
        u.pm = fm + ((wgid % nig) % gsz); u.pn = (wgid % nig) / gsz; return true;
    }
    __device__ __forceinline__ void a_ready(const Unit&) const {}
    __device__ __forceinline__ void done(const Unit&) const {}
};

typedef float f32x2_c __attribute__((ext_vector_type(2))); typedef __bf16 bf16x2_c __attribute__((ext_vector_type(2)));
__device__ __forceinline__ unsigned cvt_pk_bf16(float lo, float hi) { const f32x2_c v = {lo, hi}; return __builtin_bit_cast(unsigned, __builtin_convertvector(v, bf16x2_c)); }
__device__ __forceinline__ float bf_lo(unsigned u) { return __uint_as_float(u << 16); }
__device__ __forceinline__ float bf_hi(unsigned u) { return __uint_as_float(u & 0xffff0000u); }
__device__ __forceinline__ void st8(bf16_t* p, const f32x4 a, const f32x4 b) { u32x4 w; w.x = cvt_pk_bf16(a[0], a[1]); w.y = cvt_pk_bf16(a[2], a[3]); w.z = cvt_pk_bf16(b[0], b[1]); w.w = cvt_pk_bf16(b[2], b[3]); *(u32x4*)p = w; }
__device__ __forceinline__ void ld8(const bf16_t* p, f32x4& a, f32x4& b) { const u32x4 w = *(const u32x4*)p; a = (f32x4){bf_lo(w.x), bf_hi(w.x), bf_lo(w.y), bf_hi(w.y)}; b = (f32x4){bf_lo(w.z), bf_hi(w.z), bf_lo(w.w), bf_hi(w.w)}; }
__device__ __forceinline__ float fsigmoid(float x) { return __builtin_amdgcn_rcpf(1.0f + __builtin_amdgcn_exp2f(-1.4426950408889634f * x)); }
__device__ __forceinline__ f32x4 sig4(const f32x4 v) { return (f32x4){fsigmoid(v[0]), fsigmoid(v[1]), fsigmoid(v[2]), fsigmoid(v[3])}; }
__device__ __forceinline__ f32x4 silu4(const f32x4 v) { return v * sig4(v); }

__device__ __forceinline__ void st8x(bf16_t* p, const f32x4 a, const f32x4 b) { if (!(EPI_EXP & 2) || ((size_t)p & 1)) st8(p, a, b); else { asm volatile("" :: "v"(a), "v"(b)); } }
struct EpiInProj {
    static constexpr bool PERM = true, AFTER_DRAIN = false;
    unsigned char* ws;
    size_t oHQ, oFF, oFB, oHI, oSG, oQ, oK, oV, oGA, oGB, oROPE;
    const float *qg, *kg;
    template <int ACT> __device__ __forceinline__ void plain(const f32x4 (&acc)[2][2][4][2], bf16_t* base, long row0, int pitch, int col0) const {
#pragma unroll
        for (int ai = 0; ai < 2; ++ai)
#pragma unroll
            for (int m = 0; m < 4; ++m) { bf16_t* rowp = base + (row0 + ai * HALF + m * 16) * pitch + col0;
#pragma unroll
                for (int bj = 0; bj < 2; ++bj) { f32x4 v0 = acc[ai][bj][m][0], v1 = acc[ai][bj][m][1];
                    if (ACT == 1) { v0 = silu4(v0); v1 = silu4(v1); } if (ACT == 2) { v0 = sig4(v0); v1 = sig4(v1); }
                    st8x(rowp + bj * HALF, v0, v1); } }
    }
    __device__ __forceinline__ void gate8(const f32x4 (&acc)[2][2][4][2], unsigned char* base, long row0, int col0) const {
#pragma unroll
        for (int ai = 0; ai < 2; ++ai)
#pragma unroll
            for (int m = 0; m < 4; ++m) { unsigned char* rowp = base + (row0 + ai * HALF + m * 16) * 1024 + col0;
#pragma unroll
                for (int bj = 0; bj < 2; ++bj) { const f32x4 v0 = sig4(acc[ai][bj][m][0]) * 255.0f, v1 = sig4(acc[ai][bj][m][1]) * 255.0f;
                    unsigned w0 = 0, w1 = 0;
                    w0 = __builtin_amdgcn_cvt_pk_u8_f32(v0[0], 0, w0); w0 = __builtin_amdgcn_cvt_pk_u8_f32(v0[1], 1, w0); w0 = __builtin_amdgcn_cvt_pk_u8_f32(v0[2], 2, w0); w0 = __builtin_amdgcn_cvt_pk_u8_f32(v0[3], 3, w0);
                    w1 = __builtin_amdgcn_cvt_pk_u8_f32(v1[0], 0, w1); w1 = __builtin_amdgcn_cvt_pk_u8_f32(v1[1], 1, w1); w1 = __builtin_amdgcn_cvt_pk_u8_f32(v1[2], 2, w1); w1 = __builtin_amdgcn_cvt_pk_u8_f32(v1[3], 3, w1);
                    *(unsigned long long*)(rowp + bj * HALF) = (unsigned long long)w0 | ((unsigned long long)w1 << 32); } }
    }
    __device__ __forceinline__ void qk(const f32x4 (&acc)[2][2][4][2], bf16_t* base, long row0, int pitch, int col0, const float* gain, bool do_rope, int t0, float oscale, int fq) const {
        const float* rope = (const float*)(ws + oROPE);
        f32x4 gv[2][2];
#pragma unroll
        for (int bj = 0; bj < 2; ++bj)
#pragma unroll
            for (int n = 0; n < 2; ++n) gv[bj][n] = *(const f32x4*)(gain + 32 * bj + 16 * n + 4 * fq);
        f32x4 cc[4], sc[4], cr[2], sr[2];
        if (do_rope) {
#pragma unroll
            for (int m = 0; m < 4; ++m) { const int pos = (t0 + m * 16) & 63; cc[m] = *(const f32x4*)(rope + pos * 32 + 4 * fq); sc[m] = *(const f32x4*)(rope + pos * 32 + 16 + 4 * fq); }
#pragma unroll
            for (int ai = 0; ai < 2; ++ai) { const int pos = (t0 + ai * HALF) >> 6; cr[ai] = *(const f32x4*)(rope + pos * 32 + 4 * fq); sr[ai] = *(const f32x4*)(rope + pos * 32 + 16 + 4 * fq); }
        } else {
#pragma unroll
            for (int m = 0; m < 4; ++m) { cc[m] = (f32x4){1.f, 1.f, 1.f, 1.f}; sc[m] = (f32x4){0.f, 0.f, 0.f, 0.f}; }
#pragma unroll
            for (int ai = 0; ai < 2; ++ai) { cr[ai] = (f32x4){1.f, 1.f, 1.f, 1.f}; sr[ai] = (f32x4){0.f, 0.f, 0.f, 0.f}; }
        }
#pragma unroll
        for (int ai = 0; ai < 2; ++ai)
#pragma unroll
            for (int m = 0; m < 4; ++m) {
                float ss = 0.f;
#pragma unroll
                for (int bj = 0; bj < 2; ++bj)
#pragma unroll
                    for (int n = 0; n < 2; ++n) { const f32x4 x = acc[ai][bj][m][n]; ss += (x[0] * x[0] + x[1] * x[1]) + (x[2] * x[2] + x[3] * x[3]); }
                ss += __shfl_xor(ss, 16); ss += __shfl_xor(ss, 32);
                const float rstd = 1.0f / sqrtf(ss * (1.0f / 64.0f) + 1e-6f);
                bf16_t* rowp = base + (row0 + ai * HALF + m * 16) * pitch + col0;
#pragma unroll
                for (int bj = 0; bj < 2; ++bj) {
                    const f32x4 x1 = acc[ai][bj][m][0] * rstd * gv[bj][0], x2 = acc[ai][bj][m][1] * rstd * gv[bj][1];
                    const f32x4 c = bj ? cc[m] : cr[ai], s = bj ? sc[m] : sr[ai];
                    const f32x4 o1 = x1 * c - x2 * s, o2 = x2 * c + x1 * s;
                    st8x(rowp + bj * 32, o1 * oscale, o2 * oscale); }
            }
    }
    __device__ __forceinline__ void operator()(const f32x4 (&acc)[2][2][4][2], const Unit& u, int wr, int wc, int fr_, int fq_) const {
        int fr = fr_, fq = fq_; asm volatile("" : "+v"(fr), "+v"(fq));
        if (EPI_EXP & 1) return;
        const int pn = u.pn, bb = u.pm / 9, jt = u.pm - bb * 9;
        const int rloc = wr * 64 + fr;
        const long r0 = (long)u.pm * BM + rloc;
        const long rl0 = (long)bb * 2048 + (jt - 1) * 256 + rloc;
        const int c8 = wc * 32 + 8 * fq;
        if (pn < 2)        plain<0>(acc, (bf16_t*)(ws + oHQ), rl0, 512, pn * 256 + c8);
        else if (pn < 4)   plain<0>(acc, (bf16_t*)(ws + oFF), r0, 512, (pn - 2) * 256 + c8);
        else if (pn < 6)   plain<0>(acc, (bf16_t*)(ws + oFB), r0, 512, (pn - 4) * 256 + c8);
        else if (pn < 8)   plain<0>(acc, (bf16_t*)(ws + oHI), r0, 512, (pn - 6) * 256 + c8);
        else if (pn < 10)  plain<1>(acc, (bf16_t*)(ws + oSG), rl0, 512, (pn - 8) * 256 + c8);
        else if (pn < 12)  qk(acc, (bf16_t*)(ws + oQ), rl0, 512, ((pn - 10) * 4 + wc) * 64 + 8 * fq, qg, true, (jt - 1) * 256 + rloc, 0.125f * 1.4426950408889634f, fq);
        else if (pn == 12) {
            if (wc < 2)    qk(acc, (bf16_t*)(ws + oK), r0, 128, wc * 64 + 8 * fq, kg, jt >= 1, (jt - 1) * 256 + rloc, 1.0f, fq);
            else {
#pragma unroll
                for (int ai = 0; ai < 2; ++ai)
#pragma unroll
                    for (int m = 0; m < 4; ++m) { bf16_t* rowp = (bf16_t*)(ws + oV) + (r0 + ai * HALF + m * 16) * 128 + (wc - 2) * 64 + 8 * fq;
#pragma unroll
                        for (int bj = 0; bj < 2; ++bj) st8x(rowp + bj * 32, acc[ai][bj][m][0], acc[ai][bj][m][1]); }
            }
        }
        else if (pn < 17)  gate8(acc, ws + oGA, rl0, (pn - 13) * 256 + c8);
        else               gate8(acc, ws + oGB, rl0, (pn - 17) * 256 + c8);
    }
};

template <int SECOND> struct EpiZ {
    static constexpr bool PERM = true, AFTER_DRAIN = false;
    bf16_t* Z; const unsigned char* G;
    __device__ __forceinline__ void ld(int ai, int mh, long row0, int col0, unsigned long long (&gw)[2][2], u32x4 (&zw)[2][2]) const {
#pragma unroll
        for (int mm = 0; mm < 2; ++mm)
#pragma unroll
            for (int bj = 0; bj < 2; ++bj) { const long off = (row0 + ai * HALF + (2 * mh + mm) * 16) * 1024 + col0 + bj * HALF;
                gw[mm][bj] = *(const unsigned long long*)(G + off); if (SECOND) zw[mm][bj] = *(const u32x4*)(Z + off); }
    }
    __device__ __forceinline__ void proc(const f32x4 (&acc)[2][2][4][2], int ai, int mh, long row0, int col0, const unsigned long long (&gw)[2][2], const u32x4 (&zw)[2][2]) const {
#pragma unroll
        for (int mm = 0; mm < 2; ++mm)
#pragma unroll
            for (int bj = 0; bj < 2; ++bj) { const int m = 2 * mh + mm; const long off = (row0 + ai * HALF + m * 16) * 1024 + col0 + bj * HALF;
                const unsigned wl = (unsigned)gw[mm][bj], wh = (unsigned)(gw[mm][bj] >> 32);
                const f32x4 g0 = (f32x4){(float)(wl & 255u), (float)((wl >> 8) & 255u), (float)((wl >> 16) & 255u), (float)(wl >> 24)} * (1.0f / 255.0f), g1 = (f32x4){(float)(wh & 255u), (float)((wh >> 8) & 255u), (float)((wh >> 16) & 255u), (float)(wh >> 24)} * (1.0f / 255.0f);
                f32x4 v0 = acc[ai][bj][m][0] * g0, v1 = acc[ai][bj][m][1] * g1;
                if (SECOND) { const u32x4 z = zw[mm][bj]; v0 += (f32x4){bf_lo(z.x), bf_hi(z.x), bf_lo(z.y), bf_hi(z.y)}; v1 += (f32x4){bf_lo(z.z), bf_hi(z.z), bf_lo(z.w), bf_hi(z.w)}; }
                st8(Z + off, v0, v1); }
    }
    __device__ __forceinline__ void operator()(const f32x4 (&acc)[2][2][4][2], const Unit& u, int wr, int wc, int fr_, int fq_) const {
        int fr = fr_, fq = fq_; asm volatile("" : "+v"(fr), "+v"(fq));
        const long row0 = (long)u.pm * BM + wr * 64 + fr; const int col0 = u.pn * BM + wc * 32 + 8 * fq;
        unsigned long long gA[2][2], gB[2][2]; u32x4 zA[2][2], zB[2][2];
        ld(0, 0, row0, col0, gA, zA);
        ld(0, 1, row0, col0, gB, zB); proc(acc, 0, 0, row0, col0, gA, zA);
        ld(1, 0, row0, col0, gA, zA); proc(acc, 0, 1, row0, col0, gB, zB);
        ld(1, 1, row0, col0, gB, zB); proc(acc, 1, 0, row0, col0, gA, zA);
        proc(acc, 1, 1, row0, col0, gB, zB);
    }
};
struct EpiZ2 {
    static constexpr bool PERM = true, AFTER_DRAIN = false;
    bf16_t* Z; const unsigned char* GA; const unsigned char* GB;
    __device__ __forceinline__ static void dec8(unsigned long long w, f32x4& lo, f32x4& hi) { const unsigned wl = (unsigned)w, wh = (unsigned)(w >> 32);
        lo = (f32x4){(float)(wl & 255u), (float)((wl >> 8) & 255u), (float)((wl >> 16) & 255u), (float)(wl >> 24)}; hi = (f32x4){(float)(wh & 255u), (float)((wh >> 8) & 255u), (float)((wh >> 16) & 255u), (float)(wh >> 24)}; }
    __device__ __forceinline__ void mid(f32x4 (&acc)[2][2][4][2], const Unit& u, int wr, int wc, int fr_, int fq_) const {
        int fr = fr_, fq = fq_; asm volatile("" : "+v"(fr), "+v"(fq));
        const long row0 = (long)u.pm * BM + wr * 64 + fr; const int col0 = u.pn * BM + wc * 32 + 8 * fq;
#pragma unroll
        for (int ai = 0; ai < 2; ++ai)
#pragma unroll
            for (int mh = 0; mh < 2; ++mh) {
                unsigned long long ga[2][2], gb[2][2];
#pragma unroll
                for (int mm = 0; mm < 2; ++mm)
#pragma unroll
                    for (int bj = 0; bj < 2; ++bj) { const long off = (row0 + ai * HALF + (2 * mh + mm) * 16) * 1024 + col0 + bj * HALF; ga[mm][bj] = *(const unsigned long long*)(GA + off); gb[mm][bj] = *(const unsigned long long*)(GB + off); }
#pragma unroll
                for (int mm = 0; mm < 2; ++mm)
#pragma unroll
                    for (int bj = 0; bj < 2; ++bj) { const int m = 2 * mh + mm; f32x4 a0, a1, b0, b1; dec8(ga[mm][bj], a0, a1); dec8(gb[mm][bj], b0, b1);
#pragma unroll
                        for (int j = 0; j < 4; ++j) { a0[j] *= __builtin_amdgcn_rcpf(fmaxf(b0[j], 1.0f)); a1[j] *= __builtin_amdgcn_rcpf(fmaxf(b1[j], 1.0f)); }
                        acc[ai][bj][m][0] = acc[ai][bj][m][0] * a0; acc[ai][bj][m][1] = acc[ai][bj][m][1] * a1; }
            }
    }
    __device__ __forceinline__ void operator()(const f32x4 (&acc)[2][2][4][2], const Unit& u, int wr, int wc, int fr_, int fq_) const {
        int fr = fr_, fq = fq_; asm volatile("" : "+v"(fr), "+v"(fq));
        const long row0 = (long)u.pm * BM + wr * 64 + fr; const int col0 = u.pn * BM + wc * 32 + 8 * fq;
#pragma unroll
        for (int ai = 0; ai < 2; ++ai)
#pragma unroll
            for (int mh = 0; mh < 2; ++mh) {
                unsigned long long gb[2][2];
#pragma unroll
                for (int mm = 0; mm < 2; ++mm)
#pragma unroll
                    for (int bj = 0; bj < 2; ++bj) gb[mm][bj] = *(const unsigned long long*)(GB + (row0 + ai * HALF + (2 * mh + mm) * 16) * 1024 + col0 + bj * HALF);
#pragma unroll
                for (int mm = 0; mm < 2; ++mm)
#pragma unroll
                    for (int bj = 0; bj < 2; ++bj) { const int m = 2 * mh + mm; f32x4 b0, b1; dec8(gb[mm][bj], b0, b1);
#pragma unroll
                        for (int j = 0; j < 4; ++j) { b0[j] = fmaxf(b0[j], 1.0f) * (1.0f / 255.0f); b1[j] = fmaxf(b1[j], 1.0f) * (1.0f / 255.0f); }
                        st8(Z + (row0 + ai * HALF + m * 16) * 1024 + col0 + bj * HALF, acc[ai][bj][m][0] * b0, acc[ai][bj][m][1] * b1); }
            }
    }
};
struct EpiX1 {
    static constexpr bool PERM = false, AFTER_DRAIN = false;
    const float* x; const float* mod; bf16_t* out;
    __device__ __forceinline__ void ld(int ai, int mh, long row0, int col0, f32x4 (&xv)[2][2][2]) const {
#pragma unroll
        for (int mm = 0; mm < 2; ++mm)
#pragma unroll
            for (int bj = 0; bj < 2; ++bj)
#pragma unroll
                for (int n = 0; n < 2; ++n) xv[mm][bj][n] = *(const f32x4*)(x + (row0 + ai * HALF + (2 * mh + mm) * 16) * 1024 + col0 + bj * HALF + n * 16);
    }
    __device__ __forceinline__ void proc(const f32x4 (&acc)[2][2][4][2], int ai, int mh, long row0, int col0, const f32x4 (&xv)[2][2][2], const f32x4 (&gv)[2][2]) const {
#pragma unroll
        for (int mm = 0; mm < 2; ++mm)
#pragma unroll
            for (int bj = 0; bj < 2; ++bj)
#pragma unroll
                for (int n = 0; n < 2; ++n) { const int m = 2 * mh + mm; const f32x4 o = xv[mm][bj][n] + gv[bj][n] * acc[ai][bj][m][n];
                    unsigned w0 = cvt_pk_bf16(o[0], o[1]), w1 = cvt_pk_bf16(o[2], o[3]);
                    *(unsigned long long*)(out + (row0 + ai * HALF + m * 16) * 1024 + col0 + bj * HALF + n * 16) = (unsigned long long)w0 | ((unsigned long long)w1 << 32); }
    }
    __device__ __forceinline__ void operator()(const f32x4 (&acc)[2][2][4][2], const Unit& u, int wr, int wc, int fr_, int fq_) const {
        int fr = fr_, fq = fq_; asm volatile("" : "+v"(fr), "+v"(fq));
        const long row0 = (long)u.pm * BM + wr * 64 + fr; const int col0 = u.pn * BM + wc * 32 + 4 * fq; const int b = u.pm >> 3;
        f32x4 gv[2][2];
#pragma unroll
        for (int bj = 0; bj < 2; ++bj)
#pragma unroll
            for (int n = 0; n < 2; ++n) gv[bj][n] = *(const f32x4*)(mod + (size_t)b * 6144 + 2048 + col0 + bj * HALF + n * 16);
        f32x4 xA[2][2][2], xB[2][2][2];
        ld(0, 0, row0, col0, xA);
        ld(0, 1, row0, col0, xB); proc(acc, 0, 0, row0, col0, xA, gv);
        ld(1, 0, row0, col0, xA); proc(acc, 0, 1, row0, col0, xB, gv);
        ld(1, 1, row0, col0, xB); proc(acc, 1, 0, row0, col0, xA, gv);
        proc(acc, 1, 1, row0, col0, xB, gv);
    }
};
struct EpiHid {
    static constexpr bool PERM = true, AFTER_DRAIN = false;
    bf16_t* H;
    __device__ __forceinline__ void operator()(const f32x4 (&acc)[2][2][4][2], const Unit& u, int wr, int wc, int fr, int fq) const {
        const int row0 = wr * 64 + fr, col0 = u.pn * HALF + wc * 32 + 8 * fq;
#pragma unroll
        for (int ai = 0; ai < 2; ++ai)
#pragma unroll
            for (int m = 0; m < 4; ++m) st8(H + (size_t)(row0 + ai * HALF + m * 16) * 1024 + col0, silu4(acc[ai][0][m][0]) * acc[ai][1][m][0], silu4(acc[ai][0][m][1]) * acc[ai][1][m][1]);
    }
};
struct EpiHidQ {
    static constexpr bool PERM = true, AFTER_DRAIN = false;
    bf16_t* H; const float* scl; const float* tq;
    __device__ __forceinline__ static f32x4 cvt4(const f32x4 a) { return (f32x4){(float)__float_as_int(a[0]), (float)__float_as_int(a[1]), (float)__float_as_int(a[2]), (float)__float_as_int(a[3])}; }
    __device__ __forceinline__ void operator()(const f32x4 (&acc)[2][2][4][2], const Unit& u, int wr, int wc, int fr, int fq) const {
        const int row0 = wr * 64 + fr, col0 = u.pn * HALF + wc * 32 + 8 * fq;
        const float* tc = tq + u.pn * BM + wc * 32 + 8 * fq;
        const f32x4 cg0 = *(const f32x4*)(tc), cg1 = *(const f32x4*)(tc + 4), cu0 = *(const f32x4*)(tc + HALF), cu1 = *(const f32x4*)(tc + HALF + 4);
        float sr[2][4];
#pragma unroll
        for (int ai = 0; ai < 2; ++ai)
#pragma unroll
            for (int m = 0; m < 4; ++m) sr[ai][m] = scl[row0 + ai * HALF + m * 16];
#pragma unroll
        for (int ai = 0; ai < 2; ++ai)
#pragma unroll
            for (int m = 0; m < 4; ++m) { const float r = sr[ai][m];
                const f32x4 g0 = cvt4(acc[ai][0][m][0]) * (cg0 * r), g1 = cvt4(acc[ai][0][m][1]) * (cg1 * r), u0 = cvt4(acc[ai][1][m][0]) * (cu0 * r), u1 = cvt4(acc[ai][1][m][1]) * (cu1 * r);
                st8(H + (size_t)(row0 + ai * HALF + m * 16) * 1024 + col0, silu4(g0) * u0, silu4(g1) * u1); }
    }
};
struct EpiInProjQ {
    static constexpr bool PERM = true, AFTER_DRAIN = false;
    EpiInProj base; const float* rs; const float* cs;
    __device__ __forceinline__ void operator()(const f32x4 (&acc_)[2][2][4][2], const Unit& u, int wr, int wc, int fr_, int fq_) const {
        int fr = fr_, fq = fq_; asm volatile("" : "+v"(fr), "+v"(fq));
        f32x4 (&acc)[2][2][4][2] = const_cast<f32x4 (&)[2][2][4][2]>(acc_);
        const float* rp = rs + (size_t)u.pm * BM + wr * 64 + fr; const float* cp = cs + u.pn * BM + wc * 32 + 8 * fq;
        f32x4 c4[2][2]; float r8[2][4];
#pragma unroll
        for (int bj = 0; bj < 2; ++bj)
#pragma unroll
            for (int n = 0; n < 2; ++n) c4[bj][n] = *(const f32x4*)(cp + bj * HALF + 4 * n);
#pragma unroll
        for (int ai = 0; ai < 2; ++ai)
#pragma unroll
            for (int m = 0; m < 4; ++m) r8[ai][m] = rp[ai * HALF + m * 16];
#pragma unroll
        for (int ai = 0; ai < 2; ++ai)
#pragma unroll
            for (int bj = 0; bj < 2; ++bj)
#pragma unroll
                for (int m = 0; m < 4; ++m)
#pragma unroll
                    for (int n = 0; n < 2; ++n) acc[ai][bj][m][n] = EpiHidQ::cvt4(acc[ai][bj][m][n]) * (c4[bj][n] * r8[ai][m]);
        base(acc, u, wr, wc, fr, fq);
    }
};
constexpr float YE_F8_SCALE = 32.0f;
struct EpiYe {
    static constexpr bool PERM = true, AFTER_DRAIN = false;
    unsigned char* Y; const float* gate;
    __device__ __forceinline__ void operator()(const f32x4 (&acc)[2][2][4][2], const Unit& u, int wr, int wc, int fr, int fq) const {
        const int row0 = wr * 64 + fr, col0 = u.pn * BM + wc * 32 + 8 * fq;
        float gt[2][4];
#pragma unroll
        for (int ai = 0; ai < 2; ++ai)
#pragma unroll
            for (int m = 0; m < 4; ++m) gt[ai][m] = gate[row0 + ai * HALF + m * 16];
#pragma unroll
        for (int ai = 0; ai < 2; ++ai)
#pragma unroll
            for (int m = 0; m < 4; ++m) { const int r = row0 + ai * HALF + m * 16;
#pragma unroll
                for (int bj = 0; bj < 2; ++bj) { const f32x4 a = acc[ai][bj][m][0] * (gt[ai][m] * YE_F8_SCALE), b = acc[ai][bj][m][1] * (gt[ai][m] * YE_F8_SCALE);
                    int w0 = __builtin_amdgcn_cvt_pk_fp8_f32(a[0], a[1], 0, false); w0 = __builtin_amdgcn_cvt_pk_fp8_f32(a[2], a[3], w0, true);
                    int w1 = __builtin_amdgcn_cvt_pk_fp8_f32(b[0], b[1], 0, false); w1 = __builtin_amdgcn_cvt_pk_fp8_f32(b[2], b[3], w1, true);
                    *(unsigned long long*)(Y + (size_t)r * 1024 + col0 + bj * HALF) = (unsigned long long)(unsigned)w0 | ((unsigned long long)(unsigned)w1 << 32); } }
    }
};
struct EpiYeQ {
    static constexpr bool PERM = true, AFTER_DRAIN = false;
    unsigned char* Y; const float* gate; const float* rs; const float* td;
    __device__ __forceinline__ void operator()(const f32x4 (&acc)[2][2][4][2], const Unit& u, int wr, int wc, int fr, int fq) const {
        const int row0 = wr * 64 + fr, col0 = u.pn * BM + wc * 32 + 8 * fq;
        const float* tc = td + col0;
        f32x4 c4[2][2];
#pragma unroll
        for (int bj = 0; bj < 2; ++bj)
#pragma unroll
            for (int n = 0; n < 2; ++n) c4[bj][n] = *(const f32x4*)(tc + bj * HALF + 4 * n);
        float gt[2][4];
#pragma unroll
        for (int ai = 0; ai < 2; ++ai)
#pragma unroll
            for (int m = 0; m < 4; ++m) gt[ai][m] = gate[row0 + ai * HALF + m * 16] * rs[row0 + ai * HALF + m * 16] * YE_F8_SCALE;
#pragma unroll
        for (int ai = 0; ai < 2; ++ai)
#pragma unroll
            for (int m = 0; m < 4; ++m) { const int r = row0 + ai * HALF + m * 16;
#pragma unroll
                for (int bj = 0; bj < 2; ++bj) { f32x4 a = EpiHidQ::cvt4(acc[ai][bj][m][0]) * (c4[bj][0] * gt[ai][m]), b = EpiHidQ::cvt4(acc[ai][bj][m][1]) * (c4[bj][1] * gt[ai][m]);
#pragma unroll
                    for (int j = 0; j < 4; ++j) { a[j] = __builtin_amdgcn_fmed3f(a[j], -440.0f, 440.0f); b[j] = __builtin_amdgcn_fmed3f(b[j], -440.0f, 440.0f); }
                    int w0 = __builtin_amdgcn_cvt_pk_fp8_f32(a[0], a[1], 0, false); w0 = __builtin_amdgcn_cvt_pk_fp8_f32(a[2], a[3], w0, true);
                    int w1 = __builtin_amdgcn_cvt_pk_fp8_f32(b[0], b[1], 0, false); w1 = __builtin_amdgcn_cvt_pk_fp8_f32(b[2], b[3], w1, true);
                    *(unsigned long long*)(Y + (size_t)r * 1024 + col0 + bj * HALF) = (unsigned long long)(unsigned)w0 | ((unsigned long long)(unsigned)w1 << 32); } }
    }
};
struct InProjOrder {
    StaticOrder so;
    __device__ void init(int G_, int c_) { so.init(ML, INC, G_, c_); }
    __device__ bool next(int i, Unit& u) const {
#if DBG_GA_ONLY
        { const long L = (long)i * so.G + so.c; if (L >= 512) return false; u.pm = (int)(L >> 2); u.pn = 13 + (int)(L & 3); u.pm = (u.pm >> 3) * 9 + 1 + (u.pm & 7); return true; }
#endif
        if (so.next(i, u)) { u.pm = (u.pm >> 3) * 9 + 1 + (u.pm & 7); return true; }
        const long L = (long)i * so.G + so.c - so.nwg; if (L >= 16 * 7) return false;
        const int cb = (int)L / 7, k = (int)L % 7; u.pm = cb * 9; u.pn = k < 6 ? 2 + k : 12; return true;
    }
    __device__ __forceinline__ void a_ready(const Unit&) const {}
    __device__ __forceinline__ void done(const Unit&) const {}
};
struct LocalOrder {
    int n;
    __device__ bool next(int i, Unit& u) const { if (i >= n) return false; u.pm = 0; u.pn = i; return true; }
    __device__ __forceinline__ void a_ready(const Unit&) const {}
    __device__ __forceinline__ void done(const Unit&) const {}
};
typedef int i32x4_pg8 __attribute__((ext_vector_type(4)));
template <bool I8> __device__ __forceinline__ f32x4 mma16(const bf16x8 b, const bf16x8 a, const f32x4 c) {
    if constexpr (I8) return __builtin_bit_cast(f32x4, __builtin_amdgcn_mfma_i32_16x16x64_i8(__builtin_bit_cast(i32x4_pg8, b), __builtin_bit_cast(i32x4_pg8, a), __builtin_bit_cast(i32x4_pg8, c), 0, 0, 0));
    else return __builtin_amdgcn_mfma_f32_16x16x32_bf16(b, a, c, 0, 0, 0);
}
template <class Epi, class Sched, bool ALIGN_EPI = false, bool SP2 = false, bool I8 = false, bool MID = false>
__device__ __forceinline__ void gemm_phase(PG8_LAS unsigned char* lds, const Gemm g, const Sched& S, const Epi& E) {
    int tid_ = threadIdx.x; asm volatile("" : "+v"(tid_));
    const int tid = tid_, wid = __builtin_amdgcn_readfirstlane(tid >> 6), lane = tid & 63, wr = wid >> 2, wc = wid & 3, fr = lane & 15, fq = lane >> 4;
    const int K = g.K, nt = K / BK;
    unsigned voffA[2], voffA1[2], voffB[2];
#pragma unroll
    for (int i = 0; i < 2; ++i) { int R, C; stage_rc(tid * 16 + i * 8192, R, C); const int Rb = Epi::PERM ? ((R & ~31) + perm32(R & 31)) : R;
        if (g.gather) { voffA[i] = ((unsigned)g.gather[R] * (unsigned)K + (unsigned)C) * 2u; voffA1[i] = ((unsigned)g.gather[R + HALF] * (unsigned)K + (unsigned)C) * 2u; }
        else { voffA[i] = (unsigned)(R * K + C) * 2u; voffA1[i] = voffA[i] + (unsigned)(HALF * K * 2); }
        voffB[i] = (unsigned)(Rb * K + C) * 2u; }
    const size_t kstep = (size_t)(BK * 2);
    const size_t hstep = (size_t)HALF * K * 2;
    const size_t tstep = 2 * hstep;
    const unsigned ldsw = (unsigned)wid * 1024u;
    const int aoff = lds_byte(wr * 64 + fr, fq * 8), boff = lds_byte(wc * 32 + fr, fq * 8);
#define PG8_SA(b, h) (((b) * 2 + (h)) * HTB)
#define PG8_SB(b, h) ((4 + (b) * 2 + (h)) * HTB)
#define PG8_STAGE(bufoff, gbase, voff) do { _Pragma("unroll") for (int _i = 0; _i < 2; ++_i) \
        __builtin_amdgcn_global_load_lds((const unsigned*)((const char*)(gbase) + (voff)[_i]), (PG8_LAS unsigned*)(lds + (bufoff) + ldsw + _i * 8192), 16, 0, PG8_DMA_AUX); } while (0)
#define PG8_LDA(dst, b, h) do { _Pragma("unroll") for (int m = 0; m < 4; ++m) _Pragma("unroll") for (int k = 0; k < 2; ++k) dst[m][k] = *(const PG8_LAS bf16x8*)(lds + PG8_SA(b, h) + aoff + m * 2048 + k * 1024); } while (0)
#define PG8_LDB(dst, b, h) do { _Pragma("unroll") for (int n = 0; n < 2; ++n) _Pragma("unroll") for (int k = 0; k < 2; ++k) dst[n][k] = *(const PG8_LAS bf16x8*)(lds + PG8_SB(b, h) + boff + n * 2048 + k * 1024); } while (0)
#define PG8_MMA(ai, bj, At, Bt) do { __builtin_amdgcn_s_setprio(1); _Pragma("unroll") for (int m = 0; m < 4; ++m) _Pragma("unroll") for (int n = 0; n < 2; ++n) _Pragma("unroll") for (int k = 0; k < 2; ++k) \
        acc[ai][bj][m][n] = mma16<I8>(Bt[n][k], At[m][k], acc[ai][bj][m][n]); __builtin_amdgcn_s_setprio(0); } while (0)
#define PG8_WAIT_V(n) asm volatile("s_waitcnt vmcnt(" #n ")" ::: "memory")
#define PG8_WAIT_L(n) asm volatile("s_waitcnt lgkmcnt(" #n ")" ::: "memory")
#define PG8_BAR __builtin_amdgcn_s_barrier()
#define PG8_SCHED __builtin_amdgcn_sched_barrier(0)
    Unit cur, nxt; int ui = 0;
    if (!S.next(0, cur)) return;
    f32x4 acc[2][2][4][2];
#pragma unroll
    for (int a = 0; a < 2; ++a)
#pragma unroll
        for (int b = 0; b < 2; ++b)
#pragma unroll
            for (int m = 0; m < 4; ++m)
#pragma unroll
                for (int n = 0; n < 2; ++n) acc[a][b][m][n] = (f32x4){0.f, 0.f, 0.f, 0.f};
    bf16x8 At[4][2], B0[2][2], B1[2][2];
    const char* cA = (const char*)g.A + (size_t)cur.pm * tstep; const char* cB = (const char*)g.Bt + (size_t)cur.pn * tstep;
    S.a_ready(cur);
    if constexpr (SP2) {
        PG8_STAGE(PG8_SB(0, 0), cB, voffB); PG8_STAGE(PG8_SB(0, 1), cB + hstep, voffB); PG8_STAGE(PG8_SA(0, 0), cA, voffA); PG8_STAGE(PG8_SA(0, 1), cA, voffA1);
        if (wr == 1) PG8_BAR;
        PG8_WAIT_V(2); PG8_BAR;
        PG8_STAGE(PG8_SB(1, 0), cB + kstep, voffB); PG8_STAGE(PG8_SA(1, 0), cA + kstep, voffA); PG8_STAGE(PG8_SB(1, 1), cB + hstep + kstep, voffB);
        PG8_WAIT_V(6); PG8_BAR;
    } else {
        PG8_STAGE(PG8_SB(0, 0), cB, voffB); PG8_STAGE(PG8_SA(0, 0), cA, voffA); PG8_STAGE(PG8_SB(0, 1), cB + hstep, voffB); PG8_STAGE(PG8_SA(0, 1), cA, voffA1);
        if (wr == 1) PG8_BAR;
        PG8_WAIT_V(4); PG8_BAR;
        PG8_STAGE(PG8_SB(1, 0), cB + kstep, voffB); PG8_STAGE(PG8_SA(1, 0), cA + kstep, voffA); PG8_STAGE(PG8_SB(1, 1), cB + hstep + kstep, voffB);
        PG8_WAIT_V(6); PG8_BAR;
    }
    for (;;) {
        const bool has_next = S.next(ui + 1, nxt);
        const char* nA = has_next ? (const char*)g.A + (size_t)nxt.pm * tstep : cA; const char* nB = has_next ? (const char*)g.Bt + (size_t)nxt.pn * tstep : cB;
        for (int t = 0; t < nt; t += 2) {
            const bool last = (t == nt - 2);
            const char* a1 = cA + (size_t)(t + 1) * kstep;
            const char* a2 = last ? nA : cA + (size_t)(t + 2) * kstep; const char* b2 = last ? nB : cB + (size_t)(t + 2) * kstep;
            const char* a3 = a2 + kstep; const char* b3 = b2 + kstep;
            if (last && has_next) S.a_ready(nxt);
            if constexpr (MID) { if (t == nt / 2) E.mid(acc, cur, wr, wc, fr, fq); }
            if constexpr (SP2) {
            PG8_LDB(B0, 0, 0); PG8_LDB(B1, 0, 1); PG8_SCHED; PG8_LDA(At, 0, 0); PG8_STAGE(PG8_SA(1, 1), a1, voffA1);
            PG8_WAIT_V(8); PG8_WAIT_L(0); PG8_BAR; PG8_MMA(0, 0, At, B0); PG8_MMA(0, 1, At, B1); PG8_BAR; PG8_SCHED;
            PG8_LDA(At, 0, 1); PG8_STAGE(PG8_SB(0, 0), b2, voffB); PG8_STAGE(PG8_SB(0, 1), b2 + hstep, voffB); PG8_STAGE(PG8_SA(0, 0), a2, voffA);
            PG8_WAIT_V(8); PG8_WAIT_L(0); PG8_BAR; PG8_MMA(1, 0, At, B0); PG8_MMA(1, 1, At, B1); PG8_BAR; PG8_SCHED;
            PG8_LDB(B0, 1, 0); PG8_LDB(B1, 1, 1); PG8_SCHED; PG8_LDA(At, 1, 0); PG8_STAGE(PG8_SA(0, 1), a2, voffA1);
            PG8_WAIT_V(8); PG8_WAIT_L(0); PG8_BAR; PG8_MMA(0, 0, At, B0); PG8_MMA(0, 1, At, B1); PG8_BAR; PG8_SCHED;
            PG8_LDA(At, 1, 1); PG8_STAGE(PG8_SB(1, 0), b3, voffB); PG8_STAGE(PG8_SB(1, 1), b3 + hstep, voffB); PG8_STAGE(PG8_SA(1, 0), a3, voffA);
            PG8_WAIT_V(8); PG8_WAIT_L(0); PG8_BAR; PG8_MMA(1, 0, At, B0); PG8_MMA(1, 1, At, B1); PG8_BAR; PG8_SCHED;
            } else {
            PG8_LDB(B0, 0, 0); PG8_SCHED; PG8_LDA(At, 0, 0); PG8_STAGE(PG8_SA(1, 1), a1, voffA1);
            PG8_WAIT_L(8); PG8_BAR; PG8_WAIT_L(0); PG8_MMA(0, 0, At, B0); PG8_BAR; PG8_SCHED;
            PG8_LDB(B1, 0, 1); PG8_STAGE(PG8_SB(0, 0), b2, voffB);
            PG8_BAR; PG8_WAIT_L(0); PG8_MMA(0, 1, At, B1); PG8_BAR;
            PG8_LDA(At, 0, 1); PG8_STAGE(PG8_SA(0, 0), a2, voffA);
            PG8_BAR; PG8_WAIT_L(0); PG8_MMA(1, 0, At, B0); PG8_BAR; PG8_SCHED;
            PG8_STAGE(PG8_SB(0, 1), b2 + hstep, voffB);
            PG8_WAIT_V(6); PG8_BAR; PG8_MMA(1, 1, At, B1); PG8_BAR;
            PG8_LDB(B0, 1, 0); PG8_SCHED; PG8_LDA(At, 1, 0); PG8_STAGE(PG8_SA(0, 1), a2, voffA1);
            PG8_WAIT_L(8); PG8_BAR; PG8_WAIT_L(0); PG8_MMA(0, 0, At, B0); PG8_BAR; PG8_SCHED;
            PG8_LDB(B1, 1, 1); PG8_STAGE(PG8_SB(1, 0), b3, voffB);
            PG8_BAR; PG8_WAIT_L(0); PG8_MMA(0, 1, At, B1); PG8_BAR;
            PG8_LDA(At, 1, 1); PG8_STAGE(PG8_SA(1, 0), a3, voffA);
            PG8_BAR; PG8_WAIT_L(0); PG8_MMA(1, 0, At, B0); PG8_BAR; PG8_SCHED;
            PG8_STAGE(PG8_SB(1, 1), b3 + hstep, voffB);
            PG8_WAIT_V(6); PG8_BAR; PG8_MMA(1, 1, At, B1); PG8_BAR;
            }
        }
        if constexpr (ALIGN_EPI) { if (wr == 0) PG8_BAR; }
        if constexpr (!Epi::AFTER_DRAIN) { E(acc, cur, wr, wc, fr, fq); S.done(cur); }
        if (!has_next) break;
#pragma unroll
        for (int a = 0; a < 2; ++a)
#pragma unroll
            for (int b = 0; b < 2; ++b)
#pragma unroll
                for (int m = 0; m < 4; ++m)
#pragma unroll
                    for (int n = 0; n < 2; ++n) acc[a][b][m][n] = (f32x4){0.f, 0.f, 0.f, 0.f};
        cur = nxt; cA = nA; cB = nB; ++ui;
        if constexpr (ALIGN_EPI) { if (wr == 1) PG8_BAR; }
    }
    PG8_WAIT_V(0);
    if constexpr (!ALIGN_EPI) { if (wr == 0) PG8_BAR; }
    PG8_BAR;
    if constexpr (Epi::AFTER_DRAIN) { E.fused(acc, cur, wr, wc, fr, fq, lds, wid, lane); S.done(cur); }
#undef PG8_SA
#undef PG8_SB
#undef PG8_STAGE
#undef PG8_LDA
#undef PG8_LDB
#undef PG8_MMA
#undef PG8_WAIT_V
#undef PG8_WAIT_L
#undef PG8_BAR
#undef PG8_SCHED
}
}
#include <hip/hip_bf16.h>
#include <cmath>
namespace attn_body {
using bf16=__hip_bfloat16;
using bf16x8=__attribute__((ext_vector_type(8)))short;
using s16x4=__attribute__((ext_vector_type(4)))short;
using f32x16=__attribute__((ext_vector_type(16)))float;
using u32x4=__attribute__((ext_vector_type(4)))unsigned;
constexpr int D=64,QP=512,OP=1024,KP=128,NKT=36;
constexpr int NW=8,QBLK=32,QB=QBLK*NW,KVBLK=64;
__device__ __forceinline__ int crow(int r,int hi){return (r&3)+8*(r>>2)+4*hi;}
#define SBAR() __builtin_amdgcn_sched_barrier(0)
constexpr int NSLOT=3, SLOTB=8192;
constexpr int LDS_K=0, LDS_V=NSLOT*SLOTB, LDS_WS=2*NSLOT*SLOTB, LDS_OST=LDS_WS+NW*64*4, LDS_BYTES=LDS_OST+NW*4096;
constexpr float C2=0.125f*1.4426950408889634f;
__device__ __forceinline__ void glds16(const void*gsrc,unsigned lds_dst){unsigned keep;
  asm volatile("s_mov_b32 %0, m0\n\ts_mov_b32 m0, %2\n\ts_nop 0\n\tglobal_load_lds_dwordx4 %1, off\n\ts_mov_b32 m0, %0":"=&s"(keep):"v"(gsrc),"s"(lds_dst):"memory");}
__device__ __forceinline__ float max3f(float a,float b,float c){float r;asm("v_max3_f32 %0, %1, %2, %3":"=v"(r):"v"(a),"v"(b),"v"(c));return r;}
__device__ __forceinline__ float max2f(float a,float b){float r;asm("v_max_f32_e32 %0, %1, %2":"=v"(r):"v"(a),"v"(b));return r;}
__device__ __forceinline__ float fadd_s(float a,float b){float r;asm("v_add_f32_e32 %0, %1, %2":"=v"(r):"v"(a),"v"(b));return r;}
__device__ __forceinline__ float fsub_s(float a,float b){float r;asm("v_sub_f32_e32 %0, %1, %2":"=v"(r):"v"(a),"v"(b));return r;}
typedef float f32x2_t __attribute__((ext_vector_type(2))); typedef __bf16 bf16x2_t __attribute__((ext_vector_type(2)));
__device__ __forceinline__ unsigned cvtpk_s(float lo,float hi){f32x2_t v={lo,hi};bf16x2_t b=__builtin_convertvector(v,bf16x2_t);return __builtin_bit_cast(unsigned,b);}
#define WAIT_BAR(N) asm volatile("s_waitcnt vmcnt(" #N ") lgkmcnt(0)\n\ts_barrier":::"memory")

__device__ __forceinline__ void qkt(f32x16&p0,f32x16&p1,const char*Kslot,const bf16x8*qr,const f32x16&negm,int r32,int hi){
  const char*kb=Kslot+hi*1024+r32*16;
  #pragma unroll
  for(int d0=0;d0<4;++d0){
    const bf16x8 b0=*reinterpret_cast<const bf16x8*>(kb+d0*2048);
    const bf16x8 b1=*reinterpret_cast<const bf16x8*>(kb+d0*2048+512);
    if(d0==0){p0=__builtin_amdgcn_mfma_f32_32x32x16_bf16(b0,qr[0],negm,0,0,0);p1=__builtin_amdgcn_mfma_f32_32x32x16_bf16(b1,qr[0],negm,0,0,0);}
    else{p0=__builtin_amdgcn_mfma_f32_32x32x16_bf16(b0,qr[d0],p0,0,0,0);p1=__builtin_amdgcn_mfma_f32_32x32x16_bf16(b1,qr[d0],p1,0,0,0);}}
}
typedef __attribute__((address_space(3))) const char* lds_cptr;
typedef short v4i16_t __attribute__((ext_vector_type(4)));
__device__ __forceinline__ void kload8(bf16x8*kf,lds_cptr kp){
  kf[0]=*(const __attribute__((address_space(3))) bf16x8*)(kp);      kf[1]=*(const __attribute__((address_space(3))) bf16x8*)(kp+512);
  kf[2]=*(const __attribute__((address_space(3))) bf16x8*)(kp+2048); kf[3]=*(const __attribute__((address_space(3))) bf16x8*)(kp+2560);
  kf[4]=*(const __attribute__((address_space(3))) bf16x8*)(kp+4096); kf[5]=*(const __attribute__((address_space(3))) bf16x8*)(kp+4608);
  kf[6]=*(const __attribute__((address_space(3))) bf16x8*)(kp+6144); kf[7]=*(const __attribute__((address_space(3))) bf16x8*)(kp+6656);
}
__device__ __forceinline__ void kload2(bf16x8*kf,lds_cptr kp,int j){ kf[2*j]=*(const __attribute__((address_space(3))) bf16x8*)(kp+j*2048); kf[2*j+1]=*(const __attribute__((address_space(3))) bf16x8*)(kp+j*2048+512); }
__device__ __forceinline__ s16x4 vtr(lds_cptr p){ return __builtin_bit_cast(s16x4,__builtin_amdgcn_ds_read_tr16_b64_v4i16((__attribute__((address_space(3))) v4i16_t*)p)); }
__device__ __forceinline__ float rowmax(const f32x16&p0,const f32x16&p1){
  float a=max3f(p0[0],p0[1],p1[0]),b=max3f(p0[2],p0[3],p1[1]);a=max3f(a,p1[2],p1[3]);
  #pragma unroll
  for(int r=4;r<16;r+=4){a=max3f(a,p0[r],p0[r+1]);b=max3f(b,p0[r+2],p0[r+3]);a=max3f(a,p1[r],p1[r+1]);b=max3f(b,p1[r+2],p1[r+3]);}
  const float m=max2f(a,b);
  auto rr=__builtin_amdgcn_permlane32_swap(__float_as_uint(m),__float_as_uint(m),false,false);
  return max2f(__uint_as_float(rr[0]),__uint_as_float(rr[1]));
}
__device__ __forceinline__ void pv(f32x16*o,int vb,bf16x8 pa0,bf16x8 pa1,bf16x8 pa2,bf16x8 pa3){
  #pragma unroll
  for(int d0=0;d0<2;++d0){s16x4 lo[4],hi[4];
    #pragma unroll
    for(int ks=0;ks<4;++ks){
      asm volatile("ds_read_b64_tr_b16 %0,%1 offset:%c2":"=&v"(lo[ks]):"v"(vb),"i"(d0*4096+ks*1024):"memory");
      asm volatile("ds_read_b64_tr_b16 %0,%1 offset:%c2":"=&v"(hi[ks]):"v"(vb),"i"(d0*4096+ks*1024+512):"memory");}
    asm volatile("s_waitcnt lgkmcnt(0)":::"memory");SBAR();
    #define PK(k) (bf16x8){lo[k][0],lo[k][1],lo[k][2],lo[k][3],hi[k][0],hi[k][1],hi[k][2],hi[k][3]}
    o[d0]=__builtin_amdgcn_mfma_f32_32x32x16_bf16(pa0,PK(0),o[d0],0,0,0);
    o[d0]=__builtin_amdgcn_mfma_f32_32x32x16_bf16(pa1,PK(1),o[d0],0,0,0);
    o[d0]=__builtin_amdgcn_mfma_f32_32x32x16_bf16(pa2,PK(2),o[d0],0,0,0);
    o[d0]=__builtin_amdgcn_mfma_f32_32x32x16_bf16(pa3,PK(3),o[d0],0,0,0);
    #undef PK
  }
}

#ifndef ATTN_STORE16
#define ATTN_STORE16(p,v) (*(u32x4*)(p)=(v))
#endif
template<int THRL,bool FIXED> __device__ __forceinline__ void attn_unit(long qrow0,int h,long kvrow0,int kvh,const bf16*Q,const bf16*__restrict__ K,const bf16*__restrict__ V,bf16*O,char*shm,float mfix){
  int tid_=threadIdx.x; asm volatile("":"+v"(tid_)); const int tid=tid_,lane=tid&63,r32=lane&31,hi=lane>>5; const int wid=__builtin_amdgcn_readfirstlane(tid>>6);
  const bf16*Qw=Q+(qrow0+wid*QBLK)*QP+h*D;
  const bf16*Kh=K+kvrow0*KP+kvh*D,*Vh=V+kvrow0*KP+kvh*D;
  const unsigned lds0=(unsigned)(uintptr_t)shm;
  float*wsf=(float*)(shm+LDS_WS)+wid*64;
  const bf16*ksrc=Kh+(long)lane*KP+wid*8;
  const bf16*vsrc=Vh+(long)(16*(wid&3)+(lane>>2))*KP+(wid>>2)*32+(lane&3)*8;
  const unsigned kdst=lds0+LDS_K+wid*1024, vdst=lds0+LDS_V+wid*1024;
  #define DMA_K(t,slot) glds16(ksrc+(long)(t)*KVBLK*KP,(unsigned)__builtin_amdgcn_readfirstlane(kdst+(slot)))
  #define DMA_V(t,slot) glds16(vsrc+(long)(t)*KVBLK*KP,(unsigned)__builtin_amdgcn_readfirstlane(vdst+(slot)))
  const int vb0=(int)(lds0+LDS_V)+((lane>>4)&1)*32+(lane&3)*8+(4*hi+((lane&15)>>2))*64;
  const char*Kbase=shm+LDS_K; bf16x8 kf[8];
  const lds_cptr shm3=(lds_cptr)shm; const lds_cptr kp0=shm3+LDS_K+hi*1024+r32*16; const lds_cptr vp0=shm3+LDS_V+((lane>>4)&1)*32+(lane&3)*8+(4*hi+((lane&15)>>2))*64;
  constexpr int NT=NKT;
  DMA_K(0,0);DMA_V(0,0);DMA_K(1,SLOTB);
  bf16x8 qr[4];
  #pragma unroll
  for(int d0=0;d0<4;++d0)qr[d0]=*reinterpret_cast<const bf16x8*>(&Qw[(long)r32*QP+d0*16+hi*8]);
  float mhat=0.f,l_reg=0.f;f32x16 o[2];o[0]=f32x16{};o[1]=f32x16{};f32x16 negm;
  #pragma unroll
  for(int r=0;r<16;++r)negm[r]=FIXED?-mfix:0.f;
  asm volatile("":"+v"(negm));
  #define CMASK(P0,P1,t) do{}while(0)
  bool resc=false;
  #define START(P0,P1) do{ if(!FIXED){ const float rm=rowmax(P0,P1); resc=false; \
    { const float dl=rm; mhat=fadd_s(mhat,dl); \
      _Pragma("unroll") for(int r=0;r<16;++r){P0[r]=fsub_s(P0[r],dl);P1[r]=fsub_s(P1[r],dl);} \
      _Pragma("unroll") for(int r=0;r<16;++r)negm[r]=-mhat; asm volatile("":"+v"(negm)); } } \
    _Pragma("unroll") for(int r=0;r<16;++r)P0[r]=__builtin_amdgcn_exp2f(P0[r]); }while(0)
  #define RESC() do{ if(resc){ asm volatile("s_waitcnt lgkmcnt(0)":::"memory"); \
      _Pragma("unroll") for(int d_=0;d_<2;++d_) _Pragma("unroll") for(int r=0;r<16;++r)o[d_][r]*=wsf[crow(r,hi)]; } }while(0)
  f32x16 pA0,pA1,pB0,pB1;
  int sl_prev=0,sl_cur=0,sl_next=SLOTB;
  #define ROT() do{sl_prev=sl_cur;sl_cur=sl_next;sl_next=(sl_next==(NSLOT-1)*SLOTB)?0:sl_next+SLOTB;}while(0)
  DMA_K(2,2*SLOTB);
  WAIT_BAR(3);
  qkt(pA0,pA1,Kbase,qr,negm,r32,hi);asm volatile("s_nop 15\n\ts_nop 7":"+v"(pA0),"+v"(pA1));CMASK(pA0,pA1,0);
  START(pA0,pA1);
  _Pragma("unroll") for(int r=0;r<16;++r)pA1[r]=__builtin_amdgcn_exp2f(pA1[r]);
  WAIT_BAR(0);
  DMA_K(3,0);DMA_V(1,SLOTB);
  ROT();
  kload8(kf,kp0+sl_cur);
  WAIT_BAR(2);
  s16x4 vlo[8],vhi[8]; u32x4 pw0,pw1,pw2,pw3;
  #define PKW(P,B) cvtpk_s(P[B],P[B+1])
  #define PAF(k) __builtin_bit_cast(bf16x8,pw##k)
  #define VFR(i) (bf16x8){vlo[i][0],vlo[i][1],vlo[i][2],vlo[i][3],vhi[i][0],vhi[i][1],vhi[i][2],vhi[i][3]}
  #define PIN(x) asm volatile("":"+v"(x))
  #define MX3(a,b,c) __builtin_fmaxf(__builtin_fmaxf((a),(b)),(c))
  #define GAPA(MF,A0,A1,A2,A3,W0,W1,PW) do{ MF; sacc+=A0; sacc+=A1; sacc+=A2; sacc+=A3; PIN(sacc); W0; W1; PIN(PW); SBAR(); }while(0)
  #define EX(v) __builtin_amdgcn_exp2f(v)
  #define GAPB(MF,X,B) do{ MF; X[B]=EX(X[B]); X[B+1]=EX(X[B+1]); X[B+2]=EX(X[B+2]); X[B+3]=EX(X[B+3]); PIN(X); SBAR(); }while(0)
  #define VRD(i) do{ vlo[i]=vtr(vp_+(((i)>>2)*4096+((i)&3)*1024)); vhi[i]=vtr(vp_+(((i)>>2)*4096+((i)&3)*1024+512)); }while(0)
  #define KRD(G,j) do{ if(G){ kload2(kf,kp0+sl_next,j); SBAR(); } }while(0)
  #define STEP(C0,C1,P0,P1,t,GK,GV,GL) do{ SBAR(); \
    const lds_cptr vp_=vp0+sl_prev; \
    VRD(0); SBAR(); float sacc=(P0[0]+P0[1]); \
    GAPA(C0=__builtin_amdgcn_mfma_f32_32x32x16_bf16(kf[0],qr[0],negm,0,0,0), P0[2],P0[3],P0[4],P0[5],     pw0[0]=PKW(P0,0), pw0[1]=PKW(P0,2), pw0); \
    VRD(4); SBAR(); GAPA(C1=__builtin_amdgcn_mfma_f32_32x32x16_bf16(kf[1],qr[0],negm,0,0,0), P0[6],P0[7],P0[8],P0[9],     pw0[2]=PKW(P0,4), pw0[3]=PKW(P0,6), pw0); \
    VRD(1); SBAR(); GAPA(C0=__builtin_amdgcn_mfma_f32_32x32x16_bf16(kf[2],qr[1],C0,0,0,0),   P0[10],P0[11],P0[12],P0[13], pw1[0]=PKW(P0,8), pw1[1]=PKW(P0,10), pw1); \
    VRD(5); SBAR(); GAPA(C1=__builtin_amdgcn_mfma_f32_32x32x16_bf16(kf[3],qr[1],C1,0,0,0),   P0[14],P0[15],P1[0],P1[1],   pw1[2]=PKW(P0,12),pw1[3]=PKW(P0,14), pw1); \
    VRD(2); SBAR(); GAPA(C0=__builtin_amdgcn_mfma_f32_32x32x16_bf16(kf[4],qr[2],C0,0,0,0),   P1[2],P1[3],P1[4],P1[5],     pw2[0]=PKW(P1,0), pw2[1]=PKW(P1,2), pw2); \
    VRD(6); SBAR(); GAPA(C1=__builtin_amdgcn_mfma_f32_32x32x16_bf16(kf[5],qr[2],C1,0,0,0),   P1[6],P1[7],P1[8],P1[9],     pw2[2]=PKW(P1,4), pw2[3]=PKW(P1,6), pw2); \
    VRD(3); SBAR(); GAPA(C0=__builtin_amdgcn_mfma_f32_32x32x16_bf16(kf[6],qr[3],C0,0,0,0),   P1[10],P1[11],P1[12],P1[13], pw3[0]=PKW(P1,8), pw3[1]=PKW(P1,10), pw3); \
    VRD(7); SBAR(); GAPA(C1=__builtin_amdgcn_mfma_f32_32x32x16_bf16(kf[7],qr[3],C1,0,0,0),   P1[14],P1[15],0.f,0.f,       pw3[2]=PKW(P1,12),pw3[3]=PKW(P1,14), pw3); \
    l_reg+=sacc; \
    if(GK){DMA_K((t)+3,sl_cur);} if(GV){DMA_V((t)+1,sl_next);} \
    CMASK(C0,C1,t); \
    if(!FIXED){ float a=MX3(C0[0],C0[1],C1[0]),b=MX3(C0[2],C0[3],C1[1]); a=MX3(a,C1[2],C1[3]); \
      _Pragma("unroll") for(int r=4;r<16;r+=4){a=MX3(a,C0[r],C0[r+1]);b=MX3(b,C0[r+2],C0[r+3]);a=MX3(a,C1[r],C1[r+1]);b=MX3(b,C1[r+2],C1[r+3]);} \
      float rm=__builtin_fmaxf(a,b); { auto rr=__builtin_amdgcn_permlane32_swap(__float_as_uint(rm),__float_as_uint(rm),false,false); rm=__builtin_fmaxf(__uint_as_float(rr[0]),__uint_as_float(rr[1])); } \
      resc=false; \
      if(__builtin_expect(__any(rm>(float)THRL),0)){ const float dl=__builtin_fmaxf(rm,0.f); mhat+=dl; \
        _Pragma("unroll") for(int r=0;r<16;++r){C0[r]-=dl;C1[r]-=dl;} \
        _Pragma("unroll") for(int r=0;r<16;++r)negm[r]=-mhat; asm volatile("":"+v"(negm)); \
        const float f=__builtin_amdgcn_exp2f(-dl); l_reg*=f; if(hi==0)wsf[r32]=f; resc=true; } } \
    SBAR(); \
    GAPB(o[0]=__builtin_amdgcn_mfma_f32_32x32x16_bf16(PAF(0),VFR(0),o[0],0,0,0), C0,0); \
    GAPB(o[1]=__builtin_amdgcn_mfma_f32_32x32x16_bf16(PAF(0),VFR(4),o[1],0,0,0), C0,4); \
    KRD(GL,0); GAPB(o[0]=__builtin_amdgcn_mfma_f32_32x32x16_bf16(PAF(1),VFR(1),o[0],0,0,0), C0,8); \
    KRD(GL,1); GAPB(o[1]=__builtin_amdgcn_mfma_f32_32x32x16_bf16(PAF(1),VFR(5),o[1],0,0,0), C0,12); \
    KRD(GL,2); GAPB(o[0]=__builtin_amdgcn_mfma_f32_32x32x16_bf16(PAF(2),VFR(2),o[0],0,0,0), C1,0); \
    KRD(GL,3); GAPB(o[1]=__builtin_amdgcn_mfma_f32_32x32x16_bf16(PAF(2),VFR(6),o[1],0,0,0), C1,4); \
    GAPB(o[0]=__builtin_amdgcn_mfma_f32_32x32x16_bf16(PAF(3),VFR(3),o[0],0,0,0), C1,8); \
    GAPB(o[1]=__builtin_amdgcn_mfma_f32_32x32x16_bf16(PAF(3),VFR(7),o[1],0,0,0), C1,12); \
    }while(0)
  int t=1;
  #undef CMASK
  #define CMASK(P0,P1,t) do{}while(0)
  for(;t+5<NT;t+=2){
    STEP(pB0,pB1,pA0,pA1,t,true,true,true);     WAIT_BAR(2); RESC(); ROT();
    STEP(pA0,pA1,pB0,pB1,t+1,true,true,true);   WAIT_BAR(2); RESC(); ROT();
  }
  #undef CMASK
  #define CMASK(P0,P1,t) do{}while(0)
  #define ENDW(tt) do{ if((tt)+3<NT){WAIT_BAR(2);} else if((tt)+2<NT){WAIT_BAR(1);} else {WAIT_BAR(0);} }while(0)
  for(;t+1<NT;t+=2){
    STEP(pB0,pB1,pA0,pA1,t,(t+3<NT),(t+1<NT),(t+1<NT));       ENDW(t);   RESC(); ROT();
    STEP(pA0,pA1,pB0,pB1,t+1,(t+4<NT),(t+2<NT),(t+2<NT));     ENDW(t+1); RESC(); ROT();
  }
  STEP(pB0,pB1,pA0,pA1,NT-1,false,false,false); RESC();
  { float sacc=pB0[0]+pB0[1]; _Pragma("unroll") for(int r=2;r<16;++r)sacc+=pB0[r]; _Pragma("unroll") for(int r=0;r<16;++r)sacc+=pB1[r]; l_reg+=sacc;
    pw0=(u32x4){PKW(pB0,0),PKW(pB0,2),PKW(pB0,4),PKW(pB0,6)};pw1=(u32x4){PKW(pB0,8),PKW(pB0,10),PKW(pB0,12),PKW(pB0,14)};pw2=(u32x4){PKW(pB1,0),PKW(pB1,2),PKW(pB1,4),PKW(pB1,6)};pw3=(u32x4){PKW(pB1,8),PKW(pB1,10),PKW(pB1,12),PKW(pB1,14)};
    SBAR(); pv(o,vb0+sl_cur,PAF(0),PAF(1),PAF(2),PAF(3)); }
  #undef PKW
  #undef PAF
  #undef VFR
  #undef PIN
  #undef MX3
  #undef GAPA
  #undef GAPB
  #undef EX
  #undef VRD
  #undef KRD
  #undef STEP
  #undef ENDW
  {auto rr=__builtin_amdgcn_permlane32_swap(__float_as_uint(l_reg),__float_as_uint(l_reg),false,false);l_reg=__uint_as_float(rr[0])+__uint_as_float(rr[1]);}
  if(hi==0)wsf[32+r32]=l_reg;asm volatile("s_waitcnt lgkmcnt(0)":::"memory");
  float rli[16];
  #pragma unroll
  for(int r=0;r<16;++r)rli[r]=__builtin_amdgcn_rcpf(wsf[32+crow(r,hi)]);
  bf16*Ow=O+(qrow0+wid*QBLK)*OP+h*D;
  { bf16*stg=(bf16*)(shm+LDS_OST)+wid*2048;
    #pragma unroll
    for(int r=0;r<16;++r){const int orow=crow(r,hi);
      #pragma unroll
      for(int d0=0;d0<2;++d0)stg[orow*64+d0*32+r32]=__float2bfloat16(o[d0][r]*rli[r]);}
    asm volatile("s_waitcnt lgkmcnt(0)":::"memory");
    #pragma unroll
    for(int i=0;i<4;++i){const int row=i*8+(lane>>3),ch=lane&7; const u32x4 v=*(const u32x4*)(stg+row*64+ch*8); ATTN_STORE16(Ow+(long)row*OP+ch*8,v);} }
  asm volatile("s_waitcnt lgkmcnt(0)\n\ts_barrier":::"memory");
  #undef DMA_K
  #undef DMA_V
  #undef CMASK
  #undef START
  #undef RESC
  #undef ROT
}
constexpr int ATTN_LDS_BYTES=LDS_BYTES;
#undef SBAR
#undef WAIT_BAR
}
constexpr int NWAVES = 8;
using pg8::bf16_t; using pg8::bf16x8; using pg8::f32x4; using pg8::u32x4;
typedef unsigned u32x2 __attribute__((ext_vector_type(2)));
#define LAS __attribute__((address_space(3)))
#define GAS __attribute__((address_space(1)))
#define RLX_AGENT __ATOMIC_RELAXED, __HIP_MEMORY_SCOPE_AGENT
#define LDS_WAIT() asm volatile("s_waitcnt lgkmcnt(0)" ::: "memory")
#define VM_WAIT() asm volatile("s_waitcnt vmcnt(0)" ::: "memory")

constexpr size_t MiB = 1u << 20;
constexpr size_t WS_CTL = 0, CTL_ZERO_BYTES = 64 * 1024;
constexpr size_t WS_MOD = 1 * MiB;
constexpr size_t WS_LB = WS_MOD + 512 * 1024;
constexpr size_t WS_ROPE = WS_LB + 8 * 1024;
constexpr size_t WS_WIN = 2 * MiB;
constexpr size_t WS_WINS = 10 * MiB;
constexpr int CW_CMAX = 10240;
constexpr size_t WS_WA = 13 * MiB, WS_WB = 14 * MiB, WS_WO = 15 * MiB;
constexpr size_t WS_WGU = 17 * MiB, WS_WD = 81 * MiB;
constexpr size_t WS_HX = 17 * MiB;
constexpr size_t WS_A1 = 17 * MiB, WS_OATT = 49 * MiB, WS_OR = 81 * MiB;
constexpr size_t WS_HQ = 113 * MiB, WS_FF = 145 * MiB, WS_FB = 181 * MiB, WS_HI = 217 * MiB, WS_SG = 253 * MiB, WS_Q = 285 * MiB, WS_K = 317 * MiB, WS_V = 326 * MiB;
constexpr size_t WS_GA = 335 * MiB, WS_GB = 399 * MiB;
constexpr size_t WS_Z = 113 * MiB;
constexpr size_t WS_H2 = 177 * MiB;
constexpr size_t WS_AFF = 241 * MiB;
constexpr size_t WS_HS = 209 * MiB;
constexpr size_t WS_TQ = 17 * MiB + 48 * MiB;
constexpr size_t WS_TD = 81 * MiB + 24 * MiB;
constexpr size_t WS_HIDQ = 113 * MiB;
constexpr size_t WS_SCL2 = 243 * MiB + 768 * 1024;
constexpr size_t WS_SCL = 243 * MiB + 512 * 1024;
constexpr size_t WS_IDX = 243 * MiB;
constexpr size_t WS_SLOT = 244 * MiB;
constexpr size_t WS_X1B = 246 * MiB;
constexpr size_t WS_YE = 374 * MiB;
constexpr size_t WS_END = 502 * MiB;
constexpr int CW_Q3 = 64;
constexpr int CW_MFIX = 96;
constexpr int CW_BAR = 1024;

constexpr int RING_BYTES = 131072, MISC_OFF = RING_BYTES, LDS_BYTES = 147456;

#define PB_HX(A)   ((unsigned char*)(A).out)
#define PB_HXS(A)  ((float*)((unsigned char*)(A).out + 100 * MiB))
#define PB_A1(A)   ((unsigned char*)(A).out)
#define PB_OATT(A) ((unsigned char*)(A).out + 1024)
#define PB_OR(A)   ((unsigned char*)(A).out + 64 * MiB)
#define PB_HID(A)  ((unsigned char*)(A).out)
struct Args {
    const float *x, *c, *ctx, *c_ctx, *w_mod, *b_mod, *n1g, *n2g, *w_in, *lbl, *hgn, *qng, *kng, *wa, *wb, *wo, *wr, *weg, *weu, *wed, *fng;
    float* out; unsigned char* ws;
};

#define XB_TMO      128
#define XB_XCNT(j)  (256  + 64 * (j))
#define XB_XSUB(j)  (1280 + 64 * (j))
#define XB_XGEN(j)  (2304 + 64 * (j))
#define XB_TOP      3328
#define XB_TOPGEN   3392
#define XCD_BAR_WORDS 3456
#define XB_SPIN_CAP (1u << 18)
#ifndef XB_SCOPE
#define XB_SCOPE "agent"
#endif

__device__ __forceinline__ unsigned xb_ld(unsigned* p)              { return __hip_atomic_load(p, __ATOMIC_RELAXED, __HIP_MEMORY_SCOPE_AGENT); }
__device__ __forceinline__ unsigned xb_add(unsigned* p, unsigned v) { return __hip_atomic_fetch_add(p, v, __ATOMIC_RELAXED, __HIP_MEMORY_SCOPE_AGENT); }
__device__ __forceinline__ unsigned xb_xcc_id() { return (unsigned)__builtin_amdgcn_s_getreg((3 << 11) | 20) & 0xFu; }
#define XB_SPIN(cond, bar) do { unsigned _sp = 0; while (cond) { __builtin_amdgcn_s_sleep(1); \
    if ((++_sp & 255u) == 0u) { if (xb_ld(&(bar)[XB_TMO])) break; if (_sp > XB_SPIN_CAP) { atomicAdd(&(bar)[XB_TMO], 1u); break; } } } } while (0)

struct XcdBarrier {
    unsigned* bar; unsigned x;
    volatile LAS unsigned* st;
};

__device__ __forceinline__ XcdBarrier xcd_barrier_post(unsigned* bar, volatile LAS unsigned* st) {
    XcdBarrier b; b.bar = bar; b.x = xb_xcc_id(); b.st = st;
    if (threadIdx.x == 0) (void)xb_add(&bar[XB_XCNT(b.x)], 1u);
    return b;
}
__device__ __forceinline__ void xcd_barrier_complete(unsigned* bar, unsigned x, unsigned& nloc, unsigned& nx) {
    const unsigned G = gridDim.x * gridDim.y * gridDim.z;
    unsigned sum, cnt, mine, sp = 0u;
    for (;;) {
        sum = 0u; cnt = 0u; mine = 0u;
#pragma unroll
        for (unsigned j = 0; j < 16; ++j) { const unsigned c = xb_ld(&bar[XB_XCNT(j)]); sum += c; cnt += (c > 0u) ? 1u : 0u; mine = (j == x) ? c : mine; }
        if (sum == G) break;
        __builtin_amdgcn_s_sleep(1);
        if ((++sp & 255u) == 0u) { if (xb_ld(&bar[XB_TMO])) break; if (sp > XB_SPIN_CAP) { atomicAdd(&bar[XB_TMO], 1u); break; } }
    }
    nloc = mine > 0u ? mine : 1u; nx = cnt > 0u ? cnt : 1u;
}

__device__ __forceinline__ void xcd_barrier(const XcdBarrier& b) {
    asm volatile("s_waitcnt vmcnt(0)" ::: "memory");
    __syncthreads();
    if (threadIdx.x == 0) {
        unsigned* bar = b.bar;
        __builtin_amdgcn_s_waitcnt(0);
        unsigned nloc = b.st[0], nx = b.st[1];
        if (nloc == 0u) { xcd_barrier_complete(bar, b.x, nloc, nx); b.st[0] = nloc; b.st[1] = nx; }
#if DBG_RELEASE_ALL
        __builtin_amdgcn_fence(__ATOMIC_RELEASE, "agent"); asm volatile("s_waitcnt vmcnt(0)" ::: "memory");
#endif
        const unsigned old = xb_add(&bar[XB_XSUB(b.x)], 1u);
        const unsigned gen = old / nloc;
        if (old + 1u == (gen + 1u) * nloc) {
#if DBG_LEADER_DELAY
            { const unsigned long long t0_ = __builtin_amdgcn_s_memrealtime(); while (__builtin_amdgcn_s_memrealtime() - t0_ < (unsigned long long)DBG_LEADER_DELAY) __builtin_amdgcn_s_sleep(2); }
#endif
            __builtin_amdgcn_fence(__ATOMIC_RELEASE, XB_SCOPE);
            asm volatile("s_waitcnt vmcnt(0)" ::: "memory");
#if DBG_WBL2_TWICE
            { const unsigned long long t0_ = __builtin_amdgcn_s_memrealtime(); while (__builtin_amdgcn_s_memrealtime() - t0_ < 150ull) __builtin_amdgcn_s_sleep(2); }
            asm volatile("buffer_wbl2 sc1\n\ts_waitcnt vmcnt(0)" ::: "memory");
#endif
            const unsigned og = xb_add(&bar[XB_TOP], 1u);
            const unsigned tg = og / nx;
            if (og + 1u == (tg + 1u) * nx) xb_add(&bar[XB_TOPGEN], 1u);
            else XB_SPIN(xb_ld(&bar[XB_TOPGEN]) == tg, bar);
            __builtin_amdgcn_fence(__ATOMIC_ACQUIRE, XB_SCOPE);
            xb_add(&bar[XB_XGEN(b.x)], 1u);
            asm volatile("s_waitcnt vmcnt(0)" ::: "memory");
        } else {
            XB_SPIN(xb_ld(&bar[XB_XGEN(b.x)]) == gen, bar);
            __builtin_amdgcn_fence(__ATOMIC_ACQUIRE, XB_SCOPE);
            asm volatile("s_waitcnt vmcnt(0)" ::: "memory");
        }
    }
    __syncthreads();
}

__device__ __forceinline__ float wave_sum(float v) {
#pragma unroll
    for (int o = 1; o < 64; o <<= 1) v += __shfl_xor(v, o);
    return v;
}
__device__ __forceinline__ unsigned f2bf(float f) { unsigned u = __builtin_bit_cast(unsigned, f); return (u + 0x7fffu + ((u >> 16) & 1u)) >> 16; }
__device__ __forceinline__ unsigned pk2(float lo, float hi) { return f2bf(lo) | (f2bf(hi) << 16); }
__device__ __forceinline__ float bf2f(unsigned short h) { return __uint_as_float((unsigned)h << 16); }

template <bool QKPERM>
__device__ __forceinline__ void transpose_item_q8(const float* W, int Nsrc, int n0, int k0, float inv, unsigned char* WQ, long drow0, LAS float* scr, int lane) {
    float tv[32];
#pragma unroll
    for (int i = 0; i < 32; ++i) tv[i] = W[(size_t)(k0 + 2 * i + (lane >> 5)) * Nsrc + n0 + (lane & 31)];
#pragma unroll
    for (int i = 0; i < 32; ++i) scr[(2 * i + (lane >> 5)) * 33 + (lane & 31)] = __builtin_rintf(tv[i] * inv);
    LDS_WAIT(); asm volatile("" ::: "memory");
    const int c = lane & 7;
#pragma unroll
    for (int j = 0; j < 4; ++j) { const int n = (lane >> 3) + 8 * j;
        const int ns = QKPERM ? (16 * ((n & 7) >> 2) + 4 * (n >> 3) + (n & 3)) : n;
        const LAS float* s = scr + (8 * c) * 33 + ns;
        const unsigned w0 = ((unsigned)(int)s[0 * 33] & 255u) | (((unsigned)(int)s[1 * 33] & 255u) << 8) | (((unsigned)(int)s[2 * 33] & 255u) << 16) | ((unsigned)(int)s[3 * 33] << 24);
        const unsigned w1 = ((unsigned)(int)s[4 * 33] & 255u) | (((unsigned)(int)s[5 * 33] & 255u) << 8) | (((unsigned)(int)s[6 * 33] & 255u) << 16) | ((unsigned)(int)s[7 * 33] << 24);
        u32x2 o; o.x = w0; o.y = w1; *(u32x2*)(WQ + (size_t)(drow0 + n) * 1024 + k0 + 8 * c) = o; }
    LDS_WAIT(); asm volatile("" ::: "memory");
}
template <bool QKPERM>
__device__ __forceinline__ void transpose_item(const float* W, int K, int Nsrc, int n0, int k0, bf16_t* WT, long drow0, LAS float* scr, int lane) {
    float tv[32];
#pragma unroll
    for (int i = 0; i < 32; ++i) tv[i] = W[(size_t)(k0 + 2 * i + (lane >> 5)) * Nsrc + n0 + (lane & 31)];
#pragma unroll
    for (int i = 0; i < 32; ++i) scr[(2 * i + (lane >> 5)) * 33 + (lane & 31)] = tv[i];
    LDS_WAIT(); asm volatile("" ::: "memory");
    const int c = lane & 7;
#pragma unroll
    for (int j = 0; j < 4; ++j) { const int n = (lane >> 3) + 8 * j;
        const int ns = QKPERM ? (16 * ((n & 7) >> 2) + 4 * (n >> 3) + (n & 3)) : n;
        const LAS float* s = scr + (8 * c) * 33 + ns;
        u32x4 o; o.x = pk2(s[0 * 33], s[1 * 33]); o.y = pk2(s[2 * 33], s[3 * 33]); o.z = pk2(s[4 * 33], s[5 * 33]); o.w = pk2(s[6 * 33], s[7 * 33]);
        *(u32x4*)(WT + (size_t)(drow0 + n) * K + k0 + 8 * c) = o; }
    LDS_WAIT(); asm volatile("" ::: "memory");
}
__device__ __forceinline__ void p0_adaln_item(const Args& A, LAS unsigned char* lds, int item, int tid) {
    LAS float* sc = (LAS float*)lds;
    LAS float* red = (LAS float*)(lds + 17 * 1024 * 4);
    const int wave = tid >> 6, lane = tid & 63, col = lane & 31, kp = lane >> 5;
    const float* wp = A.w_mod + (size_t)(wave * 128 + kp * 64) * NMOD + item * 32 + col;
    float w[64];
#pragma unroll
    for (int kk = 0; kk < 64; ++kk) w[kk] = wp[(size_t)kk * NMOD];
    for (int i = tid; i < 17 * 1024; i += 512) { const int b = i >> 10, k = i & 1023; const float v = b < 16 ? A.c[b * 1024 + k] : A.c_ctx[k]; sc[i] = v * pg8::fsigmoid(v); }
    __syncthreads();
    float acc[17];
#pragma unroll
    for (int b = 0; b < 17; ++b) acc[b] = 0.f;
#pragma unroll
    for (int kk = 0; kk < 64; kk += 4) {
#pragma unroll
        for (int b = 0; b < 17; ++b) { const f32x4 s4 = *(const LAS f32x4*)(sc + b * 1024 + wave * 128 + kp * 64 + kk); acc[b] += (s4[0] * w[kk] + s4[1] * w[kk + 1]) + (s4[2] * w[kk + 2] + s4[3] * w[kk + 3]); } }
#pragma unroll
    for (int b = 0; b < 17; ++b) red[((wave * 2 + kp) * 17 + b) * 32 + col] = acc[b];
    __syncthreads();
    float* mod = (float*)(A.ws + WS_MOD);
    for (int i = tid; i < 17 * 32; i += 512) { const int b = i >> 5, cidx = i & 31; float s = 0.f;
#pragma unroll
        for (int w = 0; w < 16; ++w) s += red[(w * 17 + b) * 32 + cidx];
        mod[b * NMOD + item * 32 + cidx] = s + A.b_mod[item * 32 + cidx]; }
    __syncthreads();
}
__device__ __forceinline__ int win_src(int g32, bool& qk) {
    const int pn = g32 >> 3, bj = (g32 >> 2) & 1, wc = g32 & 3;
    if (pn == 10 || pn == 11) { qk = true; return 2560 + (pn - 10) * 256 + wc * 64 + 32 * bj; }
    if (pn == 12 && wc < 2) { qk = true; return 3072 + wc * 64 + 32 * bj; }
    qk = false;
    if (pn == 12) return 3200 + (wc - 2) * 64 + 32 * bj;
    return g32 * 32;
}
template <int PART>
__device__ __forceinline__ void p0_prologue(const Args& A, LAS unsigned char* lds, int vcu, int G, int tid) {
    const int wave = tid >> 6, lane = tid & 63;
    if (PART == 0) {
    for (int it = vcu; it < NMOD / 32; it += G) p0_adaln_item(A, lds, it, tid);
    if (vcu == G - 1) {
        float* lb = (float*)(A.ws + WS_LB); float* rope = (float*)(A.ws + WS_ROPE);
        for (int i = tid; i < 1024; i += 512) { const int d = i >> 9, k = i & 511; const float l0 = A.lbl[(d * 2 + 0) * 512 + k], l1 = A.lbl[(d * 2 + 1) * 512 + k]; lb[i] = 1.0f / (1.0f + expf(l1 - l0)); }
        for (int i = tid; i < 64 * 16; i += 512) { const int pos = i >> 4, f = i & 15; const float inv = powf(10000.0f, -(float)(2 * f) / 32.0f); const float ang = (float)pos * inv; rope[pos * 32 + f] = cosf(ang); rope[pos * 32 + 16 + f] = sinf(ang); }
        if (tid < 64) { float mq = fabsf(A.qng[tid]), mk = fabsf(A.kng[tid]);
#pragma unroll
            for (int o = 32; o > 0; o >>= 1) { mq = fmaxf(mq, __shfl_xor(mq, o)); mk = fmaxf(mk, __shfl_xor(mk, o)); }
            if (tid == 0) ((float*)(A.ws + WS_CTL))[CW_MFIX] = 64.0f * 0.125f * LOG2E * 1.02f * mq * mk + 0.5f; }
    }
    { unsigned* cmax = (unsigned*)(A.ws + WS_CTL) + CW_CMAX; const int gwm = vcu * NWAVES + wave, NGWM = G * NWAVES;
      for (int it = gwm; it < 16 * (INC / 32); it += NGWM) { const int kb = it / (INC / 32), g32 = it % (INC / 32); bool qk; const int n0 = win_src(g32, qk);
          float m = 0.f;
          float tv[32];
#pragma unroll
          for (int i = 0; i < 32; ++i) tv[i] = A.w_in[(size_t)(64 * kb + 2 * i + (lane >> 5)) * INC + n0 + (lane & 31)];
#pragma unroll
          for (int i = 0; i < 32; ++i) m = fmaxf(m, fabsf(tv[i]));
          m = fmaxf(m, __shfl_xor(m, 32));
          if (lane < 32) atomicMax(cmax + g32 * 32 + lane, __float_as_uint(m)); } }
    return; }
    LAS float* scr = (LAS float*)(lds + wave * 8704);
    const int gw = vcu * NWAVES + wave, NGW = G * NWAVES;
    constexpr int I_IN = 16 * (INC / 32), I_A = 8 * 32, I_O = 16 * 32;
    constexpr int NIT = I_IN + 2 * I_A + I_O;
    bf16_t* WinT = (bf16_t*)(A.ws + WS_WIN); bf16_t* WaT = (bf16_t*)(A.ws + WS_WA); bf16_t* WbT = (bf16_t*)(A.ws + WS_WB); bf16_t* WoT = (bf16_t*)(A.ws + WS_WO);
    const int it0 = gw, itstep = NGW, itend = NIT;
    for (int it = it0; it < itend; it += itstep) {
        int r = it;
        if (r < I_IN) { const int kb = r / (INC / 32), g32 = r % (INC / 32);
            bool qk; const int n0 = win_src(g32, qk);
            const unsigned* cmax = (const unsigned*)(A.ws + WS_CTL) + CW_CMAX;
            const float am = fmaxf(__uint_as_float(__hip_atomic_load(cmax + g32 * 32 + (lane & 31), RLX_AGENT)), 1e-30f), inv = 127.0f / am;
            if (kb == 0 && lane < 32) { const int n = lane, ns = qk ? (16 * ((n & 7) >> 2) + 4 * (n >> 3) + (n & 3)) : n;
                ((float*)(A.ws + WS_WINS))[g32 * 32 + n] = fmaxf(__uint_as_float(__hip_atomic_load(cmax + g32 * 32 + ns, RLX_AGENT)), 1e-30f) * (1.0f / 127.0f); }
            if (qk) transpose_item_q8<true>(A.w_in, INC, n0, 64 * kb, inv, A.ws + WS_WIN, (long)g32 * 32, scr, lane);
            else transpose_item_q8<false>(A.w_in, INC, n0, 64 * kb, inv, A.ws + WS_WIN, (long)g32 * 32, scr, lane);
            continue; }
        r -= I_IN;
        if (r < I_A) { transpose_item<false>(A.wa, 1024, 1024, (r & 31) * 32, 64 * (r >> 5), WaT, (long)(r & 31) * 32, scr, lane); continue; } r -= I_A;
        if (r < I_A) { transpose_item<false>(A.wb, 1024, 1024, (r & 31) * 32, 64 * (r >> 5), WaT + 512, (long)(r & 31) * 32, scr, lane); continue; } r -= I_A;
        transpose_item<false>(A.wo, 1024, 1024, (r & 31) * 32, 64 * (r >> 5), WoT, (long)(r & 31) * 32, scr, lane);
    }
}

__device__ __forceinline__ void p1_finish(unsigned char* HXQ, float* HXS, int r, int lane, const f32x4 (&v)[4], const f32x4 (&gs)[4], const f32x4 (&sh)[4]) {
    float ss = 0.f;
#pragma unroll
    for (int j = 0; j < 4; ++j) ss += (v[j][0] * v[j][0] + v[j][1] * v[j][1]) + (v[j][2] * v[j][2] + v[j][3] * v[j][3]);
    const float rstd = 1.0f / sqrtf(wave_sum(ss) * (1.0f / 1024.0f) + EPS);
    f32x4 o[4]; float amax = 0.f;
#pragma unroll
    for (int j = 0; j < 4; ++j) { o[j] = (v[j] * rstd) * gs[j] + sh[j]; amax = fmaxf(fmaxf(amax, fmaxf(fabsf(o[j][0]), fabsf(o[j][1]))), fmaxf(fabsf(o[j][2]), fabsf(o[j][3]))); }
#pragma unroll
    for (int o_ = 1; o_ < 64; o_ <<= 1) amax = fmaxf(amax, __shfl_xor(amax, o_));
    const float am = amax > 1e-30f ? amax : 1e-30f, inv = 127.0f / am;
    if (lane == 0) HXS[r] = am * (1.0f / 127.0f);
#pragma unroll
    for (int j = 0; j < 4; ++j) { const int cidx = 4 * lane + 256 * j; const f32x4 q = o[j] * inv;
        const int q0 = (int)__builtin_rintf(q[0]), q1 = (int)__builtin_rintf(q[1]), q2 = (int)__builtin_rintf(q[2]), q3 = (int)__builtin_rintf(q[3]);
        *(unsigned*)(HXQ + (size_t)r * 1024 + cidx) = ((unsigned)q0 & 255u) | (((unsigned)q1 & 255u) << 8) | (((unsigned)q2 & 255u) << 16) | ((unsigned)q3 << 24); }
}
__device__ __forceinline__ void p1_rows(const Args& A, int vcu, int G, int tid) {
    const int wave = tid >> 6, lane = tid & 63; const int gw = vcu * NWAVES + wave, NGW = G * NWAVES;
    const float* mod = (const float*)(A.ws + WS_MOD); unsigned char* HXQ = (unsigned char*)(PB_HX(A)); float* HXS = PB_HXS(A);
    auto src_of = [&](int r) -> const float* { const int b = r / RPB, s = r - b * RPB; return s < CTXL ? A.ctx + ((size_t)b * CTXL + s) * 1024 : A.x + ((size_t)b * SEQ + (s - CTXL)) * 1024; };
    auto cls_of = [&](int r) -> int { const int b = r / RPB, s = r - b * RPB; return s < CTXL ? 16 : b; };
    const int RPW = (MR + NGW - 1) / NGW; const int r0 = gw * RPW, r1 = r0 + RPW < MR ? r0 + RPW : MR;
    if (r0 < r1) {
        f32x4 gs[4], sh[4]; int ccur = -1;
        auto consts = [&](int r) { const int c = cls_of(r);
            if (c != ccur) { ccur = c; const float* mrow = mod + (size_t)c * NMOD;
#pragma unroll
                for (int j = 0; j < 4; ++j) { const int cidx = 4 * lane + 256 * j; sh[j] = *(const f32x4*)(mrow + cidx); gs[j] = *(const f32x4*)(A.n1g + cidx) * (*(const f32x4*)(mrow + 1024 + cidx) + 1.0f); }
                asm volatile("" : "+v"(gs[0]), "+v"(gs[1]), "+v"(gs[2]), "+v"(gs[3]), "+v"(sh[0]), "+v"(sh[1]), "+v"(sh[2]), "+v"(sh[3])); } };
        f32x4 n0[4], n1[4];
        { const float* src = src_of(r0);
#pragma unroll
          for (int j = 0; j < 4; ++j) n0[j] = *(const f32x4*)(src + 4 * lane + 256 * j); }
        for (int r = r0; r < r1; r += 2) {
            { const float* src = src_of(r + 1 < r1 ? r + 1 : r1 - 1);
#pragma unroll
              for (int j = 0; j < 4; ++j) n1[j] = *(const f32x4*)(src + 4 * lane + 256 * j); }
            consts(r); p1_finish(HXQ, HXS, r, lane, n0, gs, sh);
            { const float* src = src_of(r + 2 < r1 ? r + 2 : r1 - 1);
#pragma unroll
              for (int j = 0; j < 4; ++j) n0[j] = *(const f32x4*)(src + 4 * lane + 256 * j); }
            if (r + 1 < r1) { consts(r + 1); p1_finish(HXQ, HXS, r + 1, lane, n1, gs, sh); }
        }
    }
}

namespace hg {
constexpr int QS = 0, KD = 17408, KE = 34816, KHT = 52224, VT = 70656, PP = 89088, TT = 98304, EQ = 100352, EG = 102400, DK = 103936, SSQ = 104448, LBS = 106496  , GNS = 107008  , Q0 = 107520  , TT8 = 124928  , END = 129024;
constexpr int RS = 272  , TS = 144  ;
constexpr int CW_HG = 8192;
typedef float f32x4 __attribute__((ext_vector_type(4)));
__device__ __forceinline__ bf16x8 pack8(const f32x4 a, const f32x4 b) { u32x4 w; w.x = pg8::cvt_pk_bf16(a[0], a[1]); w.y = pg8::cvt_pk_bf16(a[2], a[3]); w.z = pg8::cvt_pk_bf16(b[0], b[1]); w.w = pg8::cvt_pk_bf16(b[2], b[3]); return __builtin_bit_cast(bf16x8, w); }
__device__ __forceinline__ void unpack8(const u32x4 w, f32x4& a, f32x4& b) { a = (f32x4){pg8::bf_lo(w.x), pg8::bf_hi(w.x), pg8::bf_lo(w.y), pg8::bf_hi(w.y)}; b = (f32x4){pg8::bf_lo(w.z), pg8::bf_hi(w.z), pg8::bf_lo(w.w), pg8::bf_hi(w.w)}; }

constexpr unsigned long long OR_SENTINEL = 0x7fff7fff7fff7fffull;
struct Inputs { unsigned f2[8], q2[8]; u32x4 vv[2]; };

template <bool BWD>
__device__ __forceinline__ void load_inputs(const Args& A, int b, int h, int c, int tid, Inputs& I) {
    const bool latent = c >= 4;
    const long rbase = (long)b * RPB + 64 * c, rlbase = (long)b * SEQ + 64 * (c - 4);
    const bf16_t* F = (const bf16_t*)(A.ws + (BWD ? WS_FB : WS_FF)) + (rbase * 512 + h * 128); const bf16_t* HI = (const bf16_t*)(A.ws + WS_HI) + (rbase * 512 + h * 128);
    const bf16_t* HQ = (const bf16_t*)(A.ws + WS_HQ) + ((latent ? rlbase : 0) * 512 + h * 128);
    const int w8 = __builtin_amdgcn_readfirstlane(tid >> 6); const unsigned voff = (unsigned)(4 * (tid & 63));
#pragma unroll
    for (int e = 0; e < 8; ++e) { const int rho = BWD ? 63 - (8 * w8 + e) : 8 * w8 + e;
        I.f2[e] = *(const unsigned*)((const char*)(F + rho * 512) + voff); I.q2[e] = *(const unsigned*)((const char*)(HQ + rho * 512) + voff); }
    const int sig = tid & 63; const unsigned voffv = (unsigned)((BWD ? 63 - sig : sig) * 1024 + (tid >> 6) * 16);
#pragma unroll
    for (int it = 0; it < 2; ++it) I.vv[it] = *(const u32x4*)((const char*)(HI + 64 * it) + voffv);
}

struct Prep { float kd[2][8], qs[2][8]; float PT[2]; u32x4 vv[2]; };
struct Mid { float kdl[2][8], qsl[2][8]; float T8[2]; u32x4 vv[2]; };
__device__ __forceinline__ void s1_math(LAS unsigned char* lds, Inputs& N, int tid, Mid& M) {
#pragma unroll
    for (int e = 0; e < 8; ++e) asm volatile("" : "+v"(N.f2[e]), "+v"(N.q2[e]));
    asm volatile("" : "+v"(N.vv[0]), "+v"(N.vv[1]));
    const int kp = tid & 63, w8 = tid >> 6;
    const pg8::f32x2_c lb2 = *(const LAS pg8::f32x2_c*)(lds + LBS + 8 * kp);
#pragma unroll
    for (int c = 0; c < 2; ++c) { const float lbv = lb2[c], oml = 1.0f - lbv; float pc = 1.0f;
#pragma unroll
        for (int e = 0; e < 8; ++e) { const float fp = c ? pg8::bf_hi(N.f2[e]) : pg8::bf_lo(N.f2[e]), q = c ? pg8::bf_hi(N.q2[e]) : pg8::bf_lo(N.q2[e]);
            const float f = lbv + oml * pg8::fsigmoid(fp);
            pc *= f; M.kdl[c][e] = (1.0f - f) * __builtin_amdgcn_rcpf(pc); M.qsl[c][e] = q * pc; }
        M.T8[c] = pc; }
    *(LAS pg8::f32x2_c*)(lds + TT8 + (w8 * 128 + 2 * kp) * 4) = (pg8::f32x2_c){M.T8[0], M.T8[1]};
    M.vv[0] = N.vv[0]; M.vv[1] = N.vv[1];
}
__device__ __forceinline__ void s1_store(LAS unsigned char* lds, const Mid& M, bool latent, int tid, Prep& P) {
    const int kp = tid & 63, w8 = __builtin_amdgcn_readfirstlane(tid >> 6);
    const pg8::f32x2_c o2 = *(const LAS pg8::f32x2_c*)(lds + TT8 + ((w8 ^ 1) * 128 + 2 * kp) * 4);
#pragma unroll
    for (int c = 0; c < 2; ++c) { P.PT[c] = M.T8[c] * o2[c];
        if (w8 & 1) { const float pre = o2[c], ipre = __builtin_amdgcn_rcpf(pre);
#pragma unroll
            for (int e = 0; e < 8; ++e) { P.kd[c][e] = M.kdl[c][e] * ipre; P.qs[c][e] = M.qsl[c][e] * pre; } }
        else {
#pragma unroll
            for (int e = 0; e < 8; ++e) { P.kd[c][e] = M.kdl[c][e]; P.qs[c][e] = M.qsl[c][e]; } } }
    P.vv[0] = M.vv[0]; P.vv[1] = M.vv[1];
    if (latent) {
#pragma unroll
        for (int e = 0; e < 8; ++e) { const int tau = 8 * w8 + e;
            *(LAS unsigned*)(lds + QS + tau * RS + 4 * kp) = pg8::cvt_pk_bf16(P.qs[0][e], P.qs[1][e]);
            *(LAS unsigned*)(lds + KD + tau * RS + 4 * kp) = pg8::cvt_pk_bf16(P.kd[0][e], P.kd[1][e]);
            *(LAS unsigned*)(lds + KE + tau * RS + 4 * kp) = pg8::cvt_pk_bf16(P.kd[0][e] * P.PT[0], P.kd[1][e] * P.PT[1]); }
    }
    if (!(w8 & 1)) *(LAS pg8::f32x2_c*)(lds + TT + ((w8 >> 1) * 128 + 2 * kp) * 4) = (pg8::f32x2_c){P.PT[0], P.PT[1]};
}
template <bool BWD, bool SECOND>
__device__ __forceinline__ void chunk_step(const Args& A, LAS unsigned char* lds, int b, int h, int c, f32x4 (&S)[8], Prep& P, Inputs& N, bool next_latent, int cpref, int tid_in) {
    int tid = tid_in; asm volatile("" : "+v"(tid));
    const int wave = __builtin_amdgcn_readfirstlane(tid >> 6), lane = tid & 63, l15 = lane & 15, g = lane >> 4;
    const bool latent = SECOND || c >= 4; constexpr bool second = SECOND;
    const long rlbase = (long)b * SEQ + 64 * (c - 4);
    const int k = tid & 127, part = tid >> 7;
    __syncthreads();
    {
        const int kp = tid & 63, w8 = wave, sb = w8 >> 1;
        const pg8::f32x2_c T0 = *(const LAS pg8::f32x2_c*)(lds + TT + (0 * 128 + 2 * kp) * 4), T1 = *(const LAS pg8::f32x2_c*)(lds + TT + (1 * 128 + 2 * kp) * 4),
                           T2 = *(const LAS pg8::f32x2_c*)(lds + TT + (2 * 128 + 2 * kp) * 4), T3 = *(const LAS pg8::f32x2_c*)(lds + TT + (3 * 128 + 2 * kp) * 4);
#pragma unroll
        for (int c = 0; c < 2; ++c) {
            const float khs = P.PT[c] * (sb == 0 ? T1[c] * T2[c] * T3[c] : sb == 1 ? T2[c] * T3[c] : sb == 2 ? T3[c] : 1.0f);
            u32x4 w0;
            w0.x = pg8::cvt_pk_bf16(P.kd[c][0] * khs, P.kd[c][1] * khs); w0.y = pg8::cvt_pk_bf16(P.kd[c][2] * khs, P.kd[c][3] * khs); w0.z = pg8::cvt_pk_bf16(P.kd[c][4] * khs, P.kd[c][5] * khs); w0.w = pg8::cvt_pk_bf16(P.kd[c][6] * khs, P.kd[c][7] * khs);
            *(LAS u32x4*)(lds + KHT + (2 * kp + c) * TS + 16 * w8) = w0; }
        if (latent) {
            const float eq0 = sb == 0 ? 1.0f : sb == 1 ? T0[0] : sb == 2 ? T0[0] * T1[0] : T0[0] * T1[0] * T2[0], eq1 = sb == 0 ? 1.0f : sb == 1 ? T0[1] : sb == 2 ? T0[1] * T1[1] : T0[1] * T1[1] * T2[1];
#pragma unroll
            for (int e = 0; e < 8; ++e) *(LAS unsigned*)(lds + Q0 + (8 * w8 + e) * RS + 4 * kp) = pg8::cvt_pk_bf16(P.qs[0][e] * eq0, P.qs[1][e] * eq1);
        }
        if (w8 == 0) *(LAS pg8::f32x2_c*)(lds + DK + 8 * kp) = (pg8::f32x2_c){(T0[0] * T1[0]) * (T2[0] * T3[0]), (T0[1] * T1[1]) * (T2[1] * T3[1])};
#pragma unroll
        for (int it = 0; it < 2; ++it) { const int idx = tid + 512 * it, sig = idx & 63, dv0 = (idx >> 6) * 8; const u32x4 w = P.vv[it];
            LAS unsigned short* vt = (LAS unsigned short*)(lds + VT + dv0 * TS + 2 * sig);
            vt[0 * (TS / 2)] = (unsigned short)(w.x & 0xffff); vt[1 * (TS / 2)] = (unsigned short)(w.x >> 16); vt[2 * (TS / 2)] = (unsigned short)(w.y & 0xffff); vt[3 * (TS / 2)] = (unsigned short)(w.y >> 16);
            vt[4 * (TS / 2)] = (unsigned short)(w.z & 0xffff); vt[5 * (TS / 2)] = (unsigned short)(w.z >> 16); vt[6 * (TS / 2)] = (unsigned short)(w.w & 0xffff); vt[7 * (TS / 2)] = (unsigned short)(w.w >> 16); }
    }
    Mid Q;
    s1_math(lds, N, tid, Q);
    load_inputs<BWD>(A, b, h, cpref, tid, N);
    if (latent) {
        for (int pi = wave; pi < 10; pi += 8) {
            const int bi = pi < 4 ? pi : pi < 7 ? pi - 3 : pi < 9 ? pi - 5 : 3;
            const int bjx = pi < 4 ? pi : pi < 7 ? pi - 4 : pi < 9 ? pi - 7 : 0;
            f32x4 cacc = (f32x4){0.f, 0.f, 0.f, 0.f};
            const int egsel = (bi == 2 && bjx == 0) ? 0 : (bi == 3 && bjx == 1) ? 1 : (bi == 3 && bjx == 0) ? 2 : -1;
            u32x4 aw[4], bw[4];
#pragma unroll
            for (int s = 0; s < 4; ++s) { aw[s] = *(const LAS u32x4*)(lds + QS + (16 * bi + l15) * RS + (32 * s + 8 * g) * 2);
                bw[s] = *(const LAS u32x4*)(lds + (bi == bjx ? KD : KE) + (16 * bjx + l15) * RS + (32 * s + 8 * g) * 2); }
            if (egsel >= 0) {
                const int t1 = egsel == 1 ? 2 : 1;
                f32x4 e0[4], e1[4];
#pragma unroll
                for (int s = 0; s < 4; ++s) { e0[s] = *(const LAS f32x4*)(lds + TT + (t1 * 128 + 32 * s + 8 * g) * 4); e1[s] = *(const LAS f32x4*)(lds + TT + (t1 * 128 + 32 * s + 8 * g + 4) * 4); }
                if (egsel == 2) {
#pragma unroll
                    for (int s = 0; s < 4; ++s) { e0[s] = e0[s] * *(const LAS f32x4*)(lds + TT + (2 * 128 + 32 * s + 8 * g) * 4); e1[s] = e1[s] * *(const LAS f32x4*)(lds + TT + (2 * 128 + 32 * s + 8 * g + 4) * 4); }
                }
#pragma unroll
                for (int s = 0; s < 4; ++s) { f32x4 a0, a1; unpack8(aw[s], a0, a1); aw[s] = __builtin_bit_cast(u32x4, pack8(a0 * e0[s], a1 * e1[s])); }
            }
#pragma unroll
            for (int s = 0; s < 4; ++s) cacc = __builtin_amdgcn_mfma_f32_16x16x32_bf16(__builtin_bit_cast(bf16x8, aw[s]), __builtin_bit_cast(bf16x8, bw[s]), cacc, 0, 0, 0);
#pragma unroll
            for (int r = 0; r < 4; ++r) { const int tl = 4 * g + r; float v = cacc[r]; if (bi == bjx && l15 > tl) v = 0.f;
                *(LAS unsigned short*)(lds + PP + (16 * bi + tl) * TS + 2 * (16 * bjx + l15)) = (unsigned short)pg8::cvt_pk_bf16(v, 0.f); }
        }
    }
    __syncthreads();
    bf16_t* ORb = (bf16_t*)(PB_OR(A)) + (rlbase * 512 + h * 128 + 16 * wave);
    unsigned long long pw[4]; u32x2 sgw[4];
    if (latent && second) {
        const bf16_t* SG = (const bf16_t*)(A.ws + WS_SG) + (rlbase * 512 + h * 128 + 16 * wave);
#pragma unroll
        for (int m = 0; m < 4; ++m) { const int tau = 16 * m + l15, rho = BWD ? 63 - tau : tau;
            pw[m] = __hip_atomic_load((unsigned long long*)(ORb + (unsigned)(rho * 512 + 4 * g)), RLX_AGENT); sgw[m] = *(const u32x2*)(SG + (unsigned)(rho * 512 + 4 * g)); }
    }
    bf16x8 vf[2];
#pragma unroll
    for (int s = 0; s < 2; ++s) vf[s] = *(const LAS bf16x8*)(lds + VT + (16 * wave + l15) * TS + (32 * s + 8 * g) * 2);
    f32x4 oT[4];
#pragma unroll
    for (int m = 0; m < 4; ++m) oT[m] = (f32x4){0.f, 0.f, 0.f, 0.f};
#define HG_RD_BQ(s) do { _Pragma("unroll") for (int m = 0; m < 4; ++m) { \
            const u32x2 q0w = *(const LAS u32x2*)(lds + Q0 + (16 * m + l15) * RS + (32 * (s) + 4 * g) * 2), q1w = *(const LAS u32x2*)(lds + Q0 + (16 * m + l15) * RS + (32 * (s) + 16 + 4 * g) * 2); \
            bq[(s) & 1][m].x = q0w.x; bq[(s) & 1][m].y = q0w.y; bq[(s) & 1][m].z = q1w.x; bq[(s) & 1][m].w = q1w.y; } } while (0)
#define HG_MM_BQ(s) do { const bf16x8 sf = pack8(S[2 * (s)], S[2 * (s) + 1]); _Pragma("unroll") for (int m = 0; m < 4; ++m) oT[m] = __builtin_amdgcn_mfma_f32_16x16x32_bf16(sf, __builtin_bit_cast(bf16x8, bq[(s) & 1][m]), oT[m], 0, 0, 0); } while (0)
#define HG_RD_KF(t) do { dk4[(t) & 3] = *(const LAS f32x4*)(lds + DK + (16 * (t) + 4 * g) * 4); _Pragma("unroll") for (int s_ = 0; s_ < 2; ++s_) kf[(t) & 3][s_] = *(const LAS bf16x8*)(lds + KHT + (16 * (t) + l15) * TS + (32 * s_ + 8 * g) * 2); } while (0)
#define HG_MM_KF(t) do { S[t] = S[t] * dk4[(t) & 3]; _Pragma("unroll") for (int s_ = 0; s_ < 2; ++s_) S[t] = __builtin_amdgcn_mfma_f32_16x16x32_bf16(kf[(t) & 3][s_], vf[s_], S[t], 0, 0, 0); } while (0)
    {
        f32x4 dk4[4]; bf16x8 kf[4][2];
        if (latent) {
            bf16x8 pf[4][2]; u32x4 bq[2][4];
#pragma unroll
            for (int m = 0; m < 4; ++m)
#pragma unroll
                for (int s = 0; s < 2; ++s) pf[m][s] = *(const LAS bf16x8*)(lds + PP + (16 * m + l15) * TS + (32 * s + 8 * g) * 2);
            HG_RD_BQ(0); HG_RD_BQ(1);
            __builtin_amdgcn_sched_barrier(0);
#pragma unroll
            for (int m = 0; m < 4; ++m)
#pragma unroll
                for (int s = 0; s < 2; ++s) oT[m] = __builtin_amdgcn_mfma_f32_16x16x32_bf16(vf[s], pf[m][s], oT[m], 0, 0, 0);
            HG_MM_BQ(0);
            __builtin_amdgcn_sched_barrier(0);
            HG_RD_BQ(2); HG_MM_BQ(1);
            __builtin_amdgcn_sched_barrier(0);
            HG_RD_BQ(3); HG_MM_BQ(2);
            __builtin_amdgcn_sched_barrier(0);
            HG_RD_KF(0); HG_RD_KF(1); HG_MM_BQ(3);
            __builtin_amdgcn_sched_barrier(0);
        } else { HG_RD_KF(0); HG_RD_KF(1); __builtin_amdgcn_sched_barrier(0); }
        HG_RD_KF(2); HG_RD_KF(3); HG_MM_KF(0); HG_MM_KF(1);
        __builtin_amdgcn_sched_barrier(0);
        HG_RD_KF(4); HG_RD_KF(5); HG_MM_KF(2); HG_MM_KF(3);
        __builtin_amdgcn_sched_barrier(0);
        HG_RD_KF(6); HG_RD_KF(7); HG_MM_KF(4); HG_MM_KF(5);
        __builtin_amdgcn_sched_barrier(0);
        HG_MM_KF(6); HG_MM_KF(7);
    }
#undef HG_RD_BQ
#undef HG_MM_BQ
#undef HG_RD_KF
#undef HG_MM_KF
    if (second) asm volatile("" : "+v"(pw[0]), "+v"(pw[1]), "+v"(pw[2]), "+v"(pw[3]), "+v"(S[7]), "+v"(oT[3]));
    if (latent) {
        if (!second) {
#pragma unroll
            for (int m = 0; m < 4; ++m) { const int tau = 16 * m + l15, rho = BWD ? 63 - tau : tau;
                const unsigned long long w = (unsigned long long)pg8::cvt_pk_bf16(oT[m][0], oT[m][1]) | ((unsigned long long)pg8::cvt_pk_bf16(oT[m][2], oT[m][3]) << 32);
                __hip_atomic_store((unsigned long long*)(ORb + (unsigned)(rho * 512 + 4 * g)), w, RLX_AGENT); }
        } else {
#pragma unroll
            for (int m = 0; m < 4; ++m) { const int tau = 16 * m + l15, rho_ = BWD ? 63 - tau : tau;
                for (unsigned sp = 0; pw[m] == OR_SENTINEL && sp < (1u << 20); ++sp) { __builtin_amdgcn_s_sleep(1); pw[m] = __hip_atomic_load((unsigned long long*)(ORb + (unsigned)(rho_ * 512 + 4 * g)), RLX_AGENT); }
                const unsigned lo = (unsigned)pw[m], hi = (unsigned)(pw[m] >> 32);
                oT[m] += (f32x4){pg8::bf_lo(lo), pg8::bf_hi(lo), pg8::bf_lo(hi), pg8::bf_hi(hi)};
                float ss = (oT[m][0] * oT[m][0] + oT[m][1] * oT[m][1]) + (oT[m][2] * oT[m][2] + oT[m][3] * oT[m][3]);
                ss += __shfl_xor(ss, 16); ss += __shfl_xor(ss, 32);
                if (g == 0) *(LAS float*)(lds + SSQ + (wave * 64 + tau) * 4) = ss; }
        }
    }
    if (latent && second) {
        __syncthreads();
        bf16_t* A1 = (bf16_t*)(PB_A1(A)) + (rlbase * 1024 + h * 128 + 16 * wave);
        const f32x4 gn = *(const LAS f32x4*)(lds + GNS + (16 * wave + 4 * g) * 4);
#pragma unroll
        for (int m = 0; m < 4; ++m) { const int tau = 16 * m + l15, rho = BWD ? 63 - tau : tau; float tot = 0.f;
#pragma unroll
            for (int w = 0; w < 8; ++w) tot += *(LAS float*)(lds + SSQ + (w * 64 + tau) * 4);
            const float rstd = 1.0f / sqrtf(tot * (1.0f / 128.0f) + EPS);
            const f32x4 sg4 = (f32x4){pg8::bf_lo(sgw[m].x), pg8::bf_hi(sgw[m].x), pg8::bf_lo(sgw[m].y), pg8::bf_hi(sgw[m].y)};
            const f32x4 o = oT[m] * rstd * gn * sg4;
            u32x2 ow; ow.x = pg8::cvt_pk_bf16(o[0], o[1]); ow.y = pg8::cvt_pk_bf16(o[2], o[3]); *(u32x2*)(A1 + (unsigned)(rho * 1024 + 4 * g)) = ow; }
    }
    s1_store(lds, Q, next_latent, tid, P);
}
template <bool BWD>
__device__ __forceinline__ void run_dir(const Args& A, LAS unsigned char* lds, int pair, int tid) {
    const int b = pair >> 2, h = pair & 3;
    if (tid < 128) { *(LAS float*)(lds + LBS + 4 * tid) = ((const float*)(A.ws + WS_LB))[(BWD ? 512 : 0) + h * 128 + tid]; *(LAS float*)(lds + GNS + 4 * tid) = A.hgn[h * 128 + tid]; }
    __syncthreads();
    f32x4 S[8];
#pragma unroll
    for (int t = 0; t < 8; ++t) S[t] = (f32x4){0.f, 0.f, 0.f, 0.f};
    {
      unsigned long long* orp = (unsigned long long*)((bf16_t*)(PB_OR(A)) + (((long)b * SEQ + (BWD ? 1024 : 0)) * 512 + h * 128));
      for (int i = tid; i < 1024 * 32; i += 512) __hip_atomic_store(orp + (size_t)(i >> 5) * 128 + (i & 31), OR_SENTINEL, RLX_AGENT); }
    auto chunk_of = [](int j) -> int { const int jj = j < 36 ? j : 35; return BWD ? (jj < 4 ? 3 - jj : 39 - jj) : jj; };
    Inputs nxt; Prep P;
    load_inputs<BWD>(A, b, h, chunk_of(0), tid, nxt);
    { Mid M0; s1_math(lds, nxt, tid, M0);
      load_inputs<BWD>(A, b, h, chunk_of(1), tid, nxt);
      __syncthreads();
      s1_store(lds, M0, false, tid, P); }
    for (int j = 0; j < 20; ++j) chunk_step<BWD, false>(A, lds, b, h, chunk_of(j), S, P, nxt, j + 1 >= 4, chunk_of(j + 2), tid);
    for (int j = 20; j < 36; ++j) chunk_step<BWD, true>(A, lds, b, h, chunk_of(j), S, P, nxt, true, chunk_of(j + 2), tid);
}
__device__ __forceinline__ void hgrn_item(const Args& A, LAS unsigned char* lds, int item, int tid) {
    for (int i = tid; i < (hg::TT - hg::PP) / 4; i += 512) *(LAS unsigned*)(lds + hg::PP + 4 * i) = 0u;
    __syncthreads();
    if (item & 1) run_dir<true>(A, lds, item >> 1, tid); else run_dir<false>(A, lds, item >> 1, tid);
}
}
namespace p5 {
constexpr int RSB = 2064  , WPTH = 0, WPTL = 16 * RSB  , GM = 2 * 16 * RSB  , SH = GM + 4096, BP = SH + 4096  , BIAS = BP + 2048, END = BIAS + 64;
__device__ __forceinline__ void rows128(const Args& A, LAS unsigned char* lds, int rb, int tid) {
    const int wave = __builtin_amdgcn_readfirstlane(tid >> 6), lane = tid & 63, l15 = lane & 15, g = lane >> 4;
    const int b = rb >> 4; const long row0 = (long)rb * 128 + wave * 16;
    const float* mod = (const float*)(A.ws + WS_MOD) + (size_t)b * NMOD;
    const bf16_t* x1 = (const bf16_t*)(A.ws + WS_X1B);
    { const int k = 2 * tid; const pg8::f32x2_c n2 = *(const pg8::f32x2_c*)(A.n2g + k), sc2 = *(const pg8::f32x2_c*)(mod + 4096 + k), sh2 = *(const pg8::f32x2_c*)(mod + 3072 + k);
      const float gm0 = n2[0] * (1.0f + sc2[0]), gm1 = n2[1] * (1.0f + sc2[1]);
      *(LAS pg8::f32x2_c*)(lds + GM + 4 * k) = (pg8::f32x2_c){gm0, gm1}; *(LAS pg8::f32x2_c*)(lds + SH + 4 * k) = sh2;
#pragma unroll
      for (int q = 0; q < 4; ++q) { const f32x4 w0 = *(const f32x4*)(A.wr + (size_t)k * 16 + 4 * q), w1 = *(const f32x4*)(A.wr + (size_t)(k + 1) * 16 + 4 * q);
#pragma unroll
          for (int j = 0; j < 4; ++j) { const float v0 = gm0 * w0[j], v1 = gm1 * w1[j]; const unsigned hi = pg8::cvt_pk_bf16(v0, v1);
              const unsigned lo = pg8::cvt_pk_bf16(v0 - pg8::bf_lo(hi), v1 - pg8::bf_hi(hi));
              *(LAS unsigned*)(lds + WPTH + (4 * q + j) * RSB + 2 * k) = hi; *(LAS unsigned*)(lds + WPTL + (4 * q + j) * RSB + 2 * k) = lo; } } }
    { const int e = tid & 15, kp = tid >> 4; float s = 0.f;
#pragma unroll
      for (int h = 0; h < 2; ++h) { float sv[16], wv[16];
#pragma unroll
          for (int i = 0; i < 16; ++i) { sv[i] = mod[3072 + kp * 32 + 16 * h + i]; wv[i] = A.wr[(size_t)(kp * 32 + 16 * h + i) * 16 + e]; }
#pragma unroll
          for (int i = 0; i < 16; ++i) s += sv[i] * wv[i]; }
      *(LAS float*)(lds + BP + (kp * 16 + e) * 4) = s; }
    __syncthreads();
    if (tid < 16) { float s = 0.f; for (int kp = 0; kp < 32; ++kp) s += *(LAS float*)(lds + BP + (kp * 16 + tid) * 4); *(LAS float*)(lds + BIAS + 4 * tid) = s; }
    __syncthreads();
    f32x4 acc = (f32x4){0.f, 0.f, 0.f, 0.f}; float ss = 0.f;
    { const bf16_t* xr = x1 + (row0 + l15) * 1024 + 8 * g;
      u32x4 xw[8];
#pragma unroll
      for (int it = 0; it < 8; ++it) xw[it] = *(const u32x4*)(xr + 32 * it);
#pragma unroll
      for (int it = 0; it < 32; ++it) {
        const bf16x8 bh = *(const LAS bf16x8*)(lds + WPTH + l15 * RSB + (32 * it + 8 * g) * 2), bl = *(const LAS bf16x8*)(lds + WPTL + l15 * RSB + (32 * it + 8 * g) * 2);
        const u32x4 w = xw[it & 7];
        if (it + 8 < 32) xw[it & 7] = *(const u32x4*)(xr + 32 * (it + 8));
        const bf16x8 a = __builtin_bit_cast(bf16x8, w);
        acc = __builtin_amdgcn_mfma_f32_16x16x32_bf16(a, bh, acc, 0, 0, 0); acc = __builtin_amdgcn_mfma_f32_16x16x32_bf16(a, bl, acc, 0, 0, 0);
        const float x0 = pg8::bf_lo(w.x), x1f = pg8::bf_hi(w.x), x2 = pg8::bf_lo(w.y), x3 = pg8::bf_hi(w.y), x4 = pg8::bf_lo(w.z), x5 = pg8::bf_hi(w.z), x6 = pg8::bf_lo(w.w), x7 = pg8::bf_hi(w.w);
        ss += ((x0 * x0 + x1f * x1f) + (x2 * x2 + x3 * x3)) + ((x4 * x4 + x5 * x5) + (x6 * x6 + x7 * x7));
        if ((it & 3) == 3) __builtin_amdgcn_sched_barrier(0);
      } }
    ss += __shfl_xor(ss, 16); ss += __shfl_xor(ss, 32);
    const float rstd = 1.0f / sqrtf(ss * (1.0f / 1024.0f) + EPS);
    const float bias = *(LAS float*)(lds + BIAS + 4 * l15);
    f32x4 aff;
#pragma unroll
    for (int r = 0; r < 4; ++r) { const float rs = __shfl(rstd, 4 * g + r); float lg = acc[r] * rs + bias;
        float mx = lg; mx = fmaxf(mx, __shfl_xor(mx, 1)); mx = fmaxf(mx, __shfl_xor(mx, 2)); mx = fmaxf(mx, __shfl_xor(mx, 4)); mx = fmaxf(mx, __shfl_xor(mx, 8));
        const float ex = expf(lg - mx); float sm = ex; sm += __shfl_xor(sm, 1); sm += __shfl_xor(sm, 2); sm += __shfl_xor(sm, 4); sm += __shfl_xor(sm, 8);
        aff[r] = ex / sm; }
    { float* AFF = (float*)(A.ws + WS_AFF); const int t = (rb & 15) * 128 + wave * 16 + 4 * g;
        *(f32x4*)(AFF + ((size_t)(b * 16 + l15)) * 2048 + t) = aff; }
    unsigned char* H2Q = A.ws + WS_H2; float* HS = (float*)(A.ws + WS_HS);
    for (int i0 = 0; i0 < 16; i0 += 4) {
        f32x4 v[4][4];
#pragma unroll
        for (int ii = 0; ii < 4; ++ii)
#pragma unroll
            for (int j = 0; j < 4; ++j) { const u32x2 w = *(const u32x2*)(x1 + (row0 + i0 + ii) * 1024 + 4 * lane + 256 * j); v[ii][j] = (f32x4){pg8::bf_lo(w.x), pg8::bf_hi(w.x), pg8::bf_lo(w.y), pg8::bf_hi(w.y)}; }
#pragma unroll
        for (int ii = 0; ii < 4; ++ii) { const float rs = __shfl(rstd, i0 + ii); float amax = 0.f;
#pragma unroll
            for (int j = 0; j < 4; ++j) { const int cidx = 4 * lane + 256 * j;
                const f32x4 gmv = *(const LAS f32x4*)(lds + GM + 4 * cidx), shv = *(const LAS f32x4*)(lds + SH + 4 * cidx);
                const f32x4 o = v[ii][j] * rs * gmv + shv; v[ii][j] = o;
                amax = fmaxf(fmaxf(amax, fmaxf(fabsf(o[0]), fabsf(o[1]))), fmaxf(fabsf(o[2]), fabsf(o[3]))); }
#pragma unroll
            for (int o_ = 1; o_ < 64; o_ <<= 1) amax = fmaxf(amax, __shfl_xor(amax, o_));
            const float am = amax > 1e-30f ? amax : 1e-30f, inv = 127.0f / am;
            if (lane == 0) HS[row0 + i0 + ii] = am * (1.0f / 127.0f);
#pragma unroll
            for (int j = 0; j < 4; ++j) { const f32x4 o = v[ii][j] * inv;
                const int q0 = (int)__builtin_rintf(o[0]), q1 = (int)__builtin_rintf(o[1]), q2 = (int)__builtin_rintf(o[2]), q3 = (int)__builtin_rintf(o[3]);
                *(unsigned*)(H2Q + (size_t)(row0 + i0 + ii) * 1024 + 4 * lane + 256 * j) = ((unsigned)q0 & 255u) | (((unsigned)q1 & 255u) << 8) | (((unsigned)q2 & 255u) << 16) | ((unsigned)q3 << 24); } } }
    __syncthreads();
}
__device__ __forceinline__ void ew_q8(const float* Wcol, unsigned char* WQ, float* TQp, LAS float* scr, int lane) {
    const int n4 = lane & 7, kr = lane >> 3;
    const float* W = Wcol + 4 * n4 + (size_t)kr * 1024;
    f32x4 ta[8], tb[8], tc[8], td[8];
#define EWQ_LD(t, kb) do { const float* w_ = W + (size_t)(64 * ((kb) < 16 ? (kb) : 15)) * 1024; _Pragma("unroll") for (int i = 0; i < 8; ++i) (t)[i] = *(const f32x4*)(w_ + (size_t)(8 * i) * 1024); } while (0)
#define EWQ_MAX(t) do { _Pragma("unroll") for (int i = 0; i < 8; ++i) { am4[0] = fmaxf(am4[0], fabsf((t)[i][0])); am4[1] = fmaxf(am4[1], fabsf((t)[i][1])); am4[2] = fmaxf(am4[2], fabsf((t)[i][2])); am4[3] = fmaxf(am4[3], fabsf((t)[i][3])); } } while (0)
    f32x4 am4 = (f32x4){0.f, 0.f, 0.f, 0.f};
    EWQ_LD(ta, 0); EWQ_LD(tb, 1); EWQ_LD(tc, 2); EWQ_LD(td, 3);
    for (int kb = 0; kb < 12; kb += 4) { EWQ_MAX(ta); EWQ_LD(ta, kb + 4); EWQ_MAX(tb); EWQ_LD(tb, kb + 5); EWQ_MAX(tc); EWQ_LD(tc, kb + 6); EWQ_MAX(td); EWQ_LD(td, kb + 7); }
    EWQ_MAX(ta); EWQ_MAX(tb); EWQ_MAX(tc); EWQ_MAX(td);
#pragma unroll
    for (int j = 0; j < 4; ++j) { float a = am4[j]; a = fmaxf(a, __shfl_xor(a, 8)); a = fmaxf(a, __shfl_xor(a, 16)); a = fmaxf(a, __shfl_xor(a, 32)); am4[j] = a > 1e-30f ? a : 1e-30f; }
    const f32x4 inv4 = (f32x4){127.0f / am4[0], 127.0f / am4[1], 127.0f / am4[2], 127.0f / am4[3]};
    if (lane < 8) *(f32x4*)(TQp + 4 * n4) = am4 * (1.0f / 127.0f);
#define EWQ_FIN(t, kb) do { _Pragma("unroll") for (int i = 0; i < 8; ++i) { const f32x4 q_ = (t)[i] * inv4; LAS float* d_ = scr + (kr + 8 * i) * 33 + 4 * n4; \
            d_[0] = __builtin_rintf(q_[0]); d_[1] = __builtin_rintf(q_[1]); d_[2] = __builtin_rintf(q_[2]); d_[3] = __builtin_rintf(q_[3]); } \
        LDS_WAIT(); asm volatile("" ::: "memory"); \
        { const int c = lane & 7; _Pragma("unroll") for (int j = 0; j < 4; ++j) { const int n = (lane >> 3) + 8 * j; const LAS float* s = scr + (8 * c) * 33 + n; \
            const unsigned w0 = ((unsigned)(int)s[0 * 33] & 255u) | (((unsigned)(int)s[1 * 33] & 255u) << 8) | (((unsigned)(int)s[2 * 33] & 255u) << 16) | ((unsigned)(int)s[3 * 33] << 24); \
            const unsigned w1 = ((unsigned)(int)s[4 * 33] & 255u) | (((unsigned)(int)s[5 * 33] & 255u) << 8) | (((unsigned)(int)s[6 * 33] & 255u) << 16) | ((unsigned)(int)s[7 * 33] << 24); \
            u32x2 o; o.x = w0; o.y = w1; *(u32x2*)(WQ + (size_t)n * 1024 + 64 * (kb) + 8 * c) = o; } } \
        LDS_WAIT(); asm volatile("" ::: "memory"); } while (0)
    EWQ_FIN(ta, 12); EWQ_LD(ta, 0); EWQ_FIN(tb, 13); EWQ_LD(tb, 1); EWQ_FIN(tc, 14); EWQ_LD(tc, 2); EWQ_FIN(td, 15); EWQ_LD(td, 3);
    for (int kb = 0; kb < 8; kb += 4) { EWQ_FIN(ta, kb); EWQ_LD(ta, kb + 4); EWQ_FIN(tb, kb + 1); EWQ_LD(tb, kb + 5); EWQ_FIN(tc, kb + 2); EWQ_LD(tc, kb + 6); EWQ_FIN(td, kb + 3); EWQ_LD(td, kb + 7); }
    EWQ_FIN(ta, 8); EWQ_FIN(tb, 9); EWQ_FIN(tc, 10); EWQ_FIN(td, 11);
#undef EWQ_LD
#undef EWQ_MAX
#undef EWQ_FIN
}
__device__ __forceinline__ void expert_weights(const Args& A, LAS unsigned char* lds, int vcu, int G, int tid) {
    const int wave = tid >> 6, lane = tid & 63; LAS float* scr = (LAS float*)(lds + wave * 8704);
    const int gw = vcu * NWAVES + wave, NGW = G * NWAVES;
    for (int it = gw; it < 16 * 64 + 16 * 32; it += NGW) {
        if (it < 16 * 64) { const int e = it >> 6, gi = it & 63, pn = gi >> 3, half = (gi >> 2) & 1, q = gi & 3;
            ew_q8((half ? A.weu : A.weg) + (size_t)e * 1024 * 1024 + 128 * pn + 32 * q, A.ws + WS_WGU + ((size_t)e * 2048 + gi * 32) * 1024, (float*)(A.ws + WS_TQ) + e * 2048 + gi * 32, scr, lane); }
        else { const int r = it - 16 * 64, e = r >> 5, gi = r & 31;
            ew_q8(A.wed + (size_t)e * 1024 * 1024 + 32 * gi, A.ws + WS_WD + ((size_t)e * 1024 + gi * 32) * 1024, (float*)(A.ws + WS_TD) + e * 1024 + gi * 32, scr, lane); } }
}
}

__device__ __forceinline__ unsigned block_exscan(unsigned v, LAS unsigned* scr, int tid, unsigned* total) {
    const int lane = tid & 63, wave = tid >> 6; unsigned inc = v;
#pragma unroll
    for (int o = 1; o < 64; o <<= 1) { const unsigned t = __shfl_up(inc, o); if (lane >= o) inc += t; }
    if (lane == 63) scr[wave] = inc;
    __syncthreads();
    unsigned base = 0, tot = 0;
#pragma unroll
    for (int w = 0; w < 8; ++w) { const unsigned x = scr[w]; if (w < wave) base += x; tot += x; }
    __syncthreads();
    *total = tot; return base + inc - v;
}
__device__ __forceinline__ void topk_unit(const Args& A, LAS unsigned char* lds, int b, int e, int tid) {
    LAS unsigned* hist = (LAS unsigned*)lds;
    LAS unsigned* ctlw = (LAS unsigned*)(lds + 1024);
    const float* AFF = (const float*)(A.ws + WS_AFF) + (size_t)(b * 16 + e) * 2048;
    const f32x4 v4 = *(const f32x4*)(AFF + 4 * tid);
    unsigned key[4];
#pragma unroll
    for (int i = 0; i < 4; ++i) key[i] = __float_as_uint(v4[i]);
    unsigned prefix = 0, need = 256;
#pragma unroll 1
    for (int pass = 0; pass < 4; ++pass) { const int shift = 24 - 8 * pass;
        if (tid < 256) hist[tid] = 0u;
        __syncthreads();
#pragma unroll
        for (int i = 0; i < 4; ++i) if (pass == 0 || (key[i] >> (shift + 8)) == prefix) (void)__hip_atomic_fetch_add(&hist[(key[i] >> shift) & 255u], 1u, __ATOMIC_RELAXED, __HIP_MEMORY_SCOPE_WORKGROUP);
        __syncthreads();
        if (tid < 64) {
            const unsigned h0 = hist[4 * tid], h1 = hist[4 * tid + 1], h2 = hist[4 * tid + 2], h3 = hist[4 * tid + 3]; const unsigned mine = h0 + h1 + h2 + h3;
            unsigned suf = mine;
#pragma unroll
            for (int o = 1; o < 64; o <<= 1) { const unsigned t = __shfl_down(suf, o); if (tid + o < 64) suf += t; }
            const unsigned above = suf - mine;
            if (above < need && suf >= need) {
                unsigned cum = above; int bin = 4 * tid + 3;
                if (cum + h3 >= need) { } else { cum += h3; bin = 4 * tid + 2; if (cum + h2 >= need) { } else { cum += h2; bin = 4 * tid + 1; if (cum + h1 >= need) { } else { cum += h1; bin = 4 * tid; } } }
                ctlw[8] = (prefix << 8) | (unsigned)bin; ctlw[9] = need - cum; } }
        __syncthreads();
        prefix = ctlw[8]; need = ctlw[9];
        __syncthreads();
    }
    unsigned eqc = 0;
#pragma unroll
    for (int i = 0; i < 4; ++i) eqc += (key[i] == prefix) ? 1u : 0u;
    unsigned tot; unsigned eqbase = block_exscan(eqc, ctlw, tid, &tot);
    unsigned sel = 0; bool take[4];
#pragma unroll
    for (int i = 0; i < 4; ++i) { take[i] = key[i] > prefix; if (key[i] == prefix) { take[i] = eqbase < need; ++eqbase; } sel += take[i] ? 1u : 0u; }
    unsigned slot = block_exscan(sel, ctlw, tid, &tot);
    int* IDX = (int*)(A.ws + WS_IDX) + (b * 16 + e) * 256; float* GATE = (float*)(A.ws + WS_IDX + 256 * 1024) + (b * 16 + e) * 256; int* SLOT = (int*)(A.ws + WS_SLOT);
    float* SCL = (float*)(A.ws + WS_SCL) + (b * 16 + e) * 256; const float* HS = (const float*)(A.ws + WS_HS);
#pragma unroll
    for (int i = 0; i < 4; ++i) { const int t = 4 * tid + i; int sl = -1;
        if (take[i]) { sl = (int)slot; ++slot; IDX[sl] = b * 2048 + t; GATE[sl] = v4[i]; SCL[sl] = HS[b * 2048 + t]; }
        SLOT[(size_t)(b * 2048 + t) * 16 + e] = sl; }
    VM_WAIT();
    __syncthreads();
}

struct P7Row { u32x4 x[2]; u32x2 y[4][2]; int ne; unsigned rest; };
typedef int i32x4_p7 __attribute__((ext_vector_type(4)));
__device__ __forceinline__ int p7_slot_of(const i32x4_p7 sl, int i, int e) {
    const int c = e & 3; const int v = c == 0 ? sl.x : c == 1 ? sl.y : c == 2 ? sl.z : sl.w;
    return __builtin_amdgcn_readlane(v, 4 * i + (e >> 2));
}
__device__ __forceinline__ unsigned p7_mask_of(const unsigned long long (&bc)[4], int i) {
    unsigned m = 0;
#pragma unroll
    for (int c = 0; c < 4; ++c) { const unsigned n = (unsigned)(bc[c] >> (4 * i)) & 15u; m |= ((n & 1u) | ((n & 2u) << 3) | ((n & 4u) << 6) | ((n & 8u) << 9)) << c; }
    return m;
}
__device__ __forceinline__ void p7_issue(const bf16_t* X1B, const unsigned char* YE, int r, const i32x4_p7 sl, const unsigned long long (&bc)[4], int i, int lane, P7Row& R) {
    const int b = r >> 11;
#pragma unroll
    for (int j = 0; j < 2; ++j) R.x[j] = *(const u32x4*)(X1B + (size_t)r * 1024 + j * 512 + 8 * lane);
    unsigned m = p7_mask_of(bc, i); int ne = 0;
#pragma unroll
    for (int q = 0; q < 4; ++q) { const unsigned char* yr = YE;
        if (m) { const int e = __builtin_ctz(m); m &= m - 1; yr = YE + ((size_t)(b * 16 + e) * 256 + p7_slot_of(sl, i, e)) * 1024; ne = q + 1; }
        if (!DBG_TIMING) { R.y[q][0] = *(const u32x2*)(yr + 8 * lane); R.y[q][1] = *(const u32x2*)(yr + 512 + 8 * lane); } }
    R.ne = DBG_TIMING ? 0 : ne; R.rest = DBG_TIMING ? 0u : m;
}
__device__ __forceinline__ void p7_f8acc(const u32x2 w, f32x4& a0, f32x4& a1) {
    const pg8::f32x2_c p0 = __builtin_amdgcn_cvt_pk_f32_fp8((int)w.x, false), p1 = __builtin_amdgcn_cvt_pk_f32_fp8((int)w.x, true), p2 = __builtin_amdgcn_cvt_pk_f32_fp8((int)w.y, false), p3 = __builtin_amdgcn_cvt_pk_f32_fp8((int)w.y, true);
    a0 += (f32x4){p0[0], p0[1], p1[0], p1[1]}; a1 += (f32x4){p2[0], p2[1], p3[0], p3[1]};
}
__device__ __forceinline__ void p7_finish(const Args& A, const unsigned char* YE, int r, const i32x4_p7 sl, int i, int lane, const P7Row& R, const f32x4 (&g2)[4], const f32x4 (&fg)[4], float scale) {
    const int b = r >> 11;
    f32x4 acc[4];
#pragma unroll
    for (int j = 0; j < 4; ++j) acc[j] = (f32x4){0.f, 0.f, 0.f, 0.f};
#pragma unroll
    for (int q = 0; q < 4; ++q) if (q < R.ne) { p7_f8acc(R.y[q][0], acc[0], acc[1]); p7_f8acc(R.y[q][1], acc[2], acc[3]); }
    for (unsigned m = R.rest; m;) { const int e = __builtin_ctz(m); m &= m - 1;
        const unsigned char* yr = YE + ((size_t)(b * 16 + e) * 256 + p7_slot_of(sl, i, e)) * 1024;
        p7_f8acc(*(const u32x2*)(yr + 8 * lane), acc[0], acc[1]); p7_f8acc(*(const u32x2*)(yr + 512 + 8 * lane), acc[2], acc[3]); }
#pragma unroll
    for (int j = 0; j < 4; ++j) acc[j] = acc[j] * (1.0f / pg8::YE_F8_SCALE);
    f32x4 xv[4];
#pragma unroll
    for (int j = 0; j < 2; ++j) { const u32x4 w = R.x[j]; xv[2 * j] = (f32x4){pg8::bf_lo(w.x), pg8::bf_hi(w.x), pg8::bf_lo(w.y), pg8::bf_hi(w.y)}; xv[2 * j + 1] = (f32x4){pg8::bf_lo(w.z), pg8::bf_hi(w.z), pg8::bf_lo(w.w), pg8::bf_hi(w.w)}; }
    float* xo = A.out + (size_t)r * 1024; f32x4 v[4]; float ss = 0.f;
#pragma unroll
    for (int j = 0; j < 4; ++j) { const int cidx = (j >> 1) * 512 + 8 * lane + (j & 1) * 4;
        v[j] = xv[j] + g2[j] * acc[j]; ss += (v[j][0] * v[j][0] + v[j][1] * v[j][1]) + (v[j][2] * v[j][2] + v[j][3] * v[j][3]); }
    const float rstd = 1.0f / sqrtf(wave_sum(ss) * (1.0f / 1024.0f) + EPS);
#pragma unroll
    for (int j = 0; j < 4; ++j) { const int cidx = (j >> 1) * 512 + 8 * lane + (j & 1) * 4; *(f32x4*)(xo + cidx) = v[j] * (rstd * scale) * fg[j]; }
}
__device__ __forceinline__ void p7_rows(const Args& A, int vcu, int G, int tid) {
    const int wave = tid >> 6, lane = tid & 63; const int gw = vcu * NWAVES + wave, NGW = G * NWAVES;
    const float* mod = (const float*)(A.ws + WS_MOD); const int* SLOT = (const int*)(A.ws + WS_SLOT); const unsigned char* YE = A.ws + WS_YE; const bf16_t* X1B = (const bf16_t*)(A.ws + WS_X1B);
#if DBG_TIMING
    const unsigned tsa_ = __hip_atomic_load((unsigned*)(A.ws + WS_CTL) + 100 + DBG_TIME_A0, RLX_AGENT), tsb_ = __hip_atomic_load((unsigned*)(A.ws + WS_CTL) + 100 + DBG_TIME_A1, RLX_AGENT);
    const float DBG_SCALE = 1.0f + (float)((tsb_ - tsa_) / (100u * DBG_TIME_Q));
#else
    const float DBG_SCALE = 1.0f;
#endif
    const int RPW = (((ML + NGW - 1) / NGW) + 15) & ~15;
    const int r0 = gw * RPW, r1 = r0 + RPW < ML ? r0 + RPW : ML;
    f32x4 fg[4], g2[4]; int bcur = -1;
#pragma unroll
    for (int j = 0; j < 4; ++j) { fg[j] = *(const f32x4*)(A.fng + (j >> 1) * 512 + 8 * lane + (j & 1) * 4); g2[j] = fg[j]; }
    asm volatile("" : "+v"(fg[0]), "+v"(fg[1]), "+v"(fg[2]), "+v"(fg[3]));
    for (int rg = r0; rg < r1; rg += 16) {
        const int nr = r1 - rg < 16 ? r1 - rg : 16, b = rg >> 11;
        if (b != bcur) { bcur = b;
#pragma unroll
            for (int j = 0; j < 4; ++j) g2[j] = *(const f32x4*)(mod + (size_t)b * NMOD + 5120 + (j >> 1) * 512 + 8 * lane + (j & 1) * 4);
            asm volatile("" : "+v"(g2[0]), "+v"(g2[1]), "+v"(g2[2]), "+v"(g2[3])); }
        i32x4_p7 sl = *(const i32x4_p7*)(SLOT + (size_t)rg * 16 + 4 * lane);
        asm volatile("" : "+v"(sl));
        unsigned long long bc[4]; bc[0] = __ballot(sl.x >= 0); bc[1] = __ballot(sl.y >= 0); bc[2] = __ballot(sl.z >= 0); bc[3] = __ballot(sl.w >= 0);
        P7Row B0, B1;
        p7_issue(X1B, YE, rg, sl, bc, 0, lane, B0);
        for (int i = 0; i < nr; i += 2) {
            { const int i1 = i + 1 < nr ? i + 1 : nr - 1; p7_issue(X1B, YE, rg + i1, sl, bc, i1, lane, B1); }
            p7_finish(A, YE, rg + i, sl, i, lane, B0, g2, fg, DBG_SCALE);
            { const int i2 = i + 2 < nr ? i + 2 : nr - 1; p7_issue(X1B, YE, rg + i2, sl, bc, i2, lane, B0); }
            if (i + 1 < nr) p7_finish(A, YE, rg + i + 1, sl, i + 1, lane, B1, g2, fg, DBG_SCALE);
        }
    }
}

#ifndef DBG_TIMING
#define DBG_TIMING 0
#endif
typedef const __attribute__((address_space(4))) Args* KArgsPtr;
__global__ void __launch_bounds__(NWAVES * 64, 2) fwd_megakernel(Args A_) {
    KArgsPtr ap = (KArgsPtr)__builtin_amdgcn_kernarg_segment_ptr(); asm volatile("" : "+s"(ap));
#define A (*(const Args*)ap)
    extern __shared__ __attribute__((aligned(16))) unsigned char lds_raw[];
    LAS unsigned char* lds = (LAS unsigned char*)lds_raw;
    volatile LAS unsigned* MISC = (volatile LAS unsigned*)(lds + MISC_OFF);
    int tid = threadIdx.x; const int bx = blockIdx.x, G = gridDim.x;
    const int vcu = (G % 8 == 0) ? (bx % 8) * (G / 8) + bx / 8 : bx;
    unsigned* ctl = (unsigned*)(A.ws + WS_CTL);
    for (int u = tid; u < 64; u += NWAVES * 64) ((LAS unsigned*)(lds + MISC_OFF))[u] = 0u;
    __syncthreads();
    const XcdBarrier xbar = xcd_barrier_post((unsigned*)(ctl + CW_BAR), MISC + 8);
#define GRID_BAR() xcd_barrier(xbar)
#define RELAUNDER() do { int t_ = threadIdx.x; asm volatile("" : "+v"(t_)); tid = t_; KArgsPtr p_ = (KArgsPtr)__builtin_amdgcn_kernarg_segment_ptr(); asm volatile("" : "+s"(p_)); ap = p_; } while (0)
#if DBG_TIMING
#define STAMP(k) do { if (bx == 0) ctl[100 + (k)] = (unsigned)__builtin_amdgcn_s_memrealtime(); } while (0)
#else
#define STAMP(k) do { } while (0)
#endif
    STAMP(0);
    RELAUNDER();
    p0_prologue<0>(A, lds, vcu, G, tid);
    GRID_BAR(); STAMP(1);
    RELAUNDER();
    p1_rows(A, vcu, G, tid);
    RELAUNDER();
    p0_prologue<1>(A, lds, vcu, G, tid);
    GRID_BAR(); STAMP(2);
    RELAUNDER();
    {
        pg8::Gemm g{(const bf16_t*)(PB_HX(A)), (const bf16_t*)(A.ws + WS_WIN), MR, INC, 512  , nullptr}; pg8::InProjOrder S; S.init(G, bx);
        pg8::EpiInProjQ E{{A.ws, WS_HQ, WS_FF, WS_FB, WS_HI, WS_SG, WS_Q, WS_K, WS_V, WS_GA, WS_GB, WS_ROPE, A.qng, A.kng}, (const float*)PB_HXS(A), (const float*)(A.ws + WS_WINS)};
        pg8::gemm_phase<pg8::EpiInProjQ, pg8::InProjOrder, true, true, true>(lds, g, S, E);
    }
    GRID_BAR(); STAMP(3);
    RELAUNDER();
    {
        if (bx < 128) { for (int it = bx; it < 128; it += G) { RELAUNDER(); hg::hgrn_item(A, lds, it, tid); } }
        else p5::expert_weights(A, lds, bx - 128, G - 128, tid);
        STAMP(20);
        __syncthreads();
        const float att_mfix = __uint_as_float(__builtin_amdgcn_readfirstlane(__hip_atomic_load(ctl + CW_MFIX, RLX_AGENT)));
#define ATT_QUEUE(FIX, MF) for (;;) { \
            if (tid == 0) MISC[0] = atomicAdd(ctl + CW_Q3, 1u); \
            __syncthreads(); \
            const unsigned u = MISC[0]; \
            __syncthreads(); \
            if (u >= 1024u) break; \
            const int bk = u >> 5, b = bk >> 1, kvh = bk & 1, gq = (u >> 3) & 3, qb = u & 7; \
            attn_body::attn_unit<8, FIX>((long)b * SEQ + qb * 256, kvh * 4 + gq, (long)b * RPB, kvh, (const attn_body::bf16*)(A.ws + WS_Q), (const attn_body::bf16*)(A.ws + WS_K), (const attn_body::bf16*)(A.ws + WS_V), \
                                    (attn_body::bf16*)(PB_OATT(A)), (char*)lds_raw, MF); }
        if (att_mfix <= 60.0f) { ATT_QUEUE(true, att_mfix) } else { ATT_QUEUE(false, 0.f) }
#undef ATT_QUEUE
    }
    GRID_BAR(); STAMP(4);
    RELAUNDER();
    {
        pg8::StaticOrder S; S.init(ML, 1024, G, bx);
        pg8::Gemm g{(const bf16_t*)(PB_A1(A)), (const bf16_t*)(A.ws + WS_WA), ML, 1024, 1024, nullptr};
        pg8::EpiZ2 E{(bf16_t*)(A.ws + WS_Z), A.ws + WS_GA, A.ws + WS_GB};
        pg8::gemm_phase<pg8::EpiZ2, pg8::StaticOrder, true, true, false, true>(lds, g, S, E);
    }
    GRID_BAR(); STAMP(5);
    RELAUNDER();
    {
        pg8::StaticOrder S; S.init(ML, 1024, G, bx);
        pg8::Gemm g{(const bf16_t*)(A.ws + WS_Z), (const bf16_t*)(A.ws + WS_WO), ML, 1024, 1024, nullptr}; pg8::EpiX1 E{A.x, (const float*)(A.ws + WS_MOD), (bf16_t*)(A.ws + WS_X1B)};
        pg8::gemm_phase<pg8::EpiX1, pg8::StaticOrder, true, true>(lds, g, S, E);
    }
    GRID_BAR(); STAMP(6);
    RELAUNDER();
    for (int rb = vcu; rb < 256; rb += G) { RELAUNDER(); p5::rows128(A, lds, rb, tid); }
    GRID_BAR(); STAMP(7);
    RELAUNDER();
    for (int uu = vcu; uu < 256; uu += G) { const int e = uu >> 4, b = uu & 15, unit = b * 16 + e;
        RELAUNDER();
        topk_unit(A, lds, b, e, tid);
        bf16_t* HID = (bf16_t*)(PB_HID(A)) + (size_t)unit * 256 * 1024;
        { pg8::Gemm g{(const bf16_t*)(A.ws + WS_H2), (const bf16_t*)(A.ws + WS_WGU) + (size_t)e * 2048 * 512, 256, 2048, 512  , (const int*)(A.ws + WS_IDX) + unit * 256};
          pg8::LocalOrder S{8}; pg8::EpiHidQ E{HID, (const float*)(A.ws + WS_SCL) + unit * 256, (const float*)(A.ws + WS_TQ) + e * 2048};
          pg8::gemm_phase<pg8::EpiHidQ, pg8::LocalOrder, true, true, true>(lds, g, S, E); }
        VM_WAIT(); __syncthreads();
        { unsigned char* HQ = A.ws + WS_HIDQ + (size_t)unit * 256 * 1024; float* S2 = (float*)(A.ws + WS_SCL2) + unit * 256; const int wv = tid >> 6, ln = tid & 63;
          for (int r0 = wv * 32; r0 < wv * 32 + 32; r0 += 8) {
              u32x4 w[8][2];
#pragma unroll
              for (int ii = 0; ii < 8; ++ii) { w[ii][0] = *(const u32x4*)(HID + (size_t)(r0 + ii) * 1024 + 16 * ln); w[ii][1] = *(const u32x4*)(HID + (size_t)(r0 + ii) * 1024 + 16 * ln + 8); }
#pragma unroll
              for (int ii = 0; ii < 8; ++ii) { f32x4 v[4];
                  v[0] = (f32x4){pg8::bf_lo(w[ii][0].x), pg8::bf_hi(w[ii][0].x), pg8::bf_lo(w[ii][0].y), pg8::bf_hi(w[ii][0].y)}; v[1] = (f32x4){pg8::bf_lo(w[ii][0].z), pg8::bf_hi(w[ii][0].z), pg8::bf_lo(w[ii][0].w), pg8::bf_hi(w[ii][0].w)};
                  v[2] = (f32x4){pg8::bf_lo(w[ii][1].x), pg8::bf_hi(w[ii][1].x), pg8::bf_lo(w[ii][1].y), pg8::bf_hi(w[ii][1].y)}; v[3] = (f32x4){pg8::bf_lo(w[ii][1].z), pg8::bf_hi(w[ii][1].z), pg8::bf_lo(w[ii][1].w), pg8::bf_hi(w[ii][1].w)};
                  float amax = 0.f;
#pragma unroll
                  for (int j = 0; j < 4; ++j) amax = fmaxf(fmaxf(amax, fmaxf(fabsf(v[j][0]), fabsf(v[j][1]))), fmaxf(fabsf(v[j][2]), fabsf(v[j][3])));
#pragma unroll
                  for (int o_ = 1; o_ < 64; o_ <<= 1) amax = fmaxf(amax, __shfl_xor(amax, o_));
                  const float am = amax > 1e-30f ? amax : 1e-30f, inv = 127.0f / am;
                  if (ln == 0) S2[r0 + ii] = am * (1.0f / 127.0f);
                  u32x4 o;
#pragma unroll
                  for (int j = 0; j < 4; ++j) { const f32x4 q = v[j] * inv;
                      const unsigned pk = ((unsigned)(int)__builtin_rintf(q[0]) & 255u) | (((unsigned)(int)__builtin_rintf(q[1]) & 255u) << 8) | (((unsigned)(int)__builtin_rintf(q[2]) & 255u) << 16) | ((unsigned)(int)__builtin_rintf(q[3]) << 24);
                      if (j == 0) o.x = pk; else if (j == 1) o.y = pk; else if (j == 2) o.z = pk; else o.w = pk; }
                  *(u32x4*)(HQ + (size_t)(r0 + ii) * 1024 + 16 * ln) = o; } } }
        VM_WAIT(); __syncthreads();
        { pg8::Gemm g{(const bf16_t*)(A.ws + WS_HIDQ) + (size_t)unit * 256 * 512, (const bf16_t*)(A.ws + WS_WD) + (size_t)e * 1024 * 512, 256, 1024, 512  , nullptr};
          pg8::LocalOrder S{4}; pg8::EpiYeQ E{A.ws + WS_YE + (size_t)unit * 256 * 1024, (const float*)(A.ws + WS_IDX + 256 * 1024) + unit * 256, (const float*)(A.ws + WS_SCL2) + unit * 256, (const float*)(A.ws + WS_TD) + e * 1024};
          pg8::gemm_phase<pg8::EpiYeQ, pg8::LocalOrder, true, true, true>(lds, g, S, E); }
        __syncthreads();
    }
    GRID_BAR(); STAMP(8);
#if DBG_TIMING
    GRID_BAR();
#endif
    RELAUNDER();
    p7_rows(A, vcu, G, tid);
}
#undef A

extern "C" void kernel_launch(void* const* d_in, const int* in_sizes, int n_in, void* d_out, int out_size, void* d_ws, size_t ws_size, hipStream_t stream) {
    static int grid = 0;
    if (grid == 0) {
        if (n_in != 21 || out_size != ML * 1024 || ws_size < WS_END) { fprintf(stderr, "kernel_launch: unexpected problem (n_in %d, out %d, ws %zu); nothing launched\n", n_in, out_size, ws_size); grid = -1; return; }
        int dev = 0, cus = 0, per_cu = 0;
        if (hipGetDevice(&dev) != hipSuccess || hipDeviceGetAttribute(&cus, hipDeviceAttributeMultiprocessorCount, dev) != hipSuccess) { grid = -1; return; }
        if (hipFuncSetAttribute((const void*)fwd_megakernel, hipFuncAttributeMaxDynamicSharedMemorySize, LDS_BYTES) != hipSuccess) { fprintf(stderr, "kernel_launch: hipFuncSetAttribute failed\n"); grid = -1; return; }
        if (hipOccupancyMaxActiveBlocksPerMultiprocessor(&per_cu, (const void*)fwd_megakernel, NWAVES * 64, LDS_BYTES) != hipSuccess || per_cu < 1) { fprintf(stderr, "kernel_launch: occupancy query says %d\n", per_cu); (void)hipGetLastError(); grid = -1; return; }
        grid = cus;
    }
    if (grid < 0) return;
    (void)hipMemsetAsync((char*)d_ws + WS_CTL, 0, CTL_ZERO_BYTES, stream);
    Args a{};
    const float** ap = (const float**)&a;
    for (int i = 0; i < 21; ++i) ap[i] = (const float*)d_in[i];
    a.out = (float*)d_out; a.ws = (unsigned char*)d_ws;
    hipLaunchKernelGGL(fwd_megakernel, dim3(grid), dim3(NWAVES * 64), LDS_BYTES, stream, a);
    const hipError_t le = hipPeekAtLastError();
    if (le != hipSuccess) fprintf(stderr, "kernel_launch: launch failed: %s (grid %d)\n", hipGetErrorName(le), grid);
}
```

```cpp
#include <hip/hip_runtime.h>
#include <hip/hip_bf16.h>
#include <hip/hip_cooperative_groups.h>
#include <cstdio>
#include <cstdint>
#include <cmath>
namespace cg = cooperative_groups;

constexpr int NB = 16, SEQ = 2048, CTXL = 256, DM_ = 1024, RPB = SEQ + CTXL  ;
constexpr int MR = NB * RPB  , ML = NB * SEQ  , INC = 5376, NMOD = 6 * DM_;
constexpr int NE = 16, CAP = 256, EFF = 1024;
constexpr float EPS = 1e-6f;
constexpr float LOG2E = 1.4426950408889634f;
#ifndef DEBUG_POISON
#define DEBUG_POISON 0
#endif
#ifndef DBG_NOMOE
#define DBG_NOMOE 0
#endif
#ifndef DBG_NOATT
#define DBG_NOATT 0
#endif
#ifndef DBG_NOHG
#define DBG_NOHG 0
#endif
#ifndef DBG_OUT_X
#define DBG_OUT_X 0
#endif
#ifndef DBG_X1_NOY
#define DBG_X1_NOY 0
#endif
#ifndef DBG_P4B_A
#define DBG_P4B_A 0
#endif
#ifndef PHASES
#define PHASES 511
#endif
#ifndef DBG_GA_ONLY
#define DBG_GA_ONLY 0
#endif
#ifndef DBG_DOUBLE_BAR
#define DBG_DOUBLE_BAR 0
#endif
#ifndef DBG_WBL2_TWICE
#define DBG_WBL2_TWICE 0
#endif
#ifndef DBG_LEADER_DELAY
#define DBG_LEADER_DELAY 0
#endif
#ifndef DBG_RELEASE_ALL
#define DBG_RELEASE_ALL 0
#endif
#ifndef PG8_DMA_AUX
#define PG8_DMA_AUX 0
#endif
#ifndef DBG_CHECKS
#define DBG_CHECKS 0
#endif
#ifndef DBG_SYSINV
#define DBG_SYSINV 0
#endif
#ifndef DBG_HG_B
#define DBG_HG_B 15
#endif
#ifndef DBG_ALPHA
#define DBG_ALPHA 1.0f
#endif
#ifndef DBG_ONLYATT
#define DBG_ONLYATT 0
#endif
#ifndef DBG_BETA
#define DBG_BETA 1.0f
#endif
#ifndef DBG_POISON_SET
#define DBG_POISON_SET 0
#endif
#ifndef PG8_USE_DMA
#define PG8_USE_DMA 0
#endif
#ifndef DBG_BARTEST
#define DBG_BARTEST 0
#endif
#ifndef DBG_OUT_BUF
#define DBG_OUT_BUF 0
#endif
#ifndef DBG_TIMING
#define DBG_TIMING 0
#define DBG_TIME_A0 3
#define DBG_TIME_A1 20
#endif
#ifndef REPEAT_PHASE
#define REPEAT_PHASE -1
#endif
#ifndef DBG_TIME_Q
#define DBG_TIME_Q 16u
#endif
#ifndef HG_EXP
#define HG_EXP 0
#endif
#ifndef EPI_EXP
#define EPI_EXP 0
#endif
#ifndef P2_STAGGER_TICKS
#define P2_STAGGER_TICKS 0
#endif
namespace pg8 {
#define PG8_LAS __attribute__((address_space(3)))
typedef unsigned short bf16_t;
typedef short bf16x8 __attribute__((ext_vector_type(8)));
typedef float f32x4 __attribute__((ext_vector_type(4)));
typedef unsigned u32x4 __attribute__((ext_vector_type(4)));
constexpr int BM = 256, BK = 64, HALF = 128, HTB = HALF * BK * 2  , STAGE_BYTES = 8 * HTB, NXCD = 8, WGM = 8;

__host__ __device__ __forceinline__ int lds_byte(int r, int c) { const int st = (r >> 4) * 2 + (c >> 5), rr = r & 15, cc = c & 31, ob = rr * 64 + cc * 2; return st * 1024 + (ob ^ (((ob >> 9) & 1) << 5)); }
__host__ __device__ __forceinline__ void stage_rc(int b, int& R, int& C) { const int st = b / 1024, sb = b % 1024, swz = sb ^ (((sb >> 9) & 1) << 5); R = (st >> 1) * 16 + swz / 64; C = (st & 1) * 32 + (swz % 64) / 2; }
__host__ __device__ __forceinline__ int perm32(int rho) { const int n = rho >> 4, i = rho & 15; return 8 * (i >> 2) + 4 * n + (i & 3); }

struct Unit { int pm, pn; };
struct Gemm { const bf16_t* A; const bf16_t* Bt; int M, N, K; const int* gather; };

struct StaticOrder {
    int nM, nN, nwg, G, c;
    __host__ __device__ void init(int M, int N, int G_, int c_) { nM = M / BM; nN = N / BM; nwg = nM * nN; G = G_; c = c_; }
    __host__ __device__ bool next(int i, Unit& u) const {
        const long L = (long)i * G + c; if (L >= nwg) return false;
        int wgid = (int)L; { const int q = nwg / NXCD, r = nwg % NXCD, xcd = wgid % NXCD, off = wgid / NXCD; wgid = (xcd < r ? xcd * (q + 1) : r * (q + 1) + (xcd - r) * q) + off; }
        const int nig = WGM * nN, gid = wgid / nig, fm = gid * WGM, gsz = (nM - fm) < WGM ? (nM - fm) : WGM;
        u.pm = fm + ((wgid % nig) % gsz); u.pn = (wgid % nig) / gsz; return true;
    }
    __device__ __forceinline__ void a_ready(const Unit&) const {}
    __device__ __forceinline__ void done(const Unit&) const {}
};

typedef float f32x2_c __attribute__((ext_vector_type(2))); typedef __bf16 bf16x2_c __attribute__((ext_vector_type(2)));
__device__ __forceinline__ unsigned cvt_pk_bf16(float lo, float hi) { const f32x2_c v = {lo, hi}; return __builtin_bit_cast(unsigned, __builtin_convertvector(v, bf16x2_c)); }
__device__ __forceinline__ float bf_lo(unsigned u) { return __uint_as_float(u << 16); }
__device__ __forceinline__ float bf_hi(unsigned u) { return __uint_as_float(u & 0xffff0000u); }
__device__ __forceinline__ void st8(bf16_t* p, const f32x4 a, const f32x4 b) { u32x4 w; w.x = cvt_pk_bf16(a[0], a[1]); w.y = cvt_pk_bf16(a[2], a[3]); w.z = cvt_pk_bf16(b[0], b[1]); w.w = cvt_pk_bf16(b[2], b[3]); *(u32x4*)p = w; }
__device__ __forceinline__ void ld8(const bf16_t* p, f32x4& a, f32x4& b) { const u32x4 w = *(const u32x4*)p; a = (f32x4){bf_lo(w.x), bf_hi(w.x), bf_lo(w.y), bf_hi(w.y)}; b = (f32x4){bf_lo(w.z), bf_hi(w.z), bf_lo(w.w), bf_hi(w.w)}; }
__device__ __forceinline__ float fsigmoid(float x) { return __builtin_amdgcn_rcpf(1.0f + __builtin_amdgcn_exp2f(-1.4426950408889634f * x)); }
__device__ __forceinline__ f32x4 sig4(const f32x4 v) { return (f32x4){fsigmoid(v[0]), fsigmoid(v[1]), fsigmoid(v[2]), fsigmoid(v[3])}; }
__device__ __forceinline__ f32x4 silu4(const f32x4 v) { return v * sig4(v); }

__device__ __forceinline__ void st8x(bf16_t* p, const f32x4 a, const f32x4 b) { if (!(EPI_EXP & 2) || ((size_t)p & 1)) st8(p, a, b); else { asm volatile("" :: "v"(a), "v"(b)); } }
struct EpiInProj {
    static constexpr bool PERM = true, AFTER_DRAIN = false;
    unsigned char* ws;
    size_t oHQ, oFF, oFB, oHI, oSG, oQ, oK, oV, oGA, oGB, oROPE;
    const float *qg, *kg;
    template <int ACT> __device__ __forceinline__ void plain(const f32x4 (&acc)[2][2][4][2], bf16_t* base, long row0, int pitch, int col0) const {
#pragma unroll
        for (int ai = 0; ai < 2; ++ai)
#pragma unroll
            for (int m = 0; m < 4; ++m) { bf16_t* rowp = base + (row0 + ai * HALF + m * 16) * pitch + col0;
#pragma unroll
                for (int bj = 0; bj < 2; ++bj) { f32x4 v0 = acc[ai][bj][m][0], v1 = acc[ai][bj][m][1];
                    if (ACT == 1) { v0 = silu4(v0); v1 = silu4(v1); } if (ACT == 2) { v0 = sig4(v0); v1 = sig4(v1); }
                    st8x(rowp + bj * HALF, v0, v1); } }
    }
    __device__ __forceinline__ void gate8(const f32x4 (&acc)[2][2][4][2], unsigned char* base, long row0, int col0) const {
#pragma unroll
        for (int ai = 0; ai < 2; ++ai)
#pragma unroll
            for (int m = 0; m < 4; ++m) { unsigned char* rowp = base + (row0 + ai * HALF + m * 16) * 1024 + col0;
#pragma unroll
                for (int bj = 0; bj < 2; ++bj) { const f32x4 v0 = sig4(acc[ai][bj][m][0]) * 255.0f, v1 = sig4(acc[ai][bj][m][1]) * 255.0f;
                    unsigned w0 = 0, w1 = 0;
                    w0 = __builtin_amdgcn_cvt_pk_u8_f32(v0[0], 0, w0); w0 = __builtin_amdgcn_cvt_pk_u8_f32(v0[1], 1, w0); w0 = __builtin_amdgcn_cvt_pk_u8_f32(v0[2], 2, w0); w0 = __builtin_amdgcn_cvt_pk_u8_f32(v0[3], 3, w0);
                    w1 = __builtin_amdgcn_cvt_pk_u8_f32(v1[0], 0, w1); w1 = __builtin_amdgcn_cvt_pk_u8_f32(v1[1], 1, w1); w1 = __builtin_amdgcn_cvt_pk_u8_f32(v1[2], 2, w1); w1 = __builtin_amdgcn_cvt_pk_u8_f32(v1[3], 3, w1);
                    *(unsigned long long*)(rowp + bj * HALF) = (unsigned long long)w0 | ((unsigned long long)w1 << 32); } }
    }
    __device__ __forceinline__ void qk(const f32x4 (&acc)[2][2][4][2], bf16_t* base, long row0, int pitch, int col0, const float* gain, bool do_rope, int t0, float oscale, int fq) const {
        const float* rope = (const float*)(ws + oROPE);
        f32x4 gv[2][2];
#pragma unroll
        for (int bj = 0; bj < 2; ++bj)
#pragma unroll
            for (int n = 0; n < 2; ++n) gv[bj][n] = *(const f32x4*)(gain + 32 * bj + 16 * n + 4 * fq);
        f32x4 cc[4], sc[4], cr[2], sr[2];
        if (do_rope) {
#pragma unroll
            for (int m = 0; m < 4; ++m) { const int pos = (t0 + m * 16) & 63; cc[m] = *(const f32x4*)(rope + pos * 32 + 4 * fq); sc[m] = *(const f32x4*)(rope + pos * 32 + 16 + 4 * fq); }
#pragma unroll
            for (int ai = 0; ai < 2; ++ai) { const int pos = (t0 + ai * HALF) >> 6; cr[ai] = *(const f32x4*)(rope + pos * 32 + 4 * fq); sr[ai] = *(const f32x4*)(rope + pos * 32 + 16 + 4 * fq); }
        } else {
#pragma unroll
            for (int m = 0; m < 4; ++m) { cc[m] = (f32x4){1.f, 1.f, 1.f, 1.f}; sc[m] = (f32x4){0.f, 0.f, 0.f, 0.f}; }
#pragma unroll
            for (int ai = 0; ai < 2; ++ai) { cr[ai] = (f32x4){1.f, 1.f, 1.f, 1.f}; sr[ai] = (f32x4){0.f, 0.f, 0.f, 0.f}; }
        }
#pragma unroll
        for (int ai = 0; ai < 2; ++ai)
#pragma unroll
            for (int m = 0; m < 4; ++m) {
                float ss = 0.f;
#pragma unroll
                for (int bj = 0; bj < 2; ++bj)
#pragma unroll
                    for (int n = 0; n < 2; ++n) { const f32x4 x = acc[ai][bj][m][n]; ss += (x[0] * x[0] + x[1] * x[1]) + (x[2] * x[2] + x[3] * x[3]); }
                ss += __shfl_xor(ss, 16); ss += __shfl_xor(ss, 32);
                const float rstd = 1.0f / sqrtf(ss * (1.0f / 64.0f) + 1e-6f);
                bf16_t* rowp = base + (row0 + ai * HALF + m * 16) * pitch + col0;
#pragma unroll
                for (int bj = 0; bj < 2; ++bj) {
                    const f32x4 x1 = acc[ai][bj][m][0] * rstd * gv[bj][0], x2 = acc[ai][bj][m][1] * rstd * gv[bj][1];
                    const f32x4 c = bj ? cc[m] : cr[ai], s = bj ? sc[m] : sr[ai];
                    const f32x4 o1 = x1 * c - x2 * s, o2 = x2 * c + x1 * s;
                    st8x(rowp + bj * 32, o1 * oscale, o2 * oscale); }
            }
    }
    __device__ __forceinline__ void operator()(const f32x4 (&acc)[2][2][4][2], const Unit& u, int wr, int wc, int fr_, int fq_) const {
        int fr = fr_, fq = fq_; asm volatile("" : "+v"(fr), "+v"(fq));
        if (EPI_EXP & 1) return;
        const int pn = u.pn, bb = u.pm / 9, jt = u.pm - bb * 9;
        const int rloc = wr * 64 + fr;
        const long r0 = (long)u.pm * BM + rloc;
        const long rl0 = (long)bb * 2048 + (jt - 1) * 256 + rloc;
        const int c8 = wc * 32 + 8 * fq;
        if (pn < 2)        plain<0>(acc, (bf16_t*)(ws + oHQ), rl0, 512, pn * 256 + c8);
        else if (pn < 4)   plain<0>(acc, (bf16_t*)(ws + oFF), r0, 512, (pn - 2) * 256 + c8);
        else if (pn < 6)   plain<0>(acc, (bf16_t*)(ws + oFB), r0, 512, (pn - 4) * 256 + c8);
        else if (pn < 8)   plain<0>(acc, (bf16_t*)(ws + oHI), r0, 512, (pn - 6) * 256 + c8);
        else if (pn < 10)  plain<1>(acc, (bf16_t*)(ws + oSG), rl0, 512, (pn - 8) * 256 + c8);
        else if (pn < 12)  qk(acc, (bf16_t*)(ws + oQ), rl0, 512, ((pn - 10) * 4 + wc) * 64 + 8 * fq, qg, true, (jt - 1) * 256 + rloc, 0.125f * 1.4426950408889634f, fq);
        else if (pn == 12) {
            if (wc < 2)    qk(acc, (bf16_t*)(ws + oK), r0, 128, wc * 64 + 8 * fq, kg, jt >= 1, (jt - 1) * 256 + rloc, 1.0f, fq);
            else {
#pragma unroll
                for (int ai = 0; ai < 2; ++ai)
#pragma unroll
                    for (int m = 0; m < 4; ++m) { bf16_t* rowp = (bf16_t*)(ws + oV) + (r0 + ai * HALF + m * 16) * 128 + (wc - 2) * 64 + 8 * fq;
#pragma unroll
                        for (int bj = 0; bj < 2; ++bj) st8x(rowp + bj * 32, acc[ai][bj][m][0], acc[ai][bj][m][1]); }
            }
        }
        else if (pn < 17)  gate8(acc, ws + oGA, rl0, (pn - 13) * 256 + c8);
        else               gate8(acc, ws + oGB, rl0, (pn - 17) * 256 + c8);
    }
};

template <int SECOND> struct EpiZ {
    static constexpr bool PERM = true, AFTER_DRAIN = false;
    bf16_t* Z; const unsigned char* G;
    __device__ __forceinline__ void ld(int ai, int mh, long row0, int col0, unsigned long long (&gw)[2][2], u32x4 (&zw)[2][2]) const {
#pragma unroll
        for (int mm = 0; mm < 2; ++mm)
#pragma unroll
            for (int bj = 0; bj < 2; ++bj) { const long off = (row0 + ai * HALF + (2 * mh + mm) * 16) * 1024 + col0 + bj * HALF;
                gw[mm][bj] = *(const unsigned long long*)(G + off); if (SECOND) zw[mm][bj] = *(const u32x4*)(Z + off); }
    }
    __device__ __forceinline__ void proc(const f32x4 (&acc)[2][2][4][2], int ai, int mh, long row0, int col0, const unsigned long long (&gw)[2][2], const u32x4 (&zw)[2][2]) const {
#pragma unroll
        for (int mm = 0; mm < 2; ++mm)
#pragma unroll
            for (int bj = 0; bj < 2; ++bj) { const int m = 2 * mh + mm; const long off = (row0 + ai * HALF + m * 16) * 1024 + col0 + bj * HALF;
                const unsigned wl = (unsigned)gw[mm][bj], wh = (unsigned)(gw[mm][bj] >> 32);
                const f32x4 g0 = (f32x4){(float)(wl & 255u), (float)((wl >> 8) & 255u), (float)((wl >> 16) & 255u), (float)(wl >> 24)} * (1.0f / 255.0f), g1 = (f32x4){(float)(wh & 255u), (float)((wh >> 8) & 255u), (float)((wh >> 16) & 255u), (float)(wh >> 24)} * (1.0f / 255.0f);
                f32x4 v0 = acc[ai][bj][m][0] * g0, v1 = acc[ai][bj][m][1] * g1;
                if (SECOND) { const u32x4 z = zw[mm][bj]; v0 += (f32x4){bf_lo(z.x), bf_hi(z.x), bf_lo(z.y), bf_hi(z.y)}; v1 += (f32x4){bf_lo(z.z), bf_hi(z.z), bf_lo(z.w), bf_hi(z.w)}; }
                st8(Z + off, v0, v1); }
    }
    __device__ __forceinline__ void operator()(const f32x4 (&acc)[2][2][4][2], const Unit& u, int wr, int wc, int fr_, int fq_) const {
        int fr = fr_, fq = fq_; asm volatile("" : "+v"(fr), "+v"(fq));
        const long row0 = (long)u.pm * BM + wr * 64 + fr; const int col0 = u.pn * BM + wc * 32 + 8 * fq;
        unsigned long long gA[2][2], gB[2][2]; u32x4 zA[2][2], zB[2][2];
        ld(0, 0, row0, col0, gA, zA);
        ld(0, 1, row0, col0, gB, zB); proc(acc, 0, 0, row0, col0, gA, zA);
        ld(1, 0, row0, col0, gA, zA); proc(acc, 0, 1, row0, col0, gB, zB);
        ld(1, 1, row0, col0, gB, zB); proc(acc, 1, 0, row0, col0, gA, zA);
        proc(acc, 1, 1, row0, col0, gB, zB);
    }
};
struct EpiZ2 {
    static constexpr bool PERM = true, AFTER_DRAIN = false;
    bf16_t* Z; const unsigned char* GA; const unsigned char* GB;
    __device__ __forceinline__ static void dec8(unsigned long long w, f32x4& lo, f32x4& hi) { const unsigned wl = (unsigned)w, wh = (unsigned)(w >> 32);
        lo = (f32x4){(float)(wl & 255u), (float)((wl >> 8) & 255u), (float)((wl >> 16) & 255u), (float)(wl >> 24)}; hi = (f32x4){(float)(wh & 255u), (float)((wh >> 8) & 255u), (float)((wh >> 16) & 255u), (float)(wh >> 24)}; }
    __device__ __forceinline__ void mid(f32x4 (&acc)[2][2][4][2], const Unit& u, int wr, int wc, int fr_, int fq_) const {
        int fr = fr_, fq = fq_; asm volatile("" : "+v"(fr), "+v"(fq));
        const long row0 = (long)u.pm * BM + wr * 64 + fr; const int col0 = u.pn * BM + wc * 32 + 8 * fq;
#pragma unroll
        for (int ai = 0; ai < 2; ++ai)
#pragma unroll
            for (int mh = 0; mh < 2; ++mh) {
                unsigned long long ga[2][2], gb[2][2];
#pragma unroll
                for (int mm = 0; mm < 2; ++mm)
#pragma unroll
                    for (int bj = 0; bj < 2; ++bj) { const long off = (row0 + ai * HALF + (2 * mh + mm) * 16) * 1024 + col0 + bj * HALF; ga[mm][bj] = *(const unsigned long long*)(GA + off); gb[mm][bj] = *(const unsigned long long*)(GB + off); }
#pragma unroll
                for (int mm = 0; mm < 2; ++mm)
#pragma unroll
                    for (int bj = 0; bj < 2; ++bj) { const int m = 2 * mh + mm; f32x4 a0, a1, b0, b1; dec8(ga[mm][bj], a0, a1); dec8(gb[mm][bj], b0, b1);
#pragma unroll
                        for (int j = 0; j < 4; ++j) { a0[j] *= __builtin_amdgcn_rcpf(fmaxf(b0[j], 1.0f)); a1[j] *= __builtin_amdgcn_rcpf(fmaxf(b1[j], 1.0f)); }
                        acc[ai][bj][m][0] = acc[ai][bj][m][0] * a0; acc[ai][bj][m][1] = acc[ai][bj][m][1] * a1; }
            }
    }
    __device__ __forceinline__ void operator()(const f32x4 (&acc)[2][2][4][2], const Unit& u, int wr, int wc, int fr_, int fq_) const {
        int fr = fr_, fq = fq_; asm volatile("" : "+v"(fr), "+v"(fq));
        const long row0 = (long)u.pm * BM + wr * 64 + fr; const int col0 = u.pn * BM + wc * 32 + 8 * fq;
#pragma unroll
        for (int ai = 0; ai < 2; ++ai)
#pragma unroll
            for (int mh = 0; mh < 2; ++mh) {
                unsigned long long gb[2][2];
#pragma unroll
                for (int mm = 0; mm < 2; ++mm)
#pragma unroll
                    for (int bj = 0; bj < 2; ++bj) gb[mm][bj] = *(const unsigned long long*)(GB + (row0 + ai * HALF + (2 * mh + mm) * 16) * 1024 + col0 + bj * HALF);
#pragma unroll
                for (int mm = 0; mm < 2; ++mm)
#pragma unroll
                    for (int bj = 0; bj < 2; ++bj) { const int m = 2 * mh + mm; f32x4 b0, b1; dec8(gb[mm][bj], b0, b1);
#pragma unroll
                        for (int j = 0; j < 4; ++j) { b0[j] = fmaxf(b0[j], 1.0f) * (1.0f / 255.0f); b1[j] = fmaxf(b1[j], 1.0f) * (1.0f / 255.0f); }
                        st8(Z + (row0 + ai * HALF + m * 16) * 1024 + col0 + bj * HALF, acc[ai][bj][m][0] * b0, acc[ai][bj][m][1] * b1); }
            }
    }
};
struct EpiX1 {
    static constexpr bool PERM = false, AFTER_DRAIN = false;
    const float* x; const float* mod; bf16_t* out;
    __device__ __forceinline__ void ld(int ai, int mh, long row0, int col0, f32x4 (&xv)[2][2][2]) const {
#pragma unroll
        for (int mm = 0; mm < 2; ++mm)
#pragma unroll
            for (int bj = 0; bj < 2; ++bj)
#pragma unroll
                for (int n = 0; n < 2; ++n) xv[mm][bj][n] = *(const f32x4*)(x + (row0 + ai * HALF + (2 * mh + mm) * 16) * 1024 + col0 + bj * HALF + n * 16);
    }
    __device__ __forceinline__ void proc(const f32x4 (&acc)[2][2][4][2], int ai, int mh, long row0, int col0, const f32x4 (&xv)[2][2][2], const f32x4 (&gv)[2][2]) const {
#pragma unroll
        for (int mm = 0; mm < 2; ++mm)
#pragma unroll
            for (int bj = 0; bj < 2; ++bj)
#pragma unroll
                for (int n = 0; n < 2; ++n) { const int m = 2 * mh + mm; const f32x4 o = xv[mm][bj][n] + gv[bj][n] * acc[ai][bj][m][n];
                    unsigned w0 = cvt_pk_bf16(o[0], o[1]), w1 = cvt_pk_bf16(o[2], o[3]);
                    *(unsigned long long*)(out + (row0 + ai * HALF + m * 16) * 1024 + col0 + bj * HALF + n * 16) = (unsigned long long)w0 | ((unsigned long long)w1 << 32); }
    }
    __device__ __forceinline__ void operator()(const f32x4 (&acc)[2][2][4][2], const Unit& u, int wr, int wc, int fr_, int fq_) const {
        int fr = fr_, fq = fq_; asm volatile("" : "+v"(fr), "+v"(fq));
        const long row0 = (long)u.pm * BM + wr * 64 + fr; const int col0 = u.pn * BM + wc * 32 + 4 * fq; const int b = u.pm >> 3;
        f32x4 gv[2][2];
#pragma unroll
        for (int bj = 0; bj < 2; ++bj)
#pragma unroll
            for (int n = 0; n < 2; ++n) gv[bj][n] = *(const f32x4*)(mod + (size_t)b * 6144 + 2048 + col0 + bj * HALF + n * 16);
        f32x4 xA[2][2][2], xB[2][2][2];
        ld(0, 0, row0, col0, xA);
        ld(0, 1, row0, col0, xB); proc(acc, 0, 0, row0, col0, xA, gv);
        ld(1, 0, row0, col0, xA); proc(acc, 0, 1, row0, col0, xB, gv);
        ld(1, 1, row0, col0, xB); proc(acc, 1, 0, row0, col0, xA, gv);
        proc(acc, 1, 1, row0, col0, xB, gv);
    }
};
struct EpiHid {
    static constexpr bool PERM = true, AFTER_DRAIN = false;
    bf16_t* H;
    __device__ __forceinline__ void operator()(const f32x4 (&acc)[2][2][4][2], const Unit& u, int wr, int wc, int fr, int fq) const {
        const int row0 = wr * 64 + fr, col0 = u.pn * HALF + wc * 32 + 8 * fq;
#pragma unroll
        for (int ai = 0; ai < 2; ++ai)
#pragma unroll
            for (int m = 0; m < 4; ++m) st8(H + (size_t)(row0 + ai * HALF + m * 16) * 1024 + col0, silu4(acc[ai][0][m][0]) * acc[ai][1][m][0], silu4(acc[ai][0][m][1]) * acc[ai][1][m][1]);
    }
};
struct EpiHidQ {
    static constexpr bool PERM = true, AFTER_DRAIN = false;
    bf16_t* H; const float* scl; const float* tq;
    __device__ __forceinline__ static f32x4 cvt4(const f32x4 a) { return (f32x4){(float)__float_as_int(a[0]), (float)__float_as_int(a[1]), (float)__float_as_int(a[2]), (float)__float_as_int(a[3])}; }
    __device__ __forceinline__ void operator()(const f32x4 (&acc)[2][2][4][2], const Unit& u, int wr, int wc, int fr, int fq) const {
        const int row0 = wr * 64 + fr, col0 = u.pn * HALF + wc * 32 + 8 * fq;
        const float* tc = tq + u.pn * BM + wc * 32 + 8 * fq;
        const f32x4 cg0 = *(const f32x4*)(tc), cg1 = *(const f32x4*)(tc + 4), cu0 = *(const f32x4*)(tc + HALF), cu1 = *(const f32x4*)(tc + HALF + 4);
        float sr[2][4];
#pragma unroll
        for (int ai = 0; ai < 2; ++ai)
#pragma unroll
            for (int m = 0; m < 4; ++m) sr[ai][m] = scl[row0 + ai * HALF + m * 16];
#pragma unroll
        for (int ai = 0; ai < 2; ++ai)
#pragma unroll
            for (int m = 0; m < 4; ++m) { const float r = sr[ai][m];
                const f32x4 g0 = cvt4(acc[ai][0][m][0]) * (cg0 * r), g1 = cvt4(acc[ai][0][m][1]) * (cg1 * r), u0 = cvt4(acc[ai][1][m][0]) * (cu0 * r), u1 = cvt4(acc[ai][1][m][1]) * (cu1 * r);
                st8(H + (size_t)(row0 + ai * HALF + m * 16) * 1024 + col0, silu4(g0) * u0, silu4(g1) * u1); }
    }
};
struct EpiInProjQ {
    static constexpr bool PERM = true, AFTER_DRAIN = false;
    EpiInProj base; const float* rs; const float* cs;
    __device__ __forceinline__ void operator()(const f32x4 (&acc_)[2][2][4][2], const Unit& u, int wr, int wc, int fr_, int fq_) const {
        int fr = fr_, fq = fq_; asm volatile("" : "+v"(fr), "+v"(fq));
        f32x4 (&acc)[2][2][4][2] = const_cast<f32x4 (&)[2][2][4][2]>(acc_);
        const float* rp = rs + (size_t)u.pm * BM + wr * 64 + fr; const float* cp = cs + u.pn * BM + wc * 32 + 8 * fq;
        f32x4 c4[2][2]; float r8[2][4];
#pragma unroll
        for (int bj = 0; bj < 2; ++bj)
#pragma unroll
            for (int n = 0; n < 2; ++n) c4[bj][n] = *(const f32x4*)(cp + bj * HALF + 4 * n);
#pragma unroll
        for (int ai = 0; ai < 2; ++ai)
#pragma unroll
            for (int m = 0; m < 4; ++m) r8[ai][m] = rp[ai * HALF + m * 16];
#pragma unroll
        for (int ai = 0; ai < 2; ++ai)
#pragma unroll
            for (int bj = 0; bj < 2; ++bj)
#pragma unroll
                for (int m = 0; m < 4; ++m)
#pragma unroll
                    for (int n = 0; n < 2; ++n) acc[ai][bj][m][n] = EpiHidQ::cvt4(acc[ai][bj][m][n]) * (c4[bj][n] * r8[ai][m]);
        base(acc, u, wr, wc, fr, fq);
    }
};
constexpr float YE_F8_SCALE = 32.0f;
struct EpiYe {
    static constexpr bool PERM = true, AFTER_DRAIN = false;
    unsigned char* Y; const float* gate;
    __device__ __forceinline__ void operator()(const f32x4 (&acc)[2][2][4][2], const Unit& u, int wr, int wc, int fr, int fq) const {
        const int row0 = wr * 64 + fr, col0 = u.pn * BM + wc * 32 + 8 * fq;
        float gt[2][4];
#pragma unroll
        for (int ai = 0; ai < 2; ++ai)
#pragma unroll
            for (int m = 0; m < 4; ++m) gt[ai][m] = gate[row0 + ai * HALF + m * 16];
#pragma unroll
        for (int ai = 0; ai < 2; ++ai)
#pragma unroll
            for (int m = 0; m < 4; ++m) { const int r = row0 + ai * HALF + m * 16;
#pragma unroll
                for (int bj = 0; bj < 2; ++bj) { const f32x4 a = acc[ai][bj][m][0] * (gt[ai][m] * YE_F8_SCALE), b = acc[ai][bj][m][1] * (gt[ai][m] * YE_F8_SCALE);
                    int w0 = __builtin_amdgcn_cvt_pk_fp8_f32(a[0], a[1], 0, false); w0 = __builtin_amdgcn_cvt_pk_fp8_f32(a[2], a[3], w0, true);
                    int w1 = __builtin_amdgcn_cvt_pk_fp8_f32(b[0], b[1], 0, false); w1 = __builtin_amdgcn_cvt_pk_fp8_f32(b[2], b[3], w1, true);
                    *(unsigned long long*)(Y + (size_t)r * 1024 + col0 + bj * HALF) = (unsigned long long)(unsigned)w0 | ((unsigned long long)(unsigned)w1 << 32); } }
    }
};
struct EpiYeQ {
    static constexpr bool PERM = true, AFTER_DRAIN = false;
    unsigned char* Y; const float* gate; const float* rs; const float* td;
    __device__ __forceinline__ void operator()(const f32x4 (&acc)[2][2][4][2], const Unit& u, int wr, int wc, int fr, int fq) const {
        const int row0 = wr * 64 + fr, col0 = u.pn * BM + wc * 32 + 8 * fq;
        const float* tc = td + col0;
        f32x4 c4[2][2];
#pragma unroll
        for (int bj = 0; bj < 2; ++bj)
#pragma unroll
            for (int n = 0; n < 2; ++n) c4[bj][n] = *(const f32x4*)(tc + bj * HALF + 4 * n);
        float gt[2][4];
#pragma unroll
        for (int ai = 0; ai < 2; ++ai)
#pragma unroll
            for (int m = 0; m < 4; ++m) gt[ai][m] = gate[row0 + ai * HALF + m * 16] * rs[row0 + ai * HALF + m * 16] * YE_F8_SCALE;
#pragma unroll
        for (int ai = 0; ai < 2; ++ai)
#pragma unroll
            for (int m = 0; m < 4; ++m) { const int r = row0 + ai * HALF + m * 16;
#pragma unroll
                for (int bj = 0; bj < 2; ++bj) { f32x4 a = EpiHidQ::cvt4(acc[ai][bj][m][0]) * (c4[bj][0] * gt[ai][m]), b = EpiHidQ::cvt4(acc[ai][bj][m][1]) * (c4[bj][1] * gt[ai][m]);
#pragma unroll
                    for (int j = 0; j < 4; ++j) { a[j] = __builtin_amdgcn_fmed3f(a[j], -440.0f, 440.0f); b[j] = __builtin_amdgcn_fmed3f(b[j], -440.0f, 440.0f); }
                    int w0 = __builtin_amdgcn_cvt_pk_fp8_f32(a[0], a[1], 0, false); w0 = __builtin_amdgcn_cvt_pk_fp8_f32(a[2], a[3], w0, true);
                    int w1 = __builtin_amdgcn_cvt_pk_fp8_f32(b[0], b[1], 0, false); w1 = __builtin_amdgcn_cvt_pk_fp8_f32(b[2], b[3], w1, true);
                    *(unsigned long long*)(Y + (size_t)r * 1024 + col0 + bj * HALF) = (unsigned long long)(unsigned)w0 | ((unsigned long long)(unsigned)w1 << 32); } }
    }
};
struct InProjOrder {
    StaticOrder so;
    __device__ void init(int G_, int c_) { so.init(ML, INC, G_, c_); }
    __device__ bool next(int i, Unit& u) const {
#if DBG_GA_ONLY
        { const long L = (long)i * so.G + so.c; if (L >= 512) return false; u.pm = (int)(L >> 2); u.pn = 13 + (int)(L & 3); u.pm = (u.pm >> 3) * 9 + 1 + (u.pm & 7); return true; }
#endif
        if (so.next(i, u)) { u.pm = (u.pm >> 3) * 9 + 1 + (u.pm & 7); return true; }
        const long L = (long)i * so.G + so.c - so.nwg; if (L >= 16 * 7) return false;
        const int cb = (int)L / 7, k = (int)L % 7; u.pm = cb * 9; u.pn = k < 6 ? 2 + k : 12; return true;
    }
    __device__ __forceinline__ void a_ready(const Unit&) const {}
    __device__ __forceinline__ void done(const Unit&) const {}
};
struct LocalOrder {
    int n;
    __device__ bool next(int i, Unit& u) const { if (i >= n) return false; u.pm = 0; u.pn = i; return true; }
    __device__ __forceinline__ void a_ready(const Unit&) const {}
    __device__ __forceinline__ void done(const Unit&) const {}
};
typedef int i32x4_pg8 __attribute__((ext_vector_type(4)));
template <bool I8> __device__ __forceinline__ f32x4 mma16(const bf16x8 b, const bf16x8 a, const f32x4 c) {
    if constexpr (I8) return __builtin_bit_cast(f32x4, __builtin_amdgcn_mfma_i32_16x16x64_i8(__builtin_bit_cast(i32x4_pg8, b), __builtin_bit_cast(i32x4_pg8, a), __builtin_bit_cast(i32x4_pg8, c), 0, 0, 0));
    else return __builtin_amdgcn_mfma_f32_16x16x32_bf16(b, a, c, 0, 0, 0);
}
template <class Epi, class Sched, bool ALIGN_EPI = false, bool SP2 = false, bool I8 = false, bool MID = false>
__device__ __forceinline__ void gemm_phase(PG8_LAS unsigned char* lds, const Gemm g, const Sched& S, const Epi& E) {
    int tid_ = threadIdx.x; asm volatile("" : "+v"(tid_));
    const int tid = tid_, wid = __builtin_amdgcn_readfirstlane(tid >> 6), lane = tid & 63, wr = wid >> 2, wc = wid & 3, fr = lane & 15, fq = lane >> 4;
    const int K = g.K, nt = K / BK;
    unsigned voffA[2], voffA1[2], voffB[2];
#pragma unroll
    for (int i = 0; i < 2; ++i) { int R, C; stage_rc(tid * 16 + i * 8192, R, C); const int Rb = Epi::PERM ? ((R & ~31) + perm32(R & 31)) : R;
        if (g.gather) { voffA[i] = ((unsigned)g.gather[R] * (unsigned)K + (unsigned)C) * 2u; voffA1[i] = ((unsigned)g.gather[R + HALF] * (unsigned)K + (unsigned)C) * 2u; }
        else { voffA[i] = (unsigned)(R * K + C) * 2u; voffA1[i] = voffA[i] + (unsigned)(HALF * K * 2); }
        voffB[i] = (unsigned)(Rb * K + C) * 2u; }
    const size_t kstep = (size_t)(BK * 2);
    const size_t hstep = (size_t)HALF * K * 2;
    const size_t tstep = 2 * hstep;
    const unsigned ldsw = (unsigned)wid * 1024u;
    const int aoff = lds_byte(wr * 64 + fr, fq * 8), boff = lds_byte(wc * 32 + fr, fq * 8);
#define PG8_SA(b, h) (((b) * 2 + (h)) * HTB)
#define PG8_SB(b, h) ((4 + (b) * 2 + (h)) * HTB)
#define PG8_STAGE(bufoff, gbase, voff) do { _Pragma("unroll") for (int _i = 0; _i < 2; ++_i) \
        __builtin_amdgcn_global_load_lds((const unsigned*)((const char*)(gbase) + (voff)[_i]), (PG8_LAS unsigned*)(lds + (bufoff) + ldsw + _i * 8192), 16, 0, PG8_DMA_AUX); } while (0)
#define PG8_LDA(dst, b, h) do { _Pragma("unroll") for (int m = 0; m < 4; ++m) _Pragma("unroll") for (int k = 0; k < 2; ++k) dst[m][k] = *(const PG8_LAS bf16x8*)(lds + PG8_SA(b, h) + aoff + m * 2048 + k * 1024); } while (0)
#define PG8_LDB(dst, b, h) do { _Pragma("unroll") for (int n = 0; n < 2; ++n) _Pragma("unroll") for (int k = 0; k < 2; ++k) dst[n][k] = *(const PG8_LAS bf16x8*)(lds + PG8_SB(b, h) + boff + n * 2048 + k * 1024); } while (0)
#define PG8_MMA(ai, bj, At, Bt) do { __builtin_amdgcn_s_setprio(1); _Pragma("unroll") for (int m = 0; m < 4; ++m) _Pragma("unroll") for (int n = 0; n < 2; ++n) _Pragma("unroll") for (int k = 0; k < 2; ++k) \
        acc[ai][bj][m][n] = mma16<I8>(Bt[n][k], At[m][k], acc[ai][bj][m][n]); __builtin_amdgcn_s_setprio(0); } while (0)
#define PG8_WAIT_V(n) asm volatile("s_waitcnt vmcnt(" #n ")" ::: "memory")
#define PG8_WAIT_L(n) asm volatile("s_waitcnt lgkmcnt(" #n ")" ::: "memory")
#define PG8_BAR __builtin_amdgcn_s_barrier()
#define PG8_SCHED __builtin_amdgcn_sched_barrier(0)
    Unit cur, nxt; int ui = 0;
    if (!S.next(0, cur)) return;
    f32x4 acc[2][2][4][2];
#pragma unroll
    for (int a = 0; a < 2; ++a)
#pragma unroll
        for (int b = 0; b < 2; ++b)
#pragma unroll
            for (int m = 0; m < 4; ++m)
#pragma unroll
                for (int n = 0; n < 2; ++n) acc[a][b][m][n] = (f32x4){0.f, 0.f, 0.f, 0.f};
    bf16x8 At[4][2], B0[2][2], B1[2][2];
    const char* cA = (const char*)g.A + (size_t)cur.pm * tstep; const char* cB = (const char*)g.Bt + (size_t)cur.pn * tstep;
    S.a_ready(cur);
    if constexpr (SP2) {
        PG8_STAGE(PG8_SB(0, 0), cB, voffB); PG8_STAGE(PG8_SB(0, 1), cB + hstep, voffB); PG8_STAGE(PG8_SA(0, 0), cA, voffA); PG8_STAGE(PG8_SA(0, 1), cA, voffA1);
        if (wr == 1) PG8_BAR;
        PG8_WAIT_V(2); PG8_BAR;
        PG8_STAGE(PG8_SB(1, 0), cB + kstep, voffB); PG8_STAGE(PG8_SA(1, 0), cA + kstep, voffA); PG8_STAGE(PG8_SB(1, 1), cB + hstep + kstep, voffB);
        PG8_WAIT_V(6); PG8_BAR;
    } else {
        PG8_STAGE(PG8_SB(0, 0), cB, voffB); PG8_STAGE(PG8_SA(0, 0), cA, voffA); PG8_STAGE(PG8_SB(0, 1), cB + hstep, voffB); PG8_STAGE(PG8_SA(0, 1), cA, voffA1);
        if (wr == 1) PG8_BAR;
        PG8_WAIT_V(4); PG8_BAR;
        PG8_STAGE(PG8_SB(1, 0), cB + kstep, voffB); PG8_STAGE(PG8_SA(1, 0), cA + kstep, voffA); PG8_STAGE(PG8_SB(1, 1), cB + hstep + kstep, voffB);
        PG8_WAIT_V(6); PG8_BAR;
    }
    for (;;) {
        const bool has_next = S.next(ui + 1, nxt);
        const char* nA = has_next ? (const char*)g.A + (size_t)nxt.pm * tstep : cA; const char* nB = has_next ? (const char*)g.Bt + (size_t)nxt.pn * tstep : cB;
        for (int t = 0; t < nt; t += 2) {
            const bool last = (t == nt - 2);
            const char* a1 = cA + (size_t)(t + 1) * kstep;
            const char* a2 = last ? nA : cA + (size_t)(t + 2) * kstep; const char* b2 = last ? nB : cB + (size_t)(t + 2) * kstep;
            const char* a3 = a2 + kstep; const char* b3 = b2 + kstep;
            if (last && has_next) S.a_ready(nxt);
            if constexpr (MID) { if (t == nt / 2) E.mid(acc, cur, wr, wc, fr, fq); }
            if constexpr (SP2) {
            PG8_LDB(B0, 0, 0); PG8_LDB(B1, 0, 1); PG8_SCHED; PG8_LDA(At, 0, 0); PG8_STAGE(PG8_SA(1, 1), a1, voffA1);
            PG8_WAIT_V(8); PG8_WAIT_L(0); PG8_BAR; PG8_MMA(0, 0, At, B0); PG8_MMA(0, 1, At, B1); PG8_BAR; PG8_SCHED;
            PG8_LDA(At, 0, 1); PG8_STAGE(PG8_SB(0, 0), b2, voffB); PG8_STAGE(PG8_SB(0, 1), b2 + hstep, voffB); PG8_STAGE(PG8_SA(0, 0), a2, voffA);
            PG8_WAIT_V(8); PG8_WAIT_L(0); PG8_BAR; PG8_MMA(1, 0, At, B0); PG8_MMA(1, 1, At, B1); PG8_BAR; PG8_SCHED;
            PG8_LDB(B0, 1, 0); PG8_LDB(B1, 1, 1); PG8_SCHED; PG8_LDA(At, 1, 0); PG8_STAGE(PG8_SA(0, 1), a2, voffA1);
            PG8_WAIT_V(8); PG8_WAIT_L(0); PG8_BAR; PG8_MMA(0, 0, At, B0); PG8_MMA(0, 1, At, B1); PG8_BAR; PG8_SCHED;
            PG8_LDA(At, 1, 1); PG8_STAGE(PG8_SB(1, 0), b3, voffB); PG8_STAGE(PG8_SB(1, 1), b3 + hstep, voffB); PG8_STAGE(PG8_SA(1, 0), a3, voffA);
            PG8_WAIT_V(8); PG8_WAIT_L(0); PG8_BAR; PG8_MMA(1, 0, At, B0); PG8_MMA(1, 1, At, B1); PG8_BAR; PG8_SCHED;
            } else {
            PG8_LDB(B0, 0, 0); PG8_SCHED; PG8_LDA(At, 0, 0); PG8_STAGE(PG8_SA(1, 1), a1, voffA1);
            PG8_WAIT_L(8); PG8_BAR; PG8_WAIT_L(0); PG8_MMA(0, 0, At, B0); PG8_BAR; PG8_SCHED;
            PG8_LDB(B1, 0, 1); PG8_STAGE(PG8_SB(0, 0), b2, voffB);
            PG8_BAR; PG8_WAIT_L(0); PG8_MMA(0, 1, At, B1); PG8_BAR;
            PG8_LDA(At, 0, 1); PG8_STAGE(PG8_SA(0, 0), a2, voffA);
            PG8_BAR; PG8_WAIT_L(0); PG8_MMA(1, 0, At, B0); PG8_BAR; PG8_SCHED;
            PG8_STAGE(PG8_SB(0, 1), b2 + hstep, voffB);
            PG8_WAIT_V(6); PG8_BAR; PG8_MMA(1, 1, At, B1); PG8_BAR;
            PG8_LDB(B0, 1, 0); PG8_SCHED; PG8_LDA(At, 1, 0); PG8_STAGE(PG8_SA(0, 1), a2, voffA1);
            PG8_WAIT_L(8); PG8_BAR; PG8_WAIT_L(0); PG8_MMA(0, 0, At, B0); PG8_BAR; PG8_SCHED;
            PG8_LDB(B1, 1, 1); PG8_STAGE(PG8_SB(1, 0), b3, voffB);
            PG8_BAR; PG8_WAIT_L(0); PG8_MMA(0, 1, At, B1); PG8_BAR;
            PG8_LDA(At, 1, 1); PG8_STAGE(PG8_SA(1, 0), a3, voffA);
            PG8_BAR; PG8_WAIT_L(0); PG8_MMA(1, 0, At, B0); PG8_BAR; PG8_SCHED;
            PG8_STAGE(PG8_SB(1, 1), b3 + hstep, voffB);
            PG8_WAIT_V(6); PG8_BAR; PG8_MMA(1, 1, At, B1); PG8_BAR;
            }
        }
        if constexpr (ALIGN_EPI) { if (wr == 0) PG8_BAR; }
        if constexpr (!Epi::AFTER_DRAIN) { E(acc, cur, wr, wc, fr, fq); S.done(cur); }
        if (!has_next) break;
#pragma unroll
        for (int a = 0; a < 2; ++a)
#pragma unroll
            for (int b = 0; b < 2; ++b)
#pragma unroll
                for (int m = 0; m < 4; ++m)
#pragma unroll
                    for (int n = 0; n < 2; ++n) acc[a][b][m][n] = (f32x4){0.f, 0.f, 0.f, 0.f};
        cur = nxt; cA = nA; cB = nB; ++ui;
        if constexpr (ALIGN_EPI) { if (wr == 1) PG8_BAR; }
    }
    PG8_WAIT_V(0);
    if constexpr (!ALIGN_EPI) { if (wr == 0) PG8_BAR; }
    PG8_BAR;
    if constexpr (Epi::AFTER_DRAIN) { E.fused(acc, cur, wr, wc, fr, fq, lds, wid, lane); S.done(cur); }
#undef PG8_SA
#undef PG8_SB
#undef PG8_STAGE
#undef PG8_LDA
#undef PG8_LDB
#undef PG8_MMA
#undef PG8_WAIT_V
#undef PG8_WAIT_L
#undef PG8_BAR
#undef PG8_SCHED
}
}
#include <hip/hip_bf16.h>
#include <cmath>
namespace attn_body {
using bf16=__hip_bfloat16;
using bf16x8=__attribute__((ext_vector_type(8)))short;
using s16x4=__attribute__((ext_vector_type(4)))short;
using f32x16=__attribute__((ext_vector_type(16)))float;
using u32x4=__attribute__((ext_vector_type(4)))unsigned;
constexpr int D=64,QP=512,OP=1024,KP=128,NKT=36;
constexpr int NW=8,QBLK=32,QB=QBLK*NW,KVBLK=64;
__device__ __forceinline__ int crow(int r,int hi){return (r&3)+8*(r>>2)+4*hi;}
#define SBAR() __builtin_amdgcn_sched_barrier(0)
constexpr int NSLOT=3, SLOTB=8192;
constexpr int LDS_K=0, LDS_V=NSLOT*SLOTB, LDS_WS=2*NSLOT*SLOTB, LDS_OST=LDS_WS+NW*64*4, LDS_BYTES=LDS_OST+NW*4096;
constexpr float C2=0.125f*1.4426950408889634f;
__device__ __forceinline__ void glds16(const void*gsrc,unsigned lds_dst){unsigned keep;
  asm volatile("s_mov_b32 %0, m0\n\ts_mov_b32 m0, %2\n\ts_nop 0\n\tglobal_load_lds_dwordx4 %1, off\n\ts_mov_b32 m0, %0":"=&s"(keep):"v"(gsrc),"s"(lds_dst):"memory");}
__device__ __forceinline__ float max3f(float a,float b,float c){float r;asm("v_max3_f32 %0, %1, %2, %3":"=v"(r):"v"(a),"v"(b),"v"(c));return r;}
__device__ __forceinline__ float max2f(float a,float b){float r;asm("v_max_f32_e32 %0, %1, %2":"=v"(r):"v"(a),"v"(b));return r;}
__device__ __forceinline__ float fadd_s(float a,float b){float r;asm("v_add_f32_e32 %0, %1, %2":"=v"(r):"v"(a),"v"(b));return r;}
__device__ __forceinline__ float fsub_s(float a,float b){float r;asm("v_sub_f32_e32 %0, %1, %2":"=v"(r):"v"(a),"v"(b));return r;}
typedef float f32x2_t __attribute__((ext_vector_type(2))); typedef __bf16 bf16x2_t __attribute__((ext_vector_type(2)));
__device__ __forceinline__ unsigned cvtpk_s(float lo,float hi){f32x2_t v={lo,hi};bf16x2_t b=__builtin_convertvector(v,bf16x2_t);return __builtin_bit_cast(unsigned,b);}
#define WAIT_BAR(N) asm volatile("s_waitcnt vmcnt(" #N ") lgkmcnt(0)\n\ts_barrier":::"memory")

__device__ __forceinline__ void qkt(f32x16&p0,f32x16&p1,const char*Kslot,const bf16x8*qr,const f32x16&negm,int r32,int hi){
  const char*kb=Kslot+hi*1024+r32*16;
  #pragma unroll
  for(int d0=0;d0<4;++d0){
    const bf16x8 b0=*reinterpret_cast<const bf16x8*>(kb+d0*2048);
    const bf16x8 b1=*reinterpret_cast<const bf16x8*>(kb+d0*2048+512);
    if(d0==0){p0=__builtin_amdgcn_mfma_f32_32x32x16_bf16(b0,qr[0],negm,0,0,0);p1=__builtin_amdgcn_mfma_f32_32x32x16_bf16(b1,qr[0],negm,0,0,0);}
    else{p0=__builtin_amdgcn_mfma_f32_32x32x16_bf16(b0,qr[d0],p0,0,0,0);p1=__builtin_amdgcn_mfma_f32_32x32x16_bf16(b1,qr[d0],p1,0,0,0);}}
}
typedef __attribute__((address_space(3))) const char* lds_cptr;
typedef short v4i16_t __attribute__((ext_vector_type(4)));
__device__ __forceinline__ void kload8(bf16x8*kf,lds_cptr kp){
  kf[0]=*(const __attribute__((address_space(3))) bf16x8*)(kp);      kf[1]=*(const __attribute__((address_space(3))) bf16x8*)(kp+512);
  kf[2]=*(const __attribute__((address_space(3))) bf16x8*)(kp+2048); kf[3]=*(const __attribute__((address_space(3))) bf16x8*)(kp+2560);
  kf[4]=*(const __attribute__((address_space(3))) bf16x8*)(kp+4096); kf[5]=*(const __attribute__((address_space(3))) bf16x8*)(kp+4608);
  kf[6]=*(const __attribute__((address_space(3))) bf16x8*)(kp+6144); kf[7]=*(const __attribute__((address_space(3))) bf16x8*)(kp+6656);
}
__device__ __forceinline__ void kload2(bf16x8*kf,lds_cptr kp,int j){ kf[2*j]=*(const __attribute__((address_space(3))) bf16x8*)(kp+j*2048); kf[2*j+1]=*(const __attribute__((address_space(3))) bf16x8*)(kp+j*2048+512); }
__device__ __forceinline__ s16x4 vtr(lds_cptr p){ return __builtin_bit_cast(s16x4,__builtin_amdgcn_ds_read_tr16_b64_v4i16((__attribute__((address_space(3))) v4i16_t*)p)); }
__device__ __forceinline__ float rowmax(const f32x16&p0,const f32x16&p1){
  float a=max3f(p0[0],p0[1],p1[0]),b=max3f(p0[2],p0[3],p1[1]);a=max3f(a,p1[2],p1[3]);
  #pragma unroll
  for(int r=4;r<16;r+=4){a=max3f(a,p0[r],p0[r+1]);b=max3f(b,p0[r+2],p0[r+3]);a=max3f(a,p1[r],p1[r+1]);b=max3f(b,p1[r+2],p1[r+3]);}
  const float m=max2f(a,b);
  auto rr=__builtin_amdgcn_permlane32_swap(__float_as_uint(m),__float_as_uint(m),false,false);
  return max2f(__uint_as_float(rr[0]),__uint_as_float(rr[1]));
}
__device__ __forceinline__ void pv(f32x16*o,int vb,bf16x8 pa0,bf16x8 pa1,bf16x8 pa2,bf16x8 pa3){
  #pragma unroll
  for(int d0=0;d0<2;++d0){s16x4 lo[4],hi[4];
    #pragma unroll
    for(int ks=0;ks<4;++ks){
      asm volatile("ds_read_b64_tr_b16 %0,%1 offset:%c2":"=&v"(lo[ks]):"v"(vb),"i"(d0*4096+ks*1024):"memory");
      asm volatile("ds_read_b64_tr_b16 %0,%1 offset:%c2":"=&v"(hi[ks]):"v"(vb),"i"(d0*4096+ks*1024+512):"memory");}
    asm volatile("s_waitcnt lgkmcnt(0)":::"memory");SBAR();
    #define PK(k) (bf16x8){lo[k][0],lo[k][1],lo[k][2],lo[k][3],hi[k][0],hi[k][1],hi[k][2],hi[k][3]}
    o[d0]=__builtin_amdgcn_mfma_f32_32x32x16_bf16(pa0,PK(0),o[d0],0,0,0);
    o[d0]=__builtin_amdgcn_mfma_f32_32x32x16_bf16(pa1,PK(1),o[d0],0,0,0);
    o[d0]=__builtin_amdgcn_mfma_f32_32x32x16_bf16(pa2,PK(2),o[d0],0,0,0);
    o[d0]=__builtin_amdgcn_mfma_f32_32x32x16_bf16(pa3,PK(3),o[d0],0,0,0);
    #undef PK
  }
}

#ifndef ATTN_STORE16
#define ATTN_STORE16(p,v) (*(u32x4*)(p)=(v))
#endif
template<int THRL,bool FIXED> __device__ __forceinline__ void attn_unit(long qrow0,int h,long kvrow0,int kvh,const bf16*Q,const bf16*__restrict__ K,const bf16*__restrict__ V,bf16*O,char*shm,float mfix){
  int tid_=threadIdx.x; asm volatile("":"+v"(tid_)); const int tid=tid_,lane=tid&63,r32=lane&31,hi=lane>>5; const int wid=__builtin_amdgcn_readfirstlane(tid>>6);
  const bf16*Qw=Q+(qrow0+wid*QBLK)*QP+h*D;
  const bf16*Kh=K+kvrow0*KP+kvh*D,*Vh=V+kvrow0*KP+kvh*D;
  const unsigned lds0=(unsigned)(uintptr_t)shm;
  float*wsf=(float*)(shm+LDS_WS)+wid*64;
  const bf16*ksrc=Kh+(long)lane*KP+wid*8;
  const bf16*vsrc=Vh+(long)(16*(wid&3)+(lane>>2))*KP+(wid>>2)*32+(lane&3)*8;
  const unsigned kdst=lds0+LDS_K+wid*1024, vdst=lds0+LDS_V+wid*1024;
  #define DMA_K(t,slot) glds16(ksrc+(long)(t)*KVBLK*KP,(unsigned)__builtin_amdgcn_readfirstlane(kdst+(slot)))
  #define DMA_V(t,slot) glds16(vsrc+(long)(t)*KVBLK*KP,(unsigned)__builtin_amdgcn_readfirstlane(vdst+(slot)))
  const int vb0=(int)(lds0+LDS_V)+((lane>>4)&1)*32+(lane&3)*8+(4*hi+((lane&15)>>2))*64;
  const char*Kbase=shm+LDS_K; bf16x8 kf[8];
  const lds_cptr shm3=(lds_cptr)shm; const lds_cptr kp0=shm3+LDS_K+hi*1024+r32*16; const lds_cptr vp0=shm3+LDS_V+((lane>>4)&1)*32+(lane&3)*8+(4*hi+((lane&15)>>2))*64;
  constexpr int NT=NKT;
  DMA_K(0,0);DMA_V(0,0);DMA_K(1,SLOTB);
  bf16x8 qr[4];
  #pragma unroll
  for(int d0=0;d0<4;++d0)qr[d0]=*reinterpret_cast<const bf16x8*>(&Qw[(long)r32*QP+d0*16+hi*8]);
  float mhat=0.f,l_reg=0.f;f32x16 o[2];o[0]=f32x16{};o[1]=f32x16{};f32x16 negm;
  #pragma unroll
  for(int r=0;r<16;++r)negm[r]=FIXED?-mfix:0.f;
  asm volatile("":"+v"(negm));
  #define CMASK(P0,P1,t) do{}while(0)
  bool resc=false;
  #define START(P0,P1) do{ if(!FIXED){ const float rm=rowmax(P0,P1); resc=false; \
    { const float dl=rm; mhat=fadd_s(mhat,dl); \
      _Pragma("unroll") for(int r=0;r<16;++r){P0[r]=fsub_s(P0[r],dl);P1[r]=fsub_s(P1[r],dl);} \
      _Pragma("unroll") for(int r=0;r<16;++r)negm[r]=-mhat; asm volatile("":"+v"(negm)); } } \
    _Pragma("unroll") for(int r=0;r<16;++r)P0[r]=__builtin_amdgcn_exp2f(P0[r]); }while(0)
  #define RESC() do{ if(resc){ asm volatile("s_waitcnt lgkmcnt(0)":::"memory"); \
      _Pragma("unroll") for(int d_=0;d_<2;++d_) _Pragma("unroll") for(int r=0;r<16;++r)o[d_][r]*=wsf[crow(r,hi)]; } }while(0)
  f32x16 pA0,pA1,pB0,pB1;
  int sl_prev=0,sl_cur=0,sl_next=SLOTB;
  #define ROT() do{sl_prev=sl_cur;sl_cur=sl_next;sl_next=(sl_next==(NSLOT-1)*SLOTB)?0:sl_next+SLOTB;}while(0)
  DMA_K(2,2*SLOTB);
  WAIT_BAR(3);
  qkt(pA0,pA1,Kbase,qr,negm,r32,hi);asm volatile("s_nop 15\n\ts_nop 7":"+v"(pA0),"+v"(pA1));CMASK(pA0,pA1,0);
  START(pA0,pA1);
  _Pragma("unroll") for(int r=0;r<16;++r)pA1[r]=__builtin_amdgcn_exp2f(pA1[r]);
  WAIT_BAR(0);
  DMA_K(3,0);DMA_V(1,SLOTB);
  ROT();
  kload8(kf,kp0+sl_cur);
  WAIT_BAR(2);
  s16x4 vlo[8],vhi[8]; u32x4 pw0,pw1,pw2,pw3;
  #define PKW(P,B) cvtpk_s(P[B],P[B+1])
  #define PAF(k) __builtin_bit_cast(bf16x8,pw##k)
  #define VFR(i) (bf16x8){vlo[i][0],vlo[i][1],vlo[i][2],vlo[i][3],vhi[i][0],vhi[i][1],vhi[i][2],vhi[i][3]}
  #define PIN(x) asm volatile("":"+v"(x))
  #define MX3(a,b,c) __builtin_fmaxf(__builtin_fmaxf((a),(b)),(c))
  #define GAPA(MF,A0,A1,A2,A3,W0,W1,PW) do{ MF; sacc+=A0; sacc+=A1; sacc+=A2; sacc+=A3; PIN(sacc); W0; W1; PIN(PW); SBAR(); }while(0)
  #define EX(v) __builtin_amdgcn_exp2f(v)
  #define GAPB(MF,X,B) do{ MF; X[B]=EX(X[B]); X[B+1]=EX(X[B+1]); X[B+2]=EX(X[B+2]); X[B+3]=EX(X[B+3]); PIN(X); SBAR(); }while(0)
  #define VRD(i) do{ vlo[i]=vtr(vp_+(((i)>>2)*4096+((i)&3)*1024)); vhi[i]=vtr(vp_+(((i)>>2)*4096+((i)&3)*1024+512)); }while(0)
  #define KRD(G,j) do{ if(G){ kload2(kf,kp0+sl_next,j); SBAR(); } }while(0)
  #define STEP(C0,C1,P0,P1,t,GK,GV,GL) do{ SBAR(); \
    const lds_cptr vp_=vp0+sl_prev; \
    VRD(0); SBAR(); float sacc=(P0[0]+P0[1]); \
    GAPA(C0=__builtin_amdgcn_mfma_f32_32x32x16_bf16(kf[0],qr[0],negm,0,0,0), P0[2],P0[3],P0[4],P0[5],     pw0[0]=PKW(P0,0), pw0[1]=PKW(P0,2), pw0); \
    VRD(4); SBAR(); GAPA(C1=__builtin_amdgcn_mfma_f32_32x32x16_bf16(kf[1],qr[0],negm,0,0,0), P0[6],P0[7],P0[8],P0[9],     pw0[2]=PKW(P0,4), pw0[3]=PKW(P0,6), pw0); \
    VRD(1); SBAR(); GAPA(C0=__builtin_amdgcn_mfma_f32_32x32x16_bf16(kf[2],qr[1],C0,0,0,0),   P0[10],P0[11],P0[12],P0[13], pw1[0]=PKW(P0,8), pw1[1]=PKW(P0,10), pw1); \
    VRD(5); SBAR(); GAPA(C1=__builtin_amdgcn_mfma_f32_32x32x16_bf16(kf[3],qr[1],C1,0,0,0),   P0[14],P0[15],P1[0],P1[1],   pw1[2]=PKW(P0,12),pw1[3]=PKW(P0,14), pw1); \
    VRD(2); SBAR(); GAPA(C0=__builtin_amdgcn_mfma_f32_32x32x16_bf16(kf[4],qr[2],C0,0,0,0),   P1[2],P1[3],P1[4],P1[5],     pw2[0]=PKW(P1,0), pw2[1]=PKW(P1,2), pw2); \
    VRD(6); SBAR(); GAPA(C1=__builtin_amdgcn_mfma_f32_32x32x16_bf16(kf[5],qr[2],C1,0,0,0),   P1[6],P1[7],P1[8],P1[9],     pw2[2]=PKW(P1,4), pw2[3]=PKW(P1,6), pw2); \
    VRD(3); SBAR(); GAPA(C0=__builtin_amdgcn_mfma_f32_32x32x16_bf16(kf[6],qr[3],C0,0,0,0),   P1[10],P1[11],P1[12],P1[13], pw3[0]=PKW(P1,8), pw3[1]=PKW(P1,10), pw3); \
    VRD(7); SBAR(); GAPA(C1=__builtin_amdgcn_mfma_f32_32x32x16_bf16(kf[7],qr[3],C1,0,0,0),   P1[14],P1[15],0.f,0.f,       pw3[2]=PKW(P1,12),pw3[3]=PKW(P1,14), pw3); \
    l_reg+=sacc; \
    if(GK){DMA_K((t)+3,sl_cur);} if(GV){DMA_V((t)+1,sl_next);} \
    CMASK(C0,C1,t); \
    if(!FIXED){ float a=MX3(C0[0],C0[1],C1[0]),b=MX3(C0[2],C0[3],C1[1]); a=MX3(a,C1[2],C1[3]); \
      _Pragma("unroll") for(int r=4;r<16;r+=4){a=MX3(a,C0[r],C0[r+1]);b=MX3(b,C0[r+2],C0[r+3]);a=MX3(a,C1[r],C1[r+1]);b=MX3(b,C1[r+2],C1[r+3]);} \
      float rm=__builtin_fmaxf(a,b); { auto rr=__builtin_amdgcn_permlane32_swap(__float_as_uint(rm),__float_as_uint(rm),false,false); rm=__builtin_fmaxf(__uint_as_float(rr[0]),__uint_as_float(rr[1])); } \
      resc=false; \
      if(__builtin_expect(__any(rm>(float)THRL),0)){ const float dl=__builtin_fmaxf(rm,0.f); mhat+=dl; \
        _Pragma("unroll") for(int r=0;r<16;++r){C0[r]-=dl;C1[r]-=dl;} \
        _Pragma("unroll") for(int r=0;r<16;++r)negm[r]=-mhat; asm volatile("":"+v"(negm)); \
        const float f=__builtin_amdgcn_exp2f(-dl); l_reg*=f; if(hi==0)wsf[r32]=f; resc=true; } } \
    SBAR(); \
    GAPB(o[0]=__builtin_amdgcn_mfma_f32_32x32x16_bf16(PAF(0),VFR(0),o[0],0,0,0), C0,0); \
    GAPB(o[1]=__builtin_amdgcn_mfma_f32_32x32x16_bf16(PAF(0),VFR(4),o[1],0,0,0), C0,4); \
    KRD(GL,0); GAPB(o[0]=__builtin_amdgcn_mfma_f32_32x32x16_bf16(PAF(1),VFR(1),o[0],0,0,0), C0,8); \
    KRD(GL,1); GAPB(o[1]=__builtin_amdgcn_mfma_f32_32x32x16_bf16(PAF(1),VFR(5),o[1],0,0,0), C0,12); \
    KRD(GL,2); GAPB(o[0]=__builtin_amdgcn_mfma_f32_32x32x16_bf16(PAF(2),VFR(2),o[0],0,0,0), C1,0); \
    KRD(GL,3); GAPB(o[1]=__builtin_amdgcn_mfma_f32_32x32x16_bf16(PAF(2),VFR(6),o[1],0,0,0), C1,4); \
    GAPB(o[0]=__builtin_amdgcn_mfma_f32_32x32x16_bf16(PAF(3),VFR(3),o[0],0,0,0), C1,8); \
    GAPB(o[1]=__builtin_amdgcn_mfma_f32_32x32x16_bf16(PAF(3),VFR(7),o[1],0,0,0), C1,12); \
    }while(0)
  int t=1;
  #undef CMASK
  #define CMASK(P0,P1,t) do{}while(0)
  for(;t+5<NT;t+=2){
    STEP(pB0,pB1,pA0,pA1,t,true,true,true);     WAIT_BAR(2); RESC(); ROT();
    STEP(pA0,pA1,pB0,pB1,t+1,true,true,true);   WAIT_BAR(2); RESC(); ROT();
  }
  #undef CMASK
  #define CMASK(P0,P1,t) do{}while(0)
  #define ENDW(tt) do{ if((tt)+3<NT){WAIT_BAR(2);} else if((tt)+2<NT){WAIT_BAR(1);} else {WAIT_BAR(0);} }while(0)
  for(;t+1<NT;t+=2){
    STEP(pB0,pB1,pA0,pA1,t,(t+3<NT),(t+1<NT),(t+1<NT));       ENDW(t);   RESC(); ROT();
    STEP(pA0,pA1,pB0,pB1,t+1,(t+4<NT),(t+2<NT),(t+2<NT));     ENDW(t+1); RESC(); ROT();
  }
  STEP(pB0,pB1,pA0,pA1,NT-1,false,false,false); RESC();
  { float sacc=pB0[0]+pB0[1]; _Pragma("unroll") for(int r=2;r<16;++r)sacc+=pB0[r]; _Pragma("unroll") for(int r=0;r<16;++r)sacc+=pB1[r]; l_reg+=sacc;
    pw0=(u32x4){PKW(pB0,0),PKW(pB0,2),PKW(pB0,4),PKW(pB0,6)};pw1=(u32x4){PKW(pB0,8),PKW(pB0,10),PKW(pB0,12),PKW(pB0,14)};pw2=(u32x4){PKW(pB1,0),PKW(pB1,2),PKW(pB1,4),PKW(pB1,6)};pw3=(u32x4){PKW(pB1,8),PKW(pB1,10),PKW(pB1,12),PKW(pB1,14)};
    SBAR(); pv(o,vb0+sl_cur,PAF(0),PAF(1),PAF(2),PAF(3)); }
  #undef PKW
  #undef PAF
  #undef VFR
  #undef PIN
  #undef MX3
  #undef GAPA
  #undef GAPB
  #undef EX
  #undef VRD
  #undef KRD
  #undef STEP
  #undef ENDW
  {auto rr=__builtin_amdgcn_permlane32_swap(__float_as_uint(l_reg),__float_as_uint(l_reg),false,false);l_reg=__uint_as_float(rr[0])+__uint_as_float(rr[1]);}
  if(hi==0)wsf[32+r32]=l_reg;asm volatile("s_waitcnt lgkmcnt(0)":::"memory");
  float rli[16];
  #pragma unroll
  for(int r=0;r<16;++r)rli[r]=__builtin_amdgcn_rcpf(wsf[32+crow(r,hi)]);
  bf16*Ow=O+(qrow0+wid*QBLK)*OP+h*D;
  { bf16*stg=(bf16*)(shm+LDS_OST)+wid*2048;
    #pragma unroll
    for(int r=0;r<16;++r){const int orow=crow(r,hi);
      #pragma unroll
      for(int d0=0;d0<2;++d0)stg[orow*64+d0*32+r32]=__float2bfloat16(o[d0][r]*rli[r]);}
    asm volatile("s_waitcnt lgkmcnt(0)":::"memory");
    #pragma unroll
    for(int i=0;i<4;++i){const int row=i*8+(lane>>3),ch=lane&7; const u32x4 v=*(const u32x4*)(stg+row*64+ch*8); ATTN_STORE16(Ow+(long)row*OP+ch*8,v);} }
  asm volatile("s_waitcnt lgkmcnt(0)\n\ts_barrier":::"memory");
  #undef DMA_K
  #undef DMA_V
  #undef CMASK
  #undef START
  #undef RESC
  #undef ROT
}
constexpr int ATTN_LDS_BYTES=LDS_BYTES;
#undef SBAR
#undef WAIT_BAR
}
constexpr int NWAVES = 8;
using pg8::bf16_t; using pg8::bf16x8; using pg8::f32x4; using pg8::u32x4;
typedef unsigned u32x2 __attribute__((ext_vector_type(2)));
#define LAS __attribute__((address_space(3)))
#define GAS __attribute__((address_space(1)))
#define RLX_AGENT __ATOMIC_RELAXED, __HIP_MEMORY_SCOPE_AGENT
#define LDS_WAIT() asm volatile("s_waitcnt lgkmcnt(0)" ::: "memory")
#define VM_WAIT() asm volatile("s_waitcnt vmcnt(0)" ::: "memory")

constexpr size_t MiB = 1u << 20;
constexpr size_t WS_CTL = 0, CTL_ZERO_BYTES = 64 * 1024;
constexpr size_t WS_MOD = 1 * MiB;
constexpr size_t WS_LB = WS_MOD + 512 * 1024;
constexpr size_t WS_ROPE = WS_LB + 8 * 1024;
constexpr size_t WS_WIN = 2 * MiB;
constexpr size_t WS_WINS = 10 * MiB;
constexpr int CW_CMAX = 10240;
constexpr size_t WS_WA = 13 * MiB, WS_WB = 14 * MiB, WS_WO = 15 * MiB;
constexpr size_t WS_WGU = 17 * MiB, WS_WD = 81 * MiB;
constexpr size_t WS_HX = 17 * MiB;
constexpr size_t WS_A1 = 17 * MiB, WS_OATT = 49 * MiB, WS_OR = 81 * MiB;
constexpr size_t WS_HQ = 113 * MiB, WS_FF = 145 * MiB, WS_FB = 181 * MiB, WS_HI = 217 * MiB, WS_SG = 253 * MiB, WS_Q = 285 * MiB, WS_K = 317 * MiB, WS_V = 326 * MiB;
constexpr size_t WS_GA = 335 * MiB, WS_GB = 399 * MiB;
constexpr size_t WS_Z = 113 * MiB;
constexpr size_t WS_H2 = 177 * MiB;
constexpr size_t WS_AFF = 241 * MiB;
constexpr size_t WS_HS = 209 * MiB;
constexpr size_t WS_TQ = 17 * MiB + 48 * MiB;
constexpr size_t WS_TD = 81 * MiB + 24 * MiB;
constexpr size_t WS_HIDQ = 113 * MiB;
constexpr size_t WS_SCL2 = 243 * MiB + 768 * 1024;
constexpr size_t WS_SCL = 243 * MiB + 512 * 1024;
constexpr size_t WS_IDX = 243 * MiB;
constexpr size_t WS_SLOT = 244 * MiB;
constexpr size_t WS_X1B = 246 * MiB;
constexpr size_t WS_YE = 374 * MiB;
constexpr size_t WS_END = 502 * MiB;
constexpr int CW_Q3 = 64;
constexpr int CW_MFIX = 96;
constexpr int CW_BAR = 1024;

constexpr int RING_BYTES = 131072, MISC_OFF = RING_BYTES, LDS_BYTES = 147456;

#define PB_HX(A)   ((unsigned char*)(A).out)
#define PB_HXS(A)  ((float*)((unsigned char*)(A).out + 100 * MiB))
#define PB_A1(A)   ((unsigned char*)(A).out)
#define PB_OATT(A) ((unsigned char*)(A).out + 1024)
#define PB_OR(A)   ((unsigned char*)(A).out + 64 * MiB)
#define PB_HID(A)  ((unsigned char*)(A).out)
struct Args {
    const float *x, *c, *ctx, *c_ctx, *w_mod, *b_mod, *n1g, *n2g, *w_in, *lbl, *hgn, *qng, *kng, *wa, *wb, *wo, *wr, *weg, *weu, *wed, *fng;
    float* out; unsigned char* ws;
};

#define XB_TMO      128
#define XB_XCNT(j)  (256  + 64 * (j))
#define XB_XSUB(j)  (1280 + 64 * (j))
#define XB_XGEN(j)  (2304 + 64 * (j))
#define XB_TOP      3328
#define XB_TOPGEN   3392
#define XCD_BAR_WORDS 3456
#define XB_SPIN_CAP (1u << 18)
#ifndef XB_SCOPE
#define XB_SCOPE "agent"
#endif

__device__ __forceinline__ unsigned xb_ld(unsigned* p)              { return __hip_atomic_load(p, __ATOMIC_RELAXED, __HIP_MEMORY_SCOPE_AGENT); }
__device__ __forceinline__ unsigned xb_add(unsigned* p, unsigned v) { return __hip_atomic_fetch_add(p, v, __ATOMIC_RELAXED, __HIP_MEMORY_SCOPE_AGENT); }
__device__ __forceinline__ unsigned xb_xcc_id() { return (unsigned)__builtin_amdgcn_s_getreg((3 << 11) | 20) & 0xFu; }
#define XB_SPIN(cond, bar) do { unsigned _sp = 0; while (cond) { __builtin_amdgcn_s_sleep(1); \
    if ((++_sp & 255u) == 0u) { if (xb_ld(&(bar)[XB_TMO])) break; if (_sp > XB_SPIN_CAP) { atomicAdd(&(bar)[XB_TMO], 1u); break; } } } } while (0)

struct XcdBarrier {
    unsigned* bar; unsigned x;
    volatile LAS unsigned* st;
};

__device__ __forceinline__ XcdBarrier xcd_barrier_post(unsigned* bar, volatile LAS unsigned* st) {
    XcdBarrier b; b.bar = bar; b.x = xb_xcc_id(); b.st = st;
    if (threadIdx.x == 0) (void)xb_add(&bar[XB_XCNT(b.x)], 1u);
    return b;
}
__device__ __forceinline__ void xcd_barrier_complete(unsigned* bar, unsigned x, unsigned& nloc, unsigned& nx) {
    const unsigned G = gridDim.x * gridDim.y * gridDim.z;
    unsigned sum, cnt, mine, sp = 0u;
    for (;;) {
        sum = 0u; cnt = 0u; mine = 0u;
#pragma unroll
        for (unsigned j = 0; j < 16; ++j) { const unsigned c = xb_ld(&bar[XB_XCNT(j)]); sum += c; cnt += (c > 0u) ? 1u : 0u; mine = (j == x) ? c : mine; }
        if (sum == G) break;
        __builtin_amdgcn_s_sleep(1);
        if ((++sp & 255u) == 0u) { if (xb_ld(&bar[XB_TMO])) break; if (sp > XB_SPIN_CAP) { atomicAdd(&bar[XB_TMO], 1u); break; } }
    }
    nloc = mine > 0u ? mine : 1u; nx = cnt > 0u ? cnt : 1u;
}

__device__ __forceinline__ void xcd_barrier(const XcdBarrier& b) {
    asm volatile("s_waitcnt vmcnt(0)" ::: "memory");
    __syncthreads();
    if (threadIdx.x == 0) {
        unsigned* bar = b.bar;
        __builtin_amdgcn_s_waitcnt(0);
        unsigned nloc = b.st[0], nx = b.st[1];
        if (nloc == 0u) { xcd_barrier_complete(bar, b.x, nloc, nx); b.st[0] = nloc; b.st[1] = nx; }
#if DBG_RELEASE_ALL
        __builtin_amdgcn_fence(__ATOMIC_RELEASE, "agent"); asm volatile("s_waitcnt vmcnt(0)" ::: "memory");
#endif
        const unsigned old = xb_add(&bar[XB_XSUB(b.x)], 1u);
        const unsigned gen = old / nloc;
        if (old + 1u == (gen + 1u) * nloc) {
#if DBG_LEADER_DELAY
            { const unsigned long long t0_ = __builtin_amdgcn_s_memrealtime(); while (__builtin_amdgcn_s_memrealtime() - t0_ < (unsigned long long)DBG_LEADER_DELAY) __builtin_amdgcn_s_sleep(2); }
#endif
            __builtin_amdgcn_fence(__ATOMIC_RELEASE, XB_SCOPE);
            asm volatile("s_waitcnt vmcnt(0)" ::: "memory");
#if DBG_WBL2_TWICE
            { const unsigned long long t0_ = __builtin_amdgcn_s_memrealtime(); while (__builtin_amdgcn_s_memrealtime() - t0_ < 150ull) __builtin_amdgcn_s_sleep(2); }
            asm volatile("buffer_wbl2 sc1\n\ts_waitcnt vmcnt(0)" ::: "memory");
#endif
            const unsigned og = xb_add(&bar[XB_TOP], 1u);
            const unsigned tg = og / nx;
            if (og + 1u == (tg + 1u) * nx) xb_add(&bar[XB_TOPGEN], 1u);
            else XB_SPIN(xb_ld(&bar[XB_TOPGEN]) == tg, bar);
            __builtin_amdgcn_fence(__ATOMIC_ACQUIRE, XB_SCOPE);
            xb_add(&bar[XB_XGEN(b.x)], 1u);
            asm volatile("s_waitcnt vmcnt(0)" ::: "memory");
        } else {
            XB_SPIN(xb_ld(&bar[XB_XGEN(b.x)]) == gen, bar);
            __builtin_amdgcn_fence(__ATOMIC_ACQUIRE, XB_SCOPE);
            asm volatile("s_waitcnt vmcnt(0)" ::: "memory");
        }
    }
    __syncthreads();
}

__device__ __forceinline__ float wave_sum(float v) {
#pragma unroll
    for (int o = 1; o < 64; o <<= 1) v += __shfl_xor(v, o);
    return v;
}
__device__ __forceinline__ unsigned f2bf(float f) { unsigned u = __builtin_bit_cast(unsigned, f); return (u + 0x7fffu + ((u >> 16) & 1u)) >> 16; }
__device__ __forceinline__ unsigned pk2(float lo, float hi) { return f2bf(lo) | (f2bf(hi) << 16); }
__device__ __forceinline__ float bf2f(unsigned short h) { return __uint_as_float((unsigned)h << 16); }

template <bool QKPERM>
__device__ __forceinline__ void transpose_item_q8(const float* W, int Nsrc, int n0, int k0, float inv, unsigned char* WQ, long drow0, LAS float* scr, int lane) {
    float tv[32];
#pragma unroll
    for (int i = 0; i < 32; ++i) tv[i] = W[(size_t)(k0 + 2 * i + (lane >> 5)) * Nsrc + n0 + (lane & 31)];
#pragma unroll
    for (int i = 0; i < 32; ++i) scr[(2 * i + (lane >> 5)) * 33 + (lane & 31)] = __builtin_rintf(tv[i] * inv);
    LDS_WAIT(); asm volatile("" ::: "memory");
    const int c = lane & 7;
#pragma unroll
    for (int j = 0; j < 4; ++j) { const int n = (lane >> 3) + 8 * j;
        const int ns = QKPERM ? (16 * ((n & 7) >> 2) + 4 * (n >> 3) + (n & 3)) : n;
        const LAS float* s = scr + (8 * c) * 33 + ns;
        const unsigned w0 = ((unsigned)(int)s[0 * 33] & 255u) | (((unsigned)(int)s[1 * 33] & 255u) << 8) | (((unsigned)(int)s[2 * 33] & 255u) << 16) | ((unsigned)(int)s[3 * 33] << 24);
        const unsigned w1 = ((unsigned)(int)s[4 * 33] & 255u) | (((unsigned)(int)s[5 * 33] & 255u) << 8) | (((unsigned)(int)s[6 * 33] & 255u) << 16) | ((unsigned)(int)s[7 * 33] << 24);
        u32x2 o; o.x = w0; o.y = w1; *(u32x2*)(WQ + (size_t)(drow0 + n) * 1024 + k0 + 8 * c) = o; }
    LDS_WAIT(); asm volatile("" ::: "memory");
}
template <bool QKPERM>
__device__ __forceinline__ void transpose_item(const float* W, int K, int Nsrc, int n0, int k0, bf16_t* WT, long drow0, LAS float* scr, int lane) {
    float tv[32];
#pragma unroll
    for (int i = 0; i < 32; ++i) tv[i] = W[(size_t)(k0 + 2 * i + (lane >> 5)) * Nsrc + n0 + (lane & 31)];
#pragma unroll
    for (int i = 0; i < 32; ++i) scr[(2 * i + (lane >> 5)) * 33 + (lane & 31)] = tv[i];
    LDS_WAIT(); asm volatile("" ::: "memory");
    const int c = lane & 7;
#pragma unroll
    for (int j = 0; j < 4; ++j) { const int n = (lane >> 3) + 8 * j;
        const int ns = QKPERM ? (16 * ((n & 7) >> 2) + 4 * (n >> 3) + (n & 3)) : n;
        const LAS float* s = scr + (8 * c) * 33 + ns;
        u32x4 o; o.x = pk2(s[0 * 33], s[1 * 33]); o.y = pk2(s[2 * 33], s[3 * 33]); o.z = pk2(s[4 * 33], s[5 * 33]); o.w = pk2(s[6 * 33], s[7 * 33]);
        *(u32x4*)(WT + (size_t)(drow0 + n) * K + k0 + 8 * c) = o; }
    LDS_WAIT(); asm volatile("" ::: "memory");
}
__device__ __forceinline__ void p0_adaln_item(const Args& A, LAS unsigned char* lds, int item, int tid) {
    LAS float* sc = (LAS float*)lds;
    LAS float* red = (LAS float*)(lds + 17 * 1024 * 4);
    const int wave = tid >> 6, lane = tid & 63, col = lane & 31, kp = lane >> 5;
    const float* wp = A.w_mod + (size_t)(wave * 128 + kp * 64) * NMOD + item * 32 + col;
    float w[64];
#pragma unroll
    for (int kk = 0; kk < 64; ++kk) w[kk] = wp[(size_t)kk * NMOD];
    for (int i = tid; i < 17 * 1024; i += 512) { const int b = i >> 10, k = i & 1023; const float v = b < 16 ? A.c[b * 1024 + k] : A.c_ctx[k]; sc[i] = v * pg8::fsigmoid(v); }
    __syncthreads();
    float acc[17];
#pragma unroll
    for (int b = 0; b < 17; ++b) acc[b] = 0.f;
#pragma unroll
    for (int kk = 0; kk < 64; kk += 4) {
#pragma unroll
        for (int b = 0; b < 17; ++b) { const f32x4 s4 = *(const LAS f32x4*)(sc + b * 1024 + wave * 128 + kp * 64 + kk); acc[b] += (s4[0] * w[kk] + s4[1] * w[kk + 1]) + (s4[2] * w[kk + 2] + s4[3] * w[kk + 3]); } }
#pragma unroll
    for (int b = 0; b < 17; ++b) red[((wave * 2 + kp) * 17 + b) * 32 + col] = acc[b];
    __syncthreads();
    float* mod = (float*)(A.ws + WS_MOD);
    for (int i = tid; i < 17 * 32; i += 512) { const int b = i >> 5, cidx = i & 31; float s = 0.f;
#pragma unroll
        for (int w = 0; w < 16; ++w) s += red[(w * 17 + b) * 32 + cidx];
        mod[b * NMOD + item * 32 + cidx] = s + A.b_mod[item * 32 + cidx]; }
    __syncthreads();
}
__device__ __forceinline__ int win_src(int g32, bool& qk) {
    const int pn = g32 >> 3, bj = (g32 >> 2) & 1, wc = g32 & 3;
    if (pn == 10 || pn == 11) { qk = true; return 2560 + (pn - 10) * 256 + wc * 64 + 32 * bj; }
    if (pn == 12 && wc < 2) { qk = true; return 3072 + wc * 64 + 32 * bj; }
    qk = false;
    if (pn == 12) return 3200 + (wc - 2) * 64 + 32 * bj;
    return g32 * 32;
}
template <int PART>
__device__ __forceinline__ void p0_prologue(const Args& A, LAS unsigned char* lds, int vcu, int G, int tid) {
    const int wave = tid >> 6, lane = tid & 63;
    if (PART == 0) {
    for (int it = vcu; it < NMOD / 32; it += G) p0_adaln_item(A, lds, it, tid);
    if (vcu == G - 1) {
        float* lb = (float*)(A.ws + WS_LB); float* rope = (float*)(A.ws + WS_ROPE);
        for (int i = tid; i < 1024; i += 512) { const int d = i >> 9, k = i & 511; const float l0 = A.lbl[(d * 2 + 0) * 512 + k], l1 = A.lbl[(d * 2 + 1) * 512 + k]; lb[i] = 1.0f / (1.0f + expf(l1 - l0)); }
        for (int i = tid; i < 64 * 16; i += 512) { const int pos = i >> 4, f = i & 15; const float inv = powf(10000.0f, -(float)(2 * f) / 32.0f); const float ang = (float)pos * inv; rope[pos * 32 + f] = cosf(ang); rope[pos * 32 + 16 + f] = sinf(ang); }
        if (tid < 64) { float mq = fabsf(A.qng[tid]), mk = fabsf(A.kng[tid]);
#pragma unroll
            for (int o = 32; o > 0; o >>= 1) { mq = fmaxf(mq, __shfl_xor(mq, o)); mk = fmaxf(mk, __shfl_xor(mk, o)); }
            if (tid == 0) ((float*)(A.ws + WS_CTL))[CW_MFIX] = 64.0f * 0.125f * LOG2E * 1.02f * mq * mk + 0.5f; }
    }
    { unsigned* cmax = (unsigned*)(A.ws + WS_CTL) + CW_CMAX; const int gwm = vcu * NWAVES + wave, NGWM = G * NWAVES;
      for (int it = gwm; it < 16 * (INC / 32); it += NGWM) { const int kb = it / (INC / 32), g32 = it % (INC / 32); bool qk; const int n0 = win_src(g32, qk);
          float m = 0.f;
          float tv[32];
#pragma unroll
          for (int i = 0; i < 32; ++i) tv[i] = A.w_in[(size_t)(64 * kb + 2 * i + (lane >> 5)) * INC + n0 + (lane & 31)];
#pragma unroll
          for (int i = 0; i < 32; ++i) m = fmaxf(m, fabsf(tv[i]));
          m = fmaxf(m, __shfl_xor(m, 32));
          if (lane < 32) atomicMax(cmax + g32 * 32 + lane, __float_as_uint(m)); } }
    return; }
    LAS float* scr = (LAS float*)(lds + wave * 8704);
    const int gw = vcu * NWAVES + wave, NGW = G * NWAVES;
    constexpr int I_IN = 16 * (INC / 32), I_A = 8 * 32, I_O = 16 * 32;
    constexpr int NIT = I_IN + 2 * I_A + I_O;
    bf16_t* WinT = (bf16_t*)(A.ws + WS_WIN); bf16_t* WaT = (bf16_t*)(A.ws + WS_WA); bf16_t* WbT = (bf16_t*)(A.ws + WS_WB); bf16_t* WoT = (bf16_t*)(A.ws + WS_WO);
    const int it0 = gw, itstep = NGW, itend = NIT;
    for (int it = it0; it < itend; it += itstep) {
        int r = it;
        if (r < I_IN) { const int kb = r / (INC / 32), g32 = r % (INC / 32);
            bool qk; const int n0 = win_src(g32, qk);
            const unsigned* cmax = (const unsigned*)(A.ws + WS_CTL) + CW_CMAX;
            const float am = fmaxf(__uint_as_float(__hip_atomic_load(cmax + g32 * 32 + (lane & 31), RLX_AGENT)), 1e-30f), inv = 127.0f / am;
            if (kb == 0 && lane < 32) { const int n = lane, ns = qk ? (16 * ((n & 7) >> 2) + 4 * (n >> 3) + (n & 3)) : n;
                ((float*)(A.ws + WS_WINS))[g32 * 32 + n] = fmaxf(__uint_as_float(__hip_atomic_load(cmax + g32 * 32 + ns, RLX_AGENT)), 1e-30f) * (1.0f / 127.0f); }
            if (qk) transpose_item_q8<true>(A.w_in, INC, n0, 64 * kb, inv, A.ws + WS_WIN, (long)g32 * 32, scr, lane);
            else transpose_item_q8<false>(A.w_in, INC, n0, 64 * kb, inv, A.ws + WS_WIN, (long)g32 * 32, scr, lane);
            continue; }
        r -= I_IN;
        if (r < I_A) { transpose_item<false>(A.wa, 1024, 1024, (r & 31) * 32, 64 * (r >> 5), WaT, (long)(r & 31) * 32, scr, lane); continue; } r -= I_A;
        if (r < I_A) { transpose_item<false>(A.wb, 1024, 1024, (r & 31) * 32, 64 * (r >> 5), WaT + 512, (long)(r & 31) * 32, scr, lane); continue; } r -= I_A;
        transpose_item<false>(A.wo, 1024, 1024, (r & 31) * 32, 64 * (r >> 5), WoT, (long)(r & 31) * 32, scr, lane);
    }
}

__device__ __forceinline__ void p1_finish(unsigned char* HXQ, float* HXS, int r, int lane, const f32x4 (&v)[4], const f32x4 (&gs)[4], const f32x4 (&sh)[4]) {
    float ss = 0.f;
#pragma unroll
    for (int j = 0; j < 4; ++j) ss += (v[j][0] * v[j][0] + v[j][1] * v[j][1]) + (v[j][2] * v[j][2] + v[j][3] * v[j][3]);
    const float rstd = 1.0f / sqrtf(wave_sum(ss) * (1.0f / 1024.0f) + EPS);
    f32x4 o[4]; float amax = 0.f;
#pragma unroll
    for (int j = 0; j < 4; ++j) { o[j] = (v[j] * rstd) * gs[j] + sh[j]; amax = fmaxf(fmaxf(amax, fmaxf(fabsf(o[j][0]), fabsf(o[j][1]))), fmaxf(fabsf(o[j][2]), fabsf(o[j][3]))); }
#pragma unroll
    for (int o_ = 1; o_ < 64; o_ <<= 1) amax = fmaxf(amax, __shfl_xor(amax, o_));
    const float am = amax > 1e-30f ? amax : 1e-30f, inv = 127.0f / am;
    if (lane == 0) HXS[r] = am * (1.0f / 127.0f);
#pragma unroll
    for (int j = 0; j < 4; ++j) { const int cidx = 4 * lane + 256 * j; const f32x4 q = o[j] * inv;
        const int q0 = (int)__builtin_rintf(q[0]), q1 = (int)__builtin_rintf(q[1]), q2 = (int)__builtin_rintf(q[2]), q3 = (int)__builtin_rintf(q[3]);
        *(unsigned*)(HXQ + (size_t)r * 1024 + cidx) = ((unsigned)q0 & 255u) | (((unsigned)q1 & 255u) << 8) | (((unsigned)q2 & 255u) << 16) | ((unsigned)q3 << 24); }
}
__device__ __forceinline__ void p1_rows(const Args& A, int vcu, int G, int tid) {
    const int wave = tid >> 6, lane = tid & 63; const int gw = vcu * NWAVES + wave, NGW = G * NWAVES;
    const float* mod = (const float*)(A.ws + WS_MOD); unsigned char* HXQ = (unsigned char*)(PB_HX(A)); float* HXS = PB_HXS(A);
    auto src_of = [&](int r) -> const float* { const int b = r / RPB, s = r - b * RPB; return s < CTXL ? A.ctx + ((size_t)b * CTXL + s) * 1024 : A.x + ((size_t)b * SEQ + (s - CTXL)) * 1024; };
    auto cls_of = [&](int r) -> int { const int b = r / RPB, s = r - b * RPB; return s < CTXL ? 16 : b; };
    const int RPW = (MR + NGW - 1) / NGW; const int r0 = gw * RPW, r1 = r0 + RPW < MR ? r0 + RPW : MR;
    if (r0 < r1) {
        f32x4 gs[4], sh[4]; int ccur = -1;
        auto consts = [&](int r) { const int c = cls_of(r);
            if (c != ccur) { ccur = c; const float* mrow = mod + (size_t)c * NMOD;
#pragma unroll
                for (int j = 0; j < 4; ++j) { const int cidx = 4 * lane + 256 * j; sh[j] = *(const f32x4*)(mrow + cidx); gs[j] = *(const f32x4*)(A.n1g + cidx) * (*(const f32x4*)(mrow + 1024 + cidx) + 1.0f); }
                asm volatile("" : "+v"(gs[0]), "+v"(gs[1]), "+v"(gs[2]), "+v"(gs[3]), "+v"(sh[0]), "+v"(sh[1]), "+v"(sh[2]), "+v"(sh[3])); } };
        f32x4 n0[4], n1[4];
        { const float* src = src_of(r0);
#pragma unroll
          for (int j = 0; j < 4; ++j) n0[j] = *(const f32x4*)(src + 4 * lane + 256 * j); }
        for (int r = r0; r < r1; r += 2) {
            { const float* src = src_of(r + 1 < r1 ? r + 1 : r1 - 1);
#pragma unroll
              for (int j = 0; j < 4; ++j) n1[j] = *(const f32x4*)(src + 4 * lane + 256 * j); }
            consts(r); p1_finish(HXQ, HXS, r, lane, n0, gs, sh);
            { const float* src = src_of(r + 2 < r1 ? r + 2 : r1 - 1);
#pragma unroll
              for (int j = 0; j < 4; ++j) n0[j] = *(const f32x4*)(src + 4 * lane + 256 * j); }
            if (r + 1 < r1) { consts(r + 1); p1_finish(HXQ, HXS, r + 1, lane, n1, gs, sh); }
        }
    }
}

namespace hg {
constexpr int QS = 0, KD = 17408, KE = 34816, KHT = 52224, VT = 70656, PP = 89088, TT = 98304, EQ = 100352, EG = 102400, DK = 103936, SSQ = 104448, LBS = 106496  , GNS = 107008  , Q0 = 107520  , TT8 = 124928  , END = 129024;
constexpr int RS = 272  , TS = 144  ;
constexpr int CW_HG = 8192;
typedef float f32x4 __attribute__((ext_vector_type(4)));
__device__ __forceinline__ bf16x8 pack8(const f32x4 a, const f32x4 b) { u32x4 w; w.x = pg8::cvt_pk_bf16(a[0], a[1]); w.y = pg8::cvt_pk_bf16(a[2], a[3]); w.z = pg8::cvt_pk_bf16(b[0], b[1]); w.w = pg8::cvt_pk_bf16(b[2], b[3]); return __builtin_bit_cast(bf16x8, w); }
__device__ __forceinline__ void unpack8(const u32x4 w, f32x4& a, f32x4& b) { a = (f32x4){pg8::bf_lo(w.x), pg8::bf_hi(w.x), pg8::bf_lo(w.y), pg8::bf_hi(w.y)}; b = (f32x4){pg8::bf_lo(w.z), pg8::bf_hi(w.z), pg8::bf_lo(w.w), pg8::bf_hi(w.w)}; }

constexpr unsigned long long OR_SENTINEL = 0x7fff7fff7fff7fffull;
struct Inputs { unsigned f2[8], q2[8]; u32x4 vv[2]; };

template <bool BWD>
__device__ __forceinline__ void load_inputs(const Args& A, int b, int h, int c, int tid, Inputs& I) {
    const bool latent = c >= 4;
    const long rbase = (long)b * RPB + 64 * c, rlbase = (long)b * SEQ + 64 * (c - 4);
    const bf16_t* F = (const bf16_t*)(A.ws + (BWD ? WS_FB : WS_FF)) + (rbase * 512 + h * 128); const bf16_t* HI = (const bf16_t*)(A.ws + WS_HI) + (rbase * 512 + h * 128);
    const bf16_t* HQ = (const bf16_t*)(A.ws + WS_HQ) + ((latent ? rlbase : 0) * 512 + h * 128);
    const int w8 = __builtin_amdgcn_readfirstlane(tid >> 6); const unsigned voff = (unsigned)(4 * (tid & 63));
#pragma unroll
    for (int e = 0; e < 8; ++e) { const int rho = BWD ? 63 - (8 * w8 + e) : 8 * w8 + e;
        I.f2[e] = *(const unsigned*)((const char*)(F + rho * 512) + voff); I.q2[e] = *(const unsigned*)((const char*)(HQ + rho * 512) + voff); }
    const int sig = tid & 63; const unsigned voffv = (unsigned)((BWD ? 63 - sig : sig) * 1024 + (tid >> 6) * 16);
#pragma unroll
    for (int it = 0; it < 2; ++it) I.vv[it] = *(const u32x4*)((const char*)(HI + 64 * it) + voffv);
}

struct Prep { float kd[2][8], qs[2][8]; float PT[2]; u32x4 vv[2]; };
struct Mid { float kdl[2][8], qsl[2][8]; float T8[2]; u32x4 vv[2]; };
__device__ __forceinline__ void s1_math(LAS unsigned char* lds, Inputs& N, int tid, Mid& M) {
#pragma unroll
    for (int e = 0; e < 8; ++e) asm volatile("" : "+v"(N.f2[e]), "+v"(N.q2[e]));
    asm volatile("" : "+v"(N.vv[0]), "+v"(N.vv[1]));
    const int kp = tid & 63, w8 = tid >> 6;
    const pg8::f32x2_c lb2 = *(const LAS pg8::f32x2_c*)(lds + LBS + 8 * kp);
#pragma unroll
    for (int c = 0; c < 2; ++c) { const float lbv = lb2[c], oml = 1.0f - lbv; float pc = 1.0f;
#pragma unroll
        for (int e = 0; e < 8; ++e) { const float fp = c ? pg8::bf_hi(N.f2[e]) : pg8::bf_lo(N.f2[e]), q = c ? pg8::bf_hi(N.q2[e]) : pg8::bf_lo(N.q2[e]);
            const float f = lbv + oml * pg8::fsigmoid(fp);
            pc *= f; M.kdl[c][e] = (1.0f - f) * __builtin_amdgcn_rcpf(pc); M.qsl[c][e] = q * pc; }
        M.T8[c] = pc; }
    *(LAS pg8::f32x2_c*)(lds + TT8 + (w8 * 128 + 2 * kp) * 4) = (pg8::f32x2_c){M.T8[0], M.T8[1]};
    M.vv[0] = N.vv[0]; M.vv[1] = N.vv[1];
}
__device__ __forceinline__ void s1_store(LAS unsigned char* lds, const Mid& M, bool latent, int tid, Prep& P) {
    const int kp = tid & 63, w8 = __builtin_amdgcn_readfirstlane(tid >> 6);
    const pg8::f32x2_c o2 = *(const LAS pg8::f32x2_c*)(lds + TT8 + ((w8 ^ 1) * 128 + 2 * kp) * 4);
#pragma unroll
    for (int c = 0; c < 2; ++c) { P.PT[c] = M.T8[c] * o2[c];
        if (w8 & 1) { const float pre = o2[c], ipre = __builtin_amdgcn_rcpf(pre);
#pragma unroll
            for (int e = 0; e < 8; ++e) { P.kd[c][e] = M.kdl[c][e] * ipre; P.qs[c][e] = M.qsl[c][e] * pre; } }
        else {
#pragma unroll
            for (int e = 0; e < 8; ++e) { P.kd[c][e] = M.kdl[c][e]; P.qs[c][e] = M.qsl[c][e]; } } }
    P.vv[0] = M.vv[0]; P.vv[1] = M.vv[1];
    if (latent) {
#pragma unroll
        for (int e = 0; e < 8; ++e) { const int tau = 8 * w8 + e;
            *(LAS unsigned*)(lds + QS + tau * RS + 4 * kp) = pg8::cvt_pk_bf16(P.qs[0][e], P.qs[1][e]);
            *(LAS unsigned*)(lds + KD + tau * RS + 4 * kp) = pg8::cvt_pk_bf16(P.kd[0][e], P.kd[1][e]);
            *(LAS unsigned*)(lds + KE + tau * RS + 4 * kp) = pg8::cvt_pk_bf16(P.kd[0][e] * P.PT[0], P.kd[1][e] * P.PT[1]); }
    }
    if (!(w8 & 1)) *(LAS pg8::f32x2_c*)(lds + TT + ((w8 >> 1) * 128 + 2 * kp) * 4) = (pg8::f32x2_c){P.PT[0], P.PT[1]};
}
template <bool BWD, bool SECOND>
__device__ __forceinline__ void chunk_step(const Args& A, LAS unsigned char* lds, int b, int h, int c, f32x4 (&S)[8], Prep& P, Inputs& N, bool next_latent, int cpref, int tid_in) {
    int tid = tid_in; asm volatile("" : "+v"(tid));
    const int wave = __builtin_amdgcn_readfirstlane(tid >> 6), lane = tid & 63, l15 = lane & 15, g = lane >> 4;
    const bool latent = SECOND || c >= 4; constexpr bool second = SECOND;
    const long rlbase = (long)b * SEQ + 64 * (c - 4);
    const int k = tid & 127, part = tid >> 7;
    __syncthreads();
    {
        const int kp = tid & 63, w8 = wave, sb = w8 >> 1;
        const pg8::f32x2_c T0 = *(const LAS pg8::f32x2_c*)(lds + TT + (0 * 128 + 2 * kp) * 4), T1 = *(const LAS pg8::f32x2_c*)(lds + TT + (1 * 128 + 2 * kp) * 4),
                           T2 = *(const LAS pg8::f32x2_c*)(lds + TT + (2 * 128 + 2 * kp) * 4), T3 = *(const LAS pg8::f32x2_c*)(lds + TT + (3 * 128 + 2 * kp) * 4);
#pragma unroll
        for (int c = 0; c < 2; ++c) {
            const float khs = P.PT[c] * (sb == 0 ? T1[c] * T2[c] * T3[c] : sb == 1 ? T2[c] * T3[c] : sb == 2 ? T3[c] : 1.0f);
            u32x4 w0;
            w0.x = pg8::cvt_pk_bf16(P.kd[c][0] * khs, P.kd[c][1] * khs); w0.y = pg8::cvt_pk_bf16(P.kd[c][2] * khs, P.kd[c][3] * khs); w0.z = pg8::cvt_pk_bf16(P.kd[c][4] * khs, P.kd[c][5] * khs); w0.w = pg8::cvt_pk_bf16(P.kd[c][6] * khs, P.kd[c][7] * khs);
            *(LAS u32x4*)(lds + KHT + (2 * kp + c) * TS + 16 * w8) = w0; }
        if (latent) {
            const float eq0 = sb == 0 ? 1.0f : sb == 1 ? T0[0] : sb == 2 ? T0[0] * T1[0] : T0[0] * T1[0] * T2[0], eq1 = sb == 0 ? 1.0f : sb == 1 ? T0[1] : sb == 2 ? T0[1] * T1[1] : T0[1] * T1[1] * T2[1];
#pragma unroll
            for (int e = 0; e < 8; ++e) *(LAS unsigned*)(lds + Q0 + (8 * w8 + e) * RS + 4 * kp) = pg8::cvt_pk_bf16(P.qs[0][e] * eq0, P.qs[1][e] * eq1);
        }
        if (w8 == 0) *(LAS pg8::f32x2_c*)(lds + DK + 8 * kp) = (pg8::f32x2_c){(T0[0] * T1[0]) * (T2[0] * T3[0]), (T0[1] * T1[1]) * (T2[1] * T3[1])};
#pragma unroll
        for (int it = 0; it < 2; ++it) { const int idx = tid + 512 * it, sig = idx & 63, dv0 = (idx >> 6) * 8; const u32x4 w = P.vv[it];
            LAS unsigned short* vt = (LAS unsigned short*)(lds + VT + dv0 * TS + 2 * sig);
            vt[0 * (TS / 2)] = (unsigned short)(w.x & 0xffff); vt[1 * (TS / 2)] = (unsigned short)(w.x >> 16); vt[2 * (TS / 2)] = (unsigned short)(w.y & 0xffff); vt[3 * (TS / 2)] = (unsigned short)(w.y >> 16);
            vt[4 * (TS / 2)] = (unsigned short)(w.z & 0xffff); vt[5 * (TS / 2)] = (unsigned short)(w.z >> 16); vt[6 * (TS / 2)] = (unsigned short)(w.w & 0xffff); vt[7 * (TS / 2)] = (unsigned short)(w.w >> 16); }
    }
    Mid Q;
    s1_math(lds, N, tid, Q);
    load_inputs<BWD>(A, b, h, cpref, tid, N);
    if (latent) {
        for (int pi = wave; pi < 10; pi += 8) {
            const int bi = pi < 4 ? pi : pi < 7 ? pi - 3 : pi < 9 ? pi - 5 : 3;
            const int bjx = pi < 4 ? pi : pi < 7 ? pi - 4 : pi < 9 ? pi - 7 : 0;
            f32x4 cacc = (f32x4){0.f, 0.f, 0.f, 0.f};
            const int egsel = (bi == 2 && bjx == 0) ? 0 : (bi == 3 && bjx == 1) ? 1 : (bi == 3 && bjx == 0) ? 2 : -1;
            u32x4 aw[4], bw[4];
#pragma unroll
            for (int s = 0; s < 4; ++s) { aw[s] = *(const LAS u32x4*)(lds + QS + (16 * bi + l15) * RS + (32 * s + 8 * g) * 2);
                bw[s] = *(const LAS u32x4*)(lds + (bi == bjx ? KD : KE) + (16 * bjx + l15) * RS + (32 * s + 8 * g) * 2); }
            if (egsel >= 0) {
                const int t1 = egsel == 1 ? 2 : 1;
                f32x4 e0[4], e1[4];
#pragma unroll
                for (int s = 0; s < 4; ++s) { e0[s] = *(const LAS f32x4*)(lds + TT + (t1 * 128 + 32 * s + 8 * g) * 4); e1[s] = *(const LAS f32x4*)(lds + TT + (t1 * 128 + 32 * s + 8 * g + 4) * 4); }
                if (egsel == 2) {
#pragma unroll
                    for (int s = 0; s < 4; ++s) { e0[s] = e0[s] * *(const LAS f32x4*)(lds + TT + (2 * 128 + 32 * s + 8 * g) * 4); e1[s] = e1[s] * *(const LAS f32x4*)(lds + TT + (2 * 128 + 32 * s + 8 * g + 4) * 4); }
                }
#pragma unroll
                for (int s = 0; s < 4; ++s) { f32x4 a0, a1; unpack8(aw[s], a0, a1); aw[s] = __builtin_bit_cast(u32x4, pack8(a0 * e0[s], a1 * e1[s])); }
            }
#pragma unroll
            for (int s = 0; s < 4; ++s) cacc = __builtin_amdgcn_mfma_f32_16x16x32_bf16(__builtin_bit_cast(bf16x8, aw[s]), __builtin_bit_cast(bf16x8, bw[s]), cacc, 0, 0, 0);
#pragma unroll
            for (int r = 0; r < 4; ++r) { const int tl = 4 * g + r; float v = cacc[r]; if (bi == bjx && l15 > tl) v = 0.f;
                *(LAS unsigned short*)(lds + PP + (16 * bi + tl) * TS + 2 * (16 * bjx + l15)) = (unsigned short)pg8::cvt_pk_bf16(v, 0.f); }
        }
    }
    __syncthreads();
    bf16_t* ORb = (bf16_t*)(PB_OR(A)) + (rlbase * 512 + h * 128 + 16 * wave);
    unsigned long long pw[4]; u32x2 sgw[4];
    if (latent && second) {
        const bf16_t* SG = (const bf16_t*)(A.ws + WS_SG) + (rlbase * 512 + h * 128 + 16 * wave);
#pragma unroll
        for (int m = 0; m < 4; ++m) { const int tau = 16 * m + l15, rho = BWD ? 63 - tau : tau;
            pw[m] = __hip_atomic_load((unsigned long long*)(ORb + (unsigned)(rho * 512 + 4 * g)), RLX_AGENT); sgw[m] = *(const u32x2*)(SG + (unsigned)(rho * 512 + 4 * g)); }
    }
    bf16x8 vf[2];
#pragma unroll
    for (int s = 0; s < 2; ++s) vf[s] = *(const LAS bf16x8*)(lds + VT + (16 * wave + l15) * TS + (32 * s + 8 * g) * 2);
    f32x4 oT[4];
#pragma unroll
    for (int m = 0; m < 4; ++m) oT[m] = (f32x4){0.f, 0.f, 0.f, 0.f};
#define HG_RD_BQ(s) do { _Pragma("unroll") for (int m = 0; m < 4; ++m) { \
            const u32x2 q0w = *(const LAS u32x2*)(lds + Q0 + (16 * m + l15) * RS + (32 * (s) + 4 * g) * 2), q1w = *(const LAS u32x2*)(lds + Q0 + (16 * m + l15) * RS + (32 * (s) + 16 + 4 * g) * 2); \
            bq[(s) & 1][m].x = q0w.x; bq[(s) & 1][m].y = q0w.y; bq[(s) & 1][m].z = q1w.x; bq[(s) & 1][m].w = q1w.y; } } while (0)
#define HG_MM_BQ(s) do { const bf16x8 sf = pack8(S[2 * (s)], S[2 * (s) + 1]); _Pragma("unroll") for (int m = 0; m < 4; ++m) oT[m] = __builtin_amdgcn_mfma_f32_16x16x32_bf16(sf, __builtin_bit_cast(bf16x8, bq[(s) & 1][m]), oT[m], 0, 0, 0); } while (0)
#define HG_RD_KF(t) do { dk4[(t) & 3] = *(const LAS f32x4*)(lds + DK + (16 * (t) + 4 * g) * 4); _Pragma("unroll") for (int s_ = 0; s_ < 2; ++s_) kf[(t) & 3][s_] = *(const LAS bf16x8*)(lds + KHT + (16 * (t) + l15) * TS + (32 * s_ + 8 * g) * 2); } while (0)
#define HG_MM_KF(t) do { S[t] = S[t] * dk4[(t) & 3]; _Pragma("unroll") for (int s_ = 0; s_ < 2; ++s_) S[t] = __builtin_amdgcn_mfma_f32_16x16x32_bf16(kf[(t) & 3][s_], vf[s_], S[t], 0, 0, 0); } while (0)
    {
        f32x4 dk4[4]; bf16x8 kf[4][2];
        if (latent) {
            bf16x8 pf[4][2]; u32x4 bq[2][4];
#pragma unroll
            for (int m = 0; m < 4; ++m)
#pragma unroll
                for (int s = 0; s < 2; ++s) pf[m][s] = *(const LAS bf16x8*)(lds + PP + (16 * m + l15) * TS + (32 * s + 8 * g) * 2);
            HG_RD_BQ(0); HG_RD_BQ(1);
            __builtin_amdgcn_sched_barrier(0);
#pragma unroll
            for (int m = 0; m < 4; ++m)
#pragma unroll
                for (int s = 0; s < 2; ++s) oT[m] = __builtin_amdgcn_mfma_f32_16x16x32_bf16(vf[s], pf[m][s], oT[m], 0, 0, 0);
            HG_MM_BQ(0);
            __builtin_amdgcn_sched_barrier(0);
            HG_RD_BQ(2); HG_MM_BQ(1);
            __builtin_amdgcn_sched_barrier(0);
            HG_RD_BQ(3); HG_MM_BQ(2);
            __builtin_amdgcn_sched_barrier(0);
            HG_RD_KF(0); HG_RD_KF(1); HG_MM_BQ(3);
            __builtin_amdgcn_sched_barrier(0);
        } else { HG_RD_KF(0); HG_RD_KF(1); __builtin_amdgcn_sched_barrier(0); }
        HG_RD_KF(2); HG_RD_KF(3); HG_MM_KF(0); HG_MM_KF(1);
        __builtin_amdgcn_sched_barrier(0);
        HG_RD_KF(4); HG_RD_KF(5); HG_MM_KF(2); HG_MM_KF(3);
        __builtin_amdgcn_sched_barrier(0);
        HG_RD_KF(6); HG_RD_KF(7); HG_MM_KF(4); HG_MM_KF(5);
        __builtin_amdgcn_sched_barrier(0);
        HG_MM_KF(6); HG_MM_KF(7);
    }
#undef HG_RD_BQ
#undef HG_MM_BQ
#undef HG_RD_KF
#undef HG_MM_KF
    if (second) asm volatile("" : "+v"(pw[0]), "+v"(pw[1]), "+v"(pw[2]), "+v"(pw[3]), "+v"(S[7]), "+v"(oT[3]));
    if (latent) {
        if (!second) {
#pragma unroll
            for (int m = 0; m < 4; ++m) { const int tau = 16 * m + l15, rho = BWD ? 63 - tau : tau;
                const unsigned long long w = (unsigned long long)pg8::cvt_pk_bf16(oT[m][0], oT[m][1]) | ((unsigned long long)pg8::cvt_pk_bf16(oT[m][2], oT[m][3]) << 32);
                __hip_atomic_store((unsigned long long*)(ORb + (unsigned)(rho * 512 + 4 * g)), w, RLX_AGENT); }
        } else {
#pragma unroll
            for (int m = 0; m < 4; ++m) { const int tau = 16 * m + l15, rho_ = BWD ? 63 - tau : tau;
                for (unsigned sp = 0; pw[m] == OR_SENTINEL && sp < (1u << 20); ++sp) { __builtin_amdgcn_s_sleep(1); pw[m] = __hip_atomic_load((unsigned long long*)(ORb + (unsigned)(rho_ * 512 + 4 * g)), RLX_AGENT); }
                const unsigned lo = (unsigned)pw[m], hi = (unsigned)(pw[m] >> 32);
                oT[m] += (f32x4){pg8::bf_lo(lo), pg8::bf_hi(lo), pg8::bf_lo(hi), pg8::bf_hi(hi)};
                float ss = (oT[m][0] * oT[m][0] + oT[m][1] * oT[m][1]) + (oT[m][2] * oT[m][2] + oT[m][3] * oT[m][3]);
                ss += __shfl_xor(ss, 16); ss += __shfl_xor(ss, 32);
                if (g == 0) *(LAS float*)(lds + SSQ + (wave * 64 + tau) * 4) = ss; }
        }
    }
    if (latent && second) {
        __syncthreads();
        bf16_t* A1 = (bf16_t*)(PB_A1(A)) + (rlbase * 1024 + h * 128 + 16 * wave);
        const f32x4 gn = *(const LAS f32x4*)(lds + GNS + (16 * wave + 4 * g) * 4);
#pragma unroll
        for (int m = 0; m < 4; ++m) { const int tau = 16 * m + l15, rho = BWD ? 63 - tau : tau; float tot = 0.f;
#pragma unroll
            for (int w = 0; w < 8; ++w) tot += *(LAS float*)(lds + SSQ + (w * 64 + tau) * 4);
            const float rstd = 1.0f / sqrtf(tot * (1.0f / 128.0f) + EPS);
            const f32x4 sg4 = (f32x4){pg8::bf_lo(sgw[m].x), pg8::bf_hi(sgw[m].x), pg8::bf_lo(sgw[m].y), pg8::bf_hi(sgw[m].y)};
            const f32x4 o = oT[m] * rstd * gn * sg4;
            u32x2 ow; ow.x = pg8::cvt_pk_bf16(o[0], o[1]); ow.y = pg8::cvt_pk_bf16(o[2], o[3]); *(u32x2*)(A1 + (unsigned)(rho * 1024 + 4 * g)) = ow; }
    }
    s1_store(lds, Q, next_latent, tid, P);
}
template <bool BWD>
__device__ __forceinline__ void run_dir(const Args& A, LAS unsigned char* lds, int pair, int tid) {
    const int b = pair >> 2, h = pair & 3;
    if (tid < 128) { *(LAS float*)(lds + LBS + 4 * tid) = ((const float*)(A.ws + WS_LB))[(BWD ? 512 : 0) + h * 128 + tid]; *(LAS float*)(lds + GNS + 4 * tid) = A.hgn[h * 128 + tid]; }
    __syncthreads();
    f32x4 S[8];
#pragma unroll
    for (int t = 0; t < 8; ++t) S[t] = (f32x4){0.f, 0.f, 0.f, 0.f};
    {
      unsigned long long* orp = (unsigned long long*)((bf16_t*)(PB_OR(A)) + (((long)b * SEQ + (BWD ? 1024 : 0)) * 512 + h * 128));
      for (int i = tid; i < 1024 * 32; i += 512) __hip_atomic_store(orp + (size_t)(i >> 5) * 128 + (i & 31), OR_SENTINEL, RLX_AGENT); }
    auto chunk_of = [](int j) -> int { const int jj = j < 36 ? j : 35; return BWD ? (jj < 4 ? 3 - jj : 39 - jj) : jj; };
    Inputs nxt; Prep P;
    load_inputs<BWD>(A, b, h, chunk_of(0), tid, nxt);
    { Mid M0; s1_math(lds, nxt, tid, M0);
      load_inputs<BWD>(A, b, h, chunk_of(1), tid, nxt);
      __syncthreads();
      s1_store(lds, M0, false, tid, P); }
    for (int j = 0; j < 20; ++j) chunk_step<BWD, false>(A, lds, b, h, chunk_of(j), S, P, nxt, j + 1 >= 4, chunk_of(j + 2), tid);
    for (int j = 20; j < 36; ++j) chunk_step<BWD, true>(A, lds, b, h, chunk_of(j), S, P, nxt, true, chunk_of(j + 2), tid);
}
__device__ __forceinline__ void hgrn_item(const Args& A, LAS unsigned char* lds, int item, int tid) {
    for (int i = tid; i < (hg::TT - hg::PP) / 4; i += 512) *(LAS unsigned*)(lds + hg::PP + 4 * i) = 0u;
    __syncthreads();
    if (item & 1) run_dir<true>(A, lds, item >> 1, tid); else run_dir<false>(A, lds, item >> 1, tid);
}
}
namespace p5 {
constexpr int RSB = 2064  , WPTH = 0, WPTL = 16 * RSB  , GM = 2 * 16 * RSB  , SH = GM + 4096, BP = SH + 4096  , BIAS = BP + 2048, END = BIAS + 64;
__device__ __forceinline__ void rows128(const Args& A, LAS unsigned char* lds, int rb, int tid) {
    const int wave = __builtin_amdgcn_readfirstlane(tid >> 6), lane = tid & 63, l15 = lane & 15, g = lane >> 4;
    const int b = rb >> 4; const long row0 = (long)rb * 128 + wave * 16;
    const float* mod = (const float*)(A.ws + WS_MOD) + (size_t)b * NMOD;
    const bf16_t* x1 = (const bf16_t*)(A.ws + WS_X1B);
    { const int k = 2 * tid; const pg8::f32x2_c n2 = *(const pg8::f32x2_c*)(A.n2g + k), sc2 = *(const pg8::f32x2_c*)(mod + 4096 + k), sh2 = *(const pg8::f32x2_c*)(mod + 3072 + k);
      const float gm0 = n2[0] * (1.0f + sc2[0]), gm1 = n2[1] * (1.0f + sc2[1]);
      *(LAS pg8::f32x2_c*)(lds + GM + 4 * k) = (pg8::f32x2_c){gm0, gm1}; *(LAS pg8::f32x2_c*)(lds + SH + 4 * k) = sh2;
#pragma unroll
      for (int q = 0; q < 4; ++q) { const f32x4 w0 = *(const f32x4*)(A.wr + (size_t)k * 16 + 4 * q), w1 = *(const f32x4*)(A.wr + (size_t)(k + 1) * 16 + 4 * q);
#pragma unroll
          for (int j = 0; j < 4; ++j) { const float v0 = gm0 * w0[j], v1 = gm1 * w1[j]; const unsigned hi = pg8::cvt_pk_bf16(v0, v1);
              const unsigned lo = pg8::cvt_pk_bf16(v0 - pg8::bf_lo(hi), v1 - pg8::bf_hi(hi));
              *(LAS unsigned*)(lds + WPTH + (4 * q + j) * RSB + 2 * k) = hi; *(LAS unsigned*)(lds + WPTL + (4 * q + j) * RSB + 2 * k) = lo; } } }
    { const int e = tid & 15, kp = tid >> 4; float s = 0.f;
#pragma unroll
      for (int h = 0; h < 2; ++h) { float sv[16], wv[16];
#pragma unroll
          for (int i = 0; i < 16; ++i) { sv[i] = mod[3072 + kp * 32 + 16 * h + i]; wv[i] = A.wr[(size_t)(kp * 32 + 16 * h + i) * 16 + e]; }
#pragma unroll
          for (int i = 0; i < 16; ++i) s += sv[i] * wv[i]; }
      *(LAS float*)(lds + BP + (kp * 16 + e) * 4) = s; }
    __syncthreads();
    if (tid < 16) { float s = 0.f; for (int kp = 0; kp < 32; ++kp) s += *(LAS float*)(lds + BP + (kp * 16 + tid) * 4); *(LAS float*)(lds + BIAS + 4 * tid) = s; }
    __syncthreads();
    f32x4 acc = (f32x4){0.f, 0.f, 0.f, 0.f}; float ss = 0.f;
    { const bf16_t* xr = x1 + (row0 + l15) * 1024 + 8 * g;
      u32x4 xw[8];
#pragma unroll
      for (int it = 0; it < 8; ++it) xw[it] = *(const u32x4*)(xr + 32 * it);
#pragma unroll
      for (int it = 0; it < 32; ++it) {
        const bf16x8 bh = *(const LAS bf16x8*)(lds + WPTH + l15 * RSB + (32 * it + 8 * g) * 2), bl = *(const LAS bf16x8*)(lds + WPTL + l15 * RSB + (32 * it + 8 * g) * 2);
        const u32x4 w = xw[it & 7];
        if (it + 8 < 32) xw[it & 7] = *(const u32x4*)(xr + 32 * (it + 8));
        const bf16x8 a = __builtin_bit_cast(bf16x8, w);
        acc = __builtin_amdgcn_mfma_f32_16x16x32_bf16(a, bh, acc, 0, 0, 0); acc = __builtin_amdgcn_mfma_f32_16x16x32_bf16(a, bl, acc, 0, 0, 0);
        const float x0 = pg8::bf_lo(w.x), x1f = pg8::bf_hi(w.x), x2 = pg8::bf_lo(w.y), x3 = pg8::bf_hi(w.y), x4 = pg8::bf_lo(w.z), x5 = pg8::bf_hi(w.z), x6 = pg8::bf_lo(w.w), x7 = pg8::bf_hi(w.w);
        ss += ((x0 * x0 + x1f * x1f) + (x2 * x2 + x3 * x3)) + ((x4 * x4 + x5 * x5) + (x6 * x6 + x7 * x7));
        if ((it & 3) == 3) __builtin_amdgcn_sched_barrier(0);
      } }
    ss += __shfl_xor(ss, 16); ss += __shfl_xor(ss, 32);
    const float rstd = 1.0f / sqrtf(ss * (1.0f / 1024.0f) + EPS);
    const float bias = *(LAS float*)(lds + BIAS + 4 * l15);
    f32x4 aff;
#pragma unroll
    for (int r = 0; r < 4; ++r) { const float rs = __shfl(rstd, 4 * g + r); float lg = acc[r] * rs + bias;
        float mx = lg; mx = fmaxf(mx, __shfl_xor(mx, 1)); mx = fmaxf(mx, __shfl_xor(mx, 2)); mx = fmaxf(mx, __shfl_xor(mx, 4)); mx = fmaxf(mx, __shfl_xor(mx, 8));
        const float ex = expf(lg - mx); float sm = ex; sm += __shfl_xor(sm, 1); sm += __shfl_xor(sm, 2); sm += __shfl_xor(sm, 4); sm += __shfl_xor(sm, 8);
        aff[r] = ex / sm; }
    { float* AFF = (float*)(A.ws + WS_AFF); const int t = (rb & 15) * 128 + wave * 16 + 4 * g;
        *(f32x4*)(AFF + ((size_t)(b * 16 + l15)) * 2048 + t) = aff; }
    unsigned char* H2Q = A.ws + WS_H2; float* HS = (float*)(A.ws + WS_HS);
    for (int i0 = 0; i0 < 16; i0 += 4) {
        f32x4 v[4][4];
#pragma unroll
        for (int ii = 0; ii < 4; ++ii)
#pragma unroll
            for (int j = 0; j < 4; ++j) { const u32x2 w = *(const u32x2*)(x1 + (row0 + i0 + ii) * 1024 + 4 * lane + 256 * j); v[ii][j] = (f32x4){pg8::bf_lo(w.x), pg8::bf_hi(w.x), pg8::bf_lo(w.y), pg8::bf_hi(w.y)}; }
#pragma unroll
        for (int ii = 0; ii < 4; ++ii) { const float rs = __shfl(rstd, i0 + ii); float amax = 0.f;
#pragma unroll
            for (int j = 0; j < 4; ++j) { const int cidx = 4 * lane + 256 * j;
                const f32x4 gmv = *(const LAS f32x4*)(lds + GM + 4 * cidx), shv = *(const LAS f32x4*)(lds + SH + 4 * cidx);
                const f32x4 o = v[ii][j] * rs * gmv + shv; v[ii][j] = o;
                amax = fmaxf(fmaxf(amax, fmaxf(fabsf(o[0]), fabsf(o[1]))), fmaxf(fabsf(o[2]), fabsf(o[3]))); }
#pragma unroll
            for (int o_ = 1; o_ < 64; o_ <<= 1) amax = fmaxf(amax, __shfl_xor(amax, o_));
            const float am = amax > 1e-30f ? amax : 1e-30f, inv = 127.0f / am;
            if (lane == 0) HS[row0 + i0 + ii] = am * (1.0f / 127.0f);
#pragma unroll
            for (int j = 0; j < 4; ++j) { const f32x4 o = v[ii][j] * inv;
                const int q0 = (int)__builtin_rintf(o[0]), q1 = (int)__builtin_rintf(o[1]), q2 = (int)__builtin_rintf(o[2]), q3 = (int)__builtin_rintf(o[3]);
                *(unsigned*)(H2Q + (size_t)(row0 + i0 + ii) * 1024 + 4 * lane + 256 * j) = ((unsigned)q0 & 255u) | (((unsigned)q1 & 255u) << 8) | (((unsigned)q2 & 255u) << 16) | ((unsigned)q3 << 24); } } }
    __syncthreads();
}
__device__ __forceinline__ void ew_q8(const float* Wcol, unsigned char* WQ, float* TQp, LAS float* scr, int lane) {
    const int n4 = lane & 7, kr = lane >> 3;
    const float* W = Wcol + 4 * n4 + (size_t)kr * 1024;
    f32x4 ta[8], tb[8], tc[8], td[8];
#define EWQ_LD(t, kb) do { const float* w_ = W + (size_t)(64 * ((kb) < 16 ? (kb) : 15)) * 1024; _Pragma("unroll") for (int i = 0; i < 8; ++i) (t)[i] = *(const f32x4*)(w_ + (size_t)(8 * i) * 1024); } while (0)
#define EWQ_MAX(t) do { _Pragma("unroll") for (int i = 0; i < 8; ++i) { am4[0] = fmaxf(am4[0], fabsf((t)[i][0])); am4[1] = fmaxf(am4[1], fabsf((t)[i][1])); am4[2] = fmaxf(am4[2], fabsf((t)[i][2])); am4[3] = fmaxf(am4[3], fabsf((t)[i][3])); } } while (0)
    f32x4 am4 = (f32x4){0.f, 0.f, 0.f, 0.f};
    EWQ_LD(ta, 0); EWQ_LD(tb, 2); EWQ_LD(tc, 4); EWQ_LD(td, 6);
    EWQ_MAX(ta); EWQ_LD(ta, 8); EWQ_MAX(tb); EWQ_LD(tb, 10); EWQ_MAX(tc); EWQ_LD(tc, 14); EWQ_MAX(td); EWQ_LD(td, 15);
    EWQ_MAX(ta); EWQ_LD(ta, 12); EWQ_MAX(tb); EWQ_LD(tb, 13);
    EWQ_MAX(tc); EWQ_MAX(td); EWQ_MAX(ta); EWQ_MAX(tb);
#pragma unroll
    for (int j = 0; j < 4; ++j) { float a = am4[j]; a = fmaxf(a, __shfl_xor(a, 8)); a = fmaxf(a, __shfl_xor(a, 16)); a = fmaxf(a, __shfl_xor(a, 32)) * 1.15f; am4[j] = a > 1e-30f ? a : 1e-30f; }
    const f32x4 inv4 = (f32x4){127.0f / am4[0], 127.0f / am4[1], 127.0f / am4[2], 127.0f / am4[3]};
    if (lane < 8) *(f32x4*)(TQp + 4 * n4) = am4 * (1.0f / 127.0f);
#define EWQ_FIN(t, kb) do { _Pragma("unroll") for (int i = 0; i < 8; ++i) { const f32x4 q_ = (t)[i] * inv4; LAS float* d_ = scr + (kr + 8 * i) * 33 + 4 * n4; \
            d_[0] = __builtin_amdgcn_fmed3f(__builtin_rintf(q_[0]), -127.0f, 127.0f); d_[1] = __builtin_amdgcn_fmed3f(__builtin_rintf(q_[1]), -127.0f, 127.0f); d_[2] = __builtin_amdgcn_fmed3f(__builtin_rintf(q_[2]), -127.0f, 127.0f); d_[3] = __builtin_amdgcn_fmed3f(__builtin_rintf(q_[3]), -127.0f, 127.0f); } \
        LDS_WAIT(); asm volatile("" ::: "memory"); \
        { const int c = lane & 7; _Pragma("unroll") for (int j = 0; j < 4; ++j) { const int n = (lane >> 3) + 8 * j; const LAS float* s = scr + (8 * c) * 33 + n; \
            const unsigned w0 = ((unsigned)(int)s[0 * 33] & 255u) | (((unsigned)(int)s[1 * 33] & 255u) << 8) | (((unsigned)(int)s[2 * 33] & 255u) << 16) | ((unsigned)(int)s[3 * 33] << 24); \
            const unsigned w1 = ((unsigned)(int)s[4 * 33] & 255u) | (((unsigned)(int)s[5 * 33] & 255u) << 8) | (((unsigned)(int)s[6 * 33] & 255u) << 16) | ((unsigned)(int)s[7 * 33] << 24); \
            u32x2 o; o.x = w0; o.y = w1; *(u32x2*)(WQ + (size_t)n * 1024 + 64 * (kb) + 8 * c) = o; } } \
        LDS_WAIT(); asm volatile("" ::: "memory"); } while (0)
    EWQ_FIN(ta, 12); EWQ_LD(ta, 0); EWQ_FIN(tb, 13); EWQ_LD(tb, 1); EWQ_FIN(tc, 14); EWQ_LD(tc, 2); EWQ_FIN(td, 15); EWQ_LD(td, 3);
    for (int kb = 0; kb < 8; kb += 4) { EWQ_FIN(ta, kb); EWQ_LD(ta, kb + 4); EWQ_FIN(tb, kb + 1); EWQ_LD(tb, kb + 5); EWQ_FIN(tc, kb + 2); EWQ_LD(tc, kb + 6); EWQ_FIN(td, kb + 3); EWQ_LD(td, kb + 7); }
    EWQ_FIN(ta, 8); EWQ_FIN(tb, 9); EWQ_FIN(tc, 10); EWQ_FIN(td, 11);
#undef EWQ_LD
#undef EWQ_MAX
#undef EWQ_FIN
}
__device__ __forceinline__ void expert_weights(const Args& A, LAS unsigned char* lds, int vcu, int G, int tid) {
    const int wave = tid >> 6, lane = tid & 63; LAS float* scr = (LAS float*)(lds + wave * 8704);
    const int gw = vcu * NWAVES + wave, NGW = G * NWAVES;
    for (int it = gw; it < 16 * 64 + 16 * 32; it += NGW) {
        if (it < 16 * 64) { const int e = it >> 6, gi = it & 63, pn = gi >> 3, half = (gi >> 2) & 1, q = gi & 3;
            ew_q8((half ? A.weu : A.weg) + (size_t)e * 1024 * 1024 + 128 * pn + 32 * q, A.ws + WS_WGU + ((size_t)e * 2048 + gi * 32) * 1024, (float*)(A.ws + WS_TQ) + e * 2048 + gi * 32, scr, lane); }
        else { const int r = it - 16 * 64, e = r >> 5, gi = r & 31;
            ew_q8(A.wed + (size_t)e * 1024 * 1024 + 32 * gi, A.ws + WS_WD + ((size_t)e * 1024 + gi * 32) * 1024, (float*)(A.ws + WS_TD) + e * 1024 + gi * 32, scr, lane); } }
}
}

__device__ __forceinline__ unsigned block_exscan(unsigned v, LAS unsigned* scr, int tid, unsigned* total) {
    const int lane = tid & 63, wave = tid >> 6; unsigned inc = v;
#pragma unroll
    for (int o = 1; o < 64; o <<= 1) { const unsigned t = __shfl_up(inc, o); if (lane >= o) inc += t; }
    if (lane == 63) scr[wave] = inc;
    __syncthreads();
    unsigned base = 0, tot = 0;
#pragma unroll
    for (int w = 0; w < 8; ++w) { const unsigned x = scr[w]; if (w < wave) base += x; tot += x; }
    __syncthreads();
    *total = tot; return base + inc - v;
}
__device__ __forceinline__ void topk_unit(const Args& A, LAS unsigned char* lds, int b, int e, int tid) {
    LAS unsigned* hist = (LAS unsigned*)lds;
    LAS unsigned* ctlw = (LAS unsigned*)(lds + 1024);
    const float* AFF = (const float*)(A.ws + WS_AFF) + (size_t)(b * 16 + e) * 2048;
    const f32x4 v4 = *(const f32x4*)(AFF + 4 * tid);
    unsigned key[4];
#pragma unroll
    for (int i = 0; i < 4; ++i) key[i] = __float_as_uint(v4[i]);
    unsigned prefix = 0, need = 256;
#pragma unroll 1
    for (int pass = 0; pass < 4; ++pass) { const int shift = 24 - 8 * pass;
        if (tid < 256) hist[tid] = 0u;
        __syncthreads();
#pragma unroll
        for (int i = 0; i < 4; ++i) if (pass == 0 || (key[i] >> (shift + 8)) == prefix) (void)__hip_atomic_fetch_add(&hist[(key[i] >> shift) & 255u], 1u, __ATOMIC_RELAXED, __HIP_MEMORY_SCOPE_WORKGROUP);
        __syncthreads();
        if (tid < 64) {
            const unsigned h0 = hist[4 * tid], h1 = hist[4 * tid + 1], h2 = hist[4 * tid + 2], h3 = hist[4 * tid + 3]; const unsigned mine = h0 + h1 + h2 + h3;
            unsigned suf = mine;
#pragma unroll
            for (int o = 1; o < 64; o <<= 1) { const unsigned t = __shfl_down(suf, o); if (tid + o < 64) suf += t; }
            const unsigned above = suf - mine;
            if (above < need && suf >= need) {
                unsigned cum = above; int bin = 4 * tid + 3;
                if (cum + h3 >= need) { } else { cum += h3; bin = 4 * tid + 2; if (cum + h2 >= need) { } else { cum += h2; bin = 4 * tid + 1; if (cum + h1 >= need) { } else { cum += h1; bin = 4 * tid; } } }
                ctlw[8] = (prefix << 8) | (unsigned)bin; ctlw[9] = need - cum; } }
        __syncthreads();
        prefix = ctlw[8]; need = ctlw[9];
        __syncthreads();
    }
    unsigned eqc = 0;
#pragma unroll
    for (int i = 0; i < 4; ++i) eqc += (key[i] == prefix) ? 1u : 0u;
    unsigned tot; unsigned eqbase = block_exscan(eqc, ctlw, tid, &tot);
    unsigned sel = 0; bool take[4];
#pragma unroll
    for (int i = 0; i < 4; ++i) { take[i] = key[i] > prefix; if (key[i] == prefix) { take[i] = eqbase < need; ++eqbase; } sel += take[i] ? 1u : 0u; }
    unsigned slot = block_exscan(sel, ctlw, tid, &tot);
    int* IDX = (int*)(A.ws + WS_IDX) + (b * 16 + e) * 256; float* GATE = (float*)(A.ws + WS_IDX + 256 * 1024) + (b * 16 + e) * 256; int* SLOT = (int*)(A.ws + WS_SLOT);
    float* SCL = (float*)(A.ws + WS_SCL) + (b * 16 + e) * 256; const float* HS = (const float*)(A.ws + WS_HS);
#pragma unroll
    for (int i = 0; i < 4; ++i) { const int t = 4 * tid + i; int sl = -1;
        if (take[i]) { sl = (int)slot; ++slot; IDX[sl] = b * 2048 + t; GATE[sl] = v4[i]; SCL[sl] = HS[b * 2048 + t]; }
        SLOT[(size_t)(b * 2048 + t) * 16 + e] = sl; }
    VM_WAIT();
    __syncthreads();
}

struct P7Row { u32x4 x[2]; u32x2 y[4][2]; int ne; unsigned rest; };
typedef int i32x4_p7 __attribute__((ext_vector_type(4)));
__device__ __forceinline__ int p7_slot_of(const i32x4_p7 sl, int i, int e) {
    const int c = e & 3; const int v = c == 0 ? sl.x : c == 1 ? sl.y : c == 2 ? sl.z : sl.w;
    return __builtin_amdgcn_readlane(v, 4 * i + (e >> 2));
}
__device__ __forceinline__ unsigned p7_mask_of(const unsigned long long (&bc)[4], int i) {
    unsigned m = 0;
#pragma unroll
    for (int c = 0; c < 4; ++c) { const unsigned n = (unsigned)(bc[c] >> (4 * i)) & 15u; m |= ((n & 1u) | ((n & 2u) << 3) | ((n & 4u) << 6) | ((n & 8u) << 9)) << c; }
    return m;
}
__device__ __forceinline__ void p7_issue(const bf16_t* X1B, const unsigned char* YE, int r, const i32x4_p7 sl, const unsigned long long (&bc)[4], int i, int lane, P7Row& R) {
    const int b = r >> 11;
#pragma unroll
    for (int j = 0; j < 2; ++j) R.x[j] = *(const u32x4*)(X1B + (size_t)r * 1024 + j * 512 + 8 * lane);
    unsigned m = p7_mask_of(bc, i); int ne = 0;
#pragma unroll
    for (int q = 0; q < 4; ++q) { const unsigned char* yr = YE;
        if (m) { const int e = __builtin_ctz(m); m &= m - 1; yr = YE + ((size_t)(b * 16 + e) * 256 + p7_slot_of(sl, i, e)) * 1024; ne = q + 1; }
        if (!DBG_TIMING) { R.y[q][0] = *(const u32x2*)(yr + 8 * lane); R.y[q][1] = *(const u32x2*)(yr + 512 + 8 * lane); } }
    R.ne = DBG_TIMING ? 0 : ne; R.rest = DBG_TIMING ? 0u : m;
}
__device__ __forceinline__ void p7_f8acc(const u32x2 w, f32x4& a0, f32x4& a1) {
    const pg8::f32x2_c p0 = __builtin_amdgcn_cvt_pk_f32_fp8((int)w.x, false), p1 = __builtin_amdgcn_cvt_pk_f32_fp8((int)w.x, true), p2 = __builtin_amdgcn_cvt_pk_f32_fp8((int)w.y, false), p3 = __builtin_amdgcn_cvt_pk_f32_fp8((int)w.y, true);
    a0 += (f32x4){p0[0], p0[1], p1[0], p1[1]}; a1 += (f32x4){p2[0], p2[1], p3[0], p3[1]};
}
__device__ __forceinline__ void p7_finish(const Args& A, const unsigned char* YE, int r, const i32x4_p7 sl, int i, int lane, const P7Row& R, const f32x4 (&g2)[4], const f32x4 (&fg)[4], float scale) {
    const int b = r >> 11;
    f32x4 acc[4];
#pragma unroll
    for (int j = 0; j < 4; ++j) acc[j] = (f32x4){0.f, 0.f, 0.f, 0.f};
#pragma unroll
    for (int q = 0; q < 4; ++q) if (q < R.ne) { p7_f8acc(R.y[q][0], acc[0], acc[1]); p7_f8acc(R.y[q][1], acc[2], acc[3]); }
    for (unsigned m = R.rest; m;) { const int e = __builtin_ctz(m); m &= m - 1;
        const unsigned char* yr = YE + ((size_t)(b * 16 + e) * 256 + p7_slot_of(sl, i, e)) * 1024;
        p7_f8acc(*(const u32x2*)(yr + 8 * lane), acc[0], acc[1]); p7_f8acc(*(const u32x2*)(yr + 512 + 8 * lane), acc[2], acc[3]); }
#pragma unroll
    for (int j = 0; j < 4; ++j) acc[j] = acc[j] * (1.0f / pg8::YE_F8_SCALE);
    f32x4 xv[4];
#pragma unroll
    for (int j = 0; j < 2; ++j) { const u32x4 w = R.x[j]; xv[2 * j] = (f32x4){pg8::bf_lo(w.x), pg8::bf_hi(w.x), pg8::bf_lo(w.y), pg8::bf_hi(w.y)}; xv[2 * j + 1] = (f32x4){pg8::bf_lo(w.z), pg8::bf_hi(w.z), pg8::bf_lo(w.w), pg8::bf_hi(w.w)}; }
    float* xo = A.out + (size_t)r * 1024; f32x4 v[4]; float ss = 0.f;
#pragma unroll
    for (int j = 0; j < 4; ++j) { const int cidx = (j >> 1) * 512 + 8 * lane + (j & 1) * 4;
        v[j] = xv[j] + g2[j] * acc[j]; ss += (v[j][0] * v[j][0] + v[j][1] * v[j][1]) + (v[j][2] * v[j][2] + v[j][3] * v[j][3]); }
    const float rstd = 1.0f / sqrtf(wave_sum(ss) * (1.0f / 1024.0f) + EPS);
#pragma unroll
    for (int j = 0; j < 4; ++j) { const int cidx = (j >> 1) * 512 + 8 * lane + (j & 1) * 4; *(f32x4*)(xo + cidx) = v[j] * (rstd * scale) * fg[j]; }
}
__device__ __forceinline__ void p7_rows(const Args& A, int vcu, int G, int tid) {
    const int wave = tid >> 6, lane = tid & 63; const int gw = vcu * NWAVES + wave, NGW = G * NWAVES;
    const float* mod = (const float*)(A.ws + WS_MOD); const int* SLOT = (const int*)(A.ws + WS_SLOT); const unsigned char* YE = A.ws + WS_YE; const bf16_t* X1B = (const bf16_t*)(A.ws + WS_X1B);
#if DBG_TIMING
    const unsigned tsa_ = __hip_atomic_load((unsigned*)(A.ws + WS_CTL) + 100 + DBG_TIME_A0, RLX_AGENT), tsb_ = __hip_atomic_load((unsigned*)(A.ws + WS_CTL) + 100 + DBG_TIME_A1, RLX_AGENT);
    const float DBG_SCALE = 1.0f + (float)((tsb_ - tsa_) / (100u * DBG_TIME_Q));
#else
    const float DBG_SCALE = 1.0f;
#endif
    const int RPW = (((ML + NGW - 1) / NGW) + 15) & ~15;
    const int r0 = gw * RPW, r1 = r0 + RPW < ML ? r0 + RPW : ML;
    f32x4 fg[4], g2[4]; int bcur = -1;
#pragma unroll
    for (int j = 0; j < 4; ++j) { fg[j] = *(const f32x4*)(A.fng + (j >> 1) * 512 + 8 * lane + (j & 1) * 4); g2[j] = fg[j]; }
    asm volatile("" : "+v"(fg[0]), "+v"(fg[1]), "+v"(fg[2]), "+v"(fg[3]));
    for (int rg = r0; rg < r1; rg += 16) {
        const int nr = r1 - rg < 16 ? r1 - rg : 16, b = rg >> 11;
        if (b != bcur) { bcur = b;
#pragma unroll
            for (int j = 0; j < 4; ++j) g2[j] = *(const f32x4*)(mod + (size_t)b * NMOD + 5120 + (j >> 1) * 512 + 8 * lane + (j & 1) * 4);
            asm volatile("" : "+v"(g2[0]), "+v"(g2[1]), "+v"(g2[2]), "+v"(g2[3])); }
        i32x4_p7 sl = *(const i32x4_p7*)(SLOT + (size_t)rg * 16 + 4 * lane);
        asm volatile("" : "+v"(sl));
        unsigned long long bc[4]; bc[0] = __ballot(sl.x >= 0); bc[1] = __ballot(sl.y >= 0); bc[2] = __ballot(sl.z >= 0); bc[3] = __ballot(sl.w >= 0);
        P7Row B0, B1;
        p7_issue(X1B, YE, rg, sl, bc, 0, lane, B0);
        for (int i = 0; i < nr; i += 2) {
            { const int i1 = i + 1 < nr ? i + 1 : nr - 1; p7_issue(X1B, YE, rg + i1, sl, bc, i1, lane, B1); }
            p7_finish(A, YE, rg + i, sl, i, lane, B0, g2, fg, DBG_SCALE);
            { const int i2 = i + 2 < nr ? i + 2 : nr - 1; p7_issue(X1B, YE, rg + i2, sl, bc, i2, lane, B0); }
            if (i + 1 < nr) p7_finish(A, YE, rg + i + 1, sl, i + 1, lane, B1, g2, fg, DBG_SCALE);
        }
    }
}

#ifndef DBG_TIMING
#define DBG_TIMING 0
#endif
typedef const __attribute__((address_space(4))) Args* KArgsPtr;
__global__ void __launch_bounds__(NWAVES * 64, 2) fwd_megakernel(Args A_) {
    KArgsPtr ap = (KArgsPtr)__builtin_amdgcn_kernarg_segment_ptr(); asm volatile("" : "+s"(ap));
#define A (*(const Args*)ap)
    extern __shared__ __attribute__((aligned(16))) unsigned char lds_raw[];
    LAS unsigned char* lds = (LAS unsigned char*)lds_raw;
    volatile LAS unsigned* MISC = (volatile LAS unsigned*)(lds + MISC_OFF);
    int tid = threadIdx.x; const int bx = blockIdx.x, G = gridDim.x;
    const int vcu = (G % 8 == 0) ? (bx % 8) * (G / 8) + bx / 8 : bx;
    unsigned* ctl = (unsigned*)(A.ws + WS_CTL);
    for (int u = tid; u < 64; u += NWAVES * 64) ((LAS unsigned*)(lds + MISC_OFF))[u] = 0u;
    __syncthreads();
    const XcdBarrier xbar = xcd_barrier_post((unsigned*)(ctl + CW_BAR), MISC + 8);
#define GRID_BAR() xcd_barrier(xbar)
#define RELAUNDER() do { int t_ = threadIdx.x; asm volatile("" : "+v"(t_)); tid = t_; KArgsPtr p_ = (KArgsPtr)__builtin_amdgcn_kernarg_segment_ptr(); asm volatile("" : "+s"(p_)); ap = p_; } while (0)
#if DBG_TIMING
#define STAMP(k) do { if (bx == 0) ctl[100 + (k)] = (unsigned)__builtin_amdgcn_s_memrealtime(); } while (0)
#else
#define STAMP(k) do { } while (0)
#endif
    STAMP(0);
    RELAUNDER();
    p0_prologue<0>(A, lds, vcu, G, tid);
    GRID_BAR(); STAMP(1);
    RELAUNDER();
    p1_rows(A, vcu, G, tid);
    RELAUNDER();
    p0_prologue<1>(A, lds, vcu, G, tid);
    GRID_BAR(); STAMP(2);
    RELAUNDER();
    {
        pg8::Gemm g{(const bf16_t*)(PB_HX(A)), (const bf16_t*)(A.ws + WS_WIN), MR, INC, 512  , nullptr}; pg8::InProjOrder S; S.init(G, bx);
        pg8::EpiInProjQ E{{A.ws, WS_HQ, WS_FF, WS_FB, WS_HI, WS_SG, WS_Q, WS_K, WS_V, WS_GA, WS_GB, WS_ROPE, A.qng, A.kng}, (const float*)PB_HXS(A), (const float*)(A.ws + WS_WINS)};
        pg8::gemm_phase<pg8::EpiInProjQ, pg8::InProjOrder, true, true, true>(lds, g, S, E);
    }
    GRID_BAR(); STAMP(3);
    RELAUNDER();
    {
        if (bx < 128) { for (int it = bx; it < 128; it += G) { RELAUNDER(); hg::hgrn_item(A, lds, it, tid); } }
        else p5::expert_weights(A, lds, bx - 128, G - 128, tid);
        STAMP(20);
        __syncthreads();
        const float att_mfix = __uint_as_float(__builtin_amdgcn_readfirstlane(__hip_atomic_load(ctl + CW_MFIX, RLX_AGENT)));
#define ATT_QUEUE(FIX, MF) for (;;) { \
            if (tid == 0) MISC[0] = atomicAdd(ctl + CW_Q3, 1u); \
            __syncthreads(); \
            const unsigned u = MISC[0]; \
            __syncthreads(); \
            if (u >= 1024u) break; \
            const int bk = u >> 5, b = bk >> 1, kvh = bk & 1, gq = (u >> 3) & 3, qb = u & 7; \
            attn_body::attn_unit<8, FIX>((long)b * SEQ + qb * 256, kvh * 4 + gq, (long)b * RPB, kvh, (const attn_body::bf16*)(A.ws + WS_Q), (const attn_body::bf16*)(A.ws + WS_K), (const attn_body::bf16*)(A.ws + WS_V), \
                                    (attn_body::bf16*)(PB_OATT(A)), (char*)lds_raw, MF); }
        if (att_mfix <= 60.0f) { ATT_QUEUE(true, att_mfix) } else { ATT_QUEUE(false, 0.f) }
#undef ATT_QUEUE
    }
    GRID_BAR(); STAMP(4);
    RELAUNDER();
    {
        pg8::StaticOrder S; S.init(ML, 1024, G, bx);
        pg8::Gemm g{(const bf16_t*)(PB_A1(A)), (const bf16_t*)(A.ws + WS_WA), ML, 1024, 1024, nullptr};
        pg8::EpiZ2 E{(bf16_t*)(A.ws + WS_Z), A.ws + WS_GA, A.ws + WS_GB};
        pg8::gemm_phase<pg8::EpiZ2, pg8::StaticOrder, true, true, false, true>(lds, g, S, E);
    }
    GRID_BAR(); STAMP(5);
    RELAUNDER();
    {
        pg8::StaticOrder S; S.init(ML, 1024, G, bx);
        pg8::Gemm g{(const bf16_t*)(A.ws + WS_Z), (const bf16_t*)(A.ws + WS_WO), ML, 1024, 1024, nullptr}; pg8::EpiX1 E{A.x, (const float*)(A.ws + WS_MOD), (bf16_t*)(A.ws + WS_X1B)};
        pg8::gemm_phase<pg8::EpiX1, pg8::StaticOrder, true, true>(lds, g, S, E);
    }
    GRID_BAR(); STAMP(6);
    RELAUNDER();
    for (int rb = vcu; rb < 256; rb += G) { RELAUNDER(); p5::rows128(A, lds, rb, tid); }
    GRID_BAR(); STAMP(7);
    RELAUNDER();
    for (int uu = vcu; uu < 256; uu += G) { const int e = uu >> 4, b = uu & 15, unit = b * 16 + e;
        RELAUNDER();
        topk_unit(A, lds, b, e, tid);
        bf16_t* HID = (bf16_t*)(PB_HID(A)) + (size_t)unit * 256 * 1024;
        { pg8::Gemm g{(const bf16_t*)(A.ws + WS_H2), (const bf16_t*)(A.ws + WS_WGU) + (size_t)e * 2048 * 512, 256, 2048, 512  , (const int*)(A.ws + WS_IDX) + unit * 256};
          pg8::LocalOrder S{8}; pg8::EpiHidQ E{HID, (const float*)(A.ws + WS_SCL) + unit * 256, (const float*)(A.ws + WS_TQ) + e * 2048};
          pg8::gemm_phase<pg8::EpiHidQ, pg8::LocalOrder, true, true, true>(lds, g, S, E); }
        VM_WAIT(); __syncthreads();
        { unsigned char* HQ = A.ws + WS_HIDQ + (size_t)unit * 256 * 1024; float* S2 = (float*)(A.ws + WS_SCL2) + unit * 256; const int wv = tid >> 6, ln = tid & 63;
          for (int r0 = wv * 32; r0 < wv * 32 + 32; r0 += 8) {
              u32x4 w[8][2];
#pragma unroll
              for (int ii = 0; ii < 8; ++ii) { w[ii][0] = *(const u32x4*)(HID + (size_t)(r0 + ii) * 1024 + 16 * ln); w[ii][1] = *(const u32x4*)(HID + (size_t)(r0 + ii) * 1024 + 16 * ln + 8); }
#pragma unroll
              for (int ii = 0; ii < 8; ++ii) { f32x4 v[4];
                  v[0] = (f32x4){pg8::bf_lo(w[ii][0].x), pg8::bf_hi(w[ii][0].x), pg8::bf_lo(w[ii][0].y), pg8::bf_hi(w[ii][0].y)}; v[1] = (f32x4){pg8::bf_lo(w[ii][0].z), pg8::bf_hi(w[ii][0].z), pg8::bf_lo(w[ii][0].w), pg8::bf_hi(w[ii][0].w)};
                  v[2] = (f32x4){pg8::bf_lo(w[ii][1].x), pg8::bf_hi(w[ii][1].x), pg8::bf_lo(w[ii][1].y), pg8::bf_hi(w[ii][1].y)}; v[3] = (f32x4){pg8::bf_lo(w[ii][1].z), pg8::bf_hi(w[ii][1].z), pg8::bf_lo(w[ii][1].w), pg8::bf_hi(w[ii][1].w)};
                  float amax = 0.f;
#pragma unroll
                  for (int j = 0; j < 4; ++j) amax = fmaxf(fmaxf(amax, fmaxf(fabsf(v[j][0]), fabsf(v[j][1]))), fmaxf(fabsf(v[j][2]), fabsf(v[j][3])));
#pragma unroll
                  for (int o_ = 1; o_ < 64; o_ <<= 1) amax = fmaxf(amax, __shfl_xor(amax, o_));
                  const float am = amax > 1e-30f ? amax : 1e-30f, inv = 127.0f / am;
                  if (ln == 0) S2[r0 + ii] = am * (1.0f / 127.0f);
                  u32x4 o;
#pragma unroll
                  for (int j = 0; j < 4; ++j) { const f32x4 q = v[j] * inv;
                      const unsigned pk = ((unsigned)(int)__builtin_rintf(q[0]) & 255u) | (((unsigned)(int)__builtin_rintf(q[1]) & 255u) << 8) | (((unsigned)(int)__builtin_rintf(q[2]) & 255u) << 16) | ((unsigned)(int)__builtin_rintf(q[3]) << 24);
                      if (j == 0) o.x = pk; else if (j == 1) o.y = pk; else if (j == 2) o.z = pk; else o.w = pk; }
                  *(u32x4*)(HQ + (size_t)(r0 + ii) * 1024 + 16 * ln) = o; } } }
        VM_WAIT(); __syncthreads();
        { pg8::Gemm g{(const bf16_t*)(A.ws + WS_HIDQ) + (size_t)unit * 256 * 512, (const bf16_t*)(A.ws + WS_WD) + (size_t)e * 1024 * 512, 256, 1024, 512  , nullptr};
          pg8::LocalOrder S{4}; pg8::EpiYeQ E{A.ws + WS_YE + (size_t)unit * 256 * 1024, (const float*)(A.ws + WS_IDX + 256 * 1024) + unit * 256, (const float*)(A.ws + WS_SCL2) + unit * 256, (const float*)(A.ws + WS_TD) + e * 1024};
          pg8::gemm_phase<pg8::EpiYeQ, pg8::LocalOrder, true, true, true>(lds, g, S, E); }
        __syncthreads();
    }
    GRID_BAR(); STAMP(8);
#if DBG_TIMING
    GRID_BAR();
#endif
    RELAUNDER();
    p7_rows(A, vcu, G, tid);
}
#undef A

extern "C" void kernel_launch(void* const* d_in, const int* in_sizes, int n_in, void* d_out, int out_size, void* d_ws, size_t ws_size, hipStream_t stream) {
    static int grid = 0;
    if (grid == 0) {
        if (n_in != 21 || out_size != ML * 1024 || ws_size < WS_END) { fprintf(stderr, "kernel_launch: unexpected problem (n_in %d, out %d, ws %zu); nothing launched\n", n_in, out_size, ws_size); grid = -1; return; }
        int dev = 0, cus = 0, per_cu = 0;
        if (hipGetDevice(&dev) != hipSuccess || hipDeviceGetAttribute(&cus, hipDeviceAttributeMultiprocessorCount, dev) != hipSuccess) { grid = -1; return; }
        if (hipFuncSetAttribute((const void*)fwd_megakernel, hipFuncAttributeMaxDynamicSharedMemorySize, LDS_BYTES) != hipSuccess) { fprintf(stderr, "kernel_launch: hipFuncSetAttribute failed\n"); grid = -1; return; }
        if (hipOccupancyMaxActiveBlocksPerMultiprocessor(&per_cu, (const void*)fwd_megakernel, NWAVES * 64, LDS_BYTES) != hipSuccess || per_cu < 1) { fprintf(stderr, "kernel_launch: occupancy query says %d\n", per_cu); (void)hipGetLastError(); grid = -1; return; }
        grid = cus;
    }
    if (grid < 0) return;
    (void)hipMemsetAsync((char*)d_ws + WS_CTL, 0, CTL_ZERO_BYTES, stream);
    Args a{};
    const float** ap = (const float**)&a;
    for (int i = 0; i < 21; ++i) ap[i] = (const float*)d_in[i];
    a.out = (float*)d_out; a.ws = (unsigned char*)d_ws;
    hipLaunchKernelGGL(fwd_megakernel, dim3(grid), dim3(NWAVES * 64), LDS_BYTES, stream, a);
    const hipError_t le = hipPeekAtLastError();
    if (le != hipSuccess) fprintf(stderr, "kernel_launch: launch failed: %s (grid %d)\n", hipGetErrorName(le), grid);
}
```

```cpp
#include <hip/hip_runtime.h>
#include <hip/hip_bf16.h>
#include <hip/hip_cooperative_groups.h>
#include <cstdio>
#include <cstdint>
#include <cmath>
namespace cg = cooperative_groups;

constexpr int NB = 16, SEQ = 2048, CTXL = 256, DM_ = 1024, RPB = SEQ + CTXL  ;
constexpr int MR = NB * RPB  , ML = NB * SEQ  , INC = 5376, NMOD = 6 * DM_;
constexpr int NE = 16, CAP = 256, EFF = 1024;
constexpr float EPS = 1e-6f;
constexpr float LOG2E = 1.4426950408889634f;
#ifndef DEBUG_POISON
#define DEBUG_POISON 0
#endif
#ifndef DBG_NOMOE
#define DBG_NOMOE 0
#endif
#ifndef DBG_NOATT
#define DBG_NOATT 0
#endif
#ifndef DBG_NOHG
#define DBG_NOHG 0
#endif
#ifndef DBG_OUT_X
#define DBG_OUT_X 0
#endif
#ifndef DBG_X1_NOY
#define DBG_X1_NOY 0
#endif
#ifndef DBG_P4B_A
#define DBG_P4B_A 0
#endif
#ifndef PHASES
#define PHASES 511
#endif
#ifndef DBG_GA_ONLY
#define DBG_GA_ONLY 0
#endif
#ifndef DBG_DOUBLE_BAR
#define DBG_DOUBLE_BAR 0
#endif
#ifndef DBG_WBL2_TWICE
#define DBG_WBL2_TWICE 0
#endif
#ifndef DBG_LEADER_DELAY
#define DBG_LEADER_DELAY 0
#endif
#ifndef DBG_RELEASE_ALL
#define DBG_RELEASE_ALL 0
#endif
#ifndef PG8_DMA_AUX
#define PG8_DMA_AUX 0
#endif
#ifndef DBG_CHECKS
#define DBG_CHECKS 0
#endif
#ifndef DBG_SYSINV
#define DBG_SYSINV 0
#endif
#ifndef DBG_HG_B
#define DBG_HG_B 15
#endif
#ifndef DBG_ALPHA
#define DBG_ALPHA 1.0f
#endif
#ifndef DBG_ONLYATT
#define DBG_ONLYATT 0
#endif
#ifndef DBG_BETA
#define DBG_BETA 1.0f
#endif
#ifndef DBG_POISON_SET
#define DBG_POISON_SET 0
#endif
#ifndef PG8_USE_DMA
#define PG8_USE_DMA 0
#endif
#ifndef DBG_BARTEST
#define DBG_BARTEST 0
#endif
#ifndef DBG_OUT_BUF
#define DBG_OUT_BUF 0
#endif
#ifndef DBG_TIMING
#define DBG_TIMING 0
#define DBG_TIME_A0 3
#define DBG_TIME_A1 20
#endif
#ifndef REPEAT_PHASE
#define REPEAT_PHASE -1
#endif
#ifndef DBG_TIME_Q
#define DBG_TIME_Q 16u
#endif
#ifndef HG_EXP
#define HG_EXP 0
#endif
#ifndef EPI_EXP
#define EPI_EXP 0
#endif
#ifndef P2_STAGGER_TICKS
#define P2_STAGGER_TICKS 0
#endif
namespace pg8 {
#define PG8_LAS __attribute__((address_space(3)))
typedef unsigned short bf16_t;
typedef short bf16x8 __attribute__((ext_vector_type(8)));
typedef float f32x4 __attribute__((ext_vector_type(4)));
typedef unsigned u32x4 __attribute__((ext_vector_type(4)));
constexpr int BM = 256, BK = 64, HALF = 128, HTB = HALF * BK * 2  , STAGE_BYTES = 8 * HTB, NXCD = 8, WGM = 8;

__host__ __device__ __forceinline__ int lds_byte(int r, int c) { const int st = (r >> 4) * 2 + (c >> 5), rr = r & 15, cc = c & 31, ob = rr * 64 + cc * 2; return st * 1024 + (ob ^ (((ob >> 9) & 1) << 5)); }
__host__ __device__ __forceinline__ void stage_rc(int b, int& R, int& C) { const int st = b / 1024, sb = b % 1024, swz = sb ^ (((sb >> 9) & 1) << 5); R = (st >> 1) * 16 + swz / 64; C = (st & 1) * 32 + (swz % 64) / 2; }
__host__ __device__ __forceinline__ int perm32(int rho) { const int n = rho >> 4, i = rho & 15; return 8 * (i >> 2) + 4 * n + (i & 3); }

struct Unit { int pm, pn; };
struct Gemm { const bf16_t* A; const bf16_t* Bt; int M, N, K; const int* gather; };

struct StaticOrder {
    int nM, nN, nwg, G, c;
    __host__ __device__ void init(int M, int N, int G_, int c_) { nM = M / BM; nN = N / BM; nwg = nM * nN; G = G_; c = c_; }
    __host__ __device__ bool next(int i, Unit& u) const {
        const long L = (long)i * G + c; if (L >= nwg) return false;
        int wgid = (int)L; { const int q = nwg / NXCD, r = nwg % NXCD, xcd = wgid % NXCD, off = wgid / NXCD; wgid = (xcd < r ? xcd * (q + 1) : r * (q + 1) + (xcd - r) * q) + off; }
        const int nig = WGM * nN, gid = wgid / nig, fm = gid * WGM, gsz = (nM - fm) < WGM ? (nM - fm) : WGM;
        u.pm = fm + ((wgid % nig) % gsz); u.pn = (wgid % nig) / gsz; return true;
    }
    __device__ __forceinline__ void a_ready(const Unit&) const {}
    __device__ __forceinline__ void done(const Unit&) const {}
};

typedef float f32x2_c __attribute__((ext_vector_type(2))); typedef __bf16 bf16x2_c __attribute__((ext_vector_type(2)));
__device__ __forceinline__ unsigned cvt_pk_bf16(float lo, float hi) { const f32x2_c v = {lo, hi}; return __builtin_bit_cast(unsigned, __builtin_convertvector(v, bf16x2_c)); }
__device__ __forceinline__ float bf_lo(unsigned u) { return __uint_as_float(u << 16); }
__device__ __forceinline__ float bf_hi(unsigned u) { return __uint_as_float(u & 0xffff0000u); }
__device__ __forceinline__ void st8(bf16_t* p, const f32x4 a, const f32x4 b) { u32x4 w; w.x = cvt_pk_bf16(a[0], a[1]); w.y = cvt_pk_bf16(a[2], a[3]); w.z = cvt_pk_bf16(b[0], b[1]); w.w = cvt_pk_bf16(b[2], b[3]); *(u32x4*)p = w; }
__device__ __forceinline__ void ld8(const bf16_t* p, f32x4& a, f32x4& b) { const u32x4 w = *(const u32x4*)p; a = (f32x4){bf_lo(w.x), bf_hi(w.x), bf_lo(w.y), bf_hi(w.y)}; b = (f32x4){bf_lo(w.z), bf_hi(w.z), bf_lo(w.w), bf_hi(w.w)}; }
__device__ __forceinline__ float fsigmoid(float x) { return __builtin_amdgcn_rcpf(1.0f + __builtin_amdgcn_exp2f(-1.4426950408889634f * x)); }
__device__ __forceinline__ f32x4 sig4(const f32x4 v) { return (f32x4){fsigmoid(v[0]), fsigmoid(v[1]), fsigmoid(v[2]), fsigmoid(v[3])}; }
__device__ __forceinline__ f32x4 silu4(const f32x4 v) { return v * sig4(v); }

__device__ __forceinline__ void st8x(bf16_t* p, const f32x4 a, const f32x4 b) { if (!(EPI_EXP & 2) || ((size_t)p & 1)) st8(p, a, b); else { asm volatile("" :: "v"(a), "v"(b)); } }
struct EpiInProj {
    static constexpr bool PERM = true, AFTER_DRAIN = false;
    unsigned char* ws;
    size_t oHQ, oFF, oFB, oHI, oSG, oQ, oK, oV, oGA, oGB, oROPE;
    const float *qg, *kg;
    template <int ACT> __device__ __forceinline__ void plain(const f32x4 (&acc)[2][2][4][2], bf16_t* base, long row0, int pitch, int col0) const {
#pragma unroll
        for (int ai = 0; ai < 2; ++ai)
#pragma unroll
            for (int m = 0; m < 4; ++m) { bf16_t* rowp = base + (row0 + ai * HALF + m * 16) * pitch + col0;
#pragma unroll
                for (int bj = 0; bj < 2; ++bj) { f32x4 v0 = acc[ai][bj][m][0], v1 = acc[ai][bj][m][1];
                    if (ACT == 1) { v0 = silu4(v0); v1 = silu4(v1); } if (ACT == 2) { v0 = sig4(v0); v1 = sig4(v1); }
                    st8x(rowp + bj * HALF, v0, v1); } }
    }
    __device__ __forceinline__ void gate8(const f32x4 (&acc)[2][2][4][2], unsigned char* base, long row0, int col0) const {
#pragma unroll
        for (int ai = 0; ai < 2; ++ai)
#pragma unroll
            for (int m = 0; m < 4; ++m) { unsigned char* rowp = base + (row0 + ai * HALF + m * 16) * 1024 + col0;
#pragma unroll
                for (int bj = 0; bj < 2; ++bj) { const f32x4 v0 = sig4(acc[ai][bj][m][0]) * 255.0f, v1 = sig4(acc[ai][bj][m][1]) * 255.0f;
                    unsigned w0 = 0, w1 = 0;
                    w0 = __builtin_amdgcn_cvt_pk_u8_f32(v0[0], 0, w0); w0 = __builtin_amdgcn_cvt_pk_u8_f32(v0[1], 1, w0); w0 = __builtin_amdgcn_cvt_pk_u8_f32(v0[2], 2, w0); w0 = __builtin_amdgcn_cvt_pk_u8_f32(v0[3], 3, w0);
                    w1 = __builtin_amdgcn_cvt_pk_u8_f32(v1[0], 0, w1); w1 = __builtin_amdgcn_cvt_pk_u8_f32(v1[1], 1, w1); w1 = __builtin_amdgcn_cvt_pk_u8_f32(v1[2], 2, w1); w1 = __builtin_amdgcn_cvt_pk_u8_f32(v1[3], 3, w1);
                    *(unsigned long long*)(rowp + bj * HALF) = (unsigned long long)w0 | ((unsigned long long)w1 << 32); } }
    }
    __device__ __forceinline__ void qk(const f32x4 (&acc)[2][2][4][2], bf16_t* base, long row0, int pitch, int col0, const float* gain, bool do_rope, int t0, float oscale, int fq) const {
        const float* rope = (const float*)(ws + oROPE);
        f32x4 gv[2][2];
#pragma unroll
        for (int bj = 0; bj < 2; ++bj)
#pragma unroll
            for (int n = 0; n < 2; ++n) gv[bj][n] = *(const f32x4*)(gain + 32 * bj + 16 * n + 4 * fq);
        f32x4 cc[4], sc[4], cr[2], sr[2];
        if (do_rope) {
#pragma unroll
            for (int m = 0; m < 4; ++m) { const int pos = (t0 + m * 16) & 63; cc[m] = *(const f32x4*)(rope + pos * 32 + 4 * fq); sc[m] = *(const f32x4*)(rope + pos * 32 + 16 + 4 * fq); }
#pragma unroll
            for (int ai = 0; ai < 2; ++ai) { const int pos = (t0 + ai * HALF) >> 6; cr[ai] = *(const f32x4*)(rope + pos * 32 + 4 * fq); sr[ai] = *(const f32x4*)(rope + pos * 32 + 16 + 4 * fq); }
        } else {
#pragma unroll
            for (int m = 0; m < 4; ++m) { cc[m] = (f32x4){1.f, 1.f, 1.f, 1.f}; sc[m] = (f32x4){0.f, 0.f, 0.f, 0.f}; }
#pragma unroll
            for (int ai = 0; ai < 2; ++ai) { cr[ai] = (f32x4){1.f, 1.f, 1.f, 1.f}; sr[ai] = (f32x4){0.f, 0.f, 0.f, 0.f}; }
        }
#pragma unroll
        for (int ai = 0; ai < 2; ++ai)
#pragma unroll
            for (int m = 0; m < 4; ++m) {
                float ss = 0.f;
#pragma unroll
                for (int bj = 0; bj < 2; ++bj)
#pragma unroll
                    for (int n = 0; n < 2; ++n) { const f32x4 x = acc[ai][bj][m][n]; ss += (x[0] * x[0] + x[1] * x[1]) + (x[2] * x[2] + x[3] * x[3]); }
                ss += __shfl_xor(ss, 16); ss += __shfl_xor(ss, 32);
                const float rstd = 1.0f / sqrtf(ss * (1.0f / 64.0f) + 1e-6f);
                bf16_t* rowp = base + (row0 + ai * HALF + m * 16) * pitch + col0;
#pragma unroll
                for (int bj = 0; bj < 2; ++bj) {
                    const f32x4 x1 = acc[ai][bj][m][0] * rstd * gv[bj][0], x2 = acc[ai][bj][m][1] * rstd * gv[bj][1];
                    const f32x4 c = bj ? cc[m] : cr[ai], s = bj ? sc[m] : sr[ai];
                    const f32x4 o1 = x1 * c - x2 * s, o2 = x2 * c + x1 * s;
                    st8x(rowp + bj * 32, o1 * oscale, o2 * oscale); }
            }
    }
    __device__ __forceinline__ void operator()(const f32x4 (&acc)[2][2][4][2], const Unit& u, int wr, int wc, int fr_, int fq_) const {
        int fr = fr_, fq = fq_; asm volatile("" : "+v"(fr), "+v"(fq));
        if (EPI_EXP & 1) return;
        const int pn = u.pn, bb = u.pm / 9, jt = u.pm - bb * 9;
        const int rloc = wr * 64 + fr;
        const long r0 = (long)u.pm * BM + rloc;
        const long rl0 = (long)bb * 2048 + (jt - 1) * 256 + rloc;
        const int c8 = wc * 32 + 8 * fq;
        if (pn < 2)        plain<0>(acc, (bf16_t*)(ws + oHQ), rl0, 512, pn * 256 + c8);
        else if (pn < 4)   plain<0>(acc, (bf16_t*)(ws + oFF), r0, 512, (pn - 2) * 256 + c8);
        else if (pn < 6)   plain<0>(acc, (bf16_t*)(ws + oFB), r0, 512, (pn - 4) * 256 + c8);
        else if (pn < 8)   plain<0>(acc, (bf16_t*)(ws + oHI), r0, 512, (pn - 6) * 256 + c8);
        else if (pn < 10)  plain<1>(acc, (bf16_t*)(ws + oSG), rl0, 512, (pn - 8) * 256 + c8);
        else if (pn < 12)  qk(acc, (bf16_t*)(ws + oQ), rl0, 512, ((pn - 10) * 4 + wc) * 64 + 8 * fq, qg, true, (jt - 1) * 256 + rloc, 0.125f * 1.4426950408889634f, fq);
        else if (pn == 12) {
            if (wc < 2)    qk(acc, (bf16_t*)(ws + oK), r0, 128, wc * 64 + 8 * fq, kg, jt >= 1, (jt - 1) * 256 + rloc, 1.0f, fq);
            else {
#pragma unroll
                for (int ai = 0; ai < 2; ++ai)
#pragma unroll
                    for (int m = 0; m < 4; ++m) { bf16_t* rowp = (bf16_t*)(ws + oV) + (r0 + ai * HALF + m * 16) * 128 + (wc - 2) * 64 + 8 * fq;
#pragma unroll
                        for (int bj = 0; bj < 2; ++bj) st8x(rowp + bj * 32, acc[ai][bj][m][0], acc[ai][bj][m][1]); }
            }
        }
        else if (pn < 17)  gate8(acc, ws + oGA, rl0, (pn - 13) * 256 + c8);
        else               gate8(acc, ws + oGB, rl0, (pn - 17) * 256 + c8);
    }
};

template <int SECOND> struct EpiZ {
    static constexpr bool PERM = true, AFTER_DRAIN = false;
    bf16_t* Z; const unsigned char* G;
    __device__ __forceinline__ void ld(int ai, int mh, long row0, int col0, unsigned long long (&gw)[2][2], u32x4 (&zw)[2][2]) const {
#pragma unroll
        for (int mm = 0; mm < 2; ++mm)
#pragma unroll
            for (int bj = 0; bj < 2; ++bj) { const long off = (row0 + ai * HALF + (2 * mh + mm) * 16) * 1024 + col0 + bj * HALF;
                gw[mm][bj] = *(const unsigned long long*)(G + off); if (SECOND) zw[mm][bj] = *(const u32x4*)(Z + off); }
    }
    __device__ __forceinline__ void proc(const f32x4 (&acc)[2][2][4][2], int ai, int mh, long row0, int col0, const unsigned long long (&gw)[2][2], const u32x4 (&zw)[2][2]) const {
#pragma unroll
        for (int mm = 0; mm < 2; ++mm)
#pragma unroll
            for (int bj = 0; bj < 2; ++bj) { const int m = 2 * mh + mm; const long off = (row0 + ai * HALF + m * 16) * 1024 + col0 + bj * HALF;
                const unsigned wl = (unsigned)gw[mm][bj], wh = (unsigned)(gw[mm][bj] >> 32);
                const f32x4 g0 = (f32x4){(float)(wl & 255u), (float)((wl >> 8) & 255u), (float)((wl >> 16) & 255u), (float)(wl >> 24)} * (1.0f / 255.0f), g1 = (f32x4){(float)(wh & 255u), (float)((wh >> 8) & 255u), (float)((wh >> 16) & 255u), (float)(wh >> 24)} * (1.0f / 255.0f);
                f32x4 v0 = acc[ai][bj][m][0] * g0, v1 = acc[ai][bj][m][1] * g1;
                if (SECOND) { const u32x4 z = zw[mm][bj]; v0 += (f32x4){bf_lo(z.x), bf_hi(z.x), bf_lo(z.y), bf_hi(z.y)}; v1 += (f32x4){bf_lo(z.z), bf_hi(z.z), bf_lo(z.w), bf_hi(z.w)}; }
                st8(Z + off, v0, v1); }
    }
    __device__ __forceinline__ void operator()(const f32x4 (&acc)[2][2][4][2], const Unit& u, int wr, int wc, int fr_, int fq_) const {
        int fr = fr_, fq = fq_; asm volatile("" : "+v"(fr), "+v"(fq));
        const long row0 = (long)u.pm * BM + wr * 64 + fr; const int col0 = u.pn * BM + wc * 32 + 8 * fq;
        unsigned long long gA[2][2], gB[2][2]; u32x4 zA[2][2], zB[2][2];
        ld(0, 0, row0, col0, gA, zA);
        ld(0, 1, row0, col0, gB, zB); proc(acc, 0, 0, row0, col0, gA, zA);
        ld(1, 0, row0, col0, gA, zA); proc(acc, 0, 1, row0, col0, gB, zB);
        ld(1, 1, row0, col0, gB, zB); proc(acc, 1, 0, row0, col0, gA, zA);
        proc(acc, 1, 1, row0, col0, gB, zB);
    }
};
struct EpiZ2 {
    static constexpr bool PERM = true, AFTER_DRAIN = false;
    bf16_t* Z; const unsigned char* GA; const unsigned char* GB;
    __device__ __forceinline__ static void dec8(unsigned long long w, f32x4& lo, f32x4& hi) { const unsigned wl = (unsigned)w, wh = (unsigned)(w >> 32);
        lo = (f32x4){(float)(wl & 255u), (float)((wl >> 8) & 255u), (float)((wl >> 16) & 255u), (float)(wl >> 24)}; hi = (f32x4){(float)(wh & 255u), (float)((wh >> 8) & 255u), (float)((wh >> 16) & 255u), (float)(wh >> 24)}; }
    __device__ __forceinline__ void mid(f32x4 (&acc)[2][2][4][2], const Unit& u, int wr, int wc, int fr_, int fq_) const {
        int fr = fr_, fq = fq_; asm volatile("" : "+v"(fr), "+v"(fq));
        const long row0 = (long)u.pm * BM + wr * 64 + fr; const int col0 = u.pn * BM + wc * 32 + 8 * fq;
#pragma unroll
        for (int ai = 0; ai < 2; ++ai)
#pragma unroll
            for (int mh = 0; mh < 2; ++mh) {
                unsigned long long ga[2][2], gb[2][2];
#pragma unroll
                for (int mm = 0; mm < 2; ++mm)
#pragma unroll
                    for (int bj = 0; bj < 2; ++bj) { const long off = (row0 + ai * HALF + (2 * mh + mm) * 16) * 1024 + col0 + bj * HALF; ga[mm][bj] = *(const unsigned long long*)(GA + off); gb[mm][bj] = *(const unsigned long long*)(GB + off); }
#pragma unroll
                for (int mm = 0; mm < 2; ++mm)
#pragma unroll
                    for (int bj = 0; bj < 2; ++bj) { const int m = 2 * mh + mm; f32x4 a0, a1, b0, b1; dec8(ga[mm][bj], a0, a1); dec8(gb[mm][bj], b0, b1);
#pragma unroll
                        for (int j = 0; j < 4; ++j) { a0[j] *= __builtin_amdgcn_rcpf(fmaxf(b0[j], 1.0f)); a1[j] *= __builtin_amdgcn_rcpf(fmaxf(b1[j], 1.0f)); }
                        acc[ai][bj][m][0] = acc[ai][bj][m][0] * a0; acc[ai][bj][m][1] = acc[ai][bj][m][1] * a1; }
            }
    }
    __device__ __forceinline__ void operator()(const f32x4 (&acc)[2][2][4][2], const Unit& u, int wr, int wc, int fr_, int fq_) const {
        int fr = fr_, fq = fq_; asm volatile("" : "+v"(fr), "+v"(fq));
        const long row0 = (long)u.pm * BM + wr * 64 + fr; const int col0 = u.pn * BM + wc * 32 + 8 * fq;
#pragma unroll
        for (int ai = 0; ai < 2; ++ai)
#pragma unroll
            for (int mh = 0; mh < 2; ++mh) {
                unsigned long long gb[2][2];
#pragma unroll
                for (int mm = 0; mm < 2; ++mm)
#pragma unroll
                    for (int bj = 0; bj < 2; ++bj) gb[mm][bj] = *(const unsigned long long*)(GB + (row0 + ai * HALF + (2 * mh + mm) * 16) * 1024 + col0 + bj * HALF);
#pragma unroll
                for (int mm = 0; mm < 2; ++mm)
#pragma unroll
                    for (int bj = 0; bj < 2; ++bj) { const int m = 2 * mh + mm; f32x4 b0, b1; dec8(gb[mm][bj], b0, b1);
#pragma unroll
                        for (int j = 0; j < 4; ++j) { b0[j] = fmaxf(b0[j], 1.0f) * (1.0f / 255.0f); b1[j] = fmaxf(b1[j], 1.0f) * (1.0f / 255.0f); }
                        st8(Z + (row0 + ai * HALF + m * 16) * 1024 + col0 + bj * HALF, acc[ai][bj][m][0] * b0, acc[ai][bj][m][1] * b1); }
            }
    }
};
struct EpiX1 {
    static constexpr bool PERM = false, AFTER_DRAIN = false;
    const float* x; const float* mod; bf16_t* out;
    __device__ __forceinline__ void ld(int ai, int mh, long row0, int col0, f32x4 (&xv)[2][2][2]) const {
#pragma unroll
        for (int mm = 0; mm < 2; ++mm)
#pragma unroll
            for (int bj = 0; bj < 2; ++bj)
#pragma unroll
                for (int n = 0; n < 2; ++n) xv[mm][bj][n] = *(const f32x4*)(x + (row0 + ai * HALF + (2 * mh + mm) * 16) * 1024 + col0 + bj * HALF + n * 16);
    }
    __device__ __forceinline__ void proc(const f32x4 (&acc)[2][2][4][2], int ai, int mh, long row0, int col0, const f32x4 (&xv)[2][2][2], const f32x4 (&gv)[2][2]) const {
#pragma unroll
        for (int mm = 0; mm < 2; ++mm)
#pragma unroll
            for (int bj = 0; bj < 2; ++bj)
#pragma unroll
                for (int n = 0; n < 2; ++n) { const int m = 2 * mh + mm; const f32x4 o = xv[mm][bj][n] + gv[bj][n] * acc[ai][bj][m][n];
                    unsigned w0 = cvt_pk_bf16(o[0], o[1]), w1 = cvt_pk_bf16(o[2], o[3]);
                    *(unsigned long long*)(out + (row0 + ai * HALF + m * 16) * 1024 + col0 + bj * HALF + n * 16) = (unsigned long long)w0 | ((unsigned long long)w1 << 32); }
    }
    __device__ __forceinline__ void operator()(const f32x4 (&acc)[2][2][4][2], const Unit& u, int wr, int wc, int fr_, int fq_) const {
        int fr = fr_, fq = fq_; asm volatile("" : "+v"(fr), "+v"(fq));
        const long row0 = (long)u.pm * BM + wr * 64 + fr; const int col0 = u.pn * BM + wc * 32 + 4 * fq; const int b = u.pm >> 3;
        f32x4 gv[2][2];
#pragma unroll
        for (int bj = 0; bj < 2; ++bj)
#pragma unroll
            for (int n = 0; n < 2; ++n) gv[bj][n] = *(const f32x4*)(mod + (size_t)b * 6144 + 2048 + col0 + bj * HALF + n * 16);
        f32x4 xA[2][2][2], xB[2][2][2];
        ld(0, 0, row0, col0, xA);
        ld(0, 1, row0, col0, xB); proc(acc, 0, 0, row0, col0, xA, gv);
        ld(1, 0, row0, col0, xA); proc(acc, 0, 1, row0, col0, xB, gv);
        ld(1, 1, row0, col0, xB); proc(acc, 1, 0, row0, col0, xA, gv);
        proc(acc, 1, 1, row0, col0, xB, gv);
    }
};
struct EpiHid {
    static constexpr bool PERM = true, AFTER_DRAIN = false;
    bf16_t* H;
    __device__ __forceinline__ void operator()(const f32x4 (&acc)[2][2][4][2], const Unit& u, int wr, int wc, int fr, int fq) const {
        const int row0 = wr * 64 + fr, col0 = u.pn * HALF + wc * 32 + 8 * fq;
#pragma unroll
        for (int ai = 0; ai < 2; ++ai)
#pragma unroll
            for (int m = 0; m < 4; ++m) st8(H + (size_t)(row0 + ai * HALF + m * 16) * 1024 + col0, silu4(acc[ai][0][m][0]) * acc[ai][1][m][0], silu4(acc[ai][0][m][1]) * acc[ai][1][m][1]);
    }
};
#define PG8_SL ((PG8_LAS float*)(unsigned)(131072 + 4096))
struct EpiHidQ {
    static constexpr bool PERM = true, AFTER_DRAIN = false;
    bf16_t* H; const float* scl; const float* tq;
    __device__ __forceinline__ static f32x4 cvt4(const f32x4 a) { return (f32x4){(float)__float_as_int(a[0]), (float)__float_as_int(a[1]), (float)__float_as_int(a[2]), (float)__float_as_int(a[3])}; }
    __device__ __forceinline__ void operator()(const f32x4 (&acc)[2][2][4][2], const Unit& u, int wr, int wc, int fr, int fq) const {
        const int row0 = wr * 64 + fr, col0 = u.pn * HALF + wc * 32 + 8 * fq;
        const float* tc = tq + u.pn * BM + wc * 32 + 8 * fq;
        const f32x4 cg0 = *(const f32x4*)(tc), cg1 = *(const f32x4*)(tc + 4), cu0 = *(const f32x4*)(tc + HALF), cu1 = *(const f32x4*)(tc + HALF + 4);
        float sr[2][4];
#pragma unroll
        for (int ai = 0; ai < 2; ++ai)
#pragma unroll
            for (int m = 0; m < 4; ++m) sr[ai][m] = scl[row0 + ai * HALF + m * 16];
#pragma unroll
        for (int ai = 0; ai < 2; ++ai)
#pragma unroll
            for (int m = 0; m < 4; ++m) { const float r = sr[ai][m];
                const f32x4 g0 = cvt4(acc[ai][0][m][0]) * (cg0 * r), g1 = cvt4(acc[ai][0][m][1]) * (cg1 * r), u0 = cvt4(acc[ai][1][m][0]) * (cu0 * r), u1 = cvt4(acc[ai][1][m][1]) * (cu1 * r);
                st8(H + (size_t)(row0 + ai * HALF + m * 16) * 1024 + col0, silu4(g0) * u0, silu4(g1) * u1); }
    }
};
struct EpiInProjQ {
    static constexpr bool PERM = true, AFTER_DRAIN = false;
    EpiInProj base; const float* rs; const float* cs;
    __device__ __forceinline__ void pre(const Unit& u, int wid, int lane) const {
        if (wid == 0) __builtin_amdgcn_global_load_lds((const unsigned*)((const char*)(rs + (size_t)u.pm * BM) + (unsigned)(16 * lane)), (PG8_LAS unsigned*)PG8_SL, 16, 0, 0);
        if (wid == 1) __builtin_amdgcn_global_load_lds((const unsigned*)((const char*)(cs + u.pn * BM) + (unsigned)(16 * lane)), (PG8_LAS unsigned*)(PG8_SL + 256), 16, 0, 0);
    }
    __device__ __forceinline__ void operator()(const f32x4 (&acc_)[2][2][4][2], const Unit& u, int wr, int wc, int fr_, int fq_) const {
        int fr = fr_, fq = fq_; asm volatile("" : "+v"(fr), "+v"(fq));
        f32x4 (&acc)[2][2][4][2] = const_cast<f32x4 (&)[2][2][4][2]>(acc_);
        const PG8_LAS float* rp = PG8_SL + wr * 64 + fr; const PG8_LAS float* cp = PG8_SL + 256 + wc * 32 + 8 * fq;
        f32x4 c4[2][2]; float r8[2][4];
#pragma unroll
        for (int bj = 0; bj < 2; ++bj)
#pragma unroll
            for (int n = 0; n < 2; ++n) c4[bj][n] = *(const PG8_LAS f32x4*)(cp + bj * HALF + 4 * n);
#pragma unroll
        for (int ai = 0; ai < 2; ++ai)
#pragma unroll
            for (int m = 0; m < 4; ++m) r8[ai][m] = rp[ai * HALF + m * 16];
#pragma unroll
        for (int ai = 0; ai < 2; ++ai)
#pragma unroll
            for (int bj = 0; bj < 2; ++bj)
#pragma unroll
                for (int m = 0; m < 4; ++m)
#pragma unroll
                    for (int n = 0; n < 2; ++n) acc[ai][bj][m][n] = EpiHidQ::cvt4(acc[ai][bj][m][n]) * (c4[bj][n] * r8[ai][m]);
        base(acc, u, wr, wc, fr, fq);
    }
};
constexpr float YE_F8_SCALE = 32.0f;
struct EpiYe {
    static constexpr bool PERM = true, AFTER_DRAIN = false;
    unsigned char* Y; const float* gate;
    __device__ __forceinline__ void operator()(const f32x4 (&acc)[2][2][4][2], const Unit& u, int wr, int wc, int fr, int fq) const {
        const int row0 = wr * 64 + fr, col0 = u.pn * BM + wc * 32 + 8 * fq;
        float gt[2][4];
#pragma unroll
        for (int ai = 0; ai < 2; ++ai)
#pragma unroll
            for (int m = 0; m < 4; ++m) gt[ai][m] = gate[row0 + ai * HALF + m * 16];
#pragma unroll
        for (int ai = 0; ai < 2; ++ai)
#pragma unroll
            for (int m = 0; m < 4; ++m) { const int r = row0 + ai * HALF + m * 16;
#pragma unroll
                for (int bj = 0; bj < 2; ++bj) { const f32x4 a = acc[ai][bj][m][0] * (gt[ai][m] * YE_F8_SCALE), b = acc[ai][bj][m][1] * (gt[ai][m] * YE_F8_SCALE);
                    int w0 = __builtin_amdgcn_cvt_pk_fp8_f32(a[0], a[1], 0, false); w0 = __builtin_amdgcn_cvt_pk_fp8_f32(a[2], a[3], w0, true);
                    int w1 = __builtin_amdgcn_cvt_pk_fp8_f32(b[0], b[1], 0, false); w1 = __builtin_amdgcn_cvt_pk_fp8_f32(b[2], b[3], w1, true);
                    *(unsigned long long*)(Y + (size_t)r * 1024 + col0 + bj * HALF) = (unsigned long long)(unsigned)w0 | ((unsigned long long)(unsigned)w1 << 32); } }
    }
};
struct EpiYeQ {
    static constexpr bool PERM = true, AFTER_DRAIN = false;
    unsigned char* Y; const float* gate; const float* rs; const float* td;
    __device__ __forceinline__ void operator()(const f32x4 (&acc)[2][2][4][2], const Unit& u, int wr, int wc, int fr, int fq) const {
        const int row0 = wr * 64 + fr, col0 = u.pn * BM + wc * 32 + 8 * fq;
        const float* tc = td + col0;
        f32x4 c4[2][2];
#pragma unroll
        for (int bj = 0; bj < 2; ++bj)
#pragma unroll
            for (int n = 0; n < 2; ++n) c4[bj][n] = *(const f32x4*)(tc + bj * HALF + 4 * n);
        float gt[2][4];
#pragma unroll
        for (int ai = 0; ai < 2; ++ai)
#pragma unroll
            for (int m = 0; m < 4; ++m) gt[ai][m] = gate[row0 + ai * HALF + m * 16] * rs[row0 + ai * HALF + m * 16] * YE_F8_SCALE;
#pragma unroll
        for (int ai = 0; ai < 2; ++ai)
#pragma unroll
            for (int m = 0; m < 4; ++m) { const int r = row0 + ai * HALF + m * 16;
#pragma unroll
                for (int bj = 0; bj < 2; ++bj) { f32x4 a = EpiHidQ::cvt4(acc[ai][bj][m][0]) * (c4[bj][0] * gt[ai][m]), b = EpiHidQ::cvt4(acc[ai][bj][m][1]) * (c4[bj][1] * gt[ai][m]);
#pragma unroll
                    for (int j = 0; j < 4; ++j) { a[j] = __builtin_amdgcn_fmed3f(a[j], -440.0f, 440.0f); b[j] = __builtin_amdgcn_fmed3f(b[j], -440.0f, 440.0f); }
                    int w0 = __builtin_amdgcn_cvt_pk_fp8_f32(a[0], a[1], 0, false); w0 = __builtin_amdgcn_cvt_pk_fp8_f32(a[2], a[3], w0, true);
                    int w1 = __builtin_amdgcn_cvt_pk_fp8_f32(b[0], b[1], 0, false); w1 = __builtin_amdgcn_cvt_pk_fp8_f32(b[2], b[3], w1, true);
                    *(unsigned long long*)(Y + (size_t)r * 1024 + col0 + bj * HALF) = (unsigned long long)(unsigned)w0 | ((unsigned long long)(unsigned)w1 << 32); } }
    }
};
struct InProjOrder {
    StaticOrder so;
    __device__ void init(int G_, int c_) { so.init(ML, INC, G_, c_); }
    __device__ bool next(int i, Unit& u) const {
#if DBG_GA_ONLY
        { const long L = (long)i * so.G + so.c; if (L >= 512) return false; u.pm = (int)(L >> 2); u.pn = 13 + (int)(L & 3); u.pm = (u.pm >> 3) * 9 + 1 + (u.pm & 7); return true; }
#endif
        if (so.next(i, u)) { u.pm = (u.pm >> 3) * 9 + 1 + (u.pm & 7); return true; }
        const long L = (long)i * so.G + so.c - so.nwg; if (L >= 16 * 7) return false;
        const int cb = (int)L / 7, k = (int)L % 7; u.pm = cb * 9; u.pn = k < 6 ? 2 + k : 12; return true;
    }
    __device__ __forceinline__ void a_ready(const Unit&) const {}
    __device__ __forceinline__ void done(const Unit&) const {}
};
struct LocalOrder {
    int n;
    __device__ bool next(int i, Unit& u) const { if (i >= n) return false; u.pm = 0; u.pn = i; return true; }
    __device__ __forceinline__ void a_ready(const Unit&) const {}
    __device__ __forceinline__ void done(const Unit&) const {}
};
typedef int i32x4_pg8 __attribute__((ext_vector_type(4)));
template <bool I8> __device__ __forceinline__ f32x4 mma16(const bf16x8 b, const bf16x8 a, const f32x4 c) {
    if constexpr (I8) return __builtin_bit_cast(f32x4, __builtin_amdgcn_mfma_i32_16x16x64_i8(__builtin_bit_cast(i32x4_pg8, b), __builtin_bit_cast(i32x4_pg8, a), __builtin_bit_cast(i32x4_pg8, c), 0, 0, 0));
    else return __builtin_amdgcn_mfma_f32_16x16x32_bf16(b, a, c, 0, 0, 0);
}
template <class Epi, class Sched, bool ALIGN_EPI = false, bool SP2 = false, bool I8 = false, bool MID = false, bool PRE = false>
__device__ __forceinline__ void gemm_phase(PG8_LAS unsigned char* lds, const Gemm g, const Sched& S, const Epi& E) {
    int tid_ = threadIdx.x; asm volatile("" : "+v"(tid_));
    const int tid = tid_, wid = __builtin_amdgcn_readfirstlane(tid >> 6), lane = tid & 63, wr = wid >> 2, wc = wid & 3, fr = lane & 15, fq = lane >> 4;
    const int K = g.K, nt = K / BK;
    unsigned voffA[2], voffA1[2], voffB[2];
#pragma unroll
    for (int i = 0; i < 2; ++i) { int R, C; stage_rc(tid * 16 + i * 8192, R, C); const int Rb = Epi::PERM ? ((R & ~31) + perm32(R & 31)) : R;
        if (g.gather) { voffA[i] = ((unsigned)g.gather[R] * (unsigned)K + (unsigned)C) * 2u; voffA1[i] = ((unsigned)g.gather[R + HALF] * (unsigned)K + (unsigned)C) * 2u; }
        else { voffA[i] = (unsigned)(R * K + C) * 2u; voffA1[i] = voffA[i] + (unsigned)(HALF * K * 2); }
        voffB[i] = (unsigned)(Rb * K + C) * 2u; }
    const size_t kstep = (size_t)(BK * 2);
    const size_t hstep = (size_t)HALF * K * 2;
    const size_t tstep = 2 * hstep;
    const unsigned ldsw = (unsigned)wid * 1024u;
    const int aoff = lds_byte(wr * 64 + fr, fq * 8), boff = lds_byte(wc * 32 + fr, fq * 8);
#define PG8_SA(b, h) (((b) * 2 + (h)) * HTB)
#define PG8_SB(b, h) ((4 + (b) * 2 + (h)) * HTB)
#define PG8_STAGE(bufoff, gbase, voff) do { _Pragma("unroll") for (int _i = 0; _i < 2; ++_i) \
        __builtin_amdgcn_global_load_lds((const unsigned*)((const char*)(gbase) + (voff)[_i]), (PG8_LAS unsigned*)(lds + (bufoff) + ldsw + _i * 8192), 16, 0, PG8_DMA_AUX); } while (0)
#define PG8_LDA(dst, b, h) do { _Pragma("unroll") for (int m = 0; m < 4; ++m) _Pragma("unroll") for (int k = 0; k < 2; ++k) dst[m][k] = *(const PG8_LAS bf16x8*)(lds + PG8_SA(b, h) + aoff + m * 2048 + k * 1024); } while (0)
#define PG8_LDB(dst, b, h) do { _Pragma("unroll") for (int n = 0; n < 2; ++n) _Pragma("unroll") for (int k = 0; k < 2; ++k) dst[n][k] = *(const PG8_LAS bf16x8*)(lds + PG8_SB(b, h) + boff + n * 2048 + k * 1024); } while (0)
#define PG8_MMA(ai, bj, At, Bt) do { __builtin_amdgcn_s_setprio(1); _Pragma("unroll") for (int m = 0; m < 4; ++m) _Pragma("unroll") for (int n = 0; n < 2; ++n) _Pragma("unroll") for (int k = 0; k < 2; ++k) \
        acc[ai][bj][m][n] = mma16<I8>(Bt[n][k], At[m][k], acc[ai][bj][m][n]); __builtin_amdgcn_s_setprio(0); } while (0)
#define PG8_WAIT_V(n) asm volatile("s_waitcnt vmcnt(" #n ")" ::: "memory")
#define PG8_WAIT_L(n) asm volatile("s_waitcnt lgkmcnt(" #n ")" ::: "memory")
#define PG8_BAR __builtin_amdgcn_s_barrier()
#define PG8_SCHED __builtin_amdgcn_sched_barrier(0)
    Unit cur, nxt; int ui = 0;
    if (!S.next(0, cur)) return;
    f32x4 acc[2][2][4][2];
#pragma unroll
    for (int a = 0; a < 2; ++a)
#pragma unroll
        for (int b = 0; b < 2; ++b)
#pragma unroll
            for (int m = 0; m < 4; ++m)
#pragma unroll
                for (int n = 0; n < 2; ++n) acc[a][b][m][n] = (f32x4){0.f, 0.f, 0.f, 0.f};
    bf16x8 At[4][2], B0[2][2], B1[2][2];
    const char* cA = (const char*)g.A + (size_t)cur.pm * tstep; const char* cB = (const char*)g.Bt + (size_t)cur.pn * tstep;
    S.a_ready(cur);
    if constexpr (SP2) {
        PG8_STAGE(PG8_SB(0, 0), cB, voffB); PG8_STAGE(PG8_SB(0, 1), cB + hstep, voffB); PG8_STAGE(PG8_SA(0, 0), cA, voffA); PG8_STAGE(PG8_SA(0, 1), cA, voffA1);
        if (wr == 1) PG8_BAR;
        PG8_WAIT_V(2); PG8_BAR;
        PG8_STAGE(PG8_SB(1, 0), cB + kstep, voffB); PG8_STAGE(PG8_SA(1, 0), cA + kstep, voffA); PG8_STAGE(PG8_SB(1, 1), cB + hstep + kstep, voffB);
        PG8_WAIT_V(6); PG8_BAR;
    } else {
        PG8_STAGE(PG8_SB(0, 0), cB, voffB); PG8_STAGE(PG8_SA(0, 0), cA, voffA); PG8_STAGE(PG8_SB(0, 1), cB + hstep, voffB); PG8_STAGE(PG8_SA(0, 1), cA, voffA1);
        if (wr == 1) PG8_BAR;
        PG8_WAIT_V(4); PG8_BAR;
        PG8_STAGE(PG8_SB(1, 0), cB + kstep, voffB); PG8_STAGE(PG8_SA(1, 0), cA + kstep, voffA); PG8_STAGE(PG8_SB(1, 1), cB + hstep + kstep, voffB);
        PG8_WAIT_V(6); PG8_BAR;
    }
    for (;;) {
        const bool has_next = S.next(ui + 1, nxt);
        const char* nA = has_next ? (const char*)g.A + (size_t)nxt.pm * tstep : cA; const char* nB = has_next ? (const char*)g.Bt + (size_t)nxt.pn * tstep : cB;
        for (int t = 0; t < nt; t += 2) {
            const bool last = (t == nt - 2);
            const char* a1 = cA + (size_t)(t + 1) * kstep;
            const char* a2 = last ? nA : cA + (size_t)(t + 2) * kstep; const char* b2 = last ? nB : cB + (size_t)(t + 2) * kstep;
            const char* a3 = a2 + kstep; const char* b3 = b2 + kstep;
            if (last && has_next) S.a_ready(nxt);
            if constexpr (MID) { if (t == nt / 2) E.mid(acc, cur, wr, wc, fr, fq); }
            if constexpr (PRE) { if (last) E.pre(cur, wid, lane); }
            if constexpr (SP2) {
            PG8_LDB(B0, 0, 0); PG8_LDB(B1, 0, 1); PG8_SCHED; PG8_LDA(At, 0, 0); PG8_STAGE(PG8_SA(1, 1), a1, voffA1);
            PG8_WAIT_V(8); PG8_WAIT_L(0); PG8_BAR; PG8_MMA(0, 0, At, B0); PG8_MMA(0, 1, At, B1); PG8_BAR; PG8_SCHED;
            PG8_LDA(At, 0, 1); PG8_STAGE(PG8_SB(0, 0), b2, voffB); PG8_STAGE(PG8_SB(0, 1), b2 + hstep, voffB); PG8_STAGE(PG8_SA(0, 0), a2, voffA);
            PG8_WAIT_V(8); PG8_WAIT_L(0); PG8_BAR; PG8_MMA(1, 0, At, B0); PG8_MMA(1, 1, At, B1); PG8_BAR; PG8_SCHED;
            PG8_LDB(B0, 1, 0); PG8_LDB(B1, 1, 1); PG8_SCHED; PG8_LDA(At, 1, 0); PG8_STAGE(PG8_SA(0, 1), a2, voffA1);
            PG8_WAIT_V(8); PG8_WAIT_L(0); PG8_BAR; PG8_MMA(0, 0, At, B0); PG8_MMA(0, 1, At, B1); PG8_BAR; PG8_SCHED;
            PG8_LDA(At, 1, 1); PG8_STAGE(PG8_SB(1, 0), b3, voffB); PG8_STAGE(PG8_SB(1, 1), b3 + hstep, voffB); PG8_STAGE(PG8_SA(1, 0), a3, voffA);
            PG8_WAIT_V(8); PG8_WAIT_L(0); PG8_BAR; PG8_MMA(1, 0, At, B0); PG8_MMA(1, 1, At, B1); PG8_BAR; PG8_SCHED;
            } else {
            PG8_LDB(B0, 0, 0); PG8_SCHED; PG8_LDA(At, 0, 0); PG8_STAGE(PG8_SA(1, 1), a1, voffA1);
            PG8_WAIT_L(8); PG8_BAR; PG8_WAIT_L(0); PG8_MMA(0, 0, At, B0); PG8_BAR; PG8_SCHED;
            PG8_LDB(B1, 0, 1); PG8_STAGE(PG8_SB(0, 0), b2, voffB);
            PG8_BAR; PG8_WAIT_L(0); PG8_MMA(0, 1, At, B1); PG8_BAR;
            PG8_LDA(At, 0, 1); PG8_STAGE(PG8_SA(0, 0), a2, voffA);
            PG8_BAR; PG8_WAIT_L(0); PG8_MMA(1, 0, At, B0); PG8_BAR; PG8_SCHED;
            PG8_STAGE(PG8_SB(0, 1), b2 + hstep, voffB);
            PG8_WAIT_V(6); PG8_BAR; PG8_MMA(1, 1, At, B1); PG8_BAR;
            PG8_LDB(B0, 1, 0); PG8_SCHED; PG8_LDA(At, 1, 0); PG8_STAGE(PG8_SA(0, 1), a2, voffA1);
            PG8_WAIT_L(8); PG8_BAR; PG8_WAIT_L(0); PG8_MMA(0, 0, At, B0); PG8_BAR; PG8_SCHED;
            PG8_LDB(B1, 1, 1); PG8_STAGE(PG8_SB(1, 0), b3, voffB);
            PG8_BAR; PG8_WAIT_L(0); PG8_MMA(0, 1, At, B1); PG8_BAR;
            PG8_LDA(At, 1, 1); PG8_STAGE(PG8_SA(1, 0), a3, voffA);
            PG8_BAR; PG8_WAIT_L(0); PG8_MMA(1, 0, At, B0); PG8_BAR; PG8_SCHED;
            PG8_STAGE(PG8_SB(1, 1), b3 + hstep, voffB);
            PG8_WAIT_V(6); PG8_BAR; PG8_MMA(1, 1, At, B1); PG8_BAR;
            }
        }
        if constexpr (ALIGN_EPI) { if (wr == 0) PG8_BAR; }
        if constexpr (!Epi::AFTER_DRAIN) { E(acc, cur, wr, wc, fr, fq); S.done(cur); }
        if (!has_next) break;
#pragma unroll
        for (int a = 0; a < 2; ++a)
#pragma unroll
            for (int b = 0; b < 2; ++b)
#pragma unroll
                for (int m = 0; m < 4; ++m)
#pragma unroll
                    for (int n = 0; n < 2; ++n) acc[a][b][m][n] = (f32x4){0.f, 0.f, 0.f, 0.f};
        cur = nxt; cA = nA; cB = nB; ++ui;
        if constexpr (ALIGN_EPI) { if (wr == 1) PG8_BAR; }
    }
    PG8_WAIT_V(0);
    if constexpr (!ALIGN_EPI) { if (wr == 0) PG8_BAR; }
    PG8_BAR;
    if constexpr (Epi::AFTER_DRAIN) { E.fused(acc, cur, wr, wc, fr, fq, lds, wid, lane); S.done(cur); }
#undef PG8_SA
#undef PG8_SB
#undef PG8_STAGE
#undef PG8_LDA
#undef PG8_LDB
#undef PG8_MMA
#undef PG8_WAIT_V
#undef PG8_WAIT_L
#undef PG8_BAR
#undef PG8_SCHED
}
}
#include <hip/hip_bf16.h>
#include <cmath>
namespace attn_body {
using bf16=__hip_bfloat16;
using bf16x8=__attribute__((ext_vector_type(8)))short;
using s16x4=__attribute__((ext_vector_type(4)))short;
using f32x16=__attribute__((ext_vector_type(16)))float;
using u32x4=__attribute__((ext_vector_type(4)))unsigned;
constexpr int D=64,QP=512,OP=1024,KP=128,NKT=36;
constexpr int NW=8,QBLK=32,QB=QBLK*NW,KVBLK=64;
__device__ __forceinline__ int crow(int r,int hi){return (r&3)+8*(r>>2)+4*hi;}
#define SBAR() __builtin_amdgcn_sched_barrier(0)
constexpr int NSLOT=3, SLOTB=8192;
constexpr int LDS_K=0, LDS_V=NSLOT*SLOTB, LDS_WS=2*NSLOT*SLOTB, LDS_OST=LDS_WS+NW*64*4, LDS_BYTES=LDS_OST+NW*4096;
constexpr float C2=0.125f*1.4426950408889634f;
__device__ __forceinline__ void glds16(const void*gsrc,unsigned lds_dst){unsigned keep;
  asm volatile("s_mov_b32 %0, m0\n\ts_mov_b32 m0, %2\n\ts_nop 0\n\tglobal_load_lds_dwordx4 %1, off\n\ts_mov_b32 m0, %0":"=&s"(keep):"v"(gsrc),"s"(lds_dst):"memory");}
__device__ __forceinline__ float max3f(float a,float b,float c){float r;asm("v_max3_f32 %0, %1, %2, %3":"=v"(r):"v"(a),"v"(b),"v"(c));return r;}
__device__ __forceinline__ float max2f(float a,float b){float r;asm("v_max_f32_e32 %0, %1, %2":"=v"(r):"v"(a),"v"(b));return r;}
__device__ __forceinline__ float fadd_s(float a,float b){float r;asm("v_add_f32_e32 %0, %1, %2":"=v"(r):"v"(a),"v"(b));return r;}
__device__ __forceinline__ float fsub_s(float a,float b){float r;asm("v_sub_f32_e32 %0, %1, %2":"=v"(r):"v"(a),"v"(b));return r;}
typedef float f32x2_t __attribute__((ext_vector_type(2))); typedef __bf16 bf16x2_t __attribute__((ext_vector_type(2)));
__device__ __forceinline__ unsigned cvtpk_s(float lo,float hi){f32x2_t v={lo,hi};bf16x2_t b=__builtin_convertvector(v,bf16x2_t);return __builtin_bit_cast(unsigned,b);}
#define WAIT_BAR(N) asm volatile("s_waitcnt vmcnt(" #N ") lgkmcnt(0)\n\ts_barrier":::"memory")

__device__ __forceinline__ void qkt(f32x16&p0,f32x16&p1,const char*Kslot,const bf16x8*qr,const f32x16&negm,int r32,int hi){
  const char*kb=Kslot+hi*1024+r32*16;
  #pragma unroll
  for(int d0=0;d0<4;++d0){
    const bf16x8 b0=*reinterpret_cast<const bf16x8*>(kb+d0*2048);
    const bf16x8 b1=*reinterpret_cast<const bf16x8*>(kb+d0*2048+512);
    if(d0==0){p0=__builtin_amdgcn_mfma_f32_32x32x16_bf16(b0,qr[0],negm,0,0,0);p1=__builtin_amdgcn_mfma_f32_32x32x16_bf16(b1,qr[0],negm,0,0,0);}
    else{p0=__builtin_amdgcn_mfma_f32_32x32x16_bf16(b0,qr[d0],p0,0,0,0);p1=__builtin_amdgcn_mfma_f32_32x32x16_bf16(b1,qr[d0],p1,0,0,0);}}
}
typedef __attribute__((address_space(3))) const char* lds_cptr;
typedef short v4i16_t __attribute__((ext_vector_type(4)));
__device__ __forceinline__ void kload8(bf16x8*kf,lds_cptr kp){
  kf[0]=*(const __attribute__((address_space(3))) bf16x8*)(kp);      kf[1]=*(const __attribute__((address_space(3))) bf16x8*)(kp+512);
  kf[2]=*(const __attribute__((address_space(3))) bf16x8*)(kp+2048); kf[3]=*(const __attribute__((address_space(3))) bf16x8*)(kp+2560);
  kf[4]=*(const __attribute__((address_space(3))) bf16x8*)(kp+4096); kf[5]=*(const __attribute__((address_space(3))) bf16x8*)(kp+4608);
  kf[6]=*(const __attribute__((address_space(3))) bf16x8*)(kp+6144); kf[7]=*(const __attribute__((address_space(3))) bf16x8*)(kp+6656);
}
__device__ __forceinline__ void kload2(bf16x8*kf,lds_cptr kp,int j){ kf[2*j]=*(const __attribute__((address_space(3))) bf16x8*)(kp+j*2048); kf[2*j+1]=*(const __attribute__((address_space(3))) bf16x8*)(kp+j*2048+512); }
__device__ __forceinline__ s16x4 vtr(lds_cptr p){ return __builtin_bit_cast(s16x4,__builtin_amdgcn_ds_read_tr16_b64_v4i16((__attribute__((address_space(3))) v4i16_t*)p)); }
__device__ __forceinline__ float rowmax(const f32x16&p0,const f32x16&p1){
  float a=max3f(p0[0],p0[1],p1[0]),b=max3f(p0[2],p0[3],p1[1]);a=max3f(a,p1[2],p1[3]);
  #pragma unroll
  for(int r=4;r<16;r+=4){a=max3f(a,p0[r],p0[r+1]);b=max3f(b,p0[r+2],p0[r+3]);a=max3f(a,p1[r],p1[r+1]);b=max3f(b,p1[r+2],p1[r+3]);}
  const float m=max2f(a,b);
  auto rr=__builtin_amdgcn_permlane32_swap(__float_as_uint(m),__float_as_uint(m),false,false);
  return max2f(__uint_as_float(rr[0]),__uint_as_float(rr[1]));
}
__device__ __forceinline__ void pv(f32x16*o,int vb,bf16x8 pa0,bf16x8 pa1,bf16x8 pa2,bf16x8 pa3){
  #pragma unroll
  for(int d0=0;d0<2;++d0){s16x4 lo[4],hi[4];
    #pragma unroll
    for(int ks=0;ks<4;++ks){
      asm volatile("ds_read_b64_tr_b16 %0,%1 offset:%c2":"=&v"(lo[ks]):"v"(vb),"i"(d0*4096+ks*1024):"memory");
      asm volatile("ds_read_b64_tr_b16 %0,%1 offset:%c2":"=&v"(hi[ks]):"v"(vb),"i"(d0*4096+ks*1024+512):"memory");}
    asm volatile("s_waitcnt lgkmcnt(0)":::"memory");SBAR();
    #define PK(k) (bf16x8){lo[k][0],lo[k][1],lo[k][2],lo[k][3],hi[k][0],hi[k][1],hi[k][2],hi[k][3]}
    o[d0]=__builtin_amdgcn_mfma_f32_32x32x16_bf16(pa0,PK(0),o[d0],0,0,0);
    o[d0]=__builtin_amdgcn_mfma_f32_32x32x16_bf16(pa1,PK(1),o[d0],0,0,0);
    o[d0]=__builtin_amdgcn_mfma_f32_32x32x16_bf16(pa2,PK(2),o[d0],0,0,0);
    o[d0]=__builtin_amdgcn_mfma_f32_32x32x16_bf16(pa3,PK(3),o[d0],0,0,0);
    #undef PK
  }
}

#ifndef ATTN_STORE16
#define ATTN_STORE16(p,v) (*(u32x4*)(p)=(v))
#endif
template<int THRL,bool FIXED> __device__ __forceinline__ void attn_unit(long qrow0,int h,long kvrow0,int kvh,const bf16*Q,const bf16*__restrict__ K,const bf16*__restrict__ V,bf16*O,char*shm,float mfix){
  int tid_=threadIdx.x; asm volatile("":"+v"(tid_)); const int tid=tid_,lane=tid&63,r32=lane&31,hi=lane>>5; const int wid=__builtin_amdgcn_readfirstlane(tid>>6);
  const bf16*Qw=Q+(qrow0+wid*QBLK)*QP+h*D;
  const bf16*Kh=K+kvrow0*KP+kvh*D,*Vh=V+kvrow0*KP+kvh*D;
  const unsigned lds0=(unsigned)(uintptr_t)shm;
  float*wsf=(float*)(shm+LDS_WS)+wid*64;
  const bf16*ksrc=Kh+(long)lane*KP+wid*8;
  const bf16*vsrc=Vh+(long)(16*(wid&3)+(lane>>2))*KP+(wid>>2)*32+(lane&3)*8;
  const unsigned kdst=lds0+LDS_K+wid*1024, vdst=lds0+LDS_V+wid*1024;
  #define DMA_K(t,slot) glds16(ksrc+(long)(t)*KVBLK*KP,(unsigned)__builtin_amdgcn_readfirstlane(kdst+(slot)))
  #define DMA_V(t,slot) glds16(vsrc+(long)(t)*KVBLK*KP,(unsigned)__builtin_amdgcn_readfirstlane(vdst+(slot)))
  const int vb0=(int)(lds0+LDS_V)+((lane>>4)&1)*32+(lane&3)*8+(4*hi+((lane&15)>>2))*64;
  const char*Kbase=shm+LDS_K; bf16x8 kf[8];
  const lds_cptr shm3=(lds_cptr)shm; const lds_cptr kp0=shm3+LDS_K+hi*1024+r32*16; const lds_cptr vp0=shm3+LDS_V+((lane>>4)&1)*32+(lane&3)*8+(4*hi+((lane&15)>>2))*64;
  constexpr int NT=NKT;
  DMA_K(0,0);DMA_V(0,0);DMA_K(1,SLOTB);
  bf16x8 qr[4];
  #pragma unroll
  for(int d0=0;d0<4;++d0)qr[d0]=*reinterpret_cast<const bf16x8*>(&Qw[(long)r32*QP+d0*16+hi*8]);
  float mhat=0.f,l_reg=0.f;f32x16 o[2];o[0]=f32x16{};o[1]=f32x16{};f32x16 negm;
  #pragma unroll
  for(int r=0;r<16;++r)negm[r]=FIXED?-mfix:0.f;
  asm volatile("":"+v"(negm));
  #define CMASK(P0,P1,t) do{}while(0)
  bool resc=false;
  #define START(P0,P1) do{ if(!FIXED){ const float rm=rowmax(P0,P1); resc=false; \
    { const float dl=rm; mhat=fadd_s(mhat,dl); \
      _Pragma("unroll") for(int r=0;r<16;++r){P0[r]=fsub_s(P0[r],dl);P1[r]=fsub_s(P1[r],dl);} \
      _Pragma("unroll") for(int r=0;r<16;++r)negm[r]=-mhat; asm volatile("":"+v"(negm)); } } \
    _Pragma("unroll") for(int r=0;r<16;++r)P0[r]=__builtin_amdgcn_exp2f(P0[r]); }while(0)
  #define RESC() do{ if(resc){ asm volatile("s_waitcnt lgkmcnt(0)":::"memory"); \
      _Pragma("unroll") for(int d_=0;d_<2;++d_) _Pragma("unroll") for(int r=0;r<16;++r)o[d_][r]*=wsf[crow(r,hi)]; } }while(0)
  f32x16 pA0,pA1,pB0,pB1;
  int sl_prev=0,sl_cur=0,sl_next=SLOTB;
  #define ROT() do{sl_prev=sl_cur;sl_cur=sl_next;sl_next=(sl_next==(NSLOT-1)*SLOTB)?0:sl_next+SLOTB;}while(0)
  DMA_K(2,2*SLOTB);
  WAIT_BAR(3);
  qkt(pA0,pA1,Kbase,qr,negm,r32,hi);asm volatile("s_nop 15\n\ts_nop 7":"+v"(pA0),"+v"(pA1));CMASK(pA0,pA1,0);
  START(pA0,pA1);
  _Pragma("unroll") for(int r=0;r<16;++r)pA1[r]=__builtin_amdgcn_exp2f(pA1[r]);
  WAIT_BAR(0);
  DMA_K(3,0);DMA_V(1,SLOTB);
  ROT();
  kload8(kf,kp0+sl_cur);
  WAIT_BAR(2);
  s16x4 vlo[8],vhi[8]; u32x4 pw0,pw1,pw2,pw3;
  #define PKW(P,B) cvtpk_s(P[B],P[B+1])
  #define PAF(k) __builtin_bit_cast(bf16x8,pw##k)
  #define VFR(i) (bf16x8){vlo[i][0],vlo[i][1],vlo[i][2],vlo[i][3],vhi[i][0],vhi[i][1],vhi[i][2],vhi[i][3]}
  #define PIN(x) asm volatile("":"+v"(x))
  #define MX3(a,b,c) __builtin_fmaxf(__builtin_fmaxf((a),(b)),(c))
  #define GAPA(MF,A0,A1,A2,A3,W0,W1,PW) do{ MF; sacc+=A0; sacc+=A1; sacc+=A2; sacc+=A3; PIN(sacc); W0; W1; PIN(PW); SBAR(); }while(0)
  #define EX(v) __builtin_amdgcn_exp2f(v)
  #define GAPB(MF,X,B) do{ MF; X[B]=EX(X[B]); X[B+1]=EX(X[B+1]); X[B+2]=EX(X[B+2]); X[B+3]=EX(X[B+3]); PIN(X); SBAR(); }while(0)
  #define VRD(i) do{ vlo[i]=vtr(vp_+(((i)>>2)*4096+((i)&3)*1024)); vhi[i]=vtr(vp_+(((i)>>2)*4096+((i)&3)*1024+512)); }while(0)
  #define KRD(G,j) do{ if(G){ kload2(kf,kp0+sl_next,j); SBAR(); } }while(0)
  #define STEP(C0,C1,P0,P1,t,GK,GV,GL) do{ SBAR(); \
    const lds_cptr vp_=vp0+sl_prev; \
    VRD(0); SBAR(); float sacc=(P0[0]+P0[1]); \
    GAPA(C0=__builtin_amdgcn_mfma_f32_32x32x16_bf16(kf[0],qr[0],negm,0,0,0), P0[2],P0[3],P0[4],P0[5],     pw0[0]=PKW(P0,0), pw0[1]=PKW(P0,2), pw0); \
    VRD(4); SBAR(); GAPA(C1=__builtin_amdgcn_mfma_f32_32x32x16_bf16(kf[1],qr[0],negm,0,0,0), P0[6],P0[7],P0[8],P0[9],     pw0[2]=PKW(P0,4), pw0[3]=PKW(P0,6), pw0); \
    VRD(1); SBAR(); GAPA(C0=__builtin_amdgcn_mfma_f32_32x32x16_bf16(kf[2],qr[1],C0,0,0,0),   P0[10],P0[11],P0[12],P0[13], pw1[0]=PKW(P0,8), pw1[1]=PKW(P0,10), pw1); \
    VRD(5); SBAR(); GAPA(C1=__builtin_amdgcn_mfma_f32_32x32x16_bf16(kf[3],qr[1],C1,0,0,0),   P0[14],P0[15],P1[0],P1[1],   pw1[2]=PKW(P0,12),pw1[3]=PKW(P0,14), pw1); \
    VRD(2); SBAR(); GAPA(C0=__builtin_amdgcn_mfma_f32_32x32x16_bf16(kf[4],qr[2],C0,0,0,0),   P1[2],P1[3],P1[4],P1[5],     pw2[0]=PKW(P1,0), pw2[1]=PKW(P1,2), pw2); \
    VRD(6); SBAR(); GAPA(C1=__builtin_amdgcn_mfma_f32_32x32x16_bf16(kf[5],qr[2],C1,0,0,0),   P1[6],P1[7],P1[8],P1[9],     pw2[2]=PKW(P1,4), pw2[3]=PKW(P1,6), pw2); \
    VRD(3); SBAR(); GAPA(C0=__builtin_amdgcn_mfma_f32_32x32x16_bf16(kf[6],qr[3],C0,0,0,0),   P1[10],P1[11],P1[12],P1[13], pw3[0]=PKW(P1,8), pw3[1]=PKW(P1,10), pw3); \
    VRD(7); SBAR(); GAPA(C1=__builtin_amdgcn_mfma_f32_32x32x16_bf16(kf[7],qr[3],C1,0,0,0),   P1[14],P1[15],0.f,0.f,       pw3[2]=PKW(P1,12),pw3[3]=PKW(P1,14), pw3); \
    l_reg+=sacc; \
    if(GK){DMA_K((t)+3,sl_cur);} if(GV){DMA_V((t)+1,sl_next);} \
    CMASK(C0,C1,t); \
    if(!FIXED){ float a=MX3(C0[0],C0[1],C1[0]),b=MX3(C0[2],C0[3],C1[1]); a=MX3(a,C1[2],C1[3]); \
      _Pragma("unroll") for(int r=4;r<16;r+=4){a=MX3(a,C0[r],C0[r+1]);b=MX3(b,C0[r+2],C0[r+3]);a=MX3(a,C1[r],C1[r+1]);b=MX3(b,C1[r+2],C1[r+3]);} \
      float rm=__builtin_fmaxf(a,b); { auto rr=__builtin_amdgcn_permlane32_swap(__float_as_uint(rm),__float_as_uint(rm),false,false); rm=__builtin_fmaxf(__uint_as_float(rr[0]),__uint_as_float(rr[1])); } \
      resc=false; \
      if(__builtin_expect(__any(rm>(float)THRL),0)){ const float dl=__builtin_fmaxf(rm,0.f); mhat+=dl; \
        _Pragma("unroll") for(int r=0;r<16;++r){C0[r]-=dl;C1[r]-=dl;} \
        _Pragma("unroll") for(int r=0;r<16;++r)negm[r]=-mhat; asm volatile("":"+v"(negm)); \
        const float f=__builtin_amdgcn_exp2f(-dl); l_reg*=f; if(hi==0)wsf[r32]=f; resc=true; } } \
    SBAR(); \
    GAPB(o[0]=__builtin_amdgcn_mfma_f32_32x32x16_bf16(PAF(0),VFR(0),o[0],0,0,0), C0,0); \
    GAPB(o[1]=__builtin_amdgcn_mfma_f32_32x32x16_bf16(PAF(0),VFR(4),o[1],0,0,0), C0,4); \
    KRD(GL,0); GAPB(o[0]=__builtin_amdgcn_mfma_f32_32x32x16_bf16(PAF(1),VFR(1),o[0],0,0,0), C0,8); \
    KRD(GL,1); GAPB(o[1]=__builtin_amdgcn_mfma_f32_32x32x16_bf16(PAF(1),VFR(5),o[1],0,0,0), C0,12); \
    KRD(GL,2); GAPB(o[0]=__builtin_amdgcn_mfma_f32_32x32x16_bf16(PAF(2),VFR(2),o[0],0,0,0), C1,0); \
    KRD(GL,3); GAPB(o[1]=__builtin_amdgcn_mfma_f32_32x32x16_bf16(PAF(2),VFR(6),o[1],0,0,0), C1,4); \
    GAPB(o[0]=__builtin_amdgcn_mfma_f32_32x32x16_bf16(PAF(3),VFR(3),o[0],0,0,0), C1,8); \
    GAPB(o[1]=__builtin_amdgcn_mfma_f32_32x32x16_bf16(PAF(3),VFR(7),o[1],0,0,0), C1,12); \
    }while(0)
  int t=1;
  #undef CMASK
  #define CMASK(P0,P1,t) do{}while(0)
  for(;t+5<NT;t+=2){
    STEP(pB0,pB1,pA0,pA1,t,true,true,true);     WAIT_BAR(2); RESC(); ROT();
    STEP(pA0,pA1,pB0,pB1,t+1,true,true,true);   WAIT_BAR(2); RESC(); ROT();
  }
  #undef CMASK
  #define CMASK(P0,P1,t) do{}while(0)
  #define ENDW(tt) do{ if((tt)+3<NT){WAIT_BAR(2);} else if((tt)+2<NT){WAIT_BAR(1);} else {WAIT_BAR(0);} }while(0)
  for(;t+1<NT;t+=2){
    STEP(pB0,pB1,pA0,pA1,t,(t+3<NT),(t+1<NT),(t+1<NT));       ENDW(t);   RESC(); ROT();
    STEP(pA0,pA1,pB0,pB1,t+1,(t+4<NT),(t+2<NT),(t+2<NT));     ENDW(t+1); RESC(); ROT();
  }
  STEP(pB0,pB1,pA0,pA1,NT-1,false,false,false); RESC();
  { float sacc=pB0[0]+pB0[1]; _Pragma("unroll") for(int r=2;r<16;++r)sacc+=pB0[r]; _Pragma("unroll") for(int r=0;r<16;++r)sacc+=pB1[r]; l_reg+=sacc;
    pw0=(u32x4){PKW(pB0,0),PKW(pB0,2),PKW(pB0,4),PKW(pB0,6)};pw1=(u32x4){PKW(pB0,8),PKW(pB0,10),PKW(pB0,12),PKW(pB0,14)};pw2=(u32x4){PKW(pB1,0),PKW(pB1,2),PKW(pB1,4),PKW(pB1,6)};pw3=(u32x4){PKW(pB1,8),PKW(pB1,10),PKW(pB1,12),PKW(pB1,14)};
    SBAR(); pv(o,vb0+sl_cur,PAF(0),PAF(1),PAF(2),PAF(3)); }
  #undef PKW
  #undef PAF
  #undef VFR
  #undef PIN
  #undef MX3
  #undef GAPA
  #undef GAPB
  #undef EX
  #undef VRD
  #undef KRD
  #undef STEP
  #undef ENDW
  {auto rr=__builtin_amdgcn_permlane32_swap(__float_as_uint(l_reg),__float_as_uint(l_reg),false,false);l_reg=__uint_as_float(rr[0])+__uint_as_float(rr[1]);}
  if(hi==0)wsf[32+r32]=l_reg;asm volatile("s_waitcnt lgkmcnt(0)":::"memory");
  float rli[16];
  #pragma unroll
  for(int r=0;r<16;++r)rli[r]=__builtin_amdgcn_rcpf(wsf[32+crow(r,hi)]);
  bf16*Ow=O+(qrow0+wid*QBLK)*OP+h*D;
  { bf16*stg=(bf16*)(shm+LDS_OST)+wid*2048;
    #pragma unroll
    for(int r=0;r<16;++r){const int orow=crow(r,hi);
      #pragma unroll
      for(int d0=0;d0<2;++d0)stg[orow*64+d0*32+r32]=__float2bfloat16(o[d0][r]*rli[r]);}
    asm volatile("s_waitcnt lgkmcnt(0)":::"memory");
    #pragma unroll
    for(int i=0;i<4;++i){const int row=i*8+(lane>>3),ch=lane&7; const u32x4 v=*(const u32x4*)(stg+row*64+ch*8); ATTN_STORE16(Ow+(long)row*OP+ch*8,v);} }
  asm volatile("s_waitcnt lgkmcnt(0)\n\ts_barrier":::"memory");
  #undef DMA_K
  #undef DMA_V
  #undef CMASK
  #undef START
  #undef RESC
  #undef ROT
}
constexpr int ATTN_LDS_BYTES=LDS_BYTES;
#undef SBAR
#undef WAIT_BAR
}
constexpr int NWAVES = 8;
using pg8::bf16_t; using pg8::bf16x8; using pg8::f32x4; using pg8::u32x4;
typedef unsigned u32x2 __attribute__((ext_vector_type(2)));
#define LAS __attribute__((address_space(3)))
#define GAS __attribute__((address_space(1)))
#define RLX_AGENT __ATOMIC_RELAXED, __HIP_MEMORY_SCOPE_AGENT
#define LDS_WAIT() asm volatile("s_waitcnt lgkmcnt(0)" ::: "memory")
#define VM_WAIT() asm volatile("s_waitcnt vmcnt(0)" ::: "memory")

constexpr size_t MiB = 1u << 20;
constexpr size_t WS_CTL = 0, CTL_ZERO_BYTES = 64 * 1024;
constexpr size_t WS_MOD = 1 * MiB;
constexpr size_t WS_LB = WS_MOD + 512 * 1024;
constexpr size_t WS_ROPE = WS_LB + 8 * 1024;
constexpr size_t WS_WIN = 2 * MiB;
constexpr size_t WS_WINS = 10 * MiB;
constexpr int CW_CMAX = 10240;
constexpr size_t WS_WA = 13 * MiB, WS_WB = 14 * MiB, WS_WO = 15 * MiB;
constexpr size_t WS_WGU = 17 * MiB, WS_WD = 81 * MiB;
constexpr size_t WS_HX = 17 * MiB;
constexpr size_t WS_A1 = 17 * MiB, WS_OATT = 49 * MiB, WS_OR = 81 * MiB;
constexpr size_t WS_HQ = 113 * MiB, WS_FF = 145 * MiB, WS_FB = 181 * MiB, WS_HI = 217 * MiB, WS_SG = 253 * MiB, WS_Q = 285 * MiB, WS_K = 317 * MiB, WS_V = 326 * MiB;
constexpr size_t WS_GA = 335 * MiB, WS_GB = 399 * MiB;
constexpr size_t WS_Z = 113 * MiB;
constexpr size_t WS_H2 = 177 * MiB;
constexpr size_t WS_AFF = 241 * MiB;
constexpr size_t WS_HS = 209 * MiB;
constexpr size_t WS_TQ = 17 * MiB + 48 * MiB;
constexpr size_t WS_TD = 81 * MiB + 24 * MiB;
constexpr size_t WS_HIDQ = 113 * MiB;
constexpr size_t WS_SCL2 = 243 * MiB + 768 * 1024;
constexpr size_t WS_SCL = 243 * MiB + 512 * 1024;
constexpr size_t WS_IDX = 243 * MiB;
constexpr size_t WS_SLOT = 244 * MiB;
constexpr size_t WS_X1B = 246 * MiB;
constexpr size_t WS_YE = 374 * MiB;
constexpr size_t WS_END = 502 * MiB;
constexpr int CW_Q3 = 64;
constexpr int CW_MFIX = 96;
constexpr int CW_BAR = 1024;

constexpr int RING_BYTES = 131072, MISC_OFF = RING_BYTES, LDS_BYTES = 147456;

#define PB_HX(A)   ((unsigned char*)(A).out)
#define PB_HXS(A)  ((float*)((unsigned char*)(A).out + 100 * MiB))
#define PB_A1(A)   ((unsigned char*)(A).out)
#define PB_OATT(A) ((unsigned char*)(A).out + 1024)
#define PB_OR(A)   ((unsigned char*)(A).out + 64 * MiB)
#define PB_HID(A)  ((unsigned char*)(A).out)
struct Args {
    const float *x, *c, *ctx, *c_ctx, *w_mod, *b_mod, *n1g, *n2g, *w_in, *lbl, *hgn, *qng, *kng, *wa, *wb, *wo, *wr, *weg, *weu, *wed, *fng;
    float* out; unsigned char* ws;
};

#define XB_TMO      128
#define XB_XCNT(j)  (256  + 64 * (j))
#define XB_XSUB(j)  (1280 + 64 * (j))
#define XB_XGEN(j)  (2304 + 64 * (j))
#define XB_TOP      3328
#define XB_TOPGEN   3392
#define XCD_BAR_WORDS 3456
#define XB_SPIN_CAP (1u << 18)
#ifndef XB_SCOPE
#define XB_SCOPE "agent"
#endif

__device__ __forceinline__ unsigned xb_ld(unsigned* p)              { return __hip_atomic_load(p, __ATOMIC_RELAXED, __HIP_MEMORY_SCOPE_AGENT); }
__device__ __forceinline__ unsigned xb_add(unsigned* p, unsigned v) { return __hip_atomic_fetch_add(p, v, __ATOMIC_RELAXED, __HIP_MEMORY_SCOPE_AGENT); }
__device__ __forceinline__ unsigned xb_xcc_id() { return (unsigned)__builtin_amdgcn_s_getreg((3 << 11) | 20) & 0xFu; }
#define XB_SPIN(cond, bar) do { unsigned _sp = 0; while (cond) { __builtin_amdgcn_s_sleep(1); \
    if ((++_sp & 255u) == 0u) { if (xb_ld(&(bar)[XB_TMO])) break; if (_sp > XB_SPIN_CAP) { atomicAdd(&(bar)[XB_TMO], 1u); break; } } } } while (0)

struct XcdBarrier {
    unsigned* bar; unsigned x;
    volatile LAS unsigned* st;
};

__device__ __forceinline__ XcdBarrier xcd_barrier_post(unsigned* bar, volatile LAS unsigned* st) {
    XcdBarrier b; b.bar = bar; b.x = xb_xcc_id(); b.st = st;
    if (threadIdx.x == 0) (void)xb_add(&bar[XB_XCNT(b.x)], 1u);
    return b;
}
__device__ __forceinline__ void xcd_barrier_complete(unsigned* bar, unsigned x, unsigned& nloc, unsigned& nx) {
    const unsigned G = gridDim.x * gridDim.y * gridDim.z;
    unsigned sum, cnt, mine, sp = 0u;
    for (;;) {
        sum = 0u; cnt = 0u; mine = 0u;
#pragma unroll
        for (unsigned j = 0; j < 16; ++j) { const unsigned c = xb_ld(&bar[XB_XCNT(j)]); sum += c; cnt += (c > 0u) ? 1u : 0u; mine = (j == x) ? c : mine; }
        if (sum == G) break;
        __builtin_amdgcn_s_sleep(1);
        if ((++sp & 255u) == 0u) { if (xb_ld(&bar[XB_TMO])) break; if (sp > XB_SPIN_CAP) { atomicAdd(&bar[XB_TMO], 1u); break; } }
    }
    nloc = mine > 0u ? mine : 1u; nx = cnt > 0u ? cnt : 1u;
}

__device__ __forceinline__ void xcd_barrier(const XcdBarrier& b) {
    asm volatile("s_waitcnt vmcnt(0)" ::: "memory");
    __syncthreads();
    if (threadIdx.x == 0) {
        unsigned* bar = b.bar;
        __builtin_amdgcn_s_waitcnt(0);
        unsigned nloc = b.st[0], nx = b.st[1];
        if (nloc == 0u) { xcd_barrier_complete(bar, b.x, nloc, nx); b.st[0] = nloc; b.st[1] = nx; }
#if DBG_RELEASE_ALL
        __builtin_amdgcn_fence(__ATOMIC_RELEASE, "agent"); asm volatile("s_waitcnt vmcnt(0)" ::: "memory");
#endif
        const unsigned old = xb_add(&bar[XB_XSUB(b.x)], 1u);
        const unsigned gen = old / nloc;
        if (old + 1u == (gen + 1u) * nloc) {
#if DBG_LEADER_DELAY
            { const unsigned long long t0_ = __builtin_amdgcn_s_memrealtime(); while (__builtin_amdgcn_s_memrealtime() - t0_ < (unsigned long long)DBG_LEADER_DELAY) __builtin_amdgcn_s_sleep(2); }
#endif
            __builtin_amdgcn_fence(__ATOMIC_RELEASE, XB_SCOPE);
            asm volatile("s_waitcnt vmcnt(0)" ::: "memory");
#if DBG_WBL2_TWICE
            { const unsigned long long t0_ = __builtin_amdgcn_s_memrealtime(); while (__builtin_amdgcn_s_memrealtime() - t0_ < 150ull) __builtin_amdgcn_s_sleep(2); }
            asm volatile("buffer_wbl2 sc1\n\ts_waitcnt vmcnt(0)" ::: "memory");
#endif
            const unsigned og = xb_add(&bar[XB_TOP], 1u);
            const unsigned tg = og / nx;
            if (og + 1u == (tg + 1u) * nx) xb_add(&bar[XB_TOPGEN], 1u);
            else XB_SPIN(xb_ld(&bar[XB_TOPGEN]) == tg, bar);
            __builtin_amdgcn_fence(__ATOMIC_ACQUIRE, XB_SCOPE);
            xb_add(&bar[XB_XGEN(b.x)], 1u);
            asm volatile("s_waitcnt vmcnt(0)" ::: "memory");
        } else {
            XB_SPIN(xb_ld(&bar[XB_XGEN(b.x)]) == gen, bar);
            __builtin_amdgcn_fence(__ATOMIC_ACQUIRE, XB_SCOPE);
            asm volatile("s_waitcnt vmcnt(0)" ::: "memory");
        }
    }
    __syncthreads();
}

__device__ __forceinline__ float wave_sum(float v) {
#pragma unroll
    for (int o = 1; o < 64; o <<= 1) v += __shfl_xor(v, o);
    return v;
}
__device__ __forceinline__ unsigned f2bf(float f) { unsigned u = __builtin_bit_cast(unsigned, f); return (u + 0x7fffu + ((u >> 16) & 1u)) >> 16; }
__device__ __forceinline__ unsigned pk2(float lo, float hi) { return f2bf(lo) | (f2bf(hi) << 16); }
__device__ __forceinline__ float bf2f(unsigned short h) { return __uint_as_float((unsigned)h << 16); }

template <bool QKPERM>
__device__ __forceinline__ void transpose_item_q8(const float* W, int Nsrc, int n0, int k0, float inv, unsigned char* WQ, long drow0, LAS float* scr, int lane) {
    float tv[32];
#pragma unroll
    for (int i = 0; i < 32; ++i) tv[i] = W[(size_t)(k0 + 2 * i + (lane >> 5)) * Nsrc + n0 + (lane & 31)];
#pragma unroll
    for (int i = 0; i < 32; ++i) scr[(2 * i + (lane >> 5)) * 33 + (lane & 31)] = __builtin_rintf(tv[i] * inv);
    LDS_WAIT(); asm volatile("" ::: "memory");
    const int c = lane & 7;
#pragma unroll
    for (int j = 0; j < 4; ++j) { const int n = (lane >> 3) + 8 * j;
        const int ns = QKPERM ? (16 * ((n & 7) >> 2) + 4 * (n >> 3) + (n & 3)) : n;
        const LAS float* s = scr + (8 * c) * 33 + ns;
        const unsigned w0 = ((unsigned)(int)s[0 * 33] & 255u) | (((unsigned)(int)s[1 * 33] & 255u) << 8) | (((unsigned)(int)s[2 * 33] & 255u) << 16) | ((unsigned)(int)s[3 * 33] << 24);
        const unsigned w1 = ((unsigned)(int)s[4 * 33] & 255u) | (((unsigned)(int)s[5 * 33] & 255u) << 8) | (((unsigned)(int)s[6 * 33] & 255u) << 16) | ((unsigned)(int)s[7 * 33] << 24);
        u32x2 o; o.x = w0; o.y = w1; *(u32x2*)(WQ + (size_t)(drow0 + n) * 1024 + k0 + 8 * c) = o; }
    LDS_WAIT(); asm volatile("" ::: "memory");
}
template <bool QKPERM>
__device__ __forceinline__ void transpose_item(const float* W, int K, int Nsrc, int n0, int k0, bf16_t* WT, long drow0, LAS float* scr, int lane) {
    float tv[32];
#pragma unroll
    for (int i = 0; i < 32; ++i) tv[i] = W[(size_t)(k0 + 2 * i + (lane >> 5)) * Nsrc + n0 + (lane & 31)];
#pragma unroll
    for (int i = 0; i < 32; ++i) scr[(2 * i + (lane >> 5)) * 33 + (lane & 31)] = tv[i];
    LDS_WAIT(); asm volatile("" ::: "memory");
    const int c = lane & 7;
#pragma unroll
    for (int j = 0; j < 4; ++j) { const int n = (lane >> 3) + 8 * j;
        const int ns = QKPERM ? (16 * ((n & 7) >> 2) + 4 * (n >> 3) + (n & 3)) : n;
        const LAS float* s = scr + (8 * c) * 33 + ns;
        u32x4 o; o.x = pk2(s[0 * 33], s[1 * 33]); o.y = pk2(s[2 * 33], s[3 * 33]); o.z = pk2(s[4 * 33], s[5 * 33]); o.w = pk2(s[6 * 33], s[7 * 33]);
        *(u32x4*)(WT + (size_t)(drow0 + n) * K + k0 + 8 * c) = o; }
    LDS_WAIT(); asm volatile("" ::: "memory");
}
__device__ __forceinline__ void p0_adaln_item(const Args& A, LAS unsigned char* lds, int item, int tid) {
    LAS float* sc = (LAS float*)lds;
    LAS float* red = (LAS float*)(lds + 17 * 1024 * 4);
    const int wave = tid >> 6, lane = tid & 63, col = lane & 31, kp = lane >> 5;
    const float* wp = A.w_mod + (size_t)(wave * 128 + kp * 64) * NMOD + item * 32 + col;
    float w[64];
#pragma unroll
    for (int kk = 0; kk < 64; ++kk) w[kk] = wp[(size_t)kk * NMOD];
    for (int i = tid; i < 17 * 1024; i += 512) { const int b = i >> 10, k = i & 1023; const float v = b < 16 ? A.c[b * 1024 + k] : A.c_ctx[k]; sc[i] = v * pg8::fsigmoid(v); }
    __syncthreads();
    float acc[17];
#pragma unroll
    for (int b = 0; b < 17; ++b) acc[b] = 0.f;
#pragma unroll
    for (int kk = 0; kk < 64; kk += 4) {
#pragma unroll
        for (int b = 0; b < 17; ++b) { const f32x4 s4 = *(const LAS f32x4*)(sc + b * 1024 + wave * 128 + kp * 64 + kk); acc[b] += (s4[0] * w[kk] + s4[1] * w[kk + 1]) + (s4[2] * w[kk + 2] + s4[3] * w[kk + 3]); } }
#pragma unroll
    for (int b = 0; b < 17; ++b) red[((wave * 2 + kp) * 17 + b) * 32 + col] = acc[b];
    __syncthreads();
    float* mod = (float*)(A.ws + WS_MOD);
    for (int i = tid; i < 17 * 32; i += 512) { const int b = i >> 5, cidx = i & 31; float s = 0.f;
#pragma unroll
        for (int w = 0; w < 16; ++w) s += red[(w * 17 + b) * 32 + cidx];
        mod[b * NMOD + item * 32 + cidx] = s + A.b_mod[item * 32 + cidx]; }
    __syncthreads();
}
__device__ __forceinline__ int win_src(int g32, bool& qk) {
    const int pn = g32 >> 3, bj = (g32 >> 2) & 1, wc = g32 & 3;
    if (pn == 10 || pn == 11) { qk = true; return 2560 + (pn - 10) * 256 + wc * 64 + 32 * bj; }
    if (pn == 12 && wc < 2) { qk = true; return 3072 + wc * 64 + 32 * bj; }
    qk = false;
    if (pn == 12) return 3200 + (wc - 2) * 64 + 32 * bj;
    return g32 * 32;
}
template <int PART>
__device__ __forceinline__ void p0_prologue(const Args& A, LAS unsigned char* lds, int vcu, int G, int tid) {
    const int wave = tid >> 6, lane = tid & 63;
    if (PART == 0) {
    for (int it = vcu; it < NMOD / 32; it += G) p0_adaln_item(A, lds, it, tid);
    if (vcu == G - 1) {
        float* lb = (float*)(A.ws + WS_LB); float* rope = (float*)(A.ws + WS_ROPE);
        for (int i = tid; i < 1024; i += 512) { const int d = i >> 9, k = i & 511; const float l0 = A.lbl[(d * 2 + 0) * 512 + k], l1 = A.lbl[(d * 2 + 1) * 512 + k]; lb[i] = 1.0f / (1.0f + expf(l1 - l0)); }
        for (int i = tid; i < 64 * 16; i += 512) { const int pos = i >> 4, f = i & 15; const float inv = powf(10000.0f, -(float)(2 * f) / 32.0f); const float ang = (float)pos * inv; rope[pos * 32 + f] = cosf(ang); rope[pos * 32 + 16 + f] = sinf(ang); }
        if (tid < 64) { float mq = fabsf(A.qng[tid]), mk = fabsf(A.kng[tid]);
#pragma unroll
            for (int o = 32; o > 0; o >>= 1) { mq = fmaxf(mq, __shfl_xor(mq, o)); mk = fmaxf(mk, __shfl_xor(mk, o)); }
            if (tid == 0) ((float*)(A.ws + WS_CTL))[CW_MFIX] = 64.0f * 0.125f * LOG2E * 1.02f * mq * mk + 0.5f; }
    }
    { unsigned* cmax = (unsigned*)(A.ws + WS_CTL) + CW_CMAX; const int gwm = vcu * NWAVES + wave, NGWM = G * NWAVES;
      for (int it = gwm; it < 16 * (INC / 32); it += NGWM) { const int kb = it / (INC / 32), g32 = it % (INC / 32); bool qk; const int n0 = win_src(g32, qk);
          float m = 0.f;
          float tv[32];
#pragma unroll
          for (int i = 0; i < 32; ++i) tv[i] = A.w_in[(size_t)(64 * kb + 2 * i + (lane >> 5)) * INC + n0 + (lane & 31)];
#pragma unroll
          for (int i = 0; i < 32; ++i) m = fmaxf(m, fabsf(tv[i]));
          m = fmaxf(m, __shfl_xor(m, 32));
          if (lane < 32) atomicMax(cmax + g32 * 32 + lane, __float_as_uint(m)); } }
    return; }
    LAS float* scr = (LAS float*)(lds + wave * 8704);
    const int gw = vcu * NWAVES + wave, NGW = G * NWAVES;
    constexpr int I_IN = 16 * (INC / 32), I_A = 8 * 32, I_O = 16 * 32;
    constexpr int NIT = I_IN + 2 * I_A + I_O;
    bf16_t* WinT = (bf16_t*)(A.ws + WS_WIN); bf16_t* WaT = (bf16_t*)(A.ws + WS_WA); bf16_t* WbT = (bf16_t*)(A.ws + WS_WB); bf16_t* WoT = (bf16_t*)(A.ws + WS_WO);
    const int it0 = gw, itstep = NGW, itend = NIT;
    for (int it = it0; it < itend; it += itstep) {
        int r = it;
        if (r < I_IN) { const int kb = r / (INC / 32), g32 = r % (INC / 32);
            bool qk; const int n0 = win_src(g32, qk);
            const unsigned* cmax = (const unsigned*)(A.ws + WS_CTL) + CW_CMAX;
            const float am = fmaxf(__uint_as_float(__hip_atomic_load(cmax + g32 * 32 + (lane & 31), RLX_AGENT)), 1e-30f), inv = 127.0f / am;
            if (kb == 0 && lane < 32) { const int n = lane, ns = qk ? (16 * ((n & 7) >> 2) + 4 * (n >> 3) + (n & 3)) : n;
                ((float*)(A.ws + WS_WINS))[g32 * 32 + n] = fmaxf(__uint_as_float(__hip_atomic_load(cmax + g32 * 32 + ns, RLX_AGENT)), 1e-30f) * (1.0f / 127.0f); }
            if (qk) transpose_item_q8<true>(A.w_in, INC, n0, 64 * kb, inv, A.ws + WS_WIN, (long)g32 * 32, scr, lane);
            else transpose_item_q8<false>(A.w_in, INC, n0, 64 * kb, inv, A.ws + WS_WIN, (long)g32 * 32, scr, lane);
            continue; }
        r -= I_IN;
        if (r < I_A) { transpose_item<false>(A.wa, 1024, 1024, (r & 31) * 32, 64 * (r >> 5), WaT, (long)(r & 31) * 32, scr, lane); continue; } r -= I_A;
        if (r < I_A) { transpose_item<false>(A.wb, 1024, 1024, (r & 31) * 32, 64 * (r >> 5), WaT + 512, (long)(r & 31) * 32, scr, lane); continue; } r -= I_A;
        transpose_item<false>(A.wo, 1024, 1024, (r & 31) * 32, 64 * (r >> 5), WoT, (long)(r & 31) * 32, scr, lane);
    }
}

__device__ __forceinline__ void p1_finish(unsigned char* HXQ, float* HXS, int r, int lane, const f32x4 (&v)[4], const f32x4 (&gs)[4], const f32x4 (&sh)[4]) {
    float ss = 0.f;
#pragma unroll
    for (int j = 0; j < 4; ++j) ss += (v[j][0] * v[j][0] + v[j][1] * v[j][1]) + (v[j][2] * v[j][2] + v[j][3] * v[j][3]);
    const float rstd = 1.0f / sqrtf(wave_sum(ss) * (1.0f / 1024.0f) + EPS);
    f32x4 o[4]; float amax = 0.f;
#pragma unroll
    for (int j = 0; j < 4; ++j) { o[j] = (v[j] * rstd) * gs[j] + sh[j]; amax = fmaxf(fmaxf(amax, fmaxf(fabsf(o[j][0]), fabsf(o[j][1]))), fmaxf(fabsf(o[j][2]), fabsf(o[j][3]))); }
#pragma unroll
    for (int o_ = 1; o_ < 64; o_ <<= 1) amax = fmaxf(amax, __shfl_xor(amax, o_));
    const float am = amax > 1e-30f ? amax : 1e-30f, inv = 127.0f / am;
    if (lane == 0) HXS[r] = am * (1.0f / 127.0f);
#pragma unroll
    for (int j = 0; j < 4; ++j) { const int cidx = 4 * lane + 256 * j; const f32x4 q = o[j] * inv;
        const int q0 = (int)__builtin_rintf(q[0]), q1 = (int)__builtin_rintf(q[1]), q2 = (int)__builtin_rintf(q[2]), q3 = (int)__builtin_rintf(q[3]);
        *(unsigned*)(HXQ + (size_t)r * 1024 + cidx) = ((unsigned)q0 & 255u) | (((unsigned)q1 & 255u) << 8) | (((unsigned)q2 & 255u) << 16) | ((unsigned)q3 << 24); }
}
__device__ __forceinline__ void p1_rows(const Args& A, int vcu, int G, int tid) {
    const int wave = tid >> 6, lane = tid & 63; const int gw = vcu * NWAVES + wave, NGW = G * NWAVES;
    const float* mod = (const float*)(A.ws + WS_MOD); unsigned char* HXQ = (unsigned char*)(PB_HX(A)); float* HXS = PB_HXS(A);
    auto src_of = [&](int r) -> const float* { const int b = r / RPB, s = r - b * RPB; return s < CTXL ? A.ctx + ((size_t)b * CTXL + s) * 1024 : A.x + ((size_t)b * SEQ + (s - CTXL)) * 1024; };
    auto cls_of = [&](int r) -> int { const int b = r / RPB, s = r - b * RPB; return s < CTXL ? 16 : b; };
    const int RPW = (MR + NGW - 1) / NGW; const int r0 = gw * RPW, r1 = r0 + RPW < MR ? r0 + RPW : MR;
    if (r0 < r1) {
        f32x4 gs[4], sh[4]; int ccur = -1;
        auto consts = [&](int r) { const int c = cls_of(r);
            if (c != ccur) { ccur = c; const float* mrow = mod + (size_t)c * NMOD;
#pragma unroll
                for (int j = 0; j < 4; ++j) { const int cidx = 4 * lane + 256 * j; sh[j] = *(const f32x4*)(mrow + cidx); gs[j] = *(const f32x4*)(A.n1g + cidx) * (*(const f32x4*)(mrow + 1024 + cidx) + 1.0f); }
                asm volatile("" : "+v"(gs[0]), "+v"(gs[1]), "+v"(gs[2]), "+v"(gs[3]), "+v"(sh[0]), "+v"(sh[1]), "+v"(sh[2]), "+v"(sh[3])); } };
        f32x4 n0[4], n1[4];
        { const float* src = src_of(r0);
#pragma unroll
          for (int j = 0; j < 4; ++j) n0[j] = *(const f32x4*)(src + 4 * lane + 256 * j); }
        for (int r = r0; r < r1; r += 2) {
            { const float* src = src_of(r + 1 < r1 ? r + 1 : r1 - 1);
#pragma unroll
              for (int j = 0; j < 4; ++j) n1[j] = *(const f32x4*)(src + 4 * lane + 256 * j); }
            consts(r); p1_finish(HXQ, HXS, r, lane, n0, gs, sh);
            { const float* src = src_of(r + 2 < r1 ? r + 2 : r1 - 1);
#pragma unroll
              for (int j = 0; j < 4; ++j) n0[j] = *(const f32x4*)(src + 4 * lane + 256 * j); }
            if (r + 1 < r1) { consts(r + 1); p1_finish(HXQ, HXS, r + 1, lane, n1, gs, sh); }
        }
    }
}

namespace hg {
constexpr int QS = 0, KD = 17408, KE = 34816, KHT = 52224, VT = 70656, PP = 89088, TT = 98304, EQ = 100352, EG = 102400, DK = 103936, SSQ = 104448, LBS = 106496  , GNS = 107008  , Q0 = 107520  , TT8 = 124928  , END = 129024;
constexpr int RS = 272  , TS = 144  ;
constexpr int CW_HG = 8192;
typedef float f32x4 __attribute__((ext_vector_type(4)));
__device__ __forceinline__ bf16x8 pack8(const f32x4 a, const f32x4 b) { u32x4 w; w.x = pg8::cvt_pk_bf16(a[0], a[1]); w.y = pg8::cvt_pk_bf16(a[2], a[3]); w.z = pg8::cvt_pk_bf16(b[0], b[1]); w.w = pg8::cvt_pk_bf16(b[2], b[3]); return __builtin_bit_cast(bf16x8, w); }
__device__ __forceinline__ void unpack8(const u32x4 w, f32x4& a, f32x4& b) { a = (f32x4){pg8::bf_lo(w.x), pg8::bf_hi(w.x), pg8::bf_lo(w.y), pg8::bf_hi(w.y)}; b = (f32x4){pg8::bf_lo(w.z), pg8::bf_hi(w.z), pg8::bf_lo(w.w), pg8::bf_hi(w.w)}; }

constexpr unsigned long long OR_SENTINEL = 0x7fff7fff7fff7fffull;
struct Inputs { unsigned f2[8], q2[8]; u32x4 vv[2]; };

template <bool BWD>
__device__ __forceinline__ void load_inputs(const Args& A, int b, int h, int c, int tid, Inputs& I) {
    const bool latent = c >= 4;
    const long rbase = (long)b * RPB + 64 * c, rlbase = (long)b * SEQ + 64 * (c - 4);
    const bf16_t* F = (const bf16_t*)(A.ws + (BWD ? WS_FB : WS_FF)) + (rbase * 512 + h * 128); const bf16_t* HI = (const bf16_t*)(A.ws + WS_HI) + (rbase * 512 + h * 128);
    const bf16_t* HQ = (const bf16_t*)(A.ws + WS_HQ) + ((latent ? rlbase : 0) * 512 + h * 128);
    const int w8 = __builtin_amdgcn_readfirstlane(tid >> 6); const unsigned voff = (unsigned)(4 * (tid & 63));
#pragma unroll
    for (int e = 0; e < 8; ++e) { const int rho = BWD ? 63 - (8 * w8 + e) : 8 * w8 + e;
        I.f2[e] = *(const unsigned*)((const char*)(F + rho * 512) + voff); I.q2[e] = *(const unsigned*)((const char*)(HQ + rho * 512) + voff); }
    const int sig = tid & 63; const unsigned voffv = (unsigned)((BWD ? 63 - sig : sig) * 1024 + (tid >> 6) * 16);
#pragma unroll
    for (int it = 0; it < 2; ++it) I.vv[it] = *(const u32x4*)((const char*)(HI + 64 * it) + voffv);
}

struct Prep { float kd[2][8], qs[2][8]; float PT[2]; u32x4 vv[2]; };
struct Mid { float kdl[2][8], qsl[2][8]; float T8[2]; u32x4 vv[2]; };
__device__ __forceinline__ void s1_math(LAS unsigned char* lds, Inputs& N, int tid, Mid& M) {
#pragma unroll
    for (int e = 0; e < 8; ++e) asm volatile("" : "+v"(N.f2[e]), "+v"(N.q2[e]));
    asm volatile("" : "+v"(N.vv[0]), "+v"(N.vv[1]));
    const int kp = tid & 63, w8 = tid >> 6;
    const pg8::f32x2_c lb2 = *(const LAS pg8::f32x2_c*)(lds + LBS + 8 * kp);
#pragma unroll
    for (int c = 0; c < 2; ++c) { const float lbv = lb2[c], oml = 1.0f - lbv; float pc = 1.0f;
#pragma unroll
        for (int e = 0; e < 8; ++e) { const float fp = c ? pg8::bf_hi(N.f2[e]) : pg8::bf_lo(N.f2[e]), q = c ? pg8::bf_hi(N.q2[e]) : pg8::bf_lo(N.q2[e]);
            const float f = lbv + oml * pg8::fsigmoid(fp);
            pc *= f; M.kdl[c][e] = (1.0f - f) * __builtin_amdgcn_rcpf(pc); M.qsl[c][e] = q * pc; }
        M.T8[c] = pc; }
    *(LAS pg8::f32x2_c*)(lds + TT8 + (w8 * 128 + 2 * kp) * 4) = (pg8::f32x2_c){M.T8[0], M.T8[1]};
    M.vv[0] = N.vv[0]; M.vv[1] = N.vv[1];
}
__device__ __forceinline__ void s1_store(LAS unsigned char* lds, const Mid& M, bool latent, int tid, Prep& P) {
    const int kp = tid & 63, w8 = __builtin_amdgcn_readfirstlane(tid >> 6);
    const pg8::f32x2_c o2 = *(const LAS pg8::f32x2_c*)(lds + TT8 + ((w8 ^ 1) * 128 + 2 * kp) * 4);
#pragma unroll
    for (int c = 0; c < 2; ++c) { P.PT[c] = M.T8[c] * o2[c];
        if (w8 & 1) { const float pre = o2[c], ipre = __builtin_amdgcn_rcpf(pre);
#pragma unroll
            for (int e = 0; e < 8; ++e) { P.kd[c][e] = M.kdl[c][e] * ipre; P.qs[c][e] = M.qsl[c][e] * pre; } }
        else {
#pragma unroll
            for (int e = 0; e < 8; ++e) { P.kd[c][e] = M.kdl[c][e]; P.qs[c][e] = M.qsl[c][e]; } } }
    P.vv[0] = M.vv[0]; P.vv[1] = M.vv[1];
    if (latent) {
#pragma unroll
        for (int e = 0; e < 8; ++e) { const int tau = 8 * w8 + e;
            *(LAS unsigned*)(lds + QS + tau * RS + 4 * kp) = pg8::cvt_pk_bf16(P.qs[0][e], P.qs[1][e]);
            *(LAS unsigned*)(lds + KD + tau * RS + 4 * kp) = pg8::cvt_pk_bf16(P.kd[0][e], P.kd[1][e]);
            *(LAS unsigned*)(lds + KE + tau * RS + 4 * kp) = pg8::cvt_pk_bf16(P.kd[0][e] * P.PT[0], P.kd[1][e] * P.PT[1]); }
    }
    if (!(w8 & 1)) *(LAS pg8::f32x2_c*)(lds + TT + ((w8 >> 1) * 128 + 2 * kp) * 4) = (pg8::f32x2_c){P.PT[0], P.PT[1]};
}
template <bool BWD, bool SECOND>
__device__ __forceinline__ void chunk_step(const Args& A, LAS unsigned char* lds, int b, int h, int c, f32x4 (&S)[8], Prep& P, Inputs& N, bool next_latent, int cpref, int tid_in) {
    int tid = tid_in; asm volatile("" : "+v"(tid));
    const int wave = __builtin_amdgcn_readfirstlane(tid >> 6), lane = tid & 63, l15 = lane & 15, g = lane >> 4;
    const bool latent = SECOND || c >= 4; constexpr bool second = SECOND;
    const long rlbase = (long)b * SEQ + 64 * (c - 4);
    const int k = tid & 127, part = tid >> 7;
    __syncthreads();
    {
        const int kp = tid & 63, w8 = wave, sb = w8 >> 1;
        const pg8::f32x2_c T0 = *(const LAS pg8::f32x2_c*)(lds + TT + (0 * 128 + 2 * kp) * 4), T1 = *(const LAS pg8::f32x2_c*)(lds + TT + (1 * 128 + 2 * kp) * 4),
                           T2 = *(const LAS pg8::f32x2_c*)(lds + TT + (2 * 128 + 2 * kp) * 4), T3 = *(const LAS pg8::f32x2_c*)(lds + TT + (3 * 128 + 2 * kp) * 4);
#pragma unroll
        for (int c = 0; c < 2; ++c) {
            const float khs = P.PT[c] * (sb == 0 ? T1[c] * T2[c] * T3[c] : sb == 1 ? T2[c] * T3[c] : sb == 2 ? T3[c] : 1.0f);
            u32x4 w0;
            w0.x = pg8::cvt_pk_bf16(P.kd[c][0] * khs, P.kd[c][1] * khs); w0.y = pg8::cvt_pk_bf16(P.kd[c][2] * khs, P.kd[c][3] * khs); w0.z = pg8::cvt_pk_bf16(P.kd[c][4] * khs, P.kd[c][5] * khs); w0.w = pg8::cvt_pk_bf16(P.kd[c][6] * khs, P.kd[c][7] * khs);
            *(LAS u32x4*)(lds + KHT + (2 * kp + c) * TS + 16 * w8) = w0; }
        if (latent) {
            const float eq0 = sb == 0 ? 1.0f : sb == 1 ? T0[0] : sb == 2 ? T0[0] * T1[0] : T0[0] * T1[0] * T2[0], eq1 = sb == 0 ? 1.0f : sb == 1 ? T0[1] : sb == 2 ? T0[1] * T1[1] : T0[1] * T1[1] * T2[1];
#pragma unroll
            for (int e = 0; e < 8; ++e) *(LAS unsigned*)(lds + Q0 + (8 * w8 + e) * RS + 4 * kp) = pg8::cvt_pk_bf16(P.qs[0][e] * eq0, P.qs[1][e] * eq1);
        }
        if (w8 == 0) *(LAS pg8::f32x2_c*)(lds + DK + 8 * kp) = (pg8::f32x2_c){(T0[0] * T1[0]) * (T2[0] * T3[0]), (T0[1] * T1[1]) * (T2[1] * T3[1])};
#pragma unroll
        for (int it = 0; it < 2; ++it) { const int idx = tid + 512 * it, sig = idx & 63, dv0 = (idx >> 6) * 8; const u32x4 w = P.vv[it];
            LAS unsigned short* vt = (LAS unsigned short*)(lds + VT + dv0 * TS + 2 * sig);
            vt[0 * (TS / 2)] = (unsigned short)(w.x & 0xffff); vt[1 * (TS / 2)] = (unsigned short)(w.x >> 16); vt[2 * (TS / 2)] = (unsigned short)(w.y & 0xffff); vt[3 * (TS / 2)] = (unsigned short)(w.y >> 16);
            vt[4 * (TS / 2)] = (unsigned short)(w.z & 0xffff); vt[5 * (TS / 2)] = (unsigned short)(w.z >> 16); vt[6 * (TS / 2)] = (unsigned short)(w.w & 0xffff); vt[7 * (TS / 2)] = (unsigned short)(w.w >> 16); }
    }
    Mid Q;
    s1_math(lds, N, tid, Q);
    load_inputs<BWD>(A, b, h, cpref, tid, N);
    if (latent) {
        for (int pi = wave; pi < 10; pi += 8) {
            const int bi = pi < 4 ? pi : pi < 7 ? pi - 3 : pi < 9 ? pi - 5 : 3;
            const int bjx = pi < 4 ? pi : pi < 7 ? pi - 4 : pi < 9 ? pi - 7 : 0;
            f32x4 cacc = (f32x4){0.f, 0.f, 0.f, 0.f};
            const int egsel = (bi == 2 && bjx == 0) ? 0 : (bi == 3 && bjx == 1) ? 1 : (bi == 3 && bjx == 0) ? 2 : -1;
            u32x4 aw[4], bw[4];
#pragma unroll
            for (int s = 0; s < 4; ++s) { aw[s] = *(const LAS u32x4*)(lds + QS + (16 * bi + l15) * RS + (32 * s + 8 * g) * 2);
                bw[s] = *(const LAS u32x4*)(lds + (bi == bjx ? KD : KE) + (16 * bjx + l15) * RS + (32 * s + 8 * g) * 2); }
            if (egsel >= 0) {
                const int t1 = egsel == 1 ? 2 : 1;
                f32x4 e0[4], e1[4];
#pragma unroll
                for (int s = 0; s < 4; ++s) { e0[s] = *(const LAS f32x4*)(lds + TT + (t1 * 128 + 32 * s + 8 * g) * 4); e1[s] = *(const LAS f32x4*)(lds + TT + (t1 * 128 + 32 * s + 8 * g + 4) * 4); }
                if (egsel == 2) {
#pragma unroll
                    for (int s = 0; s < 4; ++s) { e0[s] = e0[s] * *(const LAS f32x4*)(lds + TT + (2 * 128 + 32 * s + 8 * g) * 4); e1[s] = e1[s] * *(const LAS f32x4*)(lds + TT + (2 * 128 + 32 * s + 8 * g + 4) * 4); }
                }
#pragma unroll
                for (int s = 0; s < 4; ++s) { f32x4 a0, a1; unpack8(aw[s], a0, a1); aw[s] = __builtin_bit_cast(u32x4, pack8(a0 * e0[s], a1 * e1[s])); }
            }
#pragma unroll
            for (int s = 0; s < 4; ++s) cacc = __builtin_amdgcn_mfma_f32_16x16x32_bf16(__builtin_bit_cast(bf16x8, aw[s]), __builtin_bit_cast(bf16x8, bw[s]), cacc, 0, 0, 0);
#pragma unroll
            for (int r = 0; r < 4; ++r) { const int tl = 4 * g + r; float v = cacc[r]; if (bi == bjx && l15 > tl) v = 0.f;
                *(LAS unsigned short*)(lds + PP + (16 * bi + tl) * TS + 2 * (16 * bjx + l15)) = (unsigned short)pg8::cvt_pk_bf16(v, 0.f); }
        }
    }
    __syncthreads();
    bf16_t* ORb = (bf16_t*)(PB_OR(A)) + (rlbase * 512 + h * 128 + 16 * wave);
    unsigned long long pw[4]; u32x2 sgw[4];
    if (latent && second) {
        const bf16_t* SG = (const bf16_t*)(A.ws + WS_SG) + (rlbase * 512 + h * 128 + 16 * wave);
#pragma unroll
        for (int m = 0; m < 4; ++m) { const int tau = 16 * m + l15, rho = BWD ? 63 - tau : tau;
            pw[m] = __hip_atomic_load((unsigned long long*)(ORb + (unsigned)(rho * 512 + 4 * g)), RLX_AGENT); sgw[m] = *(const u32x2*)(SG + (unsigned)(rho * 512 + 4 * g)); }
    }
    bf16x8 vf[2];
#pragma unroll
    for (int s = 0; s < 2; ++s) vf[s] = *(const LAS bf16x8*)(lds + VT + (16 * wave + l15) * TS + (32 * s + 8 * g) * 2);
    f32x4 oT[4];
#pragma unroll
    for (int m = 0; m < 4; ++m) oT[m] = (f32x4){0.f, 0.f, 0.f, 0.f};
#define HG_RD_BQ(s) do { _Pragma("unroll") for (int m = 0; m < 4; ++m) { \
            const u32x2 q0w = *(const LAS u32x2*)(lds + Q0 + (16 * m + l15) * RS + (32 * (s) + 4 * g) * 2), q1w = *(const LAS u32x2*)(lds + Q0 + (16 * m + l15) * RS + (32 * (s) + 16 + 4 * g) * 2); \
            bq[(s) & 1][m].x = q0w.x; bq[(s) & 1][m].y = q0w.y; bq[(s) & 1][m].z = q1w.x; bq[(s) & 1][m].w = q1w.y; } } while (0)
#define HG_MM_BQ(s) do { const bf16x8 sf = pack8(S[2 * (s)], S[2 * (s) + 1]); _Pragma("unroll") for (int m = 0; m < 4; ++m) oT[m] = __builtin_amdgcn_mfma_f32_16x16x32_bf16(sf, __builtin_bit_cast(bf16x8, bq[(s) & 1][m]), oT[m], 0, 0, 0); } while (0)
#define HG_RD_KF(t) do { dk4[(t) & 3] = *(const LAS f32x4*)(lds + DK + (16 * (t) + 4 * g) * 4); _Pragma("unroll") for (int s_ = 0; s_ < 2; ++s_) kf[(t) & 3][s_] = *(const LAS bf16x8*)(lds + KHT + (16 * (t) + l15) * TS + (32 * s_ + 8 * g) * 2); } while (0)
#define HG_MM_KF(t) do { S[t] = S[t] * dk4[(t) & 3]; _Pragma("unroll") for (int s_ = 0; s_ < 2; ++s_) S[t] = __builtin_amdgcn_mfma_f32_16x16x32_bf16(kf[(t) & 3][s_], vf[s_], S[t], 0, 0, 0); } while (0)
    {
        f32x4 dk4[4]; bf16x8 kf[4][2];
        if (latent) {
            bf16x8 pf[4][2]; u32x4 bq[2][4];
#pragma unroll
            for (int m = 0; m < 4; ++m)
#pragma unroll
                for (int s = 0; s < 2; ++s) pf[m][s] = *(const LAS bf16x8*)(lds + PP + (16 * m + l15) * TS + (32 * s + 8 * g) * 2);
            HG_RD_BQ(0); HG_RD_BQ(1);
            __builtin_amdgcn_sched_barrier(0);
#pragma unroll
            for (int m = 0; m < 4; ++m)
#pragma unroll
                for (int s = 0; s < 2; ++s) oT[m] = __builtin_amdgcn_mfma_f32_16x16x32_bf16(vf[s], pf[m][s], oT[m], 0, 0, 0);
            HG_MM_BQ(0);
            __builtin_amdgcn_sched_barrier(0);
            HG_RD_BQ(2); HG_MM_BQ(1);
            __builtin_amdgcn_sched_barrier(0);
            HG_RD_BQ(3); HG_MM_BQ(2);
            __builtin_amdgcn_sched_barrier(0);
            HG_RD_KF(0); HG_RD_KF(1); HG_MM_BQ(3);
            __builtin_amdgcn_sched_barrier(0);
        } else { HG_RD_KF(0); HG_RD_KF(1); __builtin_amdgcn_sched_barrier(0); }
        HG_RD_KF(2); HG_RD_KF(3); HG_MM_KF(0); HG_MM_KF(1);
        __builtin_amdgcn_sched_barrier(0);
        HG_RD_KF(4); HG_RD_KF(5); HG_MM_KF(2); HG_MM_KF(3);
        __builtin_amdgcn_sched_barrier(0);
        HG_RD_KF(6); HG_RD_KF(7); HG_MM_KF(4); HG_MM_KF(5);
        __builtin_amdgcn_sched_barrier(0);
        HG_MM_KF(6); HG_MM_KF(7);
    }
#undef HG_RD_BQ
#undef HG_MM_BQ
#undef HG_RD_KF
#undef HG_MM_KF
    if (second) asm volatile("" : "+v"(pw[0]), "+v"(pw[1]), "+v"(pw[2]), "+v"(pw[3]), "+v"(S[7]), "+v"(oT[3]));
    if (latent) {
        if (!second) {
#pragma unroll
            for (int m = 0; m < 4; ++m) { const int tau = 16 * m + l15, rho = BWD ? 63 - tau : tau;
                const unsigned long long w = (unsigned long long)pg8::cvt_pk_bf16(oT[m][0], oT[m][1]) | ((unsigned long long)pg8::cvt_pk_bf16(oT[m][2], oT[m][3]) << 32);
                __hip_atomic_store((unsigned long long*)(ORb + (unsigned)(rho * 512 + 4 * g)), w, RLX_AGENT); }
        } else {
#pragma unroll
            for (int m = 0; m < 4; ++m) { const int tau = 16 * m + l15, rho_ = BWD ? 63 - tau : tau;
                for (unsigned sp = 0; pw[m] == OR_SENTINEL && sp < (1u << 20); ++sp) { __builtin_amdgcn_s_sleep(1); pw[m] = __hip_atomic_load((unsigned long long*)(ORb + (unsigned)(rho_ * 512 + 4 * g)), RLX_AGENT); }
                const unsigned lo = (unsigned)pw[m], hi = (unsigned)(pw[m] >> 32);
                oT[m] += (f32x4){pg8::bf_lo(lo), pg8::bf_hi(lo), pg8::bf_lo(hi), pg8::bf_hi(hi)};
                float ss = (oT[m][0] * oT[m][0] + oT[m][1] * oT[m][1]) + (oT[m][2] * oT[m][2] + oT[m][3] * oT[m][3]);
                ss += __shfl_xor(ss, 16); ss += __shfl_xor(ss, 32);
                if (g == 0) *(LAS float*)(lds + SSQ + (wave * 64 + tau) * 4) = ss; }
        }
    }
    if (latent && second) {
        __syncthreads();
        bf16_t* A1 = (bf16_t*)(PB_A1(A)) + (rlbase * 1024 + h * 128 + 16 * wave);
        const f32x4 gn = *(const LAS f32x4*)(lds + GNS + (16 * wave + 4 * g) * 4);
#pragma unroll
        for (int m = 0; m < 4; ++m) { const int tau = 16 * m + l15, rho = BWD ? 63 - tau : tau; float tot = 0.f;
#pragma unroll
            for (int w = 0; w < 8; ++w) tot += *(LAS float*)(lds + SSQ + (w * 64 + tau) * 4);
            const float rstd = 1.0f / sqrtf(tot * (1.0f / 128.0f) + EPS);
            const f32x4 sg4 = (f32x4){pg8::bf_lo(sgw[m].x), pg8::bf_hi(sgw[m].x), pg8::bf_lo(sgw[m].y), pg8::bf_hi(sgw[m].y)};
            const f32x4 o = oT[m] * rstd * gn * sg4;
            u32x2 ow; ow.x = pg8::cvt_pk_bf16(o[0], o[1]); ow.y = pg8::cvt_pk_bf16(o[2], o[3]); *(u32x2*)(A1 + (unsigned)(rho * 1024 + 4 * g)) = ow; }
    }
    s1_store(lds, Q, next_latent, tid, P);
}
template <bool BWD>
__device__ __forceinline__ void run_dir(const Args& A, LAS unsigned char* lds, int pair, int tid) {
    const int b = pair >> 2, h = pair & 3;
    if (tid < 128) { *(LAS float*)(lds + LBS + 4 * tid) = ((const float*)(A.ws + WS_LB))[(BWD ? 512 : 0) + h * 128 + tid]; *(LAS float*)(lds + GNS + 4 * tid) = A.hgn[h * 128 + tid]; }
    __syncthreads();
    f32x4 S[8];
#pragma unroll
    for (int t = 0; t < 8; ++t) S[t] = (f32x4){0.f, 0.f, 0.f, 0.f};
    {
      unsigned long long* orp = (unsigned long long*)((bf16_t*)(PB_OR(A)) + (((long)b * SEQ + (BWD ? 1024 : 0)) * 512 + h * 128));
      for (int i = tid; i < 1024 * 32; i += 512) __hip_atomic_store(orp + (size_t)(i >> 5) * 128 + (i & 31), OR_SENTINEL, RLX_AGENT); }
    auto chunk_of = [](int j) -> int { const int jj = j < 36 ? j : 35; return BWD ? (jj < 4 ? 3 - jj : 39 - jj) : jj; };
    Inputs nxt; Prep P;
    load_inputs<BWD>(A, b, h, chunk_of(0), tid, nxt);
    { Mid M0; s1_math(lds, nxt, tid, M0);
      load_inputs<BWD>(A, b, h, chunk_of(1), tid, nxt);
      __syncthreads();
      s1_store(lds, M0, false, tid, P); }
    for (int j = 0; j < 20; ++j) chunk_step<BWD, false>(A, lds, b, h, chunk_of(j), S, P, nxt, j + 1 >= 4, chunk_of(j + 2), tid);
    for (int j = 20; j < 36; ++j) chunk_step<BWD, true>(A, lds, b, h, chunk_of(j), S, P, nxt, true, chunk_of(j + 2), tid);
}
__device__ __forceinline__ void hgrn_item(const Args& A, LAS unsigned char* lds, int item, int tid) {
    for (int i = tid; i < (hg::TT - hg::PP) / 4; i += 512) *(LAS unsigned*)(lds + hg::PP + 4 * i) = 0u;
    __syncthreads();
    if (item & 1) run_dir<true>(A, lds, item >> 1, tid); else run_dir<false>(A, lds, item >> 1, tid);
}
}
namespace p5 {
constexpr int RSB = 2064  , WPTH = 0, WPTL = 16 * RSB  , GM = 2 * 16 * RSB  , SH = GM + 4096, BP = SH + 4096  , BIAS = BP + 2048, END = BIAS + 64;
__device__ __forceinline__ void rows128(const Args& A, LAS unsigned char* lds, int rb, int tid) {
    const int wave = __builtin_amdgcn_readfirstlane(tid >> 6), lane = tid & 63, l15 = lane & 15, g = lane >> 4;
    const int b = rb >> 4; const long row0 = (long)rb * 128 + wave * 16;
    const float* mod = (const float*)(A.ws + WS_MOD) + (size_t)b * NMOD;
    const bf16_t* x1 = (const bf16_t*)(A.ws + WS_X1B);
    { const int k = 2 * tid; const pg8::f32x2_c n2 = *(const pg8::f32x2_c*)(A.n2g + k), sc2 = *(const pg8::f32x2_c*)(mod + 4096 + k), sh2 = *(const pg8::f32x2_c*)(mod + 3072 + k);
      const float gm0 = n2[0] * (1.0f + sc2[0]), gm1 = n2[1] * (1.0f + sc2[1]);
      *(LAS pg8::f32x2_c*)(lds + GM + 4 * k) = (pg8::f32x2_c){gm0, gm1}; *(LAS pg8::f32x2_c*)(lds + SH + 4 * k) = sh2;
#pragma unroll
      for (int q = 0; q < 4; ++q) { const f32x4 w0 = *(const f32x4*)(A.wr + (size_t)k * 16 + 4 * q), w1 = *(const f32x4*)(A.wr + (size_t)(k + 1) * 16 + 4 * q);
#pragma unroll
          for (int j = 0; j < 4; ++j) { const float v0 = gm0 * w0[j], v1 = gm1 * w1[j]; const unsigned hi = pg8::cvt_pk_bf16(v0, v1);
              const unsigned lo = pg8::cvt_pk_bf16(v0 - pg8::bf_lo(hi), v1 - pg8::bf_hi(hi));
              *(LAS unsigned*)(lds + WPTH + (4 * q + j) * RSB + 2 * k) = hi; *(LAS unsigned*)(lds + WPTL + (4 * q + j) * RSB + 2 * k) = lo; } } }
    { const int e = tid & 15, kp = tid >> 4; float s = 0.f;
#pragma unroll
      for (int h = 0; h < 2; ++h) { float sv[16], wv[16];
#pragma unroll
          for (int i = 0; i < 16; ++i) { sv[i] = mod[3072 + kp * 32 + 16 * h + i]; wv[i] = A.wr[(size_t)(kp * 32 + 16 * h + i) * 16 + e]; }
#pragma unroll
          for (int i = 0; i < 16; ++i) s += sv[i] * wv[i]; }
      *(LAS float*)(lds + BP + (kp * 16 + e) * 4) = s; }
    __syncthreads();
    if (tid < 16) { float s = 0.f; for (int kp = 0; kp < 32; ++kp) s += *(LAS float*)(lds + BP + (kp * 16 + tid) * 4); *(LAS float*)(lds + BIAS + 4 * tid) = s; }
    __syncthreads();
    f32x4 acc = (f32x4){0.f, 0.f, 0.f, 0.f}; float ss = 0.f;
    { const bf16_t* xr = x1 + (row0 + l15) * 1024 + 8 * g;
      u32x4 xw[8];
#pragma unroll
      for (int it = 0; it < 8; ++it) xw[it] = *(const u32x4*)(xr + 32 * it);
#pragma unroll
      for (int it = 0; it < 32; ++it) {
        const bf16x8 bh = *(const LAS bf16x8*)(lds + WPTH + l15 * RSB + (32 * it + 8 * g) * 2), bl = *(const LAS bf16x8*)(lds + WPTL + l15 * RSB + (32 * it + 8 * g) * 2);
        const u32x4 w = xw[it & 7];
        if (it + 8 < 32) xw[it & 7] = *(const u32x4*)(xr + 32 * (it + 8));
        const bf16x8 a = __builtin_bit_cast(bf16x8, w);
        acc = __builtin_amdgcn_mfma_f32_16x16x32_bf16(a, bh, acc, 0, 0, 0); acc = __builtin_amdgcn_mfma_f32_16x16x32_bf16(a, bl, acc, 0, 0, 0);
        const float x0 = pg8::bf_lo(w.x), x1f = pg8::bf_hi(w.x), x2 = pg8::bf_lo(w.y), x3 = pg8::bf_hi(w.y), x4 = pg8::bf_lo(w.z), x5 = pg8::bf_hi(w.z), x6 = pg8::bf_lo(w.w), x7 = pg8::bf_hi(w.w);
        ss += ((x0 * x0 + x1f * x1f) + (x2 * x2 + x3 * x3)) + ((x4 * x4 + x5 * x5) + (x6 * x6 + x7 * x7));
        if ((it & 3) == 3) __builtin_amdgcn_sched_barrier(0);
      } }
    ss += __shfl_xor(ss, 16); ss += __shfl_xor(ss, 32);
    const float rstd = 1.0f / sqrtf(ss * (1.0f / 1024.0f) + EPS);
    const float bias = *(LAS float*)(lds + BIAS + 4 * l15);
    f32x4 aff;
#pragma unroll
    for (int r = 0; r < 4; ++r) { const float rs = __shfl(rstd, 4 * g + r); float lg = acc[r] * rs + bias;
        float mx = lg; mx = fmaxf(mx, __shfl_xor(mx, 1)); mx = fmaxf(mx, __shfl_xor(mx, 2)); mx = fmaxf(mx, __shfl_xor(mx, 4)); mx = fmaxf(mx, __shfl_xor(mx, 8));
        const float ex = expf(lg - mx); float sm = ex; sm += __shfl_xor(sm, 1); sm += __shfl_xor(sm, 2); sm += __shfl_xor(sm, 4); sm += __shfl_xor(sm, 8);
        aff[r] = ex / sm; }
    { float* AFF = (float*)(A.ws + WS_AFF); const int t = (rb & 15) * 128 + wave * 16 + 4 * g;
        *(f32x4*)(AFF + ((size_t)(b * 16 + l15)) * 2048 + t) = aff; }
    unsigned char* H2Q = A.ws + WS_H2; float* HS = (float*)(A.ws + WS_HS);
    for (int i0 = 0; i0 < 16; i0 += 4) {
        f32x4 v[4][4];
#pragma unroll
        for (int ii = 0; ii < 4; ++ii)
#pragma unroll
            for (int j = 0; j < 4; ++j) { const u32x2 w = *(const u32x2*)(x1 + (row0 + i0 + ii) * 1024 + 4 * lane + 256 * j); v[ii][j] = (f32x4){pg8::bf_lo(w.x), pg8::bf_hi(w.x), pg8::bf_lo(w.y), pg8::bf_hi(w.y)}; }
#pragma unroll
        for (int ii = 0; ii < 4; ++ii) { const float rs = __shfl(rstd, i0 + ii); float amax = 0.f;
#pragma unroll
            for (int j = 0; j < 4; ++j) { const int cidx = 4 * lane + 256 * j;
                const f32x4 gmv = *(const LAS f32x4*)(lds + GM + 4 * cidx), shv = *(const LAS f32x4*)(lds + SH + 4 * cidx);
                const f32x4 o = v[ii][j] * rs * gmv + shv; v[ii][j] = o;
                amax = fmaxf(fmaxf(amax, fmaxf(fabsf(o[0]), fabsf(o[1]))), fmaxf(fabsf(o[2]), fabsf(o[3]))); }
#pragma unroll
            for (int o_ = 1; o_ < 64; o_ <<= 1) amax = fmaxf(amax, __shfl_xor(amax, o_));
            const float am = amax > 1e-30f ? amax : 1e-30f, inv = 127.0f / am;
            if (lane == 0) HS[row0 + i0 + ii] = am * (1.0f / 127.0f);
#pragma unroll
            for (int j = 0; j < 4; ++j) { const f32x4 o = v[ii][j] * inv;
                const int q0 = (int)__builtin_rintf(o[0]), q1 = (int)__builtin_rintf(o[1]), q2 = (int)__builtin_rintf(o[2]), q3 = (int)__builtin_rintf(o[3]);
                *(unsigned*)(H2Q + (size_t)(row0 + i0 + ii) * 1024 + 4 * lane + 256 * j) = ((unsigned)q0 & 255u) | (((unsigned)q1 & 255u) << 8) | (((unsigned)q2 & 255u) << 16) | ((unsigned)q3 << 24); } } }
    __syncthreads();
}
__device__ __forceinline__ void ew_q8(const float* Wcol, unsigned char* WQ, float* TQp, LAS float* scr, int lane) {
    const int n4 = lane & 7, kr = lane >> 3;
    const float* W = Wcol + 4 * n4 + (size_t)kr * 1024;
    f32x4 ta[8], tb[8], tc[8], td[8];
#define EWQ_LD(t, kb) do { const float* w_ = W + (size_t)(64 * ((kb) < 16 ? (kb) : 15)) * 1024; _Pragma("unroll") for (int i = 0; i < 8; ++i) (t)[i] = *(const f32x4*)(w_ + (size_t)(8 * i) * 1024); } while (0)
#define EWQ_MAX(t) do { _Pragma("unroll") for (int i = 0; i < 8; ++i) { am4[0] = fmaxf(am4[0], fabsf((t)[i][0])); am4[1] = fmaxf(am4[1], fabsf((t)[i][1])); am4[2] = fmaxf(am4[2], fabsf((t)[i][2])); am4[3] = fmaxf(am4[3], fabsf((t)[i][3])); } } while (0)
    f32x4 am4 = (f32x4){0.f, 0.f, 0.f, 0.f};
    EWQ_LD(ta, 0); EWQ_LD(tb, 1); EWQ_LD(tc, 2); EWQ_LD(td, 3);
    for (int kb = 0; kb < 12; kb += 4) { EWQ_MAX(ta); EWQ_LD(ta, kb + 4); EWQ_MAX(tb); EWQ_LD(tb, kb + 5); EWQ_MAX(tc); EWQ_LD(tc, kb + 6); EWQ_MAX(td); EWQ_LD(td, kb + 7); }
    EWQ_MAX(ta); EWQ_MAX(tb); EWQ_MAX(tc); EWQ_MAX(td);
#pragma unroll
    for (int j = 0; j < 4; ++j) { float a = am4[j]; a = fmaxf(a, __shfl_xor(a, 8)); a = fmaxf(a, __shfl_xor(a, 16)); a = fmaxf(a, __shfl_xor(a, 32)); am4[j] = a > 1e-30f ? a : 1e-30f; }
    const f32x4 inv4 = (f32x4){127.0f / am4[0], 127.0f / am4[1], 127.0f / am4[2], 127.0f / am4[3]};
    if (lane < 8) *(f32x4*)(TQp + 4 * n4) = am4 * (1.0f / 127.0f);
#define EWQ_FIN(t, kb) do { _Pragma("unroll") for (int i = 0; i < 8; ++i) { const f32x4 q_ = (t)[i] * inv4; LAS float* d_ = scr + (kr + 8 * i) * 33 + 4 * n4; \
            d_[0] = __builtin_rintf(q_[0]); d_[1] = __builtin_rintf(q_[1]); d_[2] = __builtin_rintf(q_[2]); d_[3] = __builtin_rintf(q_[3]); } \
        LDS_WAIT(); asm volatile("" ::: "memory"); \
        { const int c = lane & 7; _Pragma("unroll") for (int j = 0; j < 4; ++j) { const int n = (lane >> 3) + 8 * j; const LAS float* s = scr + (8 * c) * 33 + n; \
            const unsigned w0 = ((unsigned)(int)s[0 * 33] & 255u) | (((unsigned)(int)s[1 * 33] & 255u) << 8) | (((unsigned)(int)s[2 * 33] & 255u) << 16) | ((unsigned)(int)s[3 * 33] << 24); \
            const unsigned w1 = ((unsigned)(int)s[4 * 33] & 255u) | (((unsigned)(int)s[5 * 33] & 255u) << 8) | (((unsigned)(int)s[6 * 33] & 255u) << 16) | ((unsigned)(int)s[7 * 33] << 24); \
            u32x2 o; o.x = w0; o.y = w1; *(u32x2*)(WQ + (size_t)n * 1024 + 64 * (kb) + 8 * c) = o; } } \
        LDS_WAIT(); asm volatile("" ::: "memory"); } while (0)
    EWQ_FIN(ta, 12); EWQ_LD(ta, 0); EWQ_FIN(tb, 13); EWQ_LD(tb, 1); EWQ_FIN(tc, 14); EWQ_LD(tc, 2); EWQ_FIN(td, 15); EWQ_LD(td, 3);
    for (int kb = 0; kb < 8; kb += 4) { EWQ_FIN(ta, kb); EWQ_LD(ta, kb + 4); EWQ_FIN(tb, kb + 1); EWQ_LD(tb, kb + 5); EWQ_FIN(tc, kb + 2); EWQ_LD(tc, kb + 6); EWQ_FIN(td, kb + 3); EWQ_LD(td, kb + 7); }
    EWQ_FIN(ta, 8); EWQ_FIN(tb, 9); EWQ_FIN(tc, 10); EWQ_FIN(td, 11);
#undef EWQ_LD
#undef EWQ_MAX
#undef EWQ_FIN
}
__device__ __forceinline__ void expert_weights(const Args& A, LAS unsigned char* lds, int vcu, int G, int tid) {
    const int wave = tid >> 6, lane = tid & 63; LAS float* scr = (LAS float*)(lds + wave * 8704);
    const int gw = vcu * NWAVES + wave, NGW = G * NWAVES;
    for (int it = gw; it < 16 * 64 + 16 * 32; it += NGW) {
        if (it < 16 * 64) { const int e = it >> 6, gi = it & 63, pn = gi >> 3, half = (gi >> 2) & 1, q = gi & 3;
            ew_q8((half ? A.weu : A.weg) + (size_t)e * 1024 * 1024 + 128 * pn + 32 * q, A.ws + WS_WGU + ((size_t)e * 2048 + gi * 32) * 1024, (float*)(A.ws + WS_TQ) + e * 2048 + gi * 32, scr, lane); }
        else { const int r = it - 16 * 64, e = r >> 5, gi = r & 31;
            ew_q8(A.wed + (size_t)e * 1024 * 1024 + 32 * gi, A.ws + WS_WD + ((size_t)e * 1024 + gi * 32) * 1024, (float*)(A.ws + WS_TD) + e * 1024 + gi * 32, scr, lane); } }
}
}

__device__ __forceinline__ unsigned block_exscan(unsigned v, LAS unsigned* scr, int tid, unsigned* total) {
    const int lane = tid & 63, wave = tid >> 6; unsigned inc = v;
#pragma unroll
    for (int o = 1; o < 64; o <<= 1) { const unsigned t = __shfl_up(inc, o); if (lane >= o) inc += t; }
    if (lane == 63) scr[wave] = inc;
    __syncthreads();
    unsigned base = 0, tot = 0;
#pragma unroll
    for (int w = 0; w < 8; ++w) { const unsigned x = scr[w]; if (w < wave) base += x; tot += x; }
    __syncthreads();
    *total = tot; return base + inc - v;
}
__device__ __forceinline__ void topk_unit(const Args& A, LAS unsigned char* lds, int b, int e, int tid) {
    LAS unsigned* hist = (LAS unsigned*)lds;
    LAS unsigned* ctlw = (LAS unsigned*)(lds + 1024);
    const float* AFF = (const float*)(A.ws + WS_AFF) + (size_t)(b * 16 + e) * 2048;
    const f32x4 v4 = *(const f32x4*)(AFF + 4 * tid);
    unsigned key[4];
#pragma unroll
    for (int i = 0; i < 4; ++i) key[i] = __float_as_uint(v4[i]);
    unsigned prefix = 0, need = 256;
#pragma unroll 1
    for (int pass = 0; pass < 4; ++pass) { const int shift = 24 - 8 * pass;
        if (tid < 256) hist[tid] = 0u;
        __syncthreads();
#pragma unroll
        for (int i = 0; i < 4; ++i) if (pass == 0 || (key[i] >> (shift + 8)) == prefix) (void)__hip_atomic_fetch_add(&hist[(key[i] >> shift) & 255u], 1u, __ATOMIC_RELAXED, __HIP_MEMORY_SCOPE_WORKGROUP);
        __syncthreads();
        if (tid < 64) {
            const unsigned h0 = hist[4 * tid], h1 = hist[4 * tid + 1], h2 = hist[4 * tid + 2], h3 = hist[4 * tid + 3]; const unsigned mine = h0 + h1 + h2 + h3;
            unsigned suf = mine;
#pragma unroll
            for (int o = 1; o < 64; o <<= 1) { const unsigned t = __shfl_down(suf, o); if (tid + o < 64) suf += t; }
            const unsigned above = suf - mine;
            if (above < need && suf >= need) {
                unsigned cum = above; int bin = 4 * tid + 3;
                if (cum + h3 >= need) { } else { cum += h3; bin = 4 * tid + 2; if (cum + h2 >= need) { } else { cum += h2; bin = 4 * tid + 1; if (cum + h1 >= need) { } else { cum += h1; bin = 4 * tid; } } }
                ctlw[8] = (prefix << 8) | (unsigned)bin; ctlw[9] = need - cum; } }
        __syncthreads();
        prefix = ctlw[8]; need = ctlw[9];
        __syncthreads();
    }
    unsigned eqc = 0;
#pragma unroll
    for (int i = 0; i < 4; ++i) eqc += (key[i] == prefix) ? 1u : 0u;
    unsigned tot; unsigned eqbase = block_exscan(eqc, ctlw, tid, &tot);
    unsigned sel = 0; bool take[4];
#pragma unroll
    for (int i = 0; i < 4; ++i) { take[i] = key[i] > prefix; if (key[i] == prefix) { take[i] = eqbase < need; ++eqbase; } sel += take[i] ? 1u : 0u; }
    unsigned slot = block_exscan(sel, ctlw, tid, &tot);
    int* IDX = (int*)(A.ws + WS_IDX) + (b * 16 + e) * 256; float* GATE = (float*)(A.ws + WS_IDX + 256 * 1024) + (b * 16 + e) * 256; int* SLOT = (int*)(A.ws + WS_SLOT);
    float* SCL = (float*)(A.ws + WS_SCL) + (b * 16 + e) * 256; const float* HS = (const float*)(A.ws + WS_HS);
#pragma unroll
    for (int i = 0; i < 4; ++i) { const int t = 4 * tid + i; int sl = -1;
        if (take[i]) { sl = (int)slot; ++slot; IDX[sl] = b * 2048 + t; GATE[sl] = v4[i]; SCL[sl] = HS[b * 2048 + t]; }
        SLOT[(size_t)(b * 2048 + t) * 16 + e] = sl; }
    VM_WAIT();
    __syncthreads();
}

struct P7Row { u32x4 x[2]; u32x2 y[4][2]; int ne; unsigned rest; };
typedef int i32x4_p7 __attribute__((ext_vector_type(4)));
__device__ __forceinline__ int p7_slot_of(const i32x4_p7 sl, int i, int e) {
    const int c = e & 3; const int v = c == 0 ? sl.x : c == 1 ? sl.y : c == 2 ? sl.z : sl.w;
    return __builtin_amdgcn_readlane(v, 4 * i + (e >> 2));
}
__device__ __forceinline__ unsigned p7_mask_of(const unsigned long long (&bc)[4], int i) {
    unsigned m = 0;
#pragma unroll
    for (int c = 0; c < 4; ++c) { const unsigned n = (unsigned)(bc[c] >> (4 * i)) & 15u; m |= ((n & 1u) | ((n & 2u) << 3) | ((n & 4u) << 6) | ((n & 8u) << 9)) << c; }
    return m;
}
__device__ __forceinline__ void p7_issue(const bf16_t* X1B, const unsigned char* YE, int r, const i32x4_p7 sl, const unsigned long long (&bc)[4], int i, int lane, P7Row& R) {
    const int b = r >> 11;
#pragma unroll
    for (int j = 0; j < 2; ++j) R.x[j] = *(const u32x4*)(X1B + (size_t)r * 1024 + j * 512 + 8 * lane);
    unsigned m = p7_mask_of(bc, i); int ne = 0;
#pragma unroll
    for (int q = 0; q < 4; ++q) { const unsigned char* yr = YE;
        if (m) { const int e = __builtin_ctz(m); m &= m - 1; yr = YE + ((size_t)(b * 16 + e) * 256 + p7_slot_of(sl, i, e)) * 1024; ne = q + 1; }
        if (!DBG_TIMING) { R.y[q][0] = *(const u32x2*)(yr + 8 * lane); R.y[q][1] = *(const u32x2*)(yr + 512 + 8 * lane); } }
    R.ne = DBG_TIMING ? 0 : ne; R.rest = DBG_TIMING ? 0u : m;
}
__device__ __forceinline__ void p7_f8acc(const u32x2 w, f32x4& a0, f32x4& a1) {
    const pg8::f32x2_c p0 = __builtin_amdgcn_cvt_pk_f32_fp8((int)w.x, false), p1 = __builtin_amdgcn_cvt_pk_f32_fp8((int)w.x, true), p2 = __builtin_amdgcn_cvt_pk_f32_fp8((int)w.y, false), p3 = __builtin_amdgcn_cvt_pk_f32_fp8((int)w.y, true);
    a0 += (f32x4){p0[0], p0[1], p1[0], p1[1]}; a1 += (f32x4){p2[0], p2[1], p3[0], p3[1]};
}
__device__ __forceinline__ void p7_finish(const Args& A, const unsigned char* YE, int r, const i32x4_p7 sl, int i, int lane, const P7Row& R, const f32x4 (&g2)[4], const f32x4 (&fg)[4], float scale) {
    const int b = r >> 11;
    f32x4 acc[4];
#pragma unroll
    for (int j = 0; j < 4; ++j) acc[j] = (f32x4){0.f, 0.f, 0.f, 0.f};
#pragma unroll
    for (int q = 0; q < 4; ++q) if (q < R.ne) { p7_f8acc(R.y[q][0], acc[0], acc[1]); p7_f8acc(R.y[q][1], acc[2], acc[3]); }
    for (unsigned m = R.rest; m;) { const int e = __builtin_ctz(m); m &= m - 1;
        const unsigned char* yr = YE + ((size_t)(b * 16 + e) * 256 + p7_slot_of(sl, i, e)) * 1024;
        p7_f8acc(*(const u32x2*)(yr + 8 * lane), acc[0], acc[1]); p7_f8acc(*(const u32x2*)(yr + 512 + 8 * lane), acc[2], acc[3]); }
#pragma unroll
    for (int j = 0; j < 4; ++j) acc[j] = acc[j] * (1.0f / pg8::YE_F8_SCALE);
    f32x4 xv[4];
#pragma unroll
    for (int j = 0; j < 2; ++j) { const u32x4 w = R.x[j]; xv[2 * j] = (f32x4){pg8::bf_lo(w.x), pg8::bf_hi(w.x), pg8::bf_lo(w.y), pg8::bf_hi(w.y)}; xv[2 * j + 1] = (f32x4){pg8::bf_lo(w.z), pg8::bf_hi(w.z), pg8::bf_lo(w.w), pg8::bf_hi(w.w)}; }
    float* xo = A.out + (size_t)r * 1024; f32x4 v[4]; float ss = 0.f;
#pragma unroll
    for (int j = 0; j < 4; ++j) { const int cidx = (j >> 1) * 512 + 8 * lane + (j & 1) * 4;
        v[j] = xv[j] + g2[j] * acc[j]; ss += (v[j][0] * v[j][0] + v[j][1] * v[j][1]) + (v[j][2] * v[j][2] + v[j][3] * v[j][3]); }
    const float rstd = 1.0f / sqrtf(wave_sum(ss) * (1.0f / 1024.0f) + EPS);
#pragma unroll
    for (int j = 0; j < 4; ++j) { const int cidx = (j >> 1) * 512 + 8 * lane + (j & 1) * 4; *(f32x4*)(xo + cidx) = v[j] * (rstd * scale) * fg[j]; }
}
__device__ __forceinline__ void p7_rows(const Args& A, int vcu, int G, int tid) {
    const int wave = tid >> 6, lane = tid & 63; const int gw = vcu * NWAVES + wave, NGW = G * NWAVES;
    const float* mod = (const float*)(A.ws + WS_MOD); const int* SLOT = (const int*)(A.ws + WS_SLOT); const unsigned char* YE = A.ws + WS_YE; const bf16_t* X1B = (const bf16_t*)(A.ws + WS_X1B);
#if DBG_TIMING
    const unsigned tsa_ = __hip_atomic_load((unsigned*)(A.ws + WS_CTL) + 100 + DBG_TIME_A0, RLX_AGENT), tsb_ = __hip_atomic_load((unsigned*)(A.ws + WS_CTL) + 100 + DBG_TIME_A1, RLX_AGENT);
    const float DBG_SCALE = 1.0f + (float)((tsb_ - tsa_) / (100u * DBG_TIME_Q));
#else
    const float DBG_SCALE = 1.0f;
#endif
    const int RPW = (((ML + NGW - 1) / NGW) + 15) & ~15;
    const int r0 = gw * RPW, r1 = r0 + RPW < ML ? r0 + RPW : ML;
    f32x4 fg[4], g2[4]; int bcur = -1;
#pragma unroll
    for (int j = 0; j < 4; ++j) { fg[j] = *(const f32x4*)(A.fng + (j >> 1) * 512 + 8 * lane + (j & 1) * 4); g2[j] = fg[j]; }
    asm volatile("" : "+v"(fg[0]), "+v"(fg[1]), "+v"(fg[2]), "+v"(fg[3]));
    for (int rg = r0; rg < r1; rg += 16) {
        const int nr = r1 - rg < 16 ? r1 - rg : 16, b = rg >> 11;
        if (b != bcur) { bcur = b;
#pragma unroll
            for (int j = 0; j < 4; ++j) g2[j] = *(const f32x4*)(mod + (size_t)b * NMOD + 5120 + (j >> 1) * 512 + 8 * lane + (j & 1) * 4);
            asm volatile("" : "+v"(g2[0]), "+v"(g2[1]), "+v"(g2[2]), "+v"(g2[3])); }
        i32x4_p7 sl = *(const i32x4_p7*)(SLOT + (size_t)rg * 16 + 4 * lane);
        asm volatile("" : "+v"(sl));
        unsigned long long bc[4]; bc[0] = __ballot(sl.x >= 0); bc[1] = __ballot(sl.y >= 0); bc[2] = __ballot(sl.z >= 0); bc[3] = __ballot(sl.w >= 0);
        P7Row B0, B1;
        p7_issue(X1B, YE, rg, sl, bc, 0, lane, B0);
        for (int i = 0; i < nr; i += 2) {
            { const int i1 = i + 1 < nr ? i + 1 : nr - 1; p7_issue(X1B, YE, rg + i1, sl, bc, i1, lane, B1); }
            p7_finish(A, YE, rg + i, sl, i, lane, B0, g2, fg, DBG_SCALE);
            { const int i2 = i + 2 < nr ? i + 2 : nr - 1; p7_issue(X1B, YE, rg + i2, sl, bc, i2, lane, B0); }
            if (i + 1 < nr) p7_finish(A, YE, rg + i + 1, sl, i + 1, lane, B1, g2, fg, DBG_SCALE);
        }
    }
}

#ifndef DBG_TIMING
#define DBG_TIMING 0
#endif
typedef const __attribute__((address_space(4))) Args* KArgsPtr;
__global__ void __launch_bounds__(NWAVES * 64, 2) fwd_megakernel(Args A_) {
    KArgsPtr ap = (KArgsPtr)__builtin_amdgcn_kernarg_segment_ptr(); asm volatile("" : "+s"(ap));
#define A (*(const Args*)ap)
    extern __shared__ __attribute__((aligned(16))) unsigned char lds_raw[];
    LAS unsigned char* lds = (LAS unsigned char*)lds_raw;
    volatile LAS unsigned* MISC = (volatile LAS unsigned*)(lds + MISC_OFF);
    int tid = threadIdx.x; const int bx = blockIdx.x, G = gridDim.x;
    const int vcu = (G % 8 == 0) ? (bx % 8) * (G / 8) + bx / 8 : bx;
    unsigned* ctl = (unsigned*)(A.ws + WS_CTL);
    for (int u = tid; u < 64; u += NWAVES * 64) ((LAS unsigned*)(lds + MISC_OFF))[u] = 0u;
    __syncthreads();
    const XcdBarrier xbar = xcd_barrier_post((unsigned*)(ctl + CW_BAR), MISC + 8);
#define GRID_BAR() xcd_barrier(xbar)
#define RELAUNDER() do { int t_ = threadIdx.x; asm volatile("" : "+v"(t_)); tid = t_; KArgsPtr p_ = (KArgsPtr)__builtin_amdgcn_kernarg_segment_ptr(); asm volatile("" : "+s"(p_)); ap = p_; } while (0)
#if DBG_TIMING
#define STAMP(k) do { if (bx == 0) ctl[100 + (k)] = (unsigned)__builtin_amdgcn_s_memrealtime(); } while (0)
#else
#define STAMP(k) do { } while (0)
#endif
    STAMP(0);
    RELAUNDER();
    p0_prologue<0>(A, lds, vcu, G, tid);
    GRID_BAR(); STAMP(1);
    RELAUNDER();
    p1_rows(A, vcu, G, tid);
    RELAUNDER();
    p0_prologue<1>(A, lds, vcu, G, tid);
    GRID_BAR(); STAMP(2);
    RELAUNDER();
    {
        pg8::Gemm g{(const bf16_t*)(PB_HX(A)), (const bf16_t*)(A.ws + WS_WIN), MR, INC, 512  , nullptr}; pg8::InProjOrder S; S.init(G, bx);
        pg8::EpiInProjQ E{{A.ws, WS_HQ, WS_FF, WS_FB, WS_HI, WS_SG, WS_Q, WS_K, WS_V, WS_GA, WS_GB, WS_ROPE, A.qng, A.kng}, (const float*)PB_HXS(A), (const float*)(A.ws + WS_WINS)};
        pg8::gemm_phase<pg8::EpiInProjQ, pg8::InProjOrder, true, true, true, false, true>(lds, g, S, E);
    }
    GRID_BAR(); STAMP(3);
    RELAUNDER();
    {
        if (bx < 128) { for (int it = bx; it < 128; it += G) { RELAUNDER(); hg::hgrn_item(A, lds, it, tid); } }
        else p5::expert_weights(A, lds, bx - 128, G - 128, tid);
        STAMP(20);
        __syncthreads();
        const float att_mfix = __uint_as_float(__builtin_amdgcn_readfirstlane(__hip_atomic_load(ctl + CW_MFIX, RLX_AGENT)));
#define ATT_QUEUE(FIX, MF) for (;;) { \
            if (tid == 0) MISC[0] = atomicAdd(ctl + CW_Q3, 1u); \
            __syncthreads(); \
            const unsigned u = MISC[0]; \
            __syncthreads(); \
            if (u >= 1024u) break; \
            const int bk = u >> 5, b = bk >> 1, kvh = bk & 1, gq = (u >> 3) & 3, qb = u & 7; \
            attn_body::attn_unit<8, FIX>((long)b * SEQ + qb * 256, kvh * 4 + gq, (long)b * RPB, kvh, (const attn_body::bf16*)(A.ws + WS_Q), (const attn_body::bf16*)(A.ws + WS_K), (const attn_body::bf16*)(A.ws + WS_V), \
                                    (attn_body::bf16*)(PB_OATT(A)), (char*)lds_raw, MF); }
        if (att_mfix <= 60.0f) { ATT_QUEUE(true, att_mfix) } else { ATT_QUEUE(false, 0.f) }
#undef ATT_QUEUE
    }
    GRID_BAR(); STAMP(4);
    RELAUNDER();
    {
        pg8::StaticOrder S; S.init(ML, 1024, G, bx);
        pg8::Gemm g{(const bf16_t*)(PB_A1(A)), (const bf16_t*)(A.ws + WS_WA), ML, 1024, 1024, nullptr};
        pg8::EpiZ2 E{(bf16_t*)(A.ws + WS_Z), A.ws + WS_GA, A.ws + WS_GB};
        pg8::gemm_phase<pg8::EpiZ2, pg8::StaticOrder, true, true, false, true>(lds, g, S, E);
    }
    GRID_BAR(); STAMP(5);
    RELAUNDER();
    {
        pg8::StaticOrder S; S.init(ML, 1024, G, bx);
        pg8::Gemm g{(const bf16_t*)(A.ws + WS_Z), (const bf16_t*)(A.ws + WS_WO), ML, 1024, 1024, nullptr}; pg8::EpiX1 E{A.x, (const float*)(A.ws + WS_MOD), (bf16_t*)(A.ws + WS_X1B)};
        pg8::gemm_phase<pg8::EpiX1, pg8::StaticOrder, true, true>(lds, g, S, E);
    }
    GRID_BAR(); STAMP(6);
    RELAUNDER();
    for (int rb = vcu; rb < 256; rb += G) { RELAUNDER(); p5::rows128(A, lds, rb, tid); }
    GRID_BAR(); STAMP(7);
    RELAUNDER();
    for (int uu = vcu; uu < 256; uu += G) { const int e = uu >> 4, b = uu & 15, unit = b * 16 + e;
        RELAUNDER();
        topk_unit(A, lds, b, e, tid);
        bf16_t* HID = (bf16_t*)(PB_HID(A)) + (size_t)unit * 256 * 1024;
        { pg8::Gemm g{(const bf16_t*)(A.ws + WS_H2), (const bf16_t*)(A.ws + WS_WGU) + (size_t)e * 2048 * 512, 256, 2048, 512  , (const int*)(A.ws + WS_IDX) + unit * 256};
          pg8::LocalOrder S{8}; pg8::EpiHidQ E{HID, (const float*)(A.ws + WS_SCL) + unit * 256, (const float*)(A.ws + WS_TQ) + e * 2048};
          pg8::gemm_phase<pg8::EpiHidQ, pg8::LocalOrder, true, true, true, false, false>(lds, g, S, E); }
        VM_WAIT(); __syncthreads();
        { unsigned char* HQ = A.ws + WS_HIDQ + (size_t)unit * 256 * 1024; float* S2 = (float*)(A.ws + WS_SCL2) + unit * 256; const int wv = tid >> 6, ln = tid & 63;
          for (int r0 = wv * 32; r0 < wv * 32 + 32; r0 += 8) {
              u32x4 w[8][2];
#pragma unroll
              for (int ii = 0; ii < 8; ++ii) { w[ii][0] = *(const u32x4*)(HID + (size_t)(r0 + ii) * 1024 + 16 * ln); w[ii][1] = *(const u32x4*)(HID + (size_t)(r0 + ii) * 1024 + 16 * ln + 8); }
#pragma unroll
              for (int ii = 0; ii < 8; ++ii) { f32x4 v[4];
                  v[0] = (f32x4){pg8::bf_lo(w[ii][0].x), pg8::bf_hi(w[ii][0].x), pg8::bf_lo(w[ii][0].y), pg8::bf_hi(w[ii][0].y)}; v[1] = (f32x4){pg8::bf_lo(w[ii][0].z), pg8::bf_hi(w[ii][0].z), pg8::bf_lo(w[ii][0].w), pg8::bf_hi(w[ii][0].w)};
                  v[2] = (f32x4){pg8::bf_lo(w[ii][1].x), pg8::bf_hi(w[ii][1].x), pg8::bf_lo(w[ii][1].y), pg8::bf_hi(w[ii][1].y)}; v[3] = (f32x4){pg8::bf_lo(w[ii][1].z), pg8::bf_hi(w[ii][1].z), pg8::bf_lo(w[ii][1].w), pg8::bf_hi(w[ii][1].w)};
                  float amax = 0.f;
#pragma unroll
                  for (int j = 0; j < 4; ++j) amax = fmaxf(fmaxf(amax, fmaxf(fabsf(v[j][0]), fabsf(v[j][1]))), fmaxf(fabsf(v[j][2]), fabsf(v[j][3])));
#pragma unroll
                  for (int o_ = 1; o_ < 64; o_ <<= 1) amax = fmaxf(amax, __shfl_xor(amax, o_));
                  const float am = amax > 1e-30f ? amax : 1e-30f, inv = 127.0f / am;
                  if (ln == 0) S2[r0 + ii] = am * (1.0f / 127.0f);
                  u32x4 o;
#pragma unroll
                  for (int j = 0; j < 4; ++j) { const f32x4 q = v[j] * inv;
                      const unsigned pk = ((unsigned)(int)__builtin_rintf(q[0]) & 255u) | (((unsigned)(int)__builtin_rintf(q[1]) & 255u) << 8) | (((unsigned)(int)__builtin_rintf(q[2]) & 255u) << 16) | ((unsigned)(int)__builtin_rintf(q[3]) << 24);
                      if (j == 0) o.x = pk; else if (j == 1) o.y = pk; else if (j == 2) o.z = pk; else o.w = pk; }
                  *(u32x4*)(HQ + (size_t)(r0 + ii) * 1024 + 16 * ln) = o; } } }
        VM_WAIT(); __syncthreads();
        { pg8::Gemm g{(const bf16_t*)(A.ws + WS_HIDQ) + (size_t)unit * 256 * 512, (const bf16_t*)(A.ws + WS_WD) + (size_t)e * 1024 * 512, 256, 1024, 512  , nullptr};
          pg8::LocalOrder S{4}; pg8::EpiYeQ E{A.ws + WS_YE + (size_t)unit * 256 * 1024, (const float*)(A.ws + WS_IDX + 256 * 1024) + unit * 256, (const float*)(A.ws + WS_SCL2) + unit * 256, (const float*)(A.ws + WS_TD) + e * 1024};
          pg8::gemm_phase<pg8::EpiYeQ, pg8::LocalOrder, true, true, true, false, false>(lds, g, S, E); }
        __syncthreads();
    }
    GRID_BAR(); STAMP(8);
#if DBG_TIMING
    GRID_BAR();
#endif
    RELAUNDER();
    p7_rows(A, vcu, G, tid);
}
#undef A

extern "C" void kernel_launch(void* const* d_in, const int* in_sizes, int n_in, void* d_out, int out_size, void* d_ws, size_t ws_size, hipStream_t stream) {
    static int grid = 0;
    if (grid == 0) {
        if (n_in != 21 || out_size != ML * 1024 || ws_size < WS_END) { fprintf(stderr, "kernel_launch: unexpected problem (n_in %d, out %d, ws %zu); nothing launched\n", n_in, out_size, ws_size); grid = -1; return; }
        int dev = 0, cus = 0, per_cu = 0;
        if (hipGetDevice(&dev) != hipSuccess || hipDeviceGetAttribute(&cus, hipDeviceAttributeMultiprocessorCount, dev) != hipSuccess) { grid = -1; return; }
        if (hipFuncSetAttribute((const void*)fwd_megakernel, hipFuncAttributeMaxDynamicSharedMemorySize, LDS_BYTES) != hipSuccess) { fprintf(stderr, "kernel_launch: hipFuncSetAttribute failed\n"); grid = -1; return; }
        if (hipOccupancyMaxActiveBlocksPerMultiprocessor(&per_cu, (const void*)fwd_megakernel, NWAVES * 64, LDS_BYTES) != hipSuccess || per_cu < 1) { fprintf(stderr, "kernel_launch: occupancy query says %d\n", per_cu); (void)hipGetLastError(); grid = -1; return; }
        grid = cus;
    }
    if (grid < 0) return;
    (void)hipMemsetAsync((char*)d_ws + WS_CTL, 0, CTL_ZERO_BYTES, stream);
    Args a{};
    const float** ap = (const float**)&a;
    for (int i = 0; i < 21; ++i) ap[i] = (const float*)d_in[i];
    a.out = (float*)d_out; a.ws = (unsigned char*)d_ws;
    hipLaunchKernelGGL(fwd_megakernel, dim3(grid), dim3(NWAVES * 64), LDS_BYTES, stream, a);
    const hipError_t le = hipPeekAtLastError();
    if (le != hipSuccess) fprintf(stderr, "kernel_launch: launch failed: %s (grid %d)\n", hipGetErrorName(le), grid);
}
```
